# Optimizing an MI355X kernel written in HIP

```python
import jax, jax.numpy as jnp
from jax import lax
import numpy as np

D_MODEL = 1024
BATCH = 2
SEQ = 8192
DEPTH = 4

N_MIXERS = 3
N_META = 16
D_FF = 2816
SC_WIDTH = 3
CONF_WIDTH = 31
N_HEADS = 16
HEAD_DIM = D_MODEL // N_HEADS
BLOCK = 128
EPS = 1e-6
MASK_VALUE = -1e30
N_A = (DEPTH + 2) // 3
N_B = (DEPTH + 1) // 3
N_C = DEPTH // 3

kernel_name = "hybrid_shortconv_conformer_fox_macaron"


def rms_norm(x, g):
    xf = x.astype(jnp.float32)
    y = xf * lax.rsqrt(jnp.mean(xf * xf, axis=-1, keepdims=True) + EPS)
    return (y * g.astype(jnp.float32)).astype(x.dtype)


def layer_norm(x, g, b):
    xf = x.astype(jnp.float32)
    mu = jnp.mean(xf, axis=-1, keepdims=True)
    xc = xf - mu
    var = jnp.mean(xc * xc, axis=-1, keepdims=True)
    y = xc * lax.rsqrt(var + EPS) * g.astype(jnp.float32) + b.astype(jnp.float32)
    return y.astype(x.dtype)


def causal_depthwise_conv(x, w):
    k = w.shape[0]
    return lax.conv_general_dilated(
        x, w[:, None, :].astype(x.dtype), window_strides=(1,), padding=[(k - 1, 0)],
        dimension_numbers=("NWC", "WIO", "NWC"), feature_group_count=x.shape[-1])


def swiglu(h, w_gate, w_up, w_down):
    return (jax.nn.silu(h @ w_gate) * (h @ w_up)) @ w_down


def short_conv_mixer(h, w_in, conv_w, w_out):
    b_gate, c_gate, v = jnp.split(h @ w_in, 3, axis=-1)
    y = b_gate * causal_depthwise_conv(c_gate * v, conv_w)
    return y @ w_out


def conformer_conv_mixer(h, w_in, conv_w, conv_b, ln_g, ln_b, w_out):
    a, g = jnp.split(h @ w_in, 2, axis=-1)
    u = a * jax.nn.sigmoid(g)
    u = causal_depthwise_conv(u, conv_w) + conv_b
    u = jax.nn.silu(layer_norm(u, ln_g, ln_b))
    return u @ w_out


def forgetting_attention(h, w_in, b_f, q_g, k_g, w_out):
    bsz, L, _ = h.shape
    proj = h @ w_in
    q = proj[..., :D_MODEL].reshape(bsz, L, N_HEADS, HEAD_DIM)
    k = proj[..., D_MODEL:2 * D_MODEL].reshape(bsz, L, N_HEADS, HEAD_DIM)
    v = proj[..., 2 * D_MODEL:3 * D_MODEL].reshape(bsz, L, N_HEADS, HEAD_DIM)
    f_logit = proj[..., 3 * D_MODEL:] + b_f
    q = rms_norm(q, q_g)
    k = rms_norm(k, k_g)
    log_f = jax.nn.log_sigmoid(f_logit.astype(jnp.float32))
    cum = jnp.cumsum(log_f, axis=1)
    pad = (-L) % BLOCK
    lp = L + pad
    n_blocks = lp // BLOCK
    pad4 = ((0, 0), (pad, 0), (0, 0), (0, 0))
    q = jnp.pad(q, pad4).transpose(0, 2, 1, 3)
    k = jnp.pad(k, pad4).transpose(0, 2, 1, 3)
    v = jnp.pad(v, pad4).transpose(0, 2, 1, 3)
    cum = jnp.pad(cum, ((0, 0), (pad, 0), (0, 0))).transpose(0, 2, 1)
    kpos = jnp.arange(lp)
    scale = HEAD_DIM ** -0.5

    def one_block(i):
        start = i * BLOCK
        qb = lax.dynamic_slice_in_dim(q, start, BLOCK, axis=2)
        cq = lax.dynamic_slice_in_dim(cum, start, BLOCK, axis=2)
        s = jnp.einsum("bhqd,bhkd->bhqk", qb, k, preferred_element_type=jnp.float32) * scale
        s = s + cq[..., :, None] - cum[..., None, :]
        qpos = start + jnp.arange(BLOCK)
        mask = (kpos[None, :] <= qpos[:, None]) & (kpos[None, :] >= pad)
        s = jnp.where(mask, s, MASK_VALUE)
        p = jax.nn.softmax(s, axis=-1).astype(v.dtype)
        return jnp.einsum("bhqk,bhkd->bhqd", p, v)

    o = lax.map(one_block, jnp.arange(n_blocks))
    o = o.transpose(1, 0, 3, 2, 4).reshape(bsz, lp, D_MODEL)[:, pad:]
    return o @ w_out


def setup_inputs(seed: int = 0) -> dict:
    key = jax.random.key(seed)
    ks = jax.random.split(key, 24)
    D, F, H = D_MODEL, D_FF, N_HEADS
    nrm = lambda k, shape, fan: jax.random.normal(k, shape, jnp.float32) * (fan ** -0.5)
    gain = lambda k, shape: 1.0 + 0.05 * jax.random.normal(k, shape, jnp.float32)
    small = lambda k, shape: 0.02 * jax.random.normal(k, shape, jnp.float32)
    return {
        "x": jax.random.normal(ks[0], (BATCH, SEQ, D), jnp.float32),
        "meta": jax.random.normal(ks[1], (N_META, D), jnp.float32),
        "ffn_norm": gain(ks[2], (DEPTH, 2, D)),
        "ffn_w_gate": nrm(ks[3], (DEPTH, 2, D, F), D),
        "ffn_w_up": nrm(ks[4], (DEPTH, 2, D, F), D),
        "ffn_w_down": nrm(ks[5], (DEPTH, 2, F, D), F),
        "mix_norm": gain(ks[6], (DEPTH, D)),
        "a_w_in": nrm(ks[7], (N_A, D, 3 * D), D),
        "a_conv": nrm(ks[8], (N_A, SC_WIDTH, D), SC_WIDTH),
        "a_w_out": nrm(ks[9], (N_A, D, D), D),
        "b_w_in": nrm(ks[10], (N_B, D, 2 * D), D),
        "b_conv": nrm(ks[11], (N_B, CONF_WIDTH, D), CONF_WIDTH),
        "b_conv_bias": small(ks[12], (N_B, D)),
        "b_ln_g": gain(ks[13], (N_B, D)),
        "b_ln_b": small(ks[14], (N_B, D)),
        "b_w_out": nrm(ks[15], (N_B, D, D), D),
        "c_w_in": nrm(ks[16], (N_C, D, 3 * D + H), D),
        "c_b_f": jax.random.uniform(ks[17], (N_C, H), jnp.float32, 1.0, 4.0),
        "c_q_norm": gain(ks[18], (N_C, HEAD_DIM)),
        "c_k_norm": gain(ks[19], (N_C, HEAD_DIM)),
        "c_w_out": nrm(ks[20], (N_C, D, D), D),
    }


def reference(x, meta, ffn_norm, ffn_w_gate, ffn_w_up, ffn_w_down, mix_norm,
              a_w_in, a_conv, a_w_out,
              b_w_in, b_conv, b_conv_bias, b_ln_g, b_ln_b, b_w_out,
              c_w_in, c_b_f, c_q_norm, c_k_norm, c_w_out):
    bsz = x.shape[0]
    meta_b = jnp.broadcast_to(meta[None].astype(x.dtype), (bsz, N_META, D_MODEL))
    h = jnp.concatenate([meta_b, x], axis=1)
    for i in range(DEPTH):
        m, j = i % N_MIXERS, i // N_MIXERS
        h = h + 0.5 * swiglu(rms_norm(h, ffn_norm[i, 0]), ffn_w_gate[i, 0], ffn_w_up[i, 0], ffn_w_down[i, 0])
        u = rms_norm(h, mix_norm[i])
        if m == 0:
            mix = short_conv_mixer(u, a_w_in[j], a_conv[j], a_w_out[j])
        elif m == 1:
            mix = conformer_conv_mixer(u, b_w_in[j], b_conv[j], b_conv_bias[j], b_ln_g[j], b_ln_b[j], b_w_out[j])
        else:
            mix = forgetting_attention(u, c_w_in[j], c_b_f[j], c_q_norm[j], c_k_norm[j], c_w_out[j])
        h = h + mix
        h = h + 0.5 * swiglu(rms_norm(h, ffn_norm[i, 1]), ffn_w_gate[i, 1], ffn_w_up[i, 1], ffn_w_down[i, 1])
    return h[:, N_META:]
```

```cpp
#include <hip/hip_runtime.h>
#include <hip/hip_cooperative_groups.h>
#include <cstdio>
#include <cstdint>
namespace pg8 {
#define PG8_LAS __attribute__((address_space(3)))
typedef unsigned short bf16_t;
typedef short bf16x8 __attribute__((ext_vector_type(8)));
typedef float f32x4 __attribute__((ext_vector_type(4)));
typedef unsigned u32x4 __attribute__((ext_vector_type(4)));
constexpr int BM = 256, BK = 64, HALF = 128, HTB = HALF * BK * 2  , STAGE_BYTES = 8 * HTB, NXCD = 8, WGM = 8;

__host__ __device__ __forceinline__ int lds_byte(int r, int c) { const int st = (r >> 4) * 2 + (c >> 5), rr = r & 15, cc = c & 31, ob = rr * 64 + cc * 2; return st * 1024 + (ob ^ (((ob >> 9) & 1) << 5)); }
__host__ __device__ __forceinline__ void stage_rc(int b, int& R, int& C) { const int st = b / 1024, sb = b % 1024, swz = sb ^ (((sb >> 9) & 1) << 5); R = (st >> 1) * 16 + swz / 64; C = (st & 1) * 32 + (swz % 64) / 2; }
__host__ __device__ __forceinline__ int perm32(int rho) { const int n = rho >> 4, i = rho & 15; return 8 * (i >> 2) + 4 * n + (i & 3); }

struct Unit { int pm, pn; };
struct Gemm { const bf16_t* A; const bf16_t* Bt; int M, N, K; };

struct StaticOrder {
    int nM, nN, nwg, G, c;
    __host__ __device__ void init(int M, int N, int G_, int c_) { nM = M / BM; nN = N / BM; nwg = nM * nN; G = G_; c = c_; }
    __host__ __device__ bool next(int i, Unit& u) const {
        const long L = (long)i * G + c; if (L >= nwg) return false;
        int wgid = (int)L; { const int q = nwg / NXCD, r = nwg % NXCD, xcd = wgid % NXCD, off = wgid / NXCD; wgid = (xcd < r ? xcd * (q + 1) : r * (q + 1) + (xcd - r) * q) + off; }
        const int nig = WGM * nN, gid = wgid / nig, fm = gid * WGM, gsz = (nM - fm) < WGM ? (nM - fm) : WGM;
        u.pm = fm + ((wgid % nig) % gsz); u.pn = (wgid % nig) / gsz; return true;
    }
    __device__ __forceinline__ void a_ready(const Unit&) const {}
    __device__ __forceinline__ void done(const Unit&) const {}
};

__device__ __forceinline__ unsigned cvt_pk_bf16(float lo, float hi) { unsigned r; asm volatile("v_cvt_pk_bf16_f32 %0, %1, %2" : "=v"(r) : "v"(lo), "v"(hi)); return r; }
typedef float f32x2 __attribute__((ext_vector_type(2)));
__device__ __forceinline__ float sigm(float x) { return __builtin_amdgcn_rcpf(1.0f + __builtin_amdgcn_exp2f(-1.4426950408889634f * x)); }
constexpr float QK_C2 = 0.125f * 1.4426950408889634f;
#define PG8_GAS __attribute__((address_space(1)))
struct EpiAll {
    static constexpr bool PERM = true, AFTER_DRAIN = false;
    int mode;
    int mtiles_main;
    bf16_t* O1; bf16_t* O2; bf16_t* O3; int ldo;
    float* hmain; float* hmeta; float scale;
    const float* qg; const float* kg;
    __device__ __forceinline__ void operator()(const f32x4 (&acc)[2][2][4][2], const Unit& u, int wr, int wc, int fr, int fq) const {
        const int rloc_ = wr * 64 + fr;
#define EPI_LAUNDER() int rloc = rloc_; asm volatile("" : "+v"(rloc))
        if (mode <= 1 || (mode == 2 && u.pn < 8)) {
            EPI_LAUNDER();
            bf16_t* base = O1 + (size_t)(u.pm * BM + rloc) * ldo + u.pn * HALF + wc * 32 + 8 * fq;
#pragma unroll
            for (int ai = 0; ai < 2; ++ai)
#pragma unroll
                for (int m = 0; m < 4; ++m) {
                    const f32x4 a0 = acc[ai][0][m][0], a1 = acc[ai][0][m][1], b0 = acc[ai][1][m][0], b1 = acc[ai][1][m][1];
                    f32x4 r0, r1;
                    if (mode == 0) {
#pragma unroll
                        for (int i = 0; i < 4; ++i) { r0[i] = a0[i] * sigm(a0[i]) * b0[i]; r1[i] = a1[i] * sigm(a1[i]) * b1[i]; }
                    } else if (mode == 1) {
#pragma unroll
                        for (int i = 0; i < 4; ++i) { r0[i] = a0[i] * sigm(b0[i]); r1[i] = a1[i] * sigm(b1[i]); }
                    } else { r0 = a0 * b0; r1 = a1 * b1; }
                    u32x4 w; w.x = cvt_pk_bf16(r0[0], r0[1]); w.y = cvt_pk_bf16(r0[2], r0[3]); w.z = cvt_pk_bf16(r1[0], r1[1]); w.w = cvt_pk_bf16(r1[2], r1[3]);
                    *(PG8_GAS u32x4*)(base + (size_t)(ai * HALF + m * 16) * ldo) = w;
                }
        } else if (mode == 2) {
            EPI_LAUNDER();
            bf16_t* base = O2 + (size_t)(u.pm * BM + rloc) * 1024 + (u.pn - 8) * BM + wc * 32 + 8 * fq;
#pragma unroll
            for (int ai = 0; ai < 2; ++ai)
#pragma unroll
                for (int m = 0; m < 4; ++m)
#pragma unroll
                    for (int bj = 0; bj < 2; ++bj) {
                        const f32x4 v0 = acc[ai][bj][m][0], v1 = acc[ai][bj][m][1];
                        u32x4 w; w.x = cvt_pk_bf16(v0[0], v0[1]); w.y = cvt_pk_bf16(v0[2], v0[3]); w.z = cvt_pk_bf16(v1[0], v1[1]); w.w = cvt_pk_bf16(v1[2], v1[3]);
                        *(PG8_GAS u32x4*)(base + (size_t)(ai * HALF + m * 16) * 1024 + bj * HALF) = w;
                    }
        } else if (mode == 3) {
            EPI_LAUNDER();
            const int sec = u.pn >> 2;
            const bool meta = (u.pm >= mtiles_main);
            const long krow0 = meta ? 48 : (long)u.pm * BM + 128 * (1 + (u.pm >> 5));
            bf16_t* dst = (sec == 0) ? O1 + (size_t)(u.pm * BM) * 1024 : ((sec == 1) ? O2 : O3) + (size_t)krow0 * 1024;
            const bool dup = meta && sec != 0; const int rlim = dup ? 16 : 256;
            if (sec < 2) {
                const int head = 4 * (u.pn & 3) + wc;
                const int lxor16 = (fr + 16 * (fq ^ 1)) << 2, lxor32 = (fr + 16 * (fq ^ 2)) << 2;
                const float* g = (sec == 0) ? qg : kg; const float gs = (sec == 0) ? QK_C2 : 1.0f;
                f32x4 gv[2][2];
#pragma unroll
                for (int bj = 0; bj < 2; ++bj)
#pragma unroll
                    for (int n = 0; n < 2; ++n) gv[bj][n] = *(const PG8_GAS f32x4*)(g + 32 * bj + 8 * fq + 4 * n) * gs;
#pragma unroll
                for (int ai = 0; ai < 2; ++ai)
#pragma unroll
                    for (int m = 0; m < 4; ++m) {
                        float ss = 0.f;
#pragma unroll
                        for (int bj = 0; bj < 2; ++bj)
#pragma unroll
                            for (int n = 0; n < 2; ++n) { const f32x4 x = acc[ai][bj][m][n]; ss += (x[0] * x[0] + x[1] * x[1]) + (x[2] * x[2] + x[3] * x[3]); }
                        ss += __builtin_bit_cast(float, __builtin_amdgcn_ds_bpermute(lxor16, __builtin_bit_cast(int, ss))); ss += __builtin_bit_cast(float, __builtin_amdgcn_ds_bpermute(lxor32, __builtin_bit_cast(int, ss)));
                        const float rs = __builtin_amdgcn_rsqf(ss * (1.0f / 64.0f) + 1e-6f);
                        const int rl = rloc + ai * HALF + m * 16;
#pragma unroll
                        for (int bj = 0; bj < 2; ++bj) {
                            const f32x4 v0 = acc[ai][bj][m][0] * rs * gv[bj][0], v1 = acc[ai][bj][m][1] * rs * gv[bj][1];
                            u32x4 w; w.x = cvt_pk_bf16(v0[0], v0[1]); w.y = cvt_pk_bf16(v0[2], v0[3]); w.z = cvt_pk_bf16(v1[0], v1[1]); w.w = cvt_pk_bf16(v1[2], v1[3]);
                            const int col = 64 * head + 32 * bj + 8 * fq;
                            if (rl < rlim) { *(PG8_GAS u32x4*)(dst + (size_t)rl * 1024 + col) = w; if (dup) *(PG8_GAS u32x4*)(dst + (size_t)(8320 + rl) * 1024 + col) = w; }
                        }
                    }
            } else {
#pragma unroll
                for (int ai = 0; ai < 2; ++ai)
#pragma unroll
                    for (int m = 0; m < 4; ++m) {
                        const int rl = rloc + ai * HALF + m * 16;
#pragma unroll
                        for (int bj = 0; bj < 2; ++bj) {
                            const f32x4 v0 = acc[ai][bj][m][0], v1 = acc[ai][bj][m][1];
                            u32x4 w; w.x = cvt_pk_bf16(v0[0], v0[1]); w.y = cvt_pk_bf16(v0[2], v0[3]); w.z = cvt_pk_bf16(v1[0], v1[1]); w.w = cvt_pk_bf16(v1[2], v1[3]);
                            const int col = (u.pn - 8) * BM + bj * HALF + wc * 32 + 8 * fq;
                            if (rl < rlim) { *(PG8_GAS u32x4*)(dst + (size_t)rl * 1024 + col) = w; if (dup) *(PG8_GAS u32x4*)(dst + (size_t)(8320 + rl) * 1024 + col) = w; }
                        }
                    }
            }
        } else {
            EPI_LAUNDER();
            float* base = ((u.pm < mtiles_main) ? hmain + (size_t)(u.pm * BM) * 1024 : hmeta) + (size_t)rloc * 1024 + u.pn * BM + wc * 32 + 8 * fq;
            const float sc = scale;
#pragma unroll
            for (int ai = 0; ai < 2; ++ai)
#pragma unroll
                for (int m = 0; m < 4; ++m)
#pragma unroll
                    for (int bj = 0; bj < 2; ++bj) {
                        float* p = base + (size_t)(ai * HALF + m * 16) * 1024 + bj * HALF;
                        f32x4 x0 = *(const PG8_GAS f32x4*)p, x1 = *(const PG8_GAS f32x4*)(p + 4);
                        x0 += acc[ai][bj][m][0] * sc; x1 += acc[ai][bj][m][1] * sc;
                        *(PG8_GAS f32x4*)p = x0; *(PG8_GAS f32x4*)(p + 4) = x1;
                    }
        }
    }
};
template <class Epi, class Sched, bool ALIGN_EPI = false, bool SP2 = false>
__device__ __forceinline__ void gemm_phase(PG8_LAS unsigned char* lds, const Gemm g, const Sched& S, const Epi& E, const int tid_in) {
    const int tid = tid_in, wid = __builtin_amdgcn_readfirstlane(tid >> 6), lane = tid & 63, wr = wid >> 2, wc = wid & 3, fr = lane & 15, fq = lane >> 4;
    const int K = g.K, nt = K / BK;
    unsigned voffA[2], voffB[2];
#pragma unroll
    for (int i = 0; i < 2; ++i) { int R, C; stage_rc(tid * 16 + i * 8192, R, C); const int Rb = Epi::PERM ? ((R & ~31) + perm32(R & 31)) : R;
        voffA[i] = (unsigned)(R * K + C) * 2u; voffB[i] = (unsigned)(Rb * K + C) * 2u; }
    const size_t kstep = (size_t)(BK * 2);
    const size_t hstep = (size_t)HALF * K * 2;
    const size_t tstep = 2 * hstep;
    const unsigned ldsw = (unsigned)wid * 1024u;
    const int aoff = lds_byte(wr * 64 + fr, fq * 8), boff = lds_byte(wc * 32 + fr, fq * 8);
#define PG8_SA(b, h) (((b) * 2 + (h)) * HTB)
#define PG8_SB(b, h) ((4 + (b) * 2 + (h)) * HTB)
#define PG8_STAGE(bufoff, gbase, voff) do { _Pragma("unroll") for (int _i = 0; _i < 2; ++_i) \
        __builtin_amdgcn_global_load_lds((const unsigned*)((const char*)(gbase) + (voff)[_i]), (PG8_LAS unsigned*)(lds + (bufoff) + ldsw + _i * 8192), 16, 0, 0); } while (0)
#define PG8_LDA(dst, b, h) do { _Pragma("unroll") for (int m = 0; m < 4; ++m) _Pragma("unroll") for (int k = 0; k < 2; ++k) dst[m][k] = *(const PG8_LAS bf16x8*)(lds + PG8_SA(b, h) + aoff + m * 2048 + k * 1024); } while (0)
#define PG8_LDB(dst, b, h) do { _Pragma("unroll") for (int n = 0; n < 2; ++n) _Pragma("unroll") for (int k = 0; k < 2; ++k) dst[n][k] = *(const PG8_LAS bf16x8*)(lds + PG8_SB(b, h) + boff + n * 2048 + k * 1024); } while (0)
#define PG8_MMA(ai, bj, At, Bt) do { __builtin_amdgcn_s_setprio(1); _Pragma("unroll") for (int m = 0; m < 4; ++m) _Pragma("unroll") for (int n = 0; n < 2; ++n) _Pragma("unroll") for (int k = 0; k < 2; ++k) \
        acc[ai][bj][m][n] = __builtin_amdgcn_mfma_f32_16x16x32_bf16(Bt[n][k], At[m][k], acc[ai][bj][m][n], 0, 0, 0); __builtin_amdgcn_s_setprio(0); } while (0)
#define PG8_WAIT_V(n) asm volatile("s_waitcnt vmcnt(" #n ")" ::: "memory")
#define PG8_WAIT_L(n) asm volatile("s_waitcnt lgkmcnt(" #n ")" ::: "memory")
#define PG8_BAR __builtin_amdgcn_s_barrier()
#define PG8_SCHED __builtin_amdgcn_sched_barrier(0)
    Unit cur, nxt; int ui = 0;
    if (!S.next(0, cur)) return;
    f32x4 acc[2][2][4][2];
#pragma unroll
    for (int a = 0; a < 2; ++a)
#pragma unroll
        for (int b = 0; b < 2; ++b)
#pragma unroll
            for (int m = 0; m < 4; ++m)
#pragma unroll
                for (int n = 0; n < 2; ++n) acc[a][b][m][n] = (f32x4){0.f, 0.f, 0.f, 0.f};
    bf16x8 At[4][2], B0[2][2], B1[2][2];
    const char* cA = (const char*)g.A + (size_t)cur.pm * tstep; const char* cB = (const char*)g.Bt + (size_t)cur.pn * tstep;
    S.a_ready(cur);
    if constexpr (SP2) {
        PG8_STAGE(PG8_SB(0, 0), cB, voffB); PG8_STAGE(PG8_SB(0, 1), cB + hstep, voffB); PG8_STAGE(PG8_SA(0, 0), cA, voffA); PG8_STAGE(PG8_SA(0, 1), cA + hstep, voffA);
        if (wr == 1) PG8_BAR;
        PG8_WAIT_V(2); PG8_BAR;
        PG8_STAGE(PG8_SB(1, 0), cB + kstep, voffB); PG8_STAGE(PG8_SA(1, 0), cA + kstep, voffA); PG8_STAGE(PG8_SB(1, 1), cB + hstep + kstep, voffB);
        PG8_WAIT_V(6); PG8_BAR;
    } else {
        PG8_STAGE(PG8_SB(0, 0), cB, voffB); PG8_STAGE(PG8_SA(0, 0), cA, voffA); PG8_STAGE(PG8_SB(0, 1), cB + hstep, voffB); PG8_STAGE(PG8_SA(0, 1), cA + hstep, voffA);
        if (wr == 1) PG8_BAR;
        PG8_WAIT_V(4); PG8_BAR;
        PG8_STAGE(PG8_SB(1, 0), cB + kstep, voffB); PG8_STAGE(PG8_SA(1, 0), cA + kstep, voffA); PG8_STAGE(PG8_SB(1, 1), cB + hstep + kstep, voffB);
        PG8_WAIT_V(6); PG8_BAR;
    }
    for (;;) {
        const bool has_next = S.next(ui + 1, nxt);
        const char* nA = has_next ? (const char*)g.A + (size_t)nxt.pm * tstep : cA; const char* nB = has_next ? (const char*)g.Bt + (size_t)nxt.pn * tstep : cB;
        for (int t = 0; t < nt; t += 2) {
            const bool last = (t == nt - 2);
            const char* a1 = cA + (size_t)(t + 1) * kstep;
            const char* a2 = last ? nA : cA + (size_t)(t + 2) * kstep; const char* b2 = last ? nB : cB + (size_t)(t + 2) * kstep;
            const char* a3 = a2 + kstep; const char* b3 = b2 + kstep;
            if (last && has_next) S.a_ready(nxt);
            if constexpr (SP2) {
            PG8_LDB(B0, 0, 0); PG8_LDB(B1, 0, 1); PG8_SCHED; PG8_LDA(At, 0, 0); PG8_STAGE(PG8_SA(1, 1), a1 + hstep, voffA);
            PG8_WAIT_V(8); PG8_WAIT_L(0); PG8_BAR; PG8_MMA(0, 0, At, B0); PG8_MMA(0, 1, At, B1); PG8_BAR; PG8_SCHED;
            PG8_LDA(At, 0, 1); PG8_STAGE(PG8_SB(0, 0), b2, voffB); PG8_STAGE(PG8_SB(0, 1), b2 + hstep, voffB); PG8_STAGE(PG8_SA(0, 0), a2, voffA);
            PG8_WAIT_V(8); PG8_WAIT_L(0); PG8_BAR; PG8_MMA(1, 0, At, B0); PG8_MMA(1, 1, At, B1); PG8_BAR; PG8_SCHED;
            PG8_LDB(B0, 1, 0); PG8_LDB(B1, 1, 1); PG8_SCHED; PG8_LDA(At, 1, 0); PG8_STAGE(PG8_SA(0, 1), a2 + hstep, voffA);
            PG8_WAIT_V(8); PG8_WAIT_L(0); PG8_BAR; PG8_MMA(0, 0, At, B0); PG8_MMA(0, 1, At, B1); PG8_BAR; PG8_SCHED;
            PG8_LDA(At, 1, 1); PG8_STAGE(PG8_SB(1, 0), b3, voffB); PG8_STAGE(PG8_SB(1, 1), b3 + hstep, voffB); PG8_STAGE(PG8_SA(1, 0), a3, voffA);
            PG8_WAIT_V(8); PG8_WAIT_L(0); PG8_BAR; PG8_MMA(1, 0, At, B0); PG8_MMA(1, 1, At, B1); PG8_BAR; PG8_SCHED;
            } else {
            PG8_LDB(B0, 0, 0); PG8_SCHED; PG8_LDA(At, 0, 0); PG8_STAGE(PG8_SA(1, 1), a1 + hstep, voffA);
            PG8_WAIT_L(8); PG8_BAR; PG8_WAIT_L(0); PG8_MMA(0, 0, At, B0); PG8_BAR; PG8_SCHED;
            PG8_LDB(B1, 0, 1); PG8_STAGE(PG8_SB(0, 0), b2, voffB);
            PG8_BAR; PG8_WAIT_L(0); PG8_MMA(0, 1, At, B1); PG8_BAR;
            PG8_LDA(At, 0, 1); PG8_STAGE(PG8_SA(0, 0), a2, voffA);
            PG8_BAR; PG8_WAIT_L(0); PG8_MMA(1, 0, At, B0); PG8_BAR; PG8_SCHED;
            PG8_STAGE(PG8_SB(0, 1), b2 + hstep, voffB);
            PG8_WAIT_V(6); PG8_BAR; PG8_MMA(1, 1, At, B1); PG8_BAR;
            PG8_LDB(B0, 1, 0); PG8_SCHED; PG8_LDA(At, 1, 0); PG8_STAGE(PG8_SA(0, 1), a2 + hstep, voffA);
            PG8_WAIT_L(8); PG8_BAR; PG8_WAIT_L(0); PG8_MMA(0, 0, At, B0); PG8_BAR; PG8_SCHED;
            PG8_LDB(B1, 1, 1); PG8_STAGE(PG8_SB(1, 0), b3, voffB);
            PG8_BAR; PG8_WAIT_L(0); PG8_MMA(0, 1, At, B1); PG8_BAR;
            PG8_LDA(At, 1, 1); PG8_STAGE(PG8_SA(1, 0), a3, voffA);
            PG8_BAR; PG8_WAIT_L(0); PG8_MMA(1, 0, At, B0); PG8_BAR; PG8_SCHED;
            PG8_STAGE(PG8_SB(1, 1), b3 + hstep, voffB);
            PG8_WAIT_V(6); PG8_BAR; PG8_MMA(1, 1, At, B1); PG8_BAR;
            }
        }
        if constexpr (ALIGN_EPI) { if (wr == 0) PG8_BAR; }
        if constexpr (!Epi::AFTER_DRAIN) { E(acc, cur, wr, wc, fr, fq); S.done(cur); }
        if (!has_next) break;
#pragma unroll
        for (int a = 0; a < 2; ++a)
#pragma unroll
            for (int b = 0; b < 2; ++b)
#pragma unroll
                for (int m = 0; m < 4; ++m)
#pragma unroll
                    for (int n = 0; n < 2; ++n) acc[a][b][m][n] = (f32x4){0.f, 0.f, 0.f, 0.f};
        cur = nxt; cA = nA; cB = nB; ++ui;
        if constexpr (ALIGN_EPI) { if (wr == 1) PG8_BAR; }
    }
    PG8_WAIT_V(0);
    if constexpr (!ALIGN_EPI) { if (wr == 0) PG8_BAR; }
    PG8_BAR;
    if constexpr (Epi::AFTER_DRAIN) { E.fused(acc, cur, wr, wc, fr, fq, lds, wid, lane); S.done(cur); }
#undef PG8_SA
#undef PG8_SB
#undef PG8_STAGE
#undef PG8_LDA
#undef PG8_LDB
#undef PG8_MMA
#undef PG8_WAIT_V
#undef PG8_WAIT_L
#undef PG8_BAR
#undef PG8_SCHED
}
}

#ifndef PG8_SP2
#define PG8_SP2 true
#endif
#ifndef PG8_ALIGN
#define PG8_ALIGN true
#endif
#include <hip/hip_bf16.h>
#include <cmath>
namespace attn_body {
using bf16=__hip_bfloat16;
using bf16x8=__attribute__((ext_vector_type(8)))short;
using s16x4=__attribute__((ext_vector_type(4)))short;
using f32x16=__attribute__((ext_vector_type(16)))float;
using u32x4=__attribute__((ext_vector_type(4)))unsigned;
constexpr int BATCH=2,NHEAD=16,SEQ=8192,D=64,DM=NHEAD*D;
constexpr int NW=8,QBLK=32,QB=QBLK*NW,KVBLK=64,NQB=SEQ/QB; constexpr int KVPAD=128,KVROWS=SEQ+KVPAD;
constexpr int ATTN_PITCH=DM, ATTN_UNIT_ROWS=QB;
__device__ __forceinline__ int crow(int r,int hi){return (r&3)+8*(r>>2)+4*hi;}
#define SBAR() __builtin_amdgcn_sched_barrier(0)
__device__ __forceinline__ void cmask(f32x16&p0,f32x16&p1,int jb,int qrel,int hi){
  const float NEG=-INFINITY; int kb=64*jb+4*hi;
  #pragma unroll
  for(int r=0;r<16;++r){int kv=kb+(r&3)+8*(r>>2); if(kv>qrel)p0[r]=NEG; if(kv+32>qrel)p1[r]=NEG;}
}

constexpr int NSLOT=3, SLOTB=8192;
constexpr int LDS_K=0, LDS_V=NSLOT*SLOTB, LDS_WS=2*NSLOT*SLOTB, LDS_OST=LDS_WS+NW*64*4, LDS_CS=LDS_OST+NW*4096, LDS_BYTES=LDS_CS+KVROWS*4;
constexpr float C2=0.125f*1.4426950408889634f;
__device__ __forceinline__ void glds16(const void*gsrc,unsigned lds_dst){unsigned keep;
  asm volatile("s_mov_b32 %0, m0\n\ts_mov_b32 m0, %2\n\ts_nop 0\n\tglobal_load_lds_dwordx4 %1, off\n\ts_mov_b32 m0, %0":"=&s"(keep):"v"(gsrc),"s"(lds_dst):"memory");}
__device__ __forceinline__ float max3f(float a,float b,float c){float r;asm("v_max3_f32 %0, %1, %2, %3":"=v"(r):"v"(a),"v"(b),"v"(c));return r;}
__device__ __forceinline__ float max2f(float a,float b){float r;asm("v_max_f32_e32 %0, %1, %2":"=v"(r):"v"(a),"v"(b));return r;}
__device__ __forceinline__ float fadd_s(float a,float b){float r;asm("v_add_f32_e32 %0, %1, %2":"=v"(r):"v"(a),"v"(b));return r;}
__device__ __forceinline__ float fsub_s(float a,float b){float r;asm("v_sub_f32_e32 %0, %1, %2":"=v"(r):"v"(a),"v"(b));return r;}
typedef float f32x2_t __attribute__((ext_vector_type(2))); typedef __bf16 bf16x2_t __attribute__((ext_vector_type(2)));
__device__ __forceinline__ unsigned cvtpk_s(float lo,float hi){f32x2_t v={lo,hi};bf16x2_t b=__builtin_convertvector(v,bf16x2_t);return __builtin_bit_cast(unsigned,b);}
#define WAIT_BAR(N) asm volatile("s_waitcnt vmcnt(" #N ") lgkmcnt(0)\n\ts_barrier":::"memory")

__device__ __forceinline__ void qkt(f32x16&p0,f32x16&p1,const char*Kslot,const bf16x8*qr,int r32,int hi){
  const char*kb=Kslot+hi*1024+r32*16;
  #pragma unroll
  for(int d0=0;d0<4;++d0){
    const bf16x8 b0=*reinterpret_cast<const bf16x8*>(kb+d0*2048);
    const bf16x8 b1=*reinterpret_cast<const bf16x8*>(kb+d0*2048+512);
    p0=__builtin_amdgcn_mfma_f32_32x32x16_bf16(b0,qr[d0],p0,0,0,0);p1=__builtin_amdgcn_mfma_f32_32x32x16_bf16(b1,qr[d0],p1,0,0,0);}
}
typedef __attribute__((address_space(3))) const char* lds_cptr;
typedef short v4i16_t __attribute__((ext_vector_type(4))); typedef float f32x4_t __attribute__((ext_vector_type(4)));
__device__ __forceinline__ void kload8(bf16x8*kf,lds_cptr kp){
  kf[0]=*(const __attribute__((address_space(3))) bf16x8*)(kp);      kf[1]=*(const __attribute__((address_space(3))) bf16x8*)(kp+512);
  kf[2]=*(const __attribute__((address_space(3))) bf16x8*)(kp+2048); kf[3]=*(const __attribute__((address_space(3))) bf16x8*)(kp+2560);
  kf[4]=*(const __attribute__((address_space(3))) bf16x8*)(kp+4096); kf[5]=*(const __attribute__((address_space(3))) bf16x8*)(kp+4608);
  kf[6]=*(const __attribute__((address_space(3))) bf16x8*)(kp+6144); kf[7]=*(const __attribute__((address_space(3))) bf16x8*)(kp+6656);
}
__device__ __forceinline__ void kload2(bf16x8*kf,lds_cptr kp,int j){ kf[2*j]=*(const __attribute__((address_space(3))) bf16x8*)(kp+j*2048); kf[2*j+1]=*(const __attribute__((address_space(3))) bf16x8*)(kp+j*2048+512); }
__device__ __forceinline__ s16x4 vtr(lds_cptr p){ return __builtin_bit_cast(s16x4,__builtin_amdgcn_ds_read_tr16_b64_v4i16((__attribute__((address_space(3))) v4i16_t*)p)); }
__device__ __forceinline__ float rowmax(const f32x16&p0,const f32x16&p1){
  float a=max3f(p0[0],p0[1],p1[0]),b=max3f(p0[2],p0[3],p1[1]);a=max3f(a,p1[2],p1[3]);
  #pragma unroll
  for(int r=4;r<16;r+=4){a=max3f(a,p0[r],p0[r+1]);b=max3f(b,p0[r+2],p0[r+3]);a=max3f(a,p1[r],p1[r+1]);b=max3f(b,p1[r+2],p1[r+3]);}
  const float m=max2f(a,b);
  auto rr=__builtin_amdgcn_permlane32_swap(__float_as_uint(m),__float_as_uint(m),false,false);
  return max2f(__uint_as_float(rr[0]),__uint_as_float(rr[1]));
}
__device__ __forceinline__ void pv(f32x16*o,int vb,bf16x8 pa0,bf16x8 pa1,bf16x8 pa2,bf16x8 pa3){
  #pragma unroll
  for(int d0=0;d0<2;++d0){s16x4 lo[4],hi[4];
    #pragma unroll
    for(int ks=0;ks<4;++ks){
      asm volatile("ds_read_b64_tr_b16 %0,%1 offset:%c2":"=&v"(lo[ks]):"v"(vb),"i"(d0*4096+ks*1024):"memory");
      asm volatile("ds_read_b64_tr_b16 %0,%1 offset:%c2":"=&v"(hi[ks]):"v"(vb),"i"(d0*4096+ks*1024+512):"memory");}
    asm volatile("s_waitcnt lgkmcnt(0)":::"memory");SBAR();
    #define PK(k) (bf16x8){lo[k][0],lo[k][1],lo[k][2],lo[k][3],hi[k][0],hi[k][1],hi[k][2],hi[k][3]}
    o[d0]=__builtin_amdgcn_mfma_f32_32x32x16_bf16(pa0,PK(0),o[d0],0,0,0);
    o[d0]=__builtin_amdgcn_mfma_f32_32x32x16_bf16(pa1,PK(1),o[d0],0,0,0);
    o[d0]=__builtin_amdgcn_mfma_f32_32x32x16_bf16(pa2,PK(2),o[d0],0,0,0);
    o[d0]=__builtin_amdgcn_mfma_f32_32x32x16_bf16(pa3,PK(3),o[d0],0,0,0);
    #undef PK
  }
}

#ifndef ATTN_STORE16
#define ATTN_STORE16(p,v) (*(__attribute__((address_space(1))) u32x4*)(p)=(v))
#endif
template<int THRL> __device__ __forceinline__ void attn_unit(int b,int h,int qb,const bf16*Q,const bf16*__restrict__ K,const bf16*__restrict__ V,bf16*O,const float*__restrict__ CS,char*shm,const int tid_in){
  const int tid=tid_in,lane=tid&63,r32=lane&31,hi=lane>>5; const int wid=__builtin_amdgcn_readfirstlane(tid>>6);
  const long rowbase=(long)b*SEQ, kvbase=(long)b*KVROWS; const int q0=qb*QB;
  const bf16*Qw=Q+(rowbase+q0+wid*QBLK)*DM+h*D;
  const bf16*Kh=K+kvbase*DM+h*D,*Vh=V+kvbase*DM+h*D;
  const unsigned lds0=(unsigned)(uintptr_t)shm;
  float*wsf=(float*)(shm+LDS_WS)+wid*64;
  const bf16*ksrc=Kh+(long)lane*DM+wid*8;
  const bf16*vsrc=Vh+(long)(16*(wid&3)+(lane>>2))*DM+(wid>>2)*32+(lane&3)*8;
  const unsigned kdst=lds0+LDS_K+wid*1024, vdst=lds0+LDS_V+wid*1024;
  #define DMA_K(t,slot) glds16(ksrc+(long)(t)*KVBLK*DM,(unsigned)__builtin_amdgcn_readfirstlane(kdst+(slot)))
  #define DMA_V(t,slot) glds16(vsrc+(long)(t)*KVBLK*DM,(unsigned)__builtin_amdgcn_readfirstlane(vdst+(slot)))
  const int vb0=(int)(lds0+LDS_V)+((lane>>4)&1)*32+(lane&3)*8+(4*hi+((lane&15)>>2))*64;
  const char*Kbase=shm+LDS_K; bf16x8 kf[8];
  const lds_cptr shm3=(lds_cptr)shm; const lds_cptr kp0=shm3+LDS_K+hi*1024+r32*16; const lds_cptr vp0=shm3+LDS_V+((lane>>4)&1)*32+(lane&3)*8+(4*hi+((lane&15)>>2))*64;
  const int NT=(q0+QB+KVPAD)/KVBLK;
  { const float*csg=CS+(long)(b*NHEAD+h)*KVROWS; __attribute__((address_space(3))) float*csw=(__attribute__((address_space(3))) float*)((lds_cptr)shm+LDS_CS);
    for(int i=tid*4;i<NT*KVBLK;i+=NW*64*4){ const f32x4_t v=*(const __attribute__((address_space(1))) f32x4_t*)(csg+i); *(__attribute__((address_space(3))) f32x4_t*)(csw+i)=v; } }
  DMA_K(0,0);DMA_V(0,0);DMA_K(1,SLOTB);
  bf16x8 qr[4];
  #pragma unroll
  for(int d0=0;d0<4;++d0)qr[d0]=*(const __attribute__((address_space(1))) bf16x8*)(&Qw[(long)r32*DM+d0*16+hi*8]);
  float mhat=0.f,l_reg=0.f;f32x16 o[2];o[0]=f32x16{};o[1]=f32x16{};
  const __attribute__((address_space(3))) float*csl=(const __attribute__((address_space(3))) float*)((lds_cptr)shm+LDS_CS)+4*hi;
  #define BIASINIT(C0,C1,t) do{ const __attribute__((address_space(3))) float*bp_=csl+64*(t); const float nm_=-mhat; \
    _Pragma("unroll") for(int g_=0;g_<4;++g_){ const f32x4_t a_=*(const __attribute__((address_space(3))) f32x4_t*)(bp_+8*g_), b_=*(const __attribute__((address_space(3))) f32x4_t*)(bp_+32+8*g_); \
      C0[4*g_]=nm_-a_[0];C0[4*g_+1]=nm_-a_[1];C0[4*g_+2]=nm_-a_[2];C0[4*g_+3]=nm_-a_[3]; C1[4*g_]=nm_-b_[0];C1[4*g_+1]=nm_-b_[1];C1[4*g_+2]=nm_-b_[2];C1[4*g_+3]=nm_-b_[3]; } }while(0)
  const int qrel=wid*QBLK+r32;
  #define CMASK(P0,P1,t) do{int jb_=(t)-(NT-4); if(jb_>=0)cmask(P0,P1,jb_,qrel,hi);}while(0)
  bool resc=false;
  #define START(P0,P1) do{ const float rm=rowmax(P0,P1); resc=false; \
    { const float dl=rm; mhat=fadd_s(mhat,dl); \
      _Pragma("unroll") for(int r=0;r<16;++r){P0[r]=fsub_s(P0[r],dl);P1[r]=fsub_s(P1[r],dl);} \
      } \
    _Pragma("unroll") for(int r=0;r<16;++r)P0[r]=__builtin_amdgcn_exp2f(P0[r]); }while(0)
  #define RESC() do{ if(resc){ asm volatile("s_waitcnt lgkmcnt(0)":::"memory"); \
      _Pragma("unroll") for(int d_=0;d_<2;++d_) _Pragma("unroll") for(int r=0;r<16;++r)o[d_][r]*=wsf[crow(r,hi)]; } }while(0)
  f32x16 pA0,pA1,pB0,pB1;
  int sl_prev=0,sl_cur=0,sl_next=SLOTB;
  #define ROT() do{sl_prev=sl_cur;sl_cur=sl_next;sl_next=(sl_next==(NSLOT-1)*SLOTB)?0:sl_next+SLOTB;}while(0)
  DMA_K(2,2*SLOTB);
  WAIT_BAR(3);
  BIASINIT(pA0,pA1,0); qkt(pA0,pA1,Kbase,qr,r32,hi);asm volatile("s_nop 15\n\ts_nop 7":"+v"(pA0),"+v"(pA1));
  START(pA0,pA1);
  _Pragma("unroll") for(int r=0;r<16;++r)pA1[r]=__builtin_amdgcn_exp2f(pA1[r]);
  WAIT_BAR(0);
  DMA_K(3,0);DMA_V(1,SLOTB);
  ROT();
  kload8(kf,kp0+sl_cur);
  WAIT_BAR(2);
  s16x4 vlo[8],vhi[8]; u32x4 pw0,pw1,pw2,pw3;
  #define PKW(P,B) cvtpk_s(P[B],P[B+1])
  #define PAF(k) __builtin_bit_cast(bf16x8,pw##k)
  #define VFR(i) (bf16x8){vlo[i][0],vlo[i][1],vlo[i][2],vlo[i][3],vhi[i][0],vhi[i][1],vhi[i][2],vhi[i][3]}
  #define PIN(x) asm volatile("":"+v"(x))
  #define MX3(a,b,c) __builtin_fmaxf(__builtin_fmaxf((a),(b)),(c))
  #define GAPA(MF,A0,A1,A2,A3,W0,W1,PW) do{ MF; sacc+=A0; sacc+=A1; sacc+=A2; sacc+=A3; PIN(sacc); W0; W1; PIN(PW); SBAR(); }while(0)
  #define EX(v) __builtin_amdgcn_exp2f(v)
  #define GAPB(MF,X,B) do{ MF; X[B]=EX(X[B]); X[B+1]=EX(X[B+1]); X[B+2]=EX(X[B+2]); X[B+3]=EX(X[B+3]); PIN(X); SBAR(); }while(0)
  #define VRD(i) do{ vlo[i]=vtr(vp_+(((i)>>2)*4096+((i)&3)*1024)); vhi[i]=vtr(vp_+(((i)>>2)*4096+((i)&3)*1024+512)); }while(0)
  #define KRD(G,j) do{ if(G){ kload2(kf,kp0+sl_next,j); SBAR(); } }while(0)
  #define STEP(C0,C1,P0,P1,t,GK,GV,GL) do{ SBAR(); BIASINIT(C0,C1,t); SBAR(); \
    const lds_cptr vp_=vp0+sl_prev; \
    VRD(0); SBAR(); float sacc=(P0[0]+P0[1]); \
    GAPA(C0=__builtin_amdgcn_mfma_f32_32x32x16_bf16(kf[0],qr[0],C0,0,0,0), P0[2],P0[3],P0[4],P0[5],     pw0[0]=PKW(P0,0), pw0[1]=PKW(P0,2), pw0); \
    VRD(4); SBAR(); GAPA(C1=__builtin_amdgcn_mfma_f32_32x32x16_bf16(kf[1],qr[0],C1,0,0,0), P0[6],P0[7],P0[8],P0[9],     pw0[2]=PKW(P0,4), pw0[3]=PKW(P0,6), pw0); \
    VRD(1); SBAR(); GAPA(C0=__builtin_amdgcn_mfma_f32_32x32x16_bf16(kf[2],qr[1],C0,0,0,0),   P0[10],P0[11],P0[12],P0[13], pw1[0]=PKW(P0,8), pw1[1]=PKW(P0,10), pw1); \
    VRD(5); SBAR(); GAPA(C1=__builtin_amdgcn_mfma_f32_32x32x16_bf16(kf[3],qr[1],C1,0,0,0),   P0[14],P0[15],P1[0],P1[1],   pw1[2]=PKW(P0,12),pw1[3]=PKW(P0,14), pw1); \
    VRD(2); SBAR(); GAPA(C0=__builtin_amdgcn_mfma_f32_32x32x16_bf16(kf[4],qr[2],C0,0,0,0),   P1[2],P1[3],P1[4],P1[5],     pw2[0]=PKW(P1,0), pw2[1]=PKW(P1,2), pw2); \
    VRD(6); SBAR(); GAPA(C1=__builtin_amdgcn_mfma_f32_32x32x16_bf16(kf[5],qr[2],C1,0,0,0),   P1[6],P1[7],P1[8],P1[9],     pw2[2]=PKW(P1,4), pw2[3]=PKW(P1,6), pw2); \
    VRD(3); SBAR(); GAPA(C0=__builtin_amdgcn_mfma_f32_32x32x16_bf16(kf[6],qr[3],C0,0,0,0),   P1[10],P1[11],P1[12],P1[13], pw3[0]=PKW(P1,8), pw3[1]=PKW(P1,10), pw3); \
    VRD(7); SBAR(); GAPA(C1=__builtin_amdgcn_mfma_f32_32x32x16_bf16(kf[7],qr[3],C1,0,0,0),   P1[14],P1[15],0.f,0.f,       pw3[2]=PKW(P1,12),pw3[3]=PKW(P1,14), pw3); \
    l_reg+=sacc; \
    if(GK){DMA_K((t)+3,sl_cur);} if(GV){DMA_V((t)+1,sl_next);} \
    CMASK(C0,C1,t); \
    { float a=MX3(C0[0],C0[1],C1[0]),b=MX3(C0[2],C0[3],C1[1]); a=MX3(a,C1[2],C1[3]); \
      _Pragma("unroll") for(int r=4;r<16;r+=4){a=MX3(a,C0[r],C0[r+1]);b=MX3(b,C0[r+2],C0[r+3]);a=MX3(a,C1[r],C1[r+1]);b=MX3(b,C1[r+2],C1[r+3]);} \
      float rm=__builtin_fmaxf(a,b); { auto rr=__builtin_amdgcn_permlane32_swap(__float_as_uint(rm),__float_as_uint(rm),false,false); rm=__builtin_fmaxf(__uint_as_float(rr[0]),__uint_as_float(rr[1])); } \
      resc=false; \
      if(__builtin_expect(__any(rm>(float)THRL),0)){ const float dl=__builtin_fmaxf(rm,0.f); mhat+=dl; \
        _Pragma("unroll") for(int r=0;r<16;++r){C0[r]-=dl;C1[r]-=dl;} \
        const float f=__builtin_amdgcn_exp2f(-dl); l_reg*=f; if(hi==0)wsf[r32]=f; resc=true; } } \
    SBAR(); \
    GAPB(o[0]=__builtin_amdgcn_mfma_f32_32x32x16_bf16(PAF(0),VFR(0),o[0],0,0,0), C0,0); \
    GAPB(o[1]=__builtin_amdgcn_mfma_f32_32x32x16_bf16(PAF(0),VFR(4),o[1],0,0,0), C0,4); \
    KRD(GL,0); GAPB(o[0]=__builtin_amdgcn_mfma_f32_32x32x16_bf16(PAF(1),VFR(1),o[0],0,0,0), C0,8); \
    KRD(GL,1); GAPB(o[1]=__builtin_amdgcn_mfma_f32_32x32x16_bf16(PAF(1),VFR(5),o[1],0,0,0), C0,12); \
    KRD(GL,2); GAPB(o[0]=__builtin_amdgcn_mfma_f32_32x32x16_bf16(PAF(2),VFR(2),o[0],0,0,0), C1,0); \
    KRD(GL,3); GAPB(o[1]=__builtin_amdgcn_mfma_f32_32x32x16_bf16(PAF(2),VFR(6),o[1],0,0,0), C1,4); \
    GAPB(o[0]=__builtin_amdgcn_mfma_f32_32x32x16_bf16(PAF(3),VFR(3),o[0],0,0,0), C1,8); \
    GAPB(o[1]=__builtin_amdgcn_mfma_f32_32x32x16_bf16(PAF(3),VFR(7),o[1],0,0,0), C1,12); \
    }while(0)
  int t=1;
  #undef CMASK
  #define CMASK(P0,P1,t) do{}while(0)
  for(;t+5<NT;t+=2){
    STEP(pB0,pB1,pA0,pA1,t,true,true,true);     WAIT_BAR(2); RESC(); ROT();
    STEP(pA0,pA1,pB0,pB1,t+1,true,true,true);   WAIT_BAR(2); RESC(); ROT();
  }
  #undef CMASK
  #define CMASK(P0,P1,t) do{int jb_=(t)-(NT-4); if(jb_>=0)cmask(P0,P1,jb_,qrel,hi);}while(0)
  #define ENDW(tt) do{ if((tt)+3<NT){WAIT_BAR(2);} else if((tt)+2<NT){WAIT_BAR(1);} else {WAIT_BAR(0);} }while(0)
  for(;t+1<NT;t+=2){
    STEP(pB0,pB1,pA0,pA1,t,(t+3<NT),(t+1<NT),(t+1<NT));       ENDW(t);   RESC(); ROT();
    STEP(pA0,pA1,pB0,pB1,t+1,(t+4<NT),(t+2<NT),(t+2<NT));     ENDW(t+1); RESC(); ROT();
  }
  STEP(pB0,pB1,pA0,pA1,NT-1,false,false,false); RESC();
  { float sacc=pB0[0]+pB0[1]; _Pragma("unroll") for(int r=2;r<16;++r)sacc+=pB0[r]; _Pragma("unroll") for(int r=0;r<16;++r)sacc+=pB1[r]; l_reg+=sacc;
    pw0=(u32x4){PKW(pB0,0),PKW(pB0,2),PKW(pB0,4),PKW(pB0,6)};pw1=(u32x4){PKW(pB0,8),PKW(pB0,10),PKW(pB0,12),PKW(pB0,14)};pw2=(u32x4){PKW(pB1,0),PKW(pB1,2),PKW(pB1,4),PKW(pB1,6)};pw3=(u32x4){PKW(pB1,8),PKW(pB1,10),PKW(pB1,12),PKW(pB1,14)};
    SBAR(); pv(o,vb0+sl_cur,PAF(0),PAF(1),PAF(2),PAF(3)); }
  #undef PKW
  #undef PAF
  #undef VFR
  #undef PIN
  #undef MX3
  #undef GAPA
  #undef GAPB
  #undef EX
  #undef VRD
  #undef KRD
  #undef STEP
  #undef ENDW
  {auto rr=__builtin_amdgcn_permlane32_swap(__float_as_uint(l_reg),__float_as_uint(l_reg),false,false);l_reg=__uint_as_float(rr[0])+__uint_as_float(rr[1]);}
  if(hi==0)wsf[32+r32]=l_reg;asm volatile("s_waitcnt lgkmcnt(0)":::"memory");
  float rli[16];
  #pragma unroll
  for(int r=0;r<16;++r)rli[r]=__builtin_amdgcn_rcpf(wsf[32+crow(r,hi)]);
  bf16*Ow=O+(rowbase+q0+wid*QBLK)*DM+h*D;
  { bf16*stg=(bf16*)(shm+LDS_OST)+wid*2048;
    #pragma unroll
    for(int r=0;r<16;++r){const int orow=crow(r,hi);
      #pragma unroll
      for(int d0=0;d0<2;++d0)stg[orow*64+d0*32+r32]=__float2bfloat16(o[d0][r]*rli[r]);}
    asm volatile("s_waitcnt lgkmcnt(0)":::"memory");
    #pragma unroll
    for(int i=0;i<4;++i){const int row=i*8+(lane>>3),ch=lane&7; const u32x4 v=*(const u32x4*)(stg+row*64+ch*8); ATTN_STORE16(Ow+(long)row*DM+ch*8,v);} }
  asm volatile("s_waitcnt lgkmcnt(0)\n\ts_barrier":::"memory");
  #undef DMA_K
  #undef DMA_V
  #undef CMASK
  #undef START
  #undef RESC
  #undef ROT
  #undef BIASINIT
}
constexpr int ATTN_LDS_BYTES=LDS_BYTES;
struct AttnTensors { const bf16* Q; const bf16* K; const bf16* V; bf16* O; const float* CS; };
struct AttnUnit { int bh; int qb; };
struct StaticOrder {
  int vcu;
  __device__ __forceinline__ explicit StaticOrder(int grid,int block):vcu((block%8)*(grid/8)+block/8){}
  __device__ __forceinline__ bool next(int i,AttnUnit&u)const{ if(i>=4)return false; const int s=vcu&7; u.bh=vcu>>3; u.qb=(i==0)?s:(i==1)?15-s:(i==2)?16+s:31-s; return true; }
  __device__ __forceinline__ void a_ready(const AttnUnit&)const{}
  __device__ __forceinline__ void done(const AttnUnit&)const{}
};
template<class Sched,int THRL=8> __device__ __forceinline__ void attn_phase(char*lds,const AttnTensors&T,const Sched&S,const int tid_in){
  AttnUnit u;
  for(int i=0;S.next(i,u);++i){ S.a_ready(u); attn_unit<THRL>(u.bh/NHEAD,u.bh%NHEAD,u.qb,T.Q,T.K,T.V,T.O,T.CS,lds,tid_in); S.done(u); }
}
#undef SBAR
#undef WAIT_BAR
}
namespace cg = cooperative_groups;
constexpr int NWAVES = 8;
constexpr int DM = 1024, FF = 2816, NH = 16, SEQ = 8192, NMETA = 16, DEPTH = 4;
constexpr int MMAIN = 2 * SEQ;
constexpr int MROWS = MMAIN + NMETA;
constexpr int MPAD = 65 * 256;
constexpr int KVROWS = attn_body::KVROWS;
constexpr float EPS = 1e-6f, LOG2E = 1.4426950408889634f;

constexpr size_t MiB = 1u << 20;
constexpr size_t SZ_GU = (size_t)5632 * 1024 * 2, SZ_DN = (size_t)1024 * 2816 * 2;
constexpr size_t WS_WGU = 1 * MiB, WS_WDN = WS_WGU + 8 * SZ_GU;
constexpr size_t WS_WAI = WS_WDN + 8 * SZ_DN, WS_WAO = WS_WAI + 2 * 6 * MiB, WS_WBI = WS_WAO + 2 * 2 * MiB, WS_WBO = WS_WBI + 4 * MiB;
constexpr size_t WS_WCI = WS_WBO + 2 * MiB, WS_WCO = WS_WCI + 6 * MiB, WS_WF = WS_WCO + 2 * MiB;
constexpr size_t WS_XN = WS_WF + 1 * MiB;
constexpr size_t SZ_ROWBUF = (size_t)MPAD * 1024 * 2;
constexpr size_t WS_ACT = WS_XN + 33 * MiB;
constexpr size_t WS_HMETA = WS_ACT + 98 * MiB, WS_LF = WS_HMETA + 1 * MiB, WS_LFM = WS_LF + 1 * MiB, WS_CS = WS_LFM + 1 * MiB, WS_END = WS_CS + 2 * MiB;
static_assert(SZ_ROWBUF <= 33 * MiB && 3 * SZ_ROWBUF <= 98 * MiB && (size_t)MPAD * FF * 2 <= 98 * MiB, "ws map");

constexpr int RING_BYTES = 131072, LDS_BYTES = 147456;
static_assert(attn_body::ATTN_LDS_BYTES <= RING_BYTES, "attention LDS");

#define GAS __attribute__((address_space(1)))
#define LAS __attribute__((address_space(3)))
typedef unsigned short bf16;
typedef unsigned v4u __attribute__((ext_vector_type(4)));
typedef unsigned v2u __attribute__((ext_vector_type(2)));
typedef float f32x4 __attribute__((ext_vector_type(4)));
typedef float f32x2 __attribute__((ext_vector_type(2)));
typedef short bf16x8 __attribute__((ext_vector_type(8)));
#define LDS_WAIT() asm volatile("s_waitcnt lgkmcnt(0)" ::: "memory")
__device__ __forceinline__ unsigned f2bf(float f) { unsigned u = __builtin_bit_cast(unsigned, f); return (u + 0x7fffu + ((u >> 16) & 1u)) >> 16; }
__device__ __forceinline__ unsigned pk2(float lo, float hi) { return f2bf(lo) | (f2bf(hi) << 16); }
__device__ __forceinline__ float bflo(unsigned w) { return __builtin_bit_cast(float, w << 16); }
__device__ __forceinline__ float bfhi(unsigned w) { return __builtin_bit_cast(float, w & 0xffff0000u); }
__device__ __forceinline__ float lane_get(float v, int src_lane) { return __builtin_bit_cast(float, __builtin_amdgcn_ds_bpermute(src_lane << 2, __builtin_bit_cast(int, v))); }
__device__ __forceinline__ float wave_sum(float v, int lane) {
#pragma unroll
    for (int o = 1; o < 64; o <<= 1) v += lane_get(v, lane ^ o);
    return v;
}

struct Args {
    const float* x; const float* meta; const float* ffn_norm; const float* ffn_w_gate; const float* ffn_w_up; const float* ffn_w_down; const float* mix_norm;
    const float* a_w_in; const float* a_conv; const float* a_w_out;
    const float* b_w_in; const float* b_conv; const float* b_conv_bias; const float* b_ln_g; const float* b_ln_b; const float* b_w_out;
    const float* c_w_in; const float* c_b_f; const float* c_q_norm; const float* c_k_norm; const float* c_w_out;
    float* out; unsigned char* ws;
};

__device__ __forceinline__ void transpose_item(const float* src, int Nsrc, bf16* dst, int K, int kb, LAS float* scr, int lane) {
    const int k0 = 64 * kb;
#pragma unroll 8
    for (int i = 0; i < 32; ++i) { const int kk = 2 * i + (lane >> 5); scr[kk * 33 + (lane & 31)] = src[(size_t)(k0 + kk) * Nsrc + (lane & 31)]; }
    LDS_WAIT(); asm volatile("" ::: "memory");
    const int c = lane & 7;
#pragma unroll
    for (int j = 0; j < 4; ++j) { const int n = (lane >> 3) + 8 * j; const LAS float* s = scr + (8 * c) * 33 + n;
        v4u o; o.x = pk2(s[0 * 33], s[1 * 33]); o.y = pk2(s[2 * 33], s[3 * 33]); o.z = pk2(s[4 * 33], s[5 * 33]); o.w = pk2(s[6 * 33], s[7 * 33]);
        *(GAS v4u*)(dst + (size_t)n * K + k0 + 8 * c) = o; }
    LDS_WAIT(); asm volatile("" ::: "memory");
}

__device__ __forceinline__ void rms_row(const float* xrow, const float* g, bf16* orow, float* hcopy, int lane) {
    const GAS f32x4* xr = (const GAS f32x4*)xrow + lane;
    f32x4 v[4]; float s = 0.f;
#pragma unroll
    for (int j = 0; j < 4; ++j) { v[j] = xr[64 * j]; s += (v[j].x * v[j].x + v[j].y * v[j].y) + (v[j].z * v[j].z + v[j].w * v[j].w); }
    const float rs = 1.0f / sqrtf(wave_sum(s, lane) * (1.f / DM) + EPS);
    if (hcopy) { GAS f32x4* hr = (GAS f32x4*)hcopy + lane;
#pragma unroll
        for (int j = 0; j < 4; ++j) hr[64 * j] = v[j]; }
    const GAS f32x4* gr = (const GAS f32x4*)g + lane;
    GAS unsigned long long* o8 = (GAS unsigned long long*)orow + lane;
#pragma unroll
    for (int j = 0; j < 4; ++j) { const f32x4 gg = gr[64 * j]; const f32x4 y = v[j] * rs * gg;
        o8[64 * j] = (unsigned long long)pk2(y.x, y.y) | ((unsigned long long)pk2(y.z, y.w) << 32); }
}

__global__ void __launch_bounds__(NWAVES * 64, 2) fwd_megakernel(Args a) {
    extern __shared__ __attribute__((aligned(16))) unsigned char lds[];
    cg::grid_group grid = cg::this_grid();
    const int G = gridDim.x, bx = blockIdx.x;
    const int vcu = (G % 8 == 0) ? (bx % 8) * (G / 8) + bx / 8 : bx;
    const int NGW = G * NWAVES;
    const int wave_s = __builtin_amdgcn_readfirstlane((int)threadIdx.x >> 6);
#define PHASE_ENV() \
    unsigned zero_ = 0u; asm volatile("" : "+s"(zero_)); \
    int tid = (wave_s << 6) | (int)__builtin_amdgcn_mbcnt_hi(~0u, __builtin_amdgcn_mbcnt_lo(~0u, zero_)); \
    const int lane = tid & 63, wave = __builtin_amdgcn_readfirstlane(tid >> 6), gw = vcu * NWAVES + wave; \
    unsigned char* ws0_ = a.ws; asm volatile("" : "+s"(ws0_)); unsigned char* const ws = (unsigned char*)(GAS unsigned char*)ws0_;     \
    float* hm0_ = a.out; asm volatile("" : "+s"(hm0_)); float* const hmain = (float*)(GAS float*)hm0_; \
    bf16* const WGU = (bf16*)(ws + WS_WGU); bf16* const WDN = (bf16*)(ws + WS_WDN); \
    bf16* const WAI = (bf16*)(ws + WS_WAI); bf16* const WAO = (bf16*)(ws + WS_WAO); bf16* const WBI = (bf16*)(ws + WS_WBI); bf16* const WBO = (bf16*)(ws + WS_WBO); \
    bf16* const WCI = (bf16*)(ws + WS_WCI); bf16* const WCO = (bf16*)(ws + WS_WCO); bf16* const WFt = (bf16*)(ws + WS_WF); \
    bf16* const XN = (bf16*)(ws + WS_XN); \
    bf16* const R0 = (bf16*)(ws + WS_ACT); bf16* const R1 = (bf16*)(ws + WS_ACT + SZ_ROWBUF); bf16* const R2 = (bf16*)(ws + WS_ACT + 2 * SZ_ROWBUF); \
    float* const hmeta = (float*)(ws + WS_HMETA); \
    float* const LF = (float*)(ws + WS_LF); float* const LFM = (float*)(ws + WS_LFM); float* const CS = (float*)(ws + WS_CS); \
    LAS unsigned char* const ldsl = (LAS unsigned char*)lds; \
    (void)WGU; (void)WDN; (void)WAI; (void)WAO; (void)WBI; (void)WBO; (void)WCI; (void)WCO; (void)WFt; (void)XN; (void)R0; (void)R1; (void)R2; (void)hmeta; (void)LF; (void)LFM; (void)CS; (void)ldsl; (void)lane; (void)gw; (void)hmain;

    {
        PHASE_ENV();
        LAS float* scr = (LAS float*)(ldsl + wave * 16384);
        constexpr int I_GU = 176 * 16, I_DN = 32 * 44, I_AI = 96 * 16, I_SQ = 32 * 16, I_BI = 64 * 16, I_CI = 96 * 16;
        constexpr int NITEMS = 8 * I_GU + 8 * I_DN + 2 * I_AI + 2 * I_SQ + I_BI + I_SQ + I_CI + I_SQ;
        for (int it = gw; it < NITEMS; it += NGW) {
            int r = it;
            if (r < 8 * I_GU) { const int mat = r / I_GU; r %= I_GU; const int kb = r / 176, nb = r % 176, pn = nb >> 3, q = nb & 7;
                const float* src = ((q < 4) ? a.ffn_w_gate : a.ffn_w_up) + (size_t)mat * 1024 * FF + 128 * pn + 32 * (q & 3);
                transpose_item(src, FF, WGU + (size_t)mat * 5632 * 1024 + (size_t)nb * 32 * 1024, 1024, kb, scr, lane); continue; }
            r -= 8 * I_GU;
            if (r < 8 * I_DN) { const int mat = r / I_DN; r %= I_DN; const int kb = r / 32, nb = r % 32;
                transpose_item(a.ffn_w_down + (size_t)mat * FF * 1024 + 32 * nb, 1024, WDN + (size_t)mat * 1024 * FF + (size_t)nb * 32 * FF, FF, kb, scr, lane); continue; }
            r -= 8 * I_DN;
            if (r < 2 * I_AI) { const int mat = r / I_AI; r %= I_AI; const int kb = r / 96, nb = r % 96, pn = nb >> 3, q = nb & 7;
                const int scol = (pn < 8) ? ((q < 4) ? 1024 + 128 * pn + 32 * q : 2048 + 128 * pn + 32 * (q - 4)) : (nb - 64) * 32;
                transpose_item(a.a_w_in + (size_t)mat * 1024 * 3072 + scol, 3072, WAI + (size_t)mat * 3072 * 1024 + (size_t)nb * 32 * 1024, 1024, kb, scr, lane); continue; }
            r -= 2 * I_AI;
            if (r < 2 * I_SQ) { const int mat = r / I_SQ; r %= I_SQ; const int kb = r / 32, nb = r % 32;
                transpose_item(a.a_w_out + (size_t)mat * 1024 * 1024 + 32 * nb, 1024, WAO + (size_t)mat * 1024 * 1024 + (size_t)nb * 32 * 1024, 1024, kb, scr, lane); continue; }
            r -= 2 * I_SQ;
            if (r < I_BI) { const int kb = r / 64, nb = r % 64, pn = nb >> 3, q = nb & 7;
                const int scol = (q < 4) ? 128 * pn + 32 * q : 1024 + 128 * pn + 32 * (q - 4);
                transpose_item(a.b_w_in + scol, 2048, WBI + (size_t)nb * 32 * 1024, 1024, kb, scr, lane); continue; }
            r -= I_BI;
            if (r < I_SQ) { const int kb = r / 32, nb = r % 32;
                transpose_item(a.b_w_out + 32 * nb, 1024, WBO + (size_t)nb * 32 * 1024, 1024, kb, scr, lane); continue; }
            r -= I_SQ;
            if (r < I_CI) { const int kb = r / 96, nb = r % 96, pn = nb >> 3, q = nb & 7;
                const int scol = (pn < 8) ? (pn >> 2) * 1024 + 64 * (4 * (pn & 3) + (q & 3)) + 32 * (q >> 2) : 2048 + (nb - 64) * 32;
                transpose_item(a.c_w_in + scol, 3088, WCI + (size_t)nb * 32 * 1024, 1024, kb, scr, lane); continue; }
            r -= I_CI;
            { const int kb = r / 32, nb = r % 32;
                transpose_item(a.c_w_out + 32 * nb, 1024, WCO + (size_t)nb * 32 * 1024, 1024, kb, scr, lane); }
        }
        for (int i = gw * 64 + lane; i < 16 * 1024; i += NGW * 64) { const int h = i >> 10, k = i & 1023; WFt[i] = (bf16)f2bf(a.c_w_in[(size_t)k * 3088 + 3072 + h]); }
        for (int m = gw; m < MROWS; m += NGW) {
            const float* src = (m < MMAIN) ? a.x + (size_t)m * DM : a.meta + (size_t)(m - MMAIN) * DM;
            float* hc = (m < MMAIN) ? hmain + (size_t)m * DM : hmeta + (size_t)(m - MMAIN) * DM;
            rms_row(src, a.ffn_norm, XN + (size_t)m * DM, hc, lane);
        }
    }
    grid.sync();

    for (int L = 0; L < DEPTH; ++L) {
        const int mx = L % 3, mj = L / 3;
        for (int s = 0; s <= 10; ++s) {
            if ((s == 6 && mx != 2) || (s == 0 && L == 0)) continue;
            PHASE_ENV();
            if (s == 0 || s == 3 || s == 8) {
                const float* g = (s == 3) ? a.mix_norm + (size_t)L * DM : a.ffn_norm + (size_t)(L * 2 + (s == 8)) * DM;
                for (int m = gw; m < MROWS; m += NGW) {
                    const float* src = (m < MMAIN) ? hmain + (size_t)m * DM : hmeta + (size_t)(m - MMAIN) * DM;
                    rms_row(src, g, XN + (size_t)m * DM, nullptr, lane);
                }
                if (s == 3 && mx == 2) {
                    for (int i = gw; i < 2 * 2 * 112; i += NGW) { const int tsel = i / 224, rr = i % 224, b = rr / 112, j = rr % 112; const int row = b * KVROWS + (j < 48 ? j : j + 16);
                        bf16* p = (tsel ? R2 : R1) + (size_t)row * 1024; ((GAS v4u*)p)[lane * 2] = (v4u){0u, 0u, 0u, 0u}; ((GAS v4u*)p)[lane * 2 + 1] = (v4u){0u, 0u, 0u, 0u}; }
                }
            } else if (s == 1 || s == 2 || s == 4 || s == 7 || s == 9 || s == 10) {
                pg8::Gemm g; pg8::EpiAll E;
                E.mtiles_main = 64; E.O1 = R0; E.O2 = R1; E.O3 = R2; E.ldo = 1024; E.hmain = hmain; E.hmeta = hmeta; E.scale = 1.f; E.qg = a.c_q_norm; E.kg = a.c_k_norm; E.mode = 0;
                g.M = MPAD;
                if (s == 1 || s == 9) { g.A = XN; g.Bt = WGU + (size_t)(L * 2 + (s == 9)) * 5632 * 1024; g.N = 5632; g.K = 1024; E.mode = 0; E.ldo = FF; }
                else if (s == 2 || s == 10) { g.A = R0; g.Bt = WDN + (size_t)(L * 2 + (s == 10)) * 1024 * FF; g.N = 1024; g.K = FF; E.mode = 4; E.scale = 0.5f; }
                else if (s == 4) {
                    g.A = XN; g.K = 1024;
                    if (mx == 0) { g.Bt = WAI + (size_t)mj * 3072 * 1024; g.N = 3072; E.mode = 2; }
                    else if (mx == 1) { g.Bt = WBI; g.N = 2048; E.mode = 1; }
                    else { g.Bt = WCI; g.N = 3072; E.mode = 3;
                        const int fr = lane & 15, fq = lane >> 4;
                        for (int grp = gw; grp < MROWS / 16; grp += NGW) {
                            const bf16* xp = XN + (size_t)(16 * grp + fr) * DM + 8 * fq; const bf16* wp = WFt + (size_t)fr * DM + 8 * fq;
                            f32x4 acc = {0.f, 0.f, 0.f, 0.f};
#pragma unroll 8
                            for (int k = 0; k < 32; ++k) { const bf16x8 xa = *(const GAS bf16x8*)(xp + 32 * k), wb = *(const GAS bf16x8*)(wp + 32 * k);
                                acc = __builtin_amdgcn_mfma_f32_16x16x32_bf16(xa, wb, acc, 0, 0, 0); }
                            const float bf = a.c_b_f[fr]; f32x4 o;
#pragma unroll
                            for (int r = 0; r < 4; ++r) { const float xv = acc[r] + bf; o[r] = fminf(xv, 0.f) - log1pf(expf(-fabsf(xv))); }
                            if (grp < MMAIN / 16) { const int r0 = 16 * grp, b = r0 >> 13, t0 = r0 & 8191; *(GAS f32x4*)(LF + ((size_t)(b * NH + fr) * SEQ + t0 + 4 * fq)) = o; }
                            else *(GAS f32x4*)(LFM + fr * 16 + 4 * fq) = o;
                        }
                        asm volatile("s_waitcnt vmcnt(0) lgkmcnt(0)" ::: "memory"); __syncthreads();
                    }
                }
                else { g.K = 1024; g.N = 1024; E.mode = 4; E.scale = 1.f;
                    if (mx == 0) { g.A = R2; g.Bt = WAO + (size_t)mj * 1024 * 1024; } else if (mx == 1) { g.A = R1; g.Bt = WBO; } else { g.A = R0; g.Bt = WCO; } }
                pg8::StaticOrder S; S.init(g.M, g.N, G, bx);
#ifndef NO_GEMM
                pg8::gemm_phase<pg8::EpiAll, pg8::StaticOrder, PG8_ALIGN, PG8_SP2>(ldsl, g, S, E, tid);
#endif
            } else if (s == 5) {
                if (mx == 0) {
                    const float* cw = a.a_conv + (size_t)mj * 3 * DM + 16 * lane;
                    f32x4 w0[4], w1[4], w2[4];
#pragma unroll
                    for (int j = 0; j < 4; ++j) { w0[j] = *(const f32x4*)(cw + 4 * j); w1[j] = *(const f32x4*)(cw + DM + 4 * j); w2[j] = *(const f32x4*)(cw + 2 * DM + 4 * j); }
                    for (int r = gw; r < MROWS; r += NGW) {
                        int r1, r2;
                        if (r < MMAIN) { const int t = r & 8191; r1 = (t >= 1) ? r - 1 : MMAIN + 15; r2 = (t >= 2) ? r - 2 : MMAIN + 14 + t; }
                        else { const int p = r - MMAIN; r1 = (p >= 1) ? r - 1 : -1; r2 = (p >= 2) ? r - 2 : -1; }
                        const v4u z4 = {0u, 0u, 0u, 0u};
                        const GAS v4u* c0p = (const GAS v4u*)(R0 + (size_t)r * DM) + 2 * lane; const GAS v4u* bp = (const GAS v4u*)(R1 + (size_t)r * DM) + 2 * lane;
                        v4u x0[2], x1[2], x2[2], bb[2];
#pragma unroll
                        for (int hh = 0; hh < 2; ++hh) { x0[hh] = c0p[hh]; bb[hh] = bp[hh];
                            x1[hh] = (r1 >= 0) ? ((const GAS v4u*)(R0 + (size_t)r1 * DM) + 2 * lane)[hh] : z4; x2[hh] = (r2 >= 0) ? ((const GAS v4u*)(R0 + (size_t)r2 * DM) + 2 * lane)[hh] : z4; }
                        GAS v4u* yp = (GAS v4u*)(R2 + (size_t)r * DM) + 2 * lane;
#pragma unroll
                        for (int hh = 0; hh < 2; ++hh) { v4u o;
#pragma unroll
                            for (int e = 0; e < 4; ++e) { const int j = 2 * hh + (e >> 1), c = 2 * (e & 1);
                                const float lo = bflo(bb[hh][e]) * (w2[j][c] * bflo(x0[hh][e]) + w1[j][c] * bflo(x1[hh][e]) + w0[j][c] * bflo(x2[hh][e]));
                                const float hi = bfhi(bb[hh][e]) * (w2[j][c + 1] * bfhi(x0[hh][e]) + w1[j][c + 1] * bfhi(x1[hh][e]) + w0[j][c + 1] * bfhi(x2[hh][e]));
                                o[e] = pk2(lo, hi); }
                            yp[hh] = o; }
                    }
                } else if (mx == 1) {
#ifndef NO_CONF
                    const int c = 2 * tid;
                    f32x2 w[31];
#pragma unroll
                    for (int k = 0; k < 31; ++k) w[k] = *(const GAS f32x2*)(a.b_conv + (size_t)k * DM + c);
                    const f32x2 cb = *(const f32x2*)(a.b_conv_bias + c), lg = *(const f32x2*)(a.b_ln_g + c), lb = *(const f32x2*)(a.b_ln_b + c);
                    LAS float* red = (LAS float*)ldsl;
                    LAS float* red2 = red + 256;
                    for (int un = vcu; un < MROWS / 16; un += G) {
                        const int r0 = 16 * un; const bool meta = (r0 >= MMAIN);
                        const int p0 = meta ? 0 : 16 + (r0 & 8191); const int rowb = meta ? 0 : (r0 >> 13) * SEQ;
                        unsigned xin[46];
#pragma unroll
                        for (int j = 0; j < 46; ++j) { const int pj = p0 - 30 + j;
                            xin[j] = (pj >= 0) ? *(const GAS unsigned*)(R0 + (size_t)((pj < 16) ? MMAIN + pj : rowb + pj - 16) * DM + c) : 0u; }
                        f32x2 acc[16];
#pragma unroll
                        for (int i = 0; i < 16; ++i) acc[i] = cb;
#pragma unroll
                        for (int j = 0; j < 46; ++j) { const f32x2 xv = {bflo(xin[j]), bfhi(xin[j])};
#pragma unroll
                            for (int i = 0; i < 16; ++i) { const int k = j - i; if (k >= 0 && k <= 30) acc[i] += w[k] * xv; } }
                        float st[32];
#pragma unroll
                        for (int i = 0; i < 16; ++i) { st[2 * i] = acc[i].x + acc[i].y; st[2 * i + 1] = acc[i].x * acc[i].x + acc[i].y * acc[i].y; }
#pragma unroll
                        for (int i = 0; i < 32; ++i) st[i] = wave_sum(st[i], lane);
                        if (lane == 0) {
#pragma unroll
                            for (int i = 0; i < 8; ++i) *(LAS f32x4*)(red + wave * 32 + 4 * i) = (f32x4){st[4 * i], st[4 * i + 1], st[4 * i + 2], st[4 * i + 3]}; }
                        __syncthreads();
                        if (tid < 32) { float t = 0.f;
#pragma unroll
                            for (int wv = 0; wv < 8; ++wv) t += red[wv * 32 + tid];
                            red2[tid] = t; }
                        __syncthreads();
#pragma unroll
                        for (int i = 0; i < 16; ++i) { const f32x2 sv = *(const LAS f32x2*)(red2 + 2 * i);
                            const float mu = sv.x * (1.f / DM), var = fmaxf(sv.y * (1.f / DM) - mu * mu, 0.f), rs = 1.0f / sqrtf(var + EPS);
                            const float y0 = (acc[i].x - mu) * rs * lg.x + lb.x, y1 = (acc[i].y - mu) * rs * lg.y + lb.y;
                            *(GAS unsigned*)(R1 + (size_t)(r0 + i) * DM + c) = pk2(y0 * pg8::sigm(y0), y1 * pg8::sigm(y1)); }
                    }
#endif
                } else {
                    if (vcu < 32) {
                        const int bh = vcu, h = bh & 15; LAS float* wt = (LAS float*)ldsl;
                        float* csrow = CS + (size_t)bh * KVROWS;
                        float cm = 0.f, cmp = 0.f;
#pragma unroll
                        for (int j = 0; j < 16; ++j) { cm += LFM[h * 16 + j]; if (j == tid) cmp = cm; }
                        const float* lp = LF + (size_t)bh * SEQ + 16 * tid; float v[16];
#pragma unroll
                        for (int j = 0; j < 4; ++j) { const f32x4 q = *(const GAS f32x4*)(lp + 4 * j); v[4 * j] = q.x; v[4 * j + 1] = q.y; v[4 * j + 2] = q.z; v[4 * j + 3] = q.w; }
#pragma unroll
                        for (int j = 1; j < 16; ++j) v[j] += v[j - 1];
                        float inc = v[15];
#pragma unroll
                        for (int o = 1; o < 64; o <<= 1) { const float t = lane_get(inc, (lane - o) & 63); if (lane >= o) inc += t; }
                        if (lane == 63) wt[wave] = inc;
                        __syncthreads();
                        float off = cm + inc - v[15];
                        for (int wv = 0; wv < wave; ++wv) off += wt[wv];
#pragma unroll
                        for (int j = 0; j < 4; ++j) *(GAS f32x4*)(csrow + 128 + 16 * tid + 4 * j) = (f32x4){(off + v[4 * j]) * LOG2E, (off + v[4 * j + 1]) * LOG2E, (off + v[4 * j + 2]) * LOG2E, (off + v[4 * j + 3]) * LOG2E};
                        const float cmsh = lane_get(cmp, (lane + 16) & 63);
                        if (tid < 128) csrow[tid] = (tid >= 48 && tid < 64) ? cmsh * LOG2E : __builtin_inff();
                        __syncthreads();
                    }
                }
            } else if (s == 6) {
                const attn_body::AttnTensors AT{(const attn_body::bf16*)R0, (const attn_body::bf16*)R1, (const attn_body::bf16*)R2, (attn_body::bf16*)R0, CS};
                const attn_body::StaticOrder S(G, bx);
#ifndef NO_ATTN
                attn_body::attn_phase<attn_body::StaticOrder>((char*)lds, AT, S, tid);
#endif
                if (gw < NH) {
                    const int h = gw, q = lane & 15, dc = lane >> 4;
                    const bf16* qp = R0 + (size_t)(MMAIN + q) * DM + 64 * h + 16 * dc;
                    const v4u qa = ((const GAS v4u*)qp)[0], qb = ((const GAS v4u*)qp)[1];
                    float qv[16];
#pragma unroll
                    for (int e = 0; e < 4; ++e) { qv[2 * e] = bflo(qa[e]); qv[2 * e + 1] = bfhi(qa[e]); qv[8 + 2 * e] = bflo(qb[e]); qv[8 + 2 * e + 1] = bfhi(qb[e]); }
                    float mrun = -__builtin_inff(), l = 0.f, o[16];
#pragma unroll
                    for (int e = 0; e < 16; ++e) o[e] = 0.f;
                    for (int j = 0; j < 16; ++j) {
                        const bf16* kp = R1 + (size_t)(48 + j) * DM + 64 * h + 16 * dc; const bf16* vp = R2 + (size_t)(48 + j) * DM + 64 * h + 16 * dc;
                        const v4u ka = ((const GAS v4u*)kp)[0], kb = ((const GAS v4u*)kp)[1], va = ((const GAS v4u*)vp)[0], vb = ((const GAS v4u*)vp)[1];
                        float d = 0.f;
#pragma unroll
                        for (int e = 0; e < 4; ++e) d += qv[2 * e] * bflo(ka[e]) + qv[2 * e + 1] * bfhi(ka[e]) + qv[8 + 2 * e] * bflo(kb[e]) + qv[8 + 2 * e + 1] * bfhi(kb[e]);
                        d += lane_get(d, lane ^ 16); d += lane_get(d, lane ^ 32);
                        const float sc = d - *(const GAS float*)(CS + (size_t)h * KVROWS + 48 + j);
                        if (j <= q) { const float mn = fmaxf(mrun, sc), f = __builtin_amdgcn_exp2f(mrun - mn), p = __builtin_amdgcn_exp2f(sc - mn); l = l * f + p; mrun = mn;
#pragma unroll
                            for (int e = 0; e < 4; ++e) { o[2 * e] = o[2 * e] * f + p * bflo(va[e]); o[2 * e + 1] = o[2 * e + 1] * f + p * bfhi(va[e]); o[8 + 2 * e] = o[8 + 2 * e] * f + p * bflo(vb[e]); o[8 + 2 * e + 1] = o[8 + 2 * e + 1] * f + p * bfhi(vb[e]); } }
                    }
                    const float rl = 1.0f / l; v4u oa, ob;
#pragma unroll
                    for (int e = 0; e < 4; ++e) { oa[e] = pk2(o[2 * e] * rl, o[2 * e + 1] * rl); ob[e] = pk2(o[8 + 2 * e] * rl, o[8 + 2 * e + 1] * rl); }
                    GAS v4u* op = (GAS v4u*)(R0 + (size_t)(MMAIN + q) * DM + 64 * h + 16 * dc); op[0] = oa; op[1] = ob;
                }
            }
            grid.sync();
        }
    }
}

extern "C" void kernel_launch(void* const* d_in, const int* in_sizes, int n_in, void* d_out, int out_size, void* d_ws, size_t ws_size, hipStream_t stream) {
    static int grid = 0;
    if (grid == 0) {
        if (n_in != 21 || out_size != MMAIN * DM || ws_size < WS_END) { fprintf(stderr, "kernel_launch: unexpected shapes (n_in %d out %d ws %zu)\n", n_in, out_size, ws_size); grid = -1; return; }
        int dev = 0, cus = 0, per_cu = 0;
        hipGetDevice(&dev); hipDeviceGetAttribute(&cus, hipDeviceAttributeMultiprocessorCount, dev);
        if (hipFuncSetAttribute((const void*)fwd_megakernel, hipFuncAttributeMaxDynamicSharedMemorySize, LDS_BYTES) != hipSuccess) { fprintf(stderr, "kernel_launch: hipFuncSetAttribute failed\n"); grid = -1; return; }
        if (hipOccupancyMaxActiveBlocksPerMultiprocessor(&per_cu, (const void*)fwd_megakernel, NWAVES * 64, LDS_BYTES) != hipSuccess || per_cu < 1) { fprintf(stderr, "kernel_launch: occupancy query says %d\n", per_cu); per_cu = 1; }
        (void)hipGetLastError();
        grid = cus * 1;
        if (grid != 256) fprintf(stderr, "kernel_launch: grid %d (expected 256)\n", grid);
    }
    if (grid < 0) return;
    Args a{};
    const float** f = (const float**)&a;
    for (int i = 0; i < 21; ++i) f[i] = (const float*)d_in[i];
    a.out = (float*)d_out; a.ws = (unsigned char*)d_ws;
    void* args[] = {&a};
    hipError_t e = hipLaunchCooperativeKernel((const void*)fwd_megakernel, dim3(grid), dim3(NWAVES * 64), args, LDS_BYTES, stream);
    if (e != hipSuccess) fprintf(stderr, "cooperative launch failed: %s (grid %d)\n", hipGetErrorString(e), grid);
}
```

```cpp
#include <hip/hip_runtime.h>
#include <hip/hip_cooperative_groups.h>
#include <cstdio>
#include <cstdint>
namespace pg8 {
#define PG8_LAS __attribute__((address_space(3)))
typedef unsigned short bf16_t;
typedef short bf16x8 __attribute__((ext_vector_type(8)));
typedef float f32x4 __attribute__((ext_vector_type(4)));
typedef unsigned u32x4 __attribute__((ext_vector_type(4)));
constexpr int BM = 256, BK = 64, HALF = 128, HTB = HALF * BK * 2  , STAGE_BYTES = 8 * HTB, NXCD = 8, WGM = 8;

__host__ __device__ __forceinline__ int lds_byte(int r, int c) { const int st = (r >> 4) * 2 + (c >> 5), rr = r & 15, cc = c & 31, ob = rr * 64 + cc * 2; return st * 1024 + (ob ^ (((ob >> 9) & 1) << 5)); }
__host__ __device__ __forceinline__ void stage_rc(int b, int& R, int& C) { const int st = b / 1024, sb = b % 1024, swz = sb ^ (((sb >> 9) & 1) << 5); R = (st >> 1) * 16 + swz / 64; C = (st & 1) * 32 + (swz % 64) / 2; }
__host__ __device__ __forceinline__ int perm32(int rho) { const int n = rho >> 4, i = rho & 15; return 8 * (i >> 2) + 4 * n + (i & 3); }

struct Unit { int pm, pn; };
struct Gemm { const bf16_t* A; const bf16_t* Bt; int M, N, K; };

struct StaticOrder {
    int nM, nN, nwg, G, c;
    __host__ __device__ void init(int M, int N, int G_, int c_) { nM = M / BM; nN = N / BM; nwg = nM * nN; G = G_; c = c_; }
    __host__ __device__ bool next(int i, Unit& u) const {
        const long L = (long)i * G + c; if (L >= nwg) return false;
        int wgid = (int)L; { const int q = nwg / NXCD, r = nwg % NXCD, xcd = wgid % NXCD, off = wgid / NXCD; wgid = (xcd < r ? xcd * (q + 1) : r * (q + 1) + (xcd - r) * q) + off; }
        const int nig = WGM * nN, gid = wgid / nig, fm = gid * WGM, gsz = (nM - fm) < WGM ? (nM - fm) : WGM;
        u.pm = fm + ((wgid % nig) % gsz); u.pn = (wgid % nig) / gsz; return true;
    }
    __device__ __forceinline__ void a_ready(const Unit&) const {}
    __device__ __forceinline__ void done(const Unit&) const {}
};

__device__ __forceinline__ unsigned cvt_pk_bf16(float lo, float hi) { unsigned r; asm volatile("v_cvt_pk_bf16_f32 %0, %1, %2" : "=v"(r) : "v"(lo), "v"(hi)); return r; }
typedef float f32x2 __attribute__((ext_vector_type(2)));
__device__ __forceinline__ float sigm(float x) { return __builtin_amdgcn_rcpf(1.0f + __builtin_amdgcn_exp2f(-1.4426950408889634f * x)); }
constexpr float QK_C2 = 0.125f * 1.4426950408889634f;
#define PG8_GAS __attribute__((address_space(1)))
struct EpiAll {
    static constexpr bool PERM = true, AFTER_DRAIN = false;
    int mode;
    int mtiles_main;
    bf16_t* O1; bf16_t* O2; bf16_t* O3; int ldo;
    float* hmain; float* hmeta; float scale;
    const float* qg; const float* kg;
    __device__ __forceinline__ void operator()(const f32x4 (&acc)[2][2][4][2], const Unit& u, int wr, int wc, int fr, int fq) const {
        const int rloc_ = wr * 64 + fr;
#define EPI_LAUNDER() int rloc = rloc_; asm volatile("" : "+v"(rloc))
        if (mode <= 1 || (mode == 2 && u.pn < 8)) {
            EPI_LAUNDER();
            bf16_t* base = O1 + (size_t)(u.pm * BM + rloc) * ldo + u.pn * HALF + wc * 32 + 8 * fq;
#pragma unroll
            for (int ai = 0; ai < 2; ++ai)
#pragma unroll
                for (int m = 0; m < 4; ++m) {
                    const f32x4 a0 = acc[ai][0][m][0], a1 = acc[ai][0][m][1], b0 = acc[ai][1][m][0], b1 = acc[ai][1][m][1];
                    f32x4 r0, r1;
                    if (mode == 0) {
#pragma unroll
                        for (int i = 0; i < 4; ++i) { r0[i] = a0[i] * sigm(a0[i]) * b0[i]; r1[i] = a1[i] * sigm(a1[i]) * b1[i]; }
                    } else if (mode == 1) {
#pragma unroll
                        for (int i = 0; i < 4; ++i) { r0[i] = a0[i] * sigm(b0[i]); r1[i] = a1[i] * sigm(b1[i]); }
                    } else { r0 = a0 * b0; r1 = a1 * b1; }
                    u32x4 w; w.x = cvt_pk_bf16(r0[0], r0[1]); w.y = cvt_pk_bf16(r0[2], r0[3]); w.z = cvt_pk_bf16(r1[0], r1[1]); w.w = cvt_pk_bf16(r1[2], r1[3]);
                    *(PG8_GAS u32x4*)(base + (size_t)(ai * HALF + m * 16) * ldo) = w;
                }
        } else if (mode == 2) {
            EPI_LAUNDER();
            bf16_t* base = O2 + (size_t)(u.pm * BM + rloc) * 1024 + (u.pn - 8) * BM + wc * 32 + 8 * fq;
#pragma unroll
            for (int ai = 0; ai < 2; ++ai)
#pragma unroll
                for (int m = 0; m < 4; ++m)
#pragma unroll
                    for (int bj = 0; bj < 2; ++bj) {
                        const f32x4 v0 = acc[ai][bj][m][0], v1 = acc[ai][bj][m][1];
                        u32x4 w; w.x = cvt_pk_bf16(v0[0], v0[1]); w.y = cvt_pk_bf16(v0[2], v0[3]); w.z = cvt_pk_bf16(v1[0], v1[1]); w.w = cvt_pk_bf16(v1[2], v1[3]);
                        *(PG8_GAS u32x4*)(base + (size_t)(ai * HALF + m * 16) * 1024 + bj * HALF) = w;
                    }
        } else if (mode == 3) {
            EPI_LAUNDER();
            const int sec = u.pn >> 2;
            const bool meta = false;
            const long krow0 = meta ? 48 : (long)u.pm * BM + 128 * (1 + (u.pm >> 5));
            bf16_t* dst = (sec == 0) ? O1 + (size_t)(u.pm * BM) * 1024 : ((sec == 1) ? O2 : O3) + (size_t)krow0 * 1024;
            const bool dup = meta && sec != 0; const int rlim = dup ? 16 : 256;
            if (sec < 2) {
                const int head = 4 * (u.pn & 3) + wc;
                const int lxor16 = (fr + 16 * (fq ^ 1)) << 2, lxor32 = (fr + 16 * (fq ^ 2)) << 2;
                const float* g = (sec == 0) ? qg : kg; const float gs = (sec == 0) ? QK_C2 : 1.0f;
                f32x4 gv[2][2];
#pragma unroll
                for (int bj = 0; bj < 2; ++bj)
#pragma unroll
                    for (int n = 0; n < 2; ++n) gv[bj][n] = *(const PG8_GAS f32x4*)(g + 32 * bj + 8 * fq + 4 * n) * gs;
#pragma unroll
                for (int ai = 0; ai < 2; ++ai)
#pragma unroll
                    for (int m = 0; m < 4; ++m) {
                        float ss = 0.f;
#pragma unroll
                        for (int bj = 0; bj < 2; ++bj)
#pragma unroll
                            for (int n = 0; n < 2; ++n) { const f32x4 x = acc[ai][bj][m][n]; ss += (x[0] * x[0] + x[1] * x[1]) + (x[2] * x[2] + x[3] * x[3]); }
                        ss += __builtin_bit_cast(float, __builtin_amdgcn_ds_bpermute(lxor16, __builtin_bit_cast(int, ss))); ss += __builtin_bit_cast(float, __builtin_amdgcn_ds_bpermute(lxor32, __builtin_bit_cast(int, ss)));
                        const float rs = __builtin_amdgcn_rsqf(ss * (1.0f / 64.0f) + 1e-6f);
                        const int rl = rloc + ai * HALF + m * 16;
#pragma unroll
                        for (int bj = 0; bj < 2; ++bj) {
                            const f32x4 v0 = acc[ai][bj][m][0] * rs * gv[bj][0], v1 = acc[ai][bj][m][1] * rs * gv[bj][1];
                            u32x4 w; w.x = cvt_pk_bf16(v0[0], v0[1]); w.y = cvt_pk_bf16(v0[2], v0[3]); w.z = cvt_pk_bf16(v1[0], v1[1]); w.w = cvt_pk_bf16(v1[2], v1[3]);
                            const int col = 64 * head + 32 * bj + 8 * fq;
                            if (rl < rlim) { *(PG8_GAS u32x4*)(dst + (size_t)rl * 1024 + col) = w; if (dup) *(PG8_GAS u32x4*)(dst + (size_t)(8320 + rl) * 1024 + col) = w; }
                        }
                    }
            } else {
#pragma unroll
                for (int ai = 0; ai < 2; ++ai)
#pragma unroll
                    for (int m = 0; m < 4; ++m) {
                        const int rl = rloc + ai * HALF + m * 16;
#pragma unroll
                        for (int bj = 0; bj < 2; ++bj) {
                            const f32x4 v0 = acc[ai][bj][m][0], v1 = acc[ai][bj][m][1];
                            u32x4 w; w.x = cvt_pk_bf16(v0[0], v0[1]); w.y = cvt_pk_bf16(v0[2], v0[3]); w.z = cvt_pk_bf16(v1[0], v1[1]); w.w = cvt_pk_bf16(v1[2], v1[3]);
                            const int col = (u.pn - 8) * BM + bj * HALF + wc * 32 + 8 * fq;
                            if (rl < rlim) { *(PG8_GAS u32x4*)(dst + (size_t)rl * 1024 + col) = w; if (dup) *(PG8_GAS u32x4*)(dst + (size_t)(8320 + rl) * 1024 + col) = w; }
                        }
                    }
            }
        } else {
            EPI_LAUNDER();
            float* base = hmain + (size_t)(u.pm * BM + rloc) * 1024 + u.pn * BM + wc * 32 + 8 * fq;
            const float sc = scale;
#pragma unroll
            for (int ai = 0; ai < 2; ++ai)
#pragma unroll
                for (int m = 0; m < 4; ++m)
#pragma unroll
                    for (int bj = 0; bj < 2; ++bj) {
                        float* p = base + (size_t)(ai * HALF + m * 16) * 1024 + bj * HALF;
                        f32x4 x0 = *(const PG8_GAS f32x4*)p, x1 = *(const PG8_GAS f32x4*)(p + 4);
                        x0 += acc[ai][bj][m][0] * sc; x1 += acc[ai][bj][m][1] * sc;
                        *(PG8_GAS f32x4*)p = x0; *(PG8_GAS f32x4*)(p + 4) = x1;
                    }
        }
    }
};
template <class Epi, class Sched, bool ALIGN_EPI = false, bool SP2 = false>
__device__ __forceinline__ void gemm_phase(PG8_LAS unsigned char* lds, const Gemm g, const Sched& S, const Epi& E, const int tid_in) {
    const int tid = tid_in, wid = __builtin_amdgcn_readfirstlane(tid >> 6), lane = tid & 63, wr = wid >> 2, wc = wid & 3, fr = lane & 15, fq = lane >> 4;
    const int K = g.K, nt = K / BK;
    unsigned voffA[2], voffB[2];
#pragma unroll
    for (int i = 0; i < 2; ++i) { int R, C; stage_rc(tid * 16 + i * 8192, R, C); const int Rb = Epi::PERM ? ((R & ~31) + perm32(R & 31)) : R;
        voffA[i] = (unsigned)(R * K + C) * 2u; voffB[i] = (unsigned)(Rb * K + C) * 2u; }
    const size_t kstep = (size_t)(BK * 2);
    const size_t hstep = (size_t)HALF * K * 2;
    const size_t tstep = 2 * hstep;
    const unsigned ldsw = (unsigned)wid * 1024u;
    const int aoff = lds_byte(wr * 64 + fr, fq * 8), boff = lds_byte(wc * 32 + fr, fq * 8);
#define PG8_SA(b, h) (((b) * 2 + (h)) * HTB)
#define PG8_SB(b, h) ((4 + (b) * 2 + (h)) * HTB)
#define PG8_STAGE(bufoff, gbase, voff) do { _Pragma("unroll") for (int _i = 0; _i < 2; ++_i) \
        __builtin_amdgcn_global_load_lds((const unsigned*)((const char*)(gbase) + (voff)[_i]), (PG8_LAS unsigned*)(lds + (bufoff) + ldsw + _i * 8192), 16, 0, 0); } while (0)
#define PG8_LDA(dst, b, h) do { _Pragma("unroll") for (int m = 0; m < 4; ++m) _Pragma("unroll") for (int k = 0; k < 2; ++k) dst[m][k] = *(const PG8_LAS bf16x8*)(lds + PG8_SA(b, h) + aoff + m * 2048 + k * 1024); } while (0)
#define PG8_LDB(dst, b, h) do { _Pragma("unroll") for (int n = 0; n < 2; ++n) _Pragma("unroll") for (int k = 0; k < 2; ++k) dst[n][k] = *(const PG8_LAS bf16x8*)(lds + PG8_SB(b, h) + boff + n * 2048 + k * 1024); } while (0)
#define PG8_MMA(ai, bj, At, Bt) do { __builtin_amdgcn_s_setprio(1); _Pragma("unroll") for (int m = 0; m < 4; ++m) _Pragma("unroll") for (int n = 0; n < 2; ++n) _Pragma("unroll") for (int k = 0; k < 2; ++k) \
        acc[ai][bj][m][n] = __builtin_amdgcn_mfma_f32_16x16x32_bf16(Bt[n][k], At[m][k], acc[ai][bj][m][n], 0, 0, 0); __builtin_amdgcn_s_setprio(0); } while (0)
#define PG8_WAIT_V(n) asm volatile("s_waitcnt vmcnt(" #n ")" ::: "memory")
#define PG8_WAIT_L(n) asm volatile("s_waitcnt lgkmcnt(" #n ")" ::: "memory")
#define PG8_BAR __builtin_amdgcn_s_barrier()
#define PG8_SCHED __builtin_amdgcn_sched_barrier(0)
    Unit cur, nxt; int ui = 0;
    if (!S.next(0, cur)) return;
    f32x4 acc[2][2][4][2];
#pragma unroll
    for (int a = 0; a < 2; ++a)
#pragma unroll
        for (int b = 0; b < 2; ++b)
#pragma unroll
            for (int m = 0; m < 4; ++m)
#pragma unroll
                for (int n = 0; n < 2; ++n) acc[a][b][m][n] = (f32x4){0.f, 0.f, 0.f, 0.f};
    bf16x8 At[4][2], B0[2][2], B1[2][2];
    const char* cA = (const char*)g.A + (size_t)cur.pm * tstep; const char* cB = (const char*)g.Bt + (size_t)cur.pn * tstep;
    S.a_ready(cur);
    if constexpr (SP2) {
        PG8_STAGE(PG8_SB(0, 0), cB, voffB); PG8_STAGE(PG8_SB(0, 1), cB + hstep, voffB); PG8_STAGE(PG8_SA(0, 0), cA, voffA); PG8_STAGE(PG8_SA(0, 1), cA + hstep, voffA);
        if (wr == 1) PG8_BAR;
        PG8_WAIT_V(2); PG8_BAR;
        PG8_STAGE(PG8_SB(1, 0), cB + kstep, voffB); PG8_STAGE(PG8_SA(1, 0), cA + kstep, voffA); PG8_STAGE(PG8_SB(1, 1), cB + hstep + kstep, voffB);
        PG8_WAIT_V(6); PG8_BAR;
    } else {
        PG8_STAGE(PG8_SB(0, 0), cB, voffB); PG8_STAGE(PG8_SA(0, 0), cA, voffA); PG8_STAGE(PG8_SB(0, 1), cB + hstep, voffB); PG8_STAGE(PG8_SA(0, 1), cA + hstep, voffA);
        if (wr == 1) PG8_BAR;
        PG8_WAIT_V(4); PG8_BAR;
        PG8_STAGE(PG8_SB(1, 0), cB + kstep, voffB); PG8_STAGE(PG8_SA(1, 0), cA + kstep, voffA); PG8_STAGE(PG8_SB(1, 1), cB + hstep + kstep, voffB);
        PG8_WAIT_V(6); PG8_BAR;
    }
    for (;;) {
        const bool has_next = S.next(ui + 1, nxt);
        const char* nA = has_next ? (const char*)g.A + (size_t)nxt.pm * tstep : cA; const char* nB = has_next ? (const char*)g.Bt + (size_t)nxt.pn * tstep : cB;
        for (int t = 0; t < nt; t += 2) {
            const bool last = (t == nt - 2);
            const char* a1 = cA + (size_t)(t + 1) * kstep;
            const char* a2 = last ? nA : cA + (size_t)(t + 2) * kstep; const char* b2 = last ? nB : cB + (size_t)(t + 2) * kstep;
            const char* a3 = a2 + kstep; const char* b3 = b2 + kstep;
            if (last && has_next) S.a_ready(nxt);
            if constexpr (SP2) {
            PG8_LDB(B0, 0, 0); PG8_LDB(B1, 0, 1); PG8_SCHED; PG8_LDA(At, 0, 0); PG8_STAGE(PG8_SA(1, 1), a1 + hstep, voffA);
            PG8_WAIT_V(8); PG8_WAIT_L(0); PG8_BAR; PG8_MMA(0, 0, At, B0); PG8_MMA(0, 1, At, B1); PG8_BAR; PG8_SCHED;
            PG8_LDA(At, 0, 1); PG8_STAGE(PG8_SB(0, 0), b2, voffB); PG8_STAGE(PG8_SB(0, 1), b2 + hstep, voffB); PG8_STAGE(PG8_SA(0, 0), a2, voffA);
            PG8_WAIT_V(8); PG8_WAIT_L(0); PG8_BAR; PG8_MMA(1, 0, At, B0); PG8_MMA(1, 1, At, B1); PG8_BAR; PG8_SCHED;
            PG8_LDB(B0, 1, 0); PG8_LDB(B1, 1, 1); PG8_SCHED; PG8_LDA(At, 1, 0); PG8_STAGE(PG8_SA(0, 1), a2 + hstep, voffA);
            PG8_WAIT_V(8); PG8_WAIT_L(0); PG8_BAR; PG8_MMA(0, 0, At, B0); PG8_MMA(0, 1, At, B1); PG8_BAR; PG8_SCHED;
            PG8_LDA(At, 1, 1); PG8_STAGE(PG8_SB(1, 0), b3, voffB); PG8_STAGE(PG8_SB(1, 1), b3 + hstep, voffB); PG8_STAGE(PG8_SA(1, 0), a3, voffA);
            PG8_WAIT_V(8); PG8_WAIT_L(0); PG8_BAR; PG8_MMA(1, 0, At, B0); PG8_MMA(1, 1, At, B1); PG8_BAR; PG8_SCHED;
            } else {
            PG8_LDB(B0, 0, 0); PG8_SCHED; PG8_LDA(At, 0, 0); PG8_STAGE(PG8_SA(1, 1), a1 + hstep, voffA);
            PG8_WAIT_L(8); PG8_BAR; PG8_WAIT_L(0); PG8_MMA(0, 0, At, B0); PG8_BAR; PG8_SCHED;
            PG8_LDB(B1, 0, 1); PG8_STAGE(PG8_SB(0, 0), b2, voffB);
            PG8_BAR; PG8_WAIT_L(0); PG8_MMA(0, 1, At, B1); PG8_BAR;
            PG8_LDA(At, 0, 1); PG8_STAGE(PG8_SA(0, 0), a2, voffA);
            PG8_BAR; PG8_WAIT_L(0); PG8_MMA(1, 0, At, B0); PG8_BAR; PG8_SCHED;
            PG8_STAGE(PG8_SB(0, 1), b2 + hstep, voffB);
            PG8_WAIT_V(6); PG8_BAR; PG8_MMA(1, 1, At, B1); PG8_BAR;
            PG8_LDB(B0, 1, 0); PG8_SCHED; PG8_LDA(At, 1, 0); PG8_STAGE(PG8_SA(0, 1), a2 + hstep, voffA);
            PG8_WAIT_L(8); PG8_BAR; PG8_WAIT_L(0); PG8_MMA(0, 0, At, B0); PG8_BAR; PG8_SCHED;
            PG8_LDB(B1, 1, 1); PG8_STAGE(PG8_SB(1, 0), b3, voffB);
            PG8_BAR; PG8_WAIT_L(0); PG8_MMA(0, 1, At, B1); PG8_BAR;
            PG8_LDA(At, 1, 1); PG8_STAGE(PG8_SA(1, 0), a3, voffA);
            PG8_BAR; PG8_WAIT_L(0); PG8_MMA(1, 0, At, B0); PG8_BAR; PG8_SCHED;
            PG8_STAGE(PG8_SB(1, 1), b3 + hstep, voffB);
            PG8_WAIT_V(6); PG8_BAR; PG8_MMA(1, 1, At, B1); PG8_BAR;
            }
        }
        if constexpr (ALIGN_EPI) { if (wr == 0) PG8_BAR; }
        if constexpr (!Epi::AFTER_DRAIN) { E(acc, cur, wr, wc, fr, fq); S.done(cur); }
        if (!has_next) break;
#pragma unroll
        for (int a = 0; a < 2; ++a)
#pragma unroll
            for (int b = 0; b < 2; ++b)
#pragma unroll
                for (int m = 0; m < 4; ++m)
#pragma unroll
                    for (int n = 0; n < 2; ++n) acc[a][b][m][n] = (f32x4){0.f, 0.f, 0.f, 0.f};
        cur = nxt; cA = nA; cB = nB; ++ui;
        if constexpr (ALIGN_EPI) { if (wr == 1) PG8_BAR; }
    }
    PG8_WAIT_V(0);
    if constexpr (!ALIGN_EPI) { if (wr == 0) PG8_BAR; }
    PG8_BAR;
    if constexpr (Epi::AFTER_DRAIN) { E.fused(acc, cur, wr, wc, fr, fq, lds, wid, lane); S.done(cur); }
#undef PG8_SA
#undef PG8_SB
#undef PG8_STAGE
#undef PG8_LDA
#undef PG8_LDB
#undef PG8_MMA
#undef PG8_WAIT_V
#undef PG8_WAIT_L
#undef PG8_BAR
#undef PG8_SCHED
}
}

#ifndef PG8_SP2
#define PG8_SP2 true
#endif
#ifndef PG8_ALIGN
#define PG8_ALIGN true
#endif
#include <hip/hip_bf16.h>
#include <cmath>
namespace attn_body {
using bf16=__hip_bfloat16;
using bf16x8=__attribute__((ext_vector_type(8)))short;
using s16x4=__attribute__((ext_vector_type(4)))short;
using f32x16=__attribute__((ext_vector_type(16)))float;
using u32x4=__attribute__((ext_vector_type(4)))unsigned;
constexpr int BATCH=2,NHEAD=16,SEQ=8192,D=64,DM=NHEAD*D;
constexpr int NW=8,QBLK=32,QB=QBLK*NW,KVBLK=64,NQB=SEQ/QB; constexpr int KVPAD=128,KVROWS=SEQ+KVPAD;
constexpr int ATTN_PITCH=DM, ATTN_UNIT_ROWS=QB;
__device__ __forceinline__ int crow(int r,int hi){return (r&3)+8*(r>>2)+4*hi;}
#define SBAR() __builtin_amdgcn_sched_barrier(0)
__device__ __forceinline__ void cmask(f32x16&p0,f32x16&p1,int jb,int qrel,int hi){
  const float NEG=-INFINITY; int kb=64*jb+4*hi;
  #pragma unroll
  for(int r=0;r<16;++r){int kv=kb+(r&3)+8*(r>>2); if(kv>qrel)p0[r]=NEG; if(kv+32>qrel)p1[r]=NEG;}
}

constexpr int NSLOT=3, SLOTB=8192;
constexpr int LDS_K=0, LDS_V=NSLOT*SLOTB, LDS_WS=2*NSLOT*SLOTB, LDS_OST=LDS_WS+NW*64*4, LDS_CS=LDS_OST+NW*4096, LDS_BYTES=LDS_CS+KVROWS*4;
constexpr float C2=0.125f*1.4426950408889634f;
__device__ __forceinline__ void glds16(const void*gsrc,unsigned lds_dst){unsigned keep;
  asm volatile("s_mov_b32 %0, m0\n\ts_mov_b32 m0, %2\n\ts_nop 0\n\tglobal_load_lds_dwordx4 %1, off\n\ts_mov_b32 m0, %0":"=&s"(keep):"v"(gsrc),"s"(lds_dst):"memory");}
__device__ __forceinline__ float max3f(float a,float b,float c){float r;asm("v_max3_f32 %0, %1, %2, %3":"=v"(r):"v"(a),"v"(b),"v"(c));return r;}
__device__ __forceinline__ float max2f(float a,float b){float r;asm("v_max_f32_e32 %0, %1, %2":"=v"(r):"v"(a),"v"(b));return r;}
__device__ __forceinline__ float fadd_s(float a,float b){float r;asm("v_add_f32_e32 %0, %1, %2":"=v"(r):"v"(a),"v"(b));return r;}
__device__ __forceinline__ float fsub_s(float a,float b){float r;asm("v_sub_f32_e32 %0, %1, %2":"=v"(r):"v"(a),"v"(b));return r;}
typedef float f32x2_t __attribute__((ext_vector_type(2))); typedef __bf16 bf16x2_t __attribute__((ext_vector_type(2)));
__device__ __forceinline__ unsigned cvtpk_s(float lo,float hi){f32x2_t v={lo,hi};bf16x2_t b=__builtin_convertvector(v,bf16x2_t);return __builtin_bit_cast(unsigned,b);}
#define WAIT_BAR(N) asm volatile("s_waitcnt vmcnt(" #N ") lgkmcnt(0)\n\ts_barrier":::"memory")

__device__ __forceinline__ void qkt(f32x16&p0,f32x16&p1,const char*Kslot,const bf16x8*qr,int r32,int hi){
  const char*kb=Kslot+hi*1024+r32*16;
  #pragma unroll
  for(int d0=0;d0<4;++d0){
    const bf16x8 b0=*reinterpret_cast<const bf16x8*>(kb+d0*2048);
    const bf16x8 b1=*reinterpret_cast<const bf16x8*>(kb+d0*2048+512);
    p0=__builtin_amdgcn_mfma_f32_32x32x16_bf16(b0,qr[d0],p0,0,0,0);p1=__builtin_amdgcn_mfma_f32_32x32x16_bf16(b1,qr[d0],p1,0,0,0);}
}
typedef __attribute__((address_space(3))) const char* lds_cptr;
typedef short v4i16_t __attribute__((ext_vector_type(4))); typedef float f32x4_t __attribute__((ext_vector_type(4)));
__device__ __forceinline__ void kload8(bf16x8*kf,lds_cptr kp){
  kf[0]=*(const __attribute__((address_space(3))) bf16x8*)(kp);      kf[1]=*(const __attribute__((address_space(3))) bf16x8*)(kp+512);
  kf[2]=*(const __attribute__((address_space(3))) bf16x8*)(kp+2048); kf[3]=*(const __attribute__((address_space(3))) bf16x8*)(kp+2560);
  kf[4]=*(const __attribute__((address_space(3))) bf16x8*)(kp+4096); kf[5]=*(const __attribute__((address_space(3))) bf16x8*)(kp+4608);
  kf[6]=*(const __attribute__((address_space(3))) bf16x8*)(kp+6144); kf[7]=*(const __attribute__((address_space(3))) bf16x8*)(kp+6656);
}
__device__ __forceinline__ void kload2(bf16x8*kf,lds_cptr kp,int j){ kf[2*j]=*(const __attribute__((address_space(3))) bf16x8*)(kp+j*2048); kf[2*j+1]=*(const __attribute__((address_space(3))) bf16x8*)(kp+j*2048+512); }
__device__ __forceinline__ s16x4 vtr(lds_cptr p){ return __builtin_bit_cast(s16x4,__builtin_amdgcn_ds_read_tr16_b64_v4i16((__attribute__((address_space(3))) v4i16_t*)p)); }
__device__ __forceinline__ float rowmax(const f32x16&p0,const f32x16&p1){
  float a=max3f(p0[0],p0[1],p1[0]),b=max3f(p0[2],p0[3],p1[1]);a=max3f(a,p1[2],p1[3]);
  #pragma unroll
  for(int r=4;r<16;r+=4){a=max3f(a,p0[r],p0[r+1]);b=max3f(b,p0[r+2],p0[r+3]);a=max3f(a,p1[r],p1[r+1]);b=max3f(b,p1[r+2],p1[r+3]);}
  const float m=max2f(a,b);
  auto rr=__builtin_amdgcn_permlane32_swap(__float_as_uint(m),__float_as_uint(m),false,false);
  return max2f(__uint_as_float(rr[0]),__uint_as_float(rr[1]));
}
__device__ __forceinline__ void pv(f32x16*o,int vb,bf16x8 pa0,bf16x8 pa1,bf16x8 pa2,bf16x8 pa3){
  #pragma unroll
  for(int d0=0;d0<2;++d0){s16x4 lo[4],hi[4];
    #pragma unroll
    for(int ks=0;ks<4;++ks){
      asm volatile("ds_read_b64_tr_b16 %0,%1 offset:%c2":"=&v"(lo[ks]):"v"(vb),"i"(d0*4096+ks*1024):"memory");
      asm volatile("ds_read_b64_tr_b16 %0,%1 offset:%c2":"=&v"(hi[ks]):"v"(vb),"i"(d0*4096+ks*1024+512):"memory");}
    asm volatile("s_waitcnt lgkmcnt(0)":::"memory");SBAR();
    #define PK(k) (bf16x8){lo[k][0],lo[k][1],lo[k][2],lo[k][3],hi[k][0],hi[k][1],hi[k][2],hi[k][3]}
    o[d0]=__builtin_amdgcn_mfma_f32_32x32x16_bf16(pa0,PK(0),o[d0],0,0,0);
    o[d0]=__builtin_amdgcn_mfma_f32_32x32x16_bf16(pa1,PK(1),o[d0],0,0,0);
    o[d0]=__builtin_amdgcn_mfma_f32_32x32x16_bf16(pa2,PK(2),o[d0],0,0,0);
    o[d0]=__builtin_amdgcn_mfma_f32_32x32x16_bf16(pa3,PK(3),o[d0],0,0,0);
    #undef PK
  }
}

#ifndef ATTN_STORE16
#define ATTN_STORE16(p,v) (*(__attribute__((address_space(1))) u32x4*)(p)=(v))
#endif
template<int THRL> __device__ __forceinline__ void attn_unit(int b,int h,int qb,const bf16*Q,const bf16*__restrict__ K,const bf16*__restrict__ V,bf16*O,const float*__restrict__ CS,char*shm,const int tid_in){
  const int tid=tid_in,lane=tid&63,r32=lane&31,hi=lane>>5; const int wid=__builtin_amdgcn_readfirstlane(tid>>6);
  const long rowbase=(long)b*SEQ, kvbase=(long)b*KVROWS; const int q0=qb*QB;
  const bf16*Qw=Q+(rowbase+q0+wid*QBLK)*DM+h*D;
  const bf16*Kh=K+kvbase*DM+h*D,*Vh=V+kvbase*DM+h*D;
  const unsigned lds0=(unsigned)(uintptr_t)shm;
  float*wsf=(float*)(shm+LDS_WS)+wid*64;
  const bf16*ksrc=Kh+(long)lane*DM+wid*8;
  const bf16*vsrc=Vh+(long)(16*(wid&3)+(lane>>2))*DM+(wid>>2)*32+(lane&3)*8;
  const unsigned kdst=lds0+LDS_K+wid*1024, vdst=lds0+LDS_V+wid*1024;
  #define DMA_K(t,slot) glds16(ksrc+(long)(t)*KVBLK*DM,(unsigned)__builtin_amdgcn_readfirstlane(kdst+(slot)))
  #define DMA_V(t,slot) glds16(vsrc+(long)(t)*KVBLK*DM,(unsigned)__builtin_amdgcn_readfirstlane(vdst+(slot)))
  const int vb0=(int)(lds0+LDS_V)+((lane>>4)&1)*32+(lane&3)*8+(4*hi+((lane&15)>>2))*64;
  const char*Kbase=shm+LDS_K; bf16x8 kf[8];
  const lds_cptr shm3=(lds_cptr)shm; const lds_cptr kp0=shm3+LDS_K+hi*1024+r32*16; const lds_cptr vp0=shm3+LDS_V+((lane>>4)&1)*32+(lane&3)*8+(4*hi+((lane&15)>>2))*64;
  const int NT=(q0+QB+KVPAD)/KVBLK;
  { const float*csg=CS+(long)(b*NHEAD+h)*KVROWS; __attribute__((address_space(3))) float*csw=(__attribute__((address_space(3))) float*)((lds_cptr)shm+LDS_CS);
    for(int i=tid*4;i<NT*KVBLK;i+=NW*64*4){ const f32x4_t v=*(const __attribute__((address_space(1))) f32x4_t*)(csg+i); *(__attribute__((address_space(3))) f32x4_t*)(csw+i)=v; } }
  DMA_K(0,0);DMA_V(0,0);DMA_K(1,SLOTB);
  bf16x8 qr[4];
  #pragma unroll
  for(int d0=0;d0<4;++d0)qr[d0]=*(const __attribute__((address_space(1))) bf16x8*)(&Qw[(long)r32*DM+d0*16+hi*8]);
  float mhat=0.f,l_reg=0.f;f32x16 o[2];o[0]=f32x16{};o[1]=f32x16{};
  const __attribute__((address_space(3))) float*csl=(const __attribute__((address_space(3))) float*)((lds_cptr)shm+LDS_CS)+4*hi;
  #define BIASINIT(C0,C1,t) do{ const __attribute__((address_space(3))) float*bp_=csl+64*(t); const float nm_=-mhat; \
    _Pragma("unroll") for(int g_=0;g_<4;++g_){ const f32x4_t a_=*(const __attribute__((address_space(3))) f32x4_t*)(bp_+8*g_), b_=*(const __attribute__((address_space(3))) f32x4_t*)(bp_+32+8*g_); \
      C0[4*g_]=nm_-a_[0];C0[4*g_+1]=nm_-a_[1];C0[4*g_+2]=nm_-a_[2];C0[4*g_+3]=nm_-a_[3]; C1[4*g_]=nm_-b_[0];C1[4*g_+1]=nm_-b_[1];C1[4*g_+2]=nm_-b_[2];C1[4*g_+3]=nm_-b_[3]; } }while(0)
  const int qrel=wid*QBLK+r32;
  #define CMASK(P0,P1,t) do{int jb_=(t)-(NT-4); if(jb_>=0)cmask(P0,P1,jb_,qrel,hi);}while(0)
  bool resc=false;
  #define START(P0,P1) do{ const float rm=rowmax(P0,P1); resc=false; \
    { const float dl=rm; mhat=fadd_s(mhat,dl); \
      _Pragma("unroll") for(int r=0;r<16;++r){P0[r]=fsub_s(P0[r],dl);P1[r]=fsub_s(P1[r],dl);} \
      } \
    _Pragma("unroll") for(int r=0;r<16;++r)P0[r]=__builtin_amdgcn_exp2f(P0[r]); }while(0)
  #define RESC() do{ if(resc){ asm volatile("s_waitcnt lgkmcnt(0)":::"memory"); \
      _Pragma("unroll") for(int d_=0;d_<2;++d_) _Pragma("unroll") for(int r=0;r<16;++r)o[d_][r]*=wsf[crow(r,hi)]; } }while(0)
  f32x16 pA0,pA1,pB0,pB1;
  int sl_prev=0,sl_cur=0,sl_next=SLOTB;
  #define ROT() do{sl_prev=sl_cur;sl_cur=sl_next;sl_next=(sl_next==(NSLOT-1)*SLOTB)?0:sl_next+SLOTB;}while(0)
  DMA_K(2,2*SLOTB);
  WAIT_BAR(3);
  BIASINIT(pA0,pA1,0); qkt(pA0,pA1,Kbase,qr,r32,hi);asm volatile("s_nop 15\n\ts_nop 7":"+v"(pA0),"+v"(pA1));
  START(pA0,pA1);
  _Pragma("unroll") for(int r=0;r<16;++r)pA1[r]=__builtin_amdgcn_exp2f(pA1[r]);
  WAIT_BAR(0);
  DMA_K(3,0);DMA_V(1,SLOTB);
  ROT();
  kload8(kf,kp0+sl_cur);
  WAIT_BAR(2);
  s16x4 vlo[8],vhi[8]; u32x4 pw0,pw1,pw2,pw3;
  #define PKW(P,B) cvtpk_s(P[B],P[B+1])
  #define PAF(k) __builtin_bit_cast(bf16x8,pw##k)
  #define VFR(i) (bf16x8){vlo[i][0],vlo[i][1],vlo[i][2],vlo[i][3],vhi[i][0],vhi[i][1],vhi[i][2],vhi[i][3]}
  #define PIN(x) asm volatile("":"+v"(x))
  #define MX3(a,b,c) __builtin_fmaxf(__builtin_fmaxf((a),(b)),(c))
  #define GAPA(MF,A0,A1,A2,A3,W0,W1,PW) do{ MF; sacc+=A0; sacc+=A1; sacc+=A2; sacc+=A3; PIN(sacc); W0; W1; PIN(PW); SBAR(); }while(0)
  #define EX(v) __builtin_amdgcn_exp2f(v)
  #define GAPB(MF,X,B) do{ MF; X[B]=EX(X[B]); X[B+1]=EX(X[B+1]); X[B+2]=EX(X[B+2]); X[B+3]=EX(X[B+3]); PIN(X); SBAR(); }while(0)
  #define VRD(i) do{ vlo[i]=vtr(vp_+(((i)>>2)*4096+((i)&3)*1024)); vhi[i]=vtr(vp_+(((i)>>2)*4096+((i)&3)*1024+512)); }while(0)
  #define KRD(G,j) do{ if(G){ kload2(kf,kp0+sl_next,j); SBAR(); } }while(0)
  #define STEP(C0,C1,P0,P1,t,GK,GV,GL) do{ SBAR(); BIASINIT(C0,C1,t); SBAR(); \
    const lds_cptr vp_=vp0+sl_prev; \
    VRD(0); SBAR(); float sacc=(P0[0]+P0[1]); \
    GAPA(C0=__builtin_amdgcn_mfma_f32_32x32x16_bf16(kf[0],qr[0],C0,0,0,0), P0[2],P0[3],P0[4],P0[5],     pw0[0]=PKW(P0,0), pw0[1]=PKW(P0,2), pw0); \
    VRD(4); SBAR(); GAPA(C1=__builtin_amdgcn_mfma_f32_32x32x16_bf16(kf[1],qr[0],C1,0,0,0), P0[6],P0[7],P0[8],P0[9],     pw0[2]=PKW(P0,4), pw0[3]=PKW(P0,6), pw0); \
    VRD(1); SBAR(); GAPA(C0=__builtin_amdgcn_mfma_f32_32x32x16_bf16(kf[2],qr[1],C0,0,0,0),   P0[10],P0[11],P0[12],P0[13], pw1[0]=PKW(P0,8), pw1[1]=PKW(P0,10), pw1); \
    VRD(5); SBAR(); GAPA(C1=__builtin_amdgcn_mfma_f32_32x32x16_bf16(kf[3],qr[1],C1,0,0,0),   P0[14],P0[15],P1[0],P1[1],   pw1[2]=PKW(P0,12),pw1[3]=PKW(P0,14), pw1); \
    VRD(2); SBAR(); GAPA(C0=__builtin_amdgcn_mfma_f32_32x32x16_bf16(kf[4],qr[2],C0,0,0,0),   P1[2],P1[3],P1[4],P1[5],     pw2[0]=PKW(P1,0), pw2[1]=PKW(P1,2), pw2); \
    VRD(6); SBAR(); GAPA(C1=__builtin_amdgcn_mfma_f32_32x32x16_bf16(kf[5],qr[2],C1,0,0,0),   P1[6],P1[7],P1[8],P1[9],     pw2[2]=PKW(P1,4), pw2[3]=PKW(P1,6), pw2); \
    VRD(3); SBAR(); GAPA(C0=__builtin_amdgcn_mfma_f32_32x32x16_bf16(kf[6],qr[3],C0,0,0,0),   P1[10],P1[11],P1[12],P1[13], pw3[0]=PKW(P1,8), pw3[1]=PKW(P1,10), pw3); \
    VRD(7); SBAR(); GAPA(C1=__builtin_amdgcn_mfma_f32_32x32x16_bf16(kf[7],qr[3],C1,0,0,0),   P1[14],P1[15],0.f,0.f,       pw3[2]=PKW(P1,12),pw3[3]=PKW(P1,14), pw3); \
    l_reg+=sacc; \
    if(GK){DMA_K((t)+3,sl_cur);} if(GV){DMA_V((t)+1,sl_next);} \
    CMASK(C0,C1,t); \
    { float a=MX3(C0[0],C0[1],C1[0]),b=MX3(C0[2],C0[3],C1[1]); a=MX3(a,C1[2],C1[3]); \
      _Pragma("unroll") for(int r=4;r<16;r+=4){a=MX3(a,C0[r],C0[r+1]);b=MX3(b,C0[r+2],C0[r+3]);a=MX3(a,C1[r],C1[r+1]);b=MX3(b,C1[r+2],C1[r+3]);} \
      float rm=__builtin_fmaxf(a,b); { auto rr=__builtin_amdgcn_permlane32_swap(__float_as_uint(rm),__float_as_uint(rm),false,false); rm=__builtin_fmaxf(__uint_as_float(rr[0]),__uint_as_float(rr[1])); } \
      resc=false; \
      if(__builtin_expect(__any(rm>(float)THRL),0)){ const float dl=__builtin_fmaxf(rm,0.f); mhat+=dl; \
        _Pragma("unroll") for(int r=0;r<16;++r){C0[r]-=dl;C1[r]-=dl;} \
        const float f=__builtin_amdgcn_exp2f(-dl); l_reg*=f; if(hi==0)wsf[r32]=f; resc=true; } } \
    SBAR(); \
    GAPB(o[0]=__builtin_amdgcn_mfma_f32_32x32x16_bf16(PAF(0),VFR(0),o[0],0,0,0), C0,0); \
    GAPB(o[1]=__builtin_amdgcn_mfma_f32_32x32x16_bf16(PAF(0),VFR(4),o[1],0,0,0), C0,4); \
    KRD(GL,0); GAPB(o[0]=__builtin_amdgcn_mfma_f32_32x32x16_bf16(PAF(1),VFR(1),o[0],0,0,0), C0,8); \
    KRD(GL,1); GAPB(o[1]=__builtin_amdgcn_mfma_f32_32x32x16_bf16(PAF(1),VFR(5),o[1],0,0,0), C0,12); \
    KRD(GL,2); GAPB(o[0]=__builtin_amdgcn_mfma_f32_32x32x16_bf16(PAF(2),VFR(2),o[0],0,0,0), C1,0); \
    KRD(GL,3); GAPB(o[1]=__builtin_amdgcn_mfma_f32_32x32x16_bf16(PAF(2),VFR(6),o[1],0,0,0), C1,4); \
    GAPB(o[0]=__builtin_amdgcn_mfma_f32_32x32x16_bf16(PAF(3),VFR(3),o[0],0,0,0), C1,8); \
    GAPB(o[1]=__builtin_amdgcn_mfma_f32_32x32x16_bf16(PAF(3),VFR(7),o[1],0,0,0), C1,12); \
    }while(0)
  int t=1;
  #undef CMASK
  #define CMASK(P0,P1,t) do{}while(0)
  for(;t+5<NT;t+=2){
    STEP(pB0,pB1,pA0,pA1,t,true,true,true);     WAIT_BAR(2); RESC(); ROT();
    STEP(pA0,pA1,pB0,pB1,t+1,true,true,true);   WAIT_BAR(2); RESC(); ROT();
  }
  #undef CMASK
  #define CMASK(P0,P1,t) do{int jb_=(t)-(NT-4); if(jb_>=0)cmask(P0,P1,jb_,qrel,hi);}while(0)
  #define ENDW(tt) do{ if((tt)+3<NT){WAIT_BAR(2);} else if((tt)+2<NT){WAIT_BAR(1);} else {WAIT_BAR(0);} }while(0)
  for(;t+1<NT;t+=2){
    STEP(pB0,pB1,pA0,pA1,t,(t+3<NT),(t+1<NT),(t+1<NT));       ENDW(t);   RESC(); ROT();
    STEP(pA0,pA1,pB0,pB1,t+1,(t+4<NT),(t+2<NT),(t+2<NT));     ENDW(t+1); RESC(); ROT();
  }
  STEP(pB0,pB1,pA0,pA1,NT-1,false,false,false); RESC();
  { float sacc=pB0[0]+pB0[1]; _Pragma("unroll") for(int r=2;r<16;++r)sacc+=pB0[r]; _Pragma("unroll") for(int r=0;r<16;++r)sacc+=pB1[r]; l_reg+=sacc;
    pw0=(u32x4){PKW(pB0,0),PKW(pB0,2),PKW(pB0,4),PKW(pB0,6)};pw1=(u32x4){PKW(pB0,8),PKW(pB0,10),PKW(pB0,12),PKW(pB0,14)};pw2=(u32x4){PKW(pB1,0),PKW(pB1,2),PKW(pB1,4),PKW(pB1,6)};pw3=(u32x4){PKW(pB1,8),PKW(pB1,10),PKW(pB1,12),PKW(pB1,14)};
    SBAR(); pv(o,vb0+sl_cur,PAF(0),PAF(1),PAF(2),PAF(3)); }
  #undef PKW
  #undef PAF
  #undef VFR
  #undef PIN
  #undef MX3
  #undef GAPA
  #undef GAPB
  #undef EX
  #undef VRD
  #undef KRD
  #undef STEP
  #undef ENDW
  {auto rr=__builtin_amdgcn_permlane32_swap(__float_as_uint(l_reg),__float_as_uint(l_reg),false,false);l_reg=__uint_as_float(rr[0])+__uint_as_float(rr[1]);}
  if(hi==0)wsf[32+r32]=l_reg;asm volatile("s_waitcnt lgkmcnt(0)":::"memory");
  float rli[16];
  #pragma unroll
  for(int r=0;r<16;++r)rli[r]=__builtin_amdgcn_rcpf(wsf[32+crow(r,hi)]);
  bf16*Ow=O+(rowbase+q0+wid*QBLK)*DM+h*D;
  { bf16*stg=(bf16*)(shm+LDS_OST)+wid*2048;
    #pragma unroll
    for(int r=0;r<16;++r){const int orow=crow(r,hi);
      #pragma unroll
      for(int d0=0;d0<2;++d0)stg[orow*64+d0*32+r32]=__float2bfloat16(o[d0][r]*rli[r]);}
    asm volatile("s_waitcnt lgkmcnt(0)":::"memory");
    #pragma unroll
    for(int i=0;i<4;++i){const int row=i*8+(lane>>3),ch=lane&7; const u32x4 v=*(const u32x4*)(stg+row*64+ch*8); ATTN_STORE16(Ow+(long)row*DM+ch*8,v);} }
  asm volatile("s_waitcnt lgkmcnt(0)\n\ts_barrier":::"memory");
  #undef DMA_K
  #undef DMA_V
  #undef CMASK
  #undef START
  #undef RESC
  #undef ROT
  #undef BIASINIT
}
constexpr int ATTN_LDS_BYTES=LDS_BYTES;
struct AttnTensors { const bf16* Q; const bf16* K; const bf16* V; bf16* O; const float* CS; };
struct AttnUnit { int bh; int qb; };
struct StaticOrder {
  int vcu;
  __device__ __forceinline__ explicit StaticOrder(int grid,int block):vcu((block%8)*(grid/8)+block/8){}
  __device__ __forceinline__ bool next(int i,AttnUnit&u)const{ if(i>=4)return false; const int s=vcu&7; u.bh=vcu>>3; u.qb=(i==0)?s:(i==1)?15-s:(i==2)?16+s:31-s; return true; }
  __device__ __forceinline__ void a_ready(const AttnUnit&)const{}
  __device__ __forceinline__ void done(const AttnUnit&)const{}
};
template<class Sched,int THRL=8> __device__ __forceinline__ void attn_phase(char*lds,const AttnTensors&T,const Sched&S,const int tid_in){
  AttnUnit u;
  for(int i=0;S.next(i,u);++i){ S.a_ready(u); attn_unit<THRL>(u.bh/NHEAD,u.bh%NHEAD,u.qb,T.Q,T.K,T.V,T.O,T.CS,lds,tid_in); S.done(u); }
}
#undef SBAR
#undef WAIT_BAR
}
namespace cg = cooperative_groups;
constexpr int NWAVES = 8;
constexpr int DM = 1024, FF = 2816, NH = 16, SEQ = 8192, NMETA = 16, DEPTH = 4;
constexpr int MMAIN = 2 * SEQ;
constexpr int MROWS = MMAIN + NMETA;
constexpr int MPAD = 65 * 256;
constexpr int KVROWS = attn_body::KVROWS;
constexpr float EPS = 1e-6f, LOG2E = 1.4426950408889634f;

constexpr size_t MiB = 1u << 20;
constexpr size_t SZ_GU = (size_t)5632 * 1024 * 2, SZ_DN = (size_t)1024 * 2816 * 2;
constexpr size_t WS_WGU = 1 * MiB, WS_WDN = WS_WGU + 8 * SZ_GU;
constexpr size_t WS_WAI = WS_WDN + 8 * SZ_DN, WS_WAO = WS_WAI + 2 * 6 * MiB, WS_WBI = WS_WAO + 2 * 2 * MiB, WS_WBO = WS_WBI + 4 * MiB;
constexpr size_t WS_WCI = WS_WBO + 2 * MiB, WS_WCO = WS_WCI + 6 * MiB, WS_WF = WS_WCO + 2 * MiB;
constexpr size_t WS_XN = WS_WF + 1 * MiB;
constexpr size_t SZ_ROWBUF = (size_t)MPAD * 1024 * 2;
constexpr size_t WS_ACT = WS_XN + 33 * MiB;
constexpr size_t WS_HMETA = WS_ACT + 98 * MiB, WS_LF = WS_HMETA + 1 * MiB, WS_LFM = WS_LF + 1 * MiB, WS_CS = WS_LFM + 1 * MiB, WS_END = WS_CS + 2 * MiB;
static_assert(SZ_ROWBUF <= 33 * MiB && 3 * SZ_ROWBUF <= 98 * MiB && (size_t)MPAD * FF * 2 <= 98 * MiB, "ws map");

constexpr int RING_BYTES = 131072, LDS_BYTES = 147456;
static_assert(attn_body::ATTN_LDS_BYTES <= RING_BYTES, "attention LDS");

#define GAS __attribute__((address_space(1)))
#define LAS __attribute__((address_space(3)))
typedef unsigned short bf16;
typedef unsigned v4u __attribute__((ext_vector_type(4)));
typedef unsigned v2u __attribute__((ext_vector_type(2)));
typedef float f32x4 __attribute__((ext_vector_type(4)));
typedef float f32x2 __attribute__((ext_vector_type(2)));
typedef short bf16x8 __attribute__((ext_vector_type(8)));
#define LDS_WAIT() asm volatile("s_waitcnt lgkmcnt(0)" ::: "memory")
__device__ __forceinline__ unsigned f2bf(float f) { unsigned u = __builtin_bit_cast(unsigned, f); return (u + 0x7fffu + ((u >> 16) & 1u)) >> 16; }
__device__ __forceinline__ unsigned pk2(float lo, float hi) { return f2bf(lo) | (f2bf(hi) << 16); }
__device__ __forceinline__ float bflo(unsigned w) { return __builtin_bit_cast(float, w << 16); }
__device__ __forceinline__ float bfhi(unsigned w) { return __builtin_bit_cast(float, w & 0xffff0000u); }
__device__ __forceinline__ float lane_get(float v, int src_lane) { return __builtin_bit_cast(float, __builtin_amdgcn_ds_bpermute(src_lane << 2, __builtin_bit_cast(int, v))); }
__device__ __forceinline__ float wave_sum(float v, int lane) {
#pragma unroll
    for (int o = 1; o < 64; o <<= 1) v += lane_get(v, lane ^ o);
    return v;
}

struct Args {
    const float* x; const float* meta; const float* ffn_norm; const float* ffn_w_gate; const float* ffn_w_up; const float* ffn_w_down; const float* mix_norm;
    const float* a_w_in; const float* a_conv; const float* a_w_out;
    const float* b_w_in; const float* b_conv; const float* b_conv_bias; const float* b_ln_g; const float* b_ln_b; const float* b_w_out;
    const float* c_w_in; const float* c_b_f; const float* c_q_norm; const float* c_k_norm; const float* c_w_out;
    float* out; unsigned char* ws;
};

__device__ __forceinline__ void transpose_item(const float* src, int Nsrc, bf16* dst, int K, int kb, LAS float* scr, int lane) {
    const int k0 = 64 * kb;
#pragma unroll 8
    for (int i = 0; i < 32; ++i) { const int kk = 2 * i + (lane >> 5); scr[kk * 33 + (lane & 31)] = src[(size_t)(k0 + kk) * Nsrc + (lane & 31)]; }
    LDS_WAIT(); asm volatile("" ::: "memory");
    const int c = lane & 7;
#pragma unroll
    for (int j = 0; j < 4; ++j) { const int n = (lane >> 3) + 8 * j; const LAS float* s = scr + (8 * c) * 33 + n;
        v4u o; o.x = pk2(s[0 * 33], s[1 * 33]); o.y = pk2(s[2 * 33], s[3 * 33]); o.z = pk2(s[4 * 33], s[5 * 33]); o.w = pk2(s[6 * 33], s[7 * 33]);
        *(GAS v4u*)(dst + (size_t)n * K + k0 + 8 * c) = o; }
    LDS_WAIT(); asm volatile("" ::: "memory");
}

__device__ __forceinline__ void rms_row(const float* xrow, const float* g, bf16* orow, float* hcopy, int lane) {
    const GAS f32x4* xr = (const GAS f32x4*)xrow + lane;
    f32x4 v[4]; float s = 0.f;
#pragma unroll
    for (int j = 0; j < 4; ++j) { v[j] = xr[64 * j]; s += (v[j].x * v[j].x + v[j].y * v[j].y) + (v[j].z * v[j].z + v[j].w * v[j].w); }
    const float rs = 1.0f / sqrtf(wave_sum(s, lane) * (1.f / DM) + EPS);
    if (hcopy) { GAS f32x4* hr = (GAS f32x4*)hcopy + lane;
#pragma unroll
        for (int j = 0; j < 4; ++j) hr[64 * j] = v[j]; }
    const GAS f32x4* gr = (const GAS f32x4*)g + lane;
    GAS unsigned long long* o8 = (GAS unsigned long long*)orow + lane;
#pragma unroll
    for (int j = 0; j < 4; ++j) { const f32x4 gg = gr[64 * j]; const f32x4 y = v[j] * rs * gg;
        o8[64 * j] = (unsigned long long)pk2(y.x, y.y) | ((unsigned long long)pk2(y.z, y.w) << 32); }
}


__device__ __forceinline__ void thin_gemm(LAS unsigned char* ldsl, const int tid, const int vcu, const bf16* A, const bf16* Bt, const int K, const int mode,
                                          bf16* R0, bf16* R1, bf16* R2, float* hmeta, const float scale, const float* qg, const float* kg) {
    const int ntasks = (mode == 0) ? 176 : (mode == 2) ? 128 : (mode == 3) ? 48 : 64;
    if (vcu >= ntasks) return;
    const int lane = tid & 63, wave = __builtin_amdgcn_readfirstlane(tid >> 6), fr = lane & 15, fq = lane >> 4, task = vcu;
    int nt = 1, b0 = 0, b1 = 0, b2 = 0, b3 = 0;
    if (mode <= 1 || (mode == 2 && task < 64)) { const int f0 = 16 * task; b0 = 256 * (f0 >> 7) + (f0 & 127); b1 = b0 + 128; nt = 2; }
    else if (mode == 2) { b0 = 2048 + 16 * (task - 64); }
    else if (mode == 3) { const int sec = task >> 4, hd = task & 15; nt = 4;
        if (sec < 2) { b0 = 256 * (sec * 4 + (hd >> 2)) + 32 * (hd & 3); b1 = b0 + 16; b2 = b0 + 128; b3 = b0 + 144; }
        else { b0 = 2048 + 64 * hd; b1 = b0 + 16; b2 = b0 + 32; b3 = b0 + 48; } }
    else { b0 = 16 * task; }
    const int kw = K >> 3, ksteps = kw >> 5;
    const GAS bf16x8* ap = (const GAS bf16x8*)(A + (size_t)(MMAIN + fr) * K + wave * kw + 8 * fq);
    const GAS bf16x8* p0 = (const GAS bf16x8*)(Bt + (size_t)(b0 + fr) * K + wave * kw + 8 * fq);
    const GAS bf16x8* p1 = (const GAS bf16x8*)(Bt + (size_t)(b1 + fr) * K + wave * kw + 8 * fq);
    const GAS bf16x8* p2 = (const GAS bf16x8*)(Bt + (size_t)(b2 + fr) * K + wave * kw + 8 * fq);
    const GAS bf16x8* p3 = (const GAS bf16x8*)(Bt + (size_t)(b3 + fr) * K + wave * kw + 8 * fq);
    f32x4 c0 = {0.f, 0.f, 0.f, 0.f}, c1 = c0, c2 = c0, c3 = c0;
#pragma unroll 4
    for (int ks = 0; ks < ksteps; ++ks) {
        const bf16x8 xa = ap[4 * ks];
        c0 = __builtin_amdgcn_mfma_f32_16x16x32_bf16(p0[4 * ks], xa, c0, 0, 0, 0);
        if (nt >= 2) c1 = __builtin_amdgcn_mfma_f32_16x16x32_bf16(p1[4 * ks], xa, c1, 0, 0, 0);
        if (nt >= 4) { c2 = __builtin_amdgcn_mfma_f32_16x16x32_bf16(p2[4 * ks], xa, c2, 0, 0, 0); c3 = __builtin_amdgcn_mfma_f32_16x16x32_bf16(p3[4 * ks], xa, c3, 0, 0, 0); }
    }
    LAS f32x4* P = (LAS f32x4*)ldsl;
    P[(wave * 4 + 0) * 64 + lane] = c0; P[(wave * 4 + 1) * 64 + lane] = c1; P[(wave * 4 + 2) * 64 + lane] = c2; P[(wave * 4 + 3) * 64 + lane] = c3;
    __syncthreads();
    if (wave == 0) {
#pragma unroll
        for (int w = 1; w < 8; ++w) { c0 += P[(w * 4 + 0) * 64 + lane]; c1 += P[(w * 4 + 1) * 64 + lane]; c2 += P[(w * 4 + 2) * 64 + lane]; c3 += P[(w * 4 + 3) * 64 + lane]; }
        const size_t mrow = (size_t)(MMAIN + fr);
        if (mode <= 1 || (mode == 2 && task < 64)) {
            f32x4 r;
            if (mode == 0) {
#pragma unroll
                for (int i = 0; i < 4; ++i) r[i] = c0[i] * pg8::sigm(c0[i]) * c1[i];
            } else if (mode == 1) {
#pragma unroll
                for (int i = 0; i < 4; ++i) r[i] = c0[i] * pg8::sigm(c1[i]);
            } else r = c0 * c1;
            *(GAS v2u*)(R0 + mrow * (mode == 0 ? FF : 1024) + 16 * task + 4 * fq) = (v2u){pk2(r[0], r[1]), pk2(r[2], r[3])};
        } else if (mode == 2) {
            *(GAS v2u*)(R1 + mrow * 1024 + 16 * (task - 64) + 4 * fq) = (v2u){pk2(c0[0], c0[1]), pk2(c0[2], c0[3])};
        } else if (mode == 3) {
            const int sec = task >> 4, hd = task & 15;
            f32x4 v0 = c0, v1 = c1, v2 = c2, v3 = c3;
            if (sec < 2) {
                float ss = (c0[0] * c0[0] + c0[1] * c0[1]) + (c0[2] * c0[2] + c0[3] * c0[3]) + (c1[0] * c1[0] + c1[1] * c1[1]) + (c1[2] * c1[2] + c1[3] * c1[3])
                         + (c2[0] * c2[0] + c2[1] * c2[1]) + (c2[2] * c2[2] + c2[3] * c2[3]) + (c3[0] * c3[0] + c3[1] * c3[1]) + (c3[2] * c3[2] + c3[3] * c3[3]);
                ss += lane_get(ss, lane ^ 16); ss += lane_get(ss, lane ^ 32);
                const float rs = __builtin_amdgcn_rsqf(ss * (1.0f / 64.0f) + EPS) * ((sec == 0) ? pg8::QK_C2 : 1.0f);
                const float* g = (sec == 0) ? qg : kg;
                v0 = c0 * rs * *(const GAS f32x4*)(g + 4 * fq); v1 = c1 * rs * *(const GAS f32x4*)(g + 16 + 4 * fq); v2 = c2 * rs * *(const GAS f32x4*)(g + 32 + 4 * fq); v3 = c3 * rs * *(const GAS f32x4*)(g + 48 + 4 * fq);
            }
            const v2u w0 = {pk2(v0[0], v0[1]), pk2(v0[2], v0[3])}, w1 = {pk2(v1[0], v1[1]), pk2(v1[2], v1[3])}, w2 = {pk2(v2[0], v2[1]), pk2(v2[2], v2[3])}, w3 = {pk2(v3[0], v3[1]), pk2(v3[2], v3[3])};
            const int col = 64 * hd + 4 * fq;
            if (sec == 0) { bf16* q = R0 + mrow * 1024 + col; *(GAS v2u*)q = w0; *(GAS v2u*)(q + 16) = w1; *(GAS v2u*)(q + 32) = w2; *(GAS v2u*)(q + 48) = w3; }
            else { bf16* T = (sec == 1) ? R1 : R2;
#pragma unroll
                for (int b = 0; b < 2; ++b) { bf16* q = T + (size_t)(b * KVROWS + 48 + fr) * 1024 + col; *(GAS v2u*)q = w0; *(GAS v2u*)(q + 16) = w1; *(GAS v2u*)(q + 32) = w2; *(GAS v2u*)(q + 48) = w3; } }
        } else {
            GAS f32x4* p = (GAS f32x4*)(hmeta + (size_t)fr * 1024 + 16 * task + 4 * fq);
            *p = *p + c0 * scale;
        }
    }
    __syncthreads();
}

__global__ void __launch_bounds__(NWAVES * 64, 2) fwd_megakernel(Args a) {
    extern __shared__ __attribute__((aligned(16))) unsigned char lds[];
    cg::grid_group grid = cg::this_grid();
    const int G = gridDim.x, bx = blockIdx.x;
    const int vcu0 = (G % 8 == 0) ? (bx % 8) * (G / 8) + bx / 8 : bx;
    const int NGW = G * NWAVES;
    const int wave_s = __builtin_amdgcn_readfirstlane((int)threadIdx.x >> 6);
#define PHASE_ENV() \
    unsigned zero_ = 0u; asm volatile("" : "+s"(zero_)); int vcu = vcu0; asm volatile("" : "+s"(vcu)); \
    int tid = (wave_s << 6) | (int)__builtin_amdgcn_mbcnt_hi(~0u, __builtin_amdgcn_mbcnt_lo(~0u, zero_)); \
    const int lane = tid & 63, wave = __builtin_amdgcn_readfirstlane(tid >> 6), gw = vcu * NWAVES + wave; \
    unsigned char* ws0_ = a.ws; asm volatile("" : "+s"(ws0_)); unsigned char* const ws = (unsigned char*)(GAS unsigned char*)ws0_;     \
    float* hm0_ = a.out; asm volatile("" : "+s"(hm0_)); float* const hmain = (float*)(GAS float*)hm0_; \
    bf16* const WGU = (bf16*)(ws + WS_WGU); bf16* const WDN = (bf16*)(ws + WS_WDN); \
    bf16* const WAI = (bf16*)(ws + WS_WAI); bf16* const WAO = (bf16*)(ws + WS_WAO); bf16* const WBI = (bf16*)(ws + WS_WBI); bf16* const WBO = (bf16*)(ws + WS_WBO); \
    bf16* const WCI = (bf16*)(ws + WS_WCI); bf16* const WCO = (bf16*)(ws + WS_WCO); bf16* const WFt = (bf16*)(ws + WS_WF); \
    bf16* const XN = (bf16*)(ws + WS_XN); \
    bf16* const R0 = (bf16*)(ws + WS_ACT); bf16* const R1 = (bf16*)(ws + WS_ACT + SZ_ROWBUF); bf16* const R2 = (bf16*)(ws + WS_ACT + 2 * SZ_ROWBUF); \
    float* const hmeta = (float*)(ws + WS_HMETA); \
    float* const LF = (float*)(ws + WS_LF); float* const LFM = (float*)(ws + WS_LFM); float* const CS = (float*)(ws + WS_CS); \
    LAS unsigned char* const ldsl = (LAS unsigned char*)lds; \
    (void)WGU; (void)WDN; (void)WAI; (void)WAO; (void)WBI; (void)WBO; (void)WCI; (void)WCO; (void)WFt; (void)XN; (void)R0; (void)R1; (void)R2; (void)hmeta; (void)LF; (void)LFM; (void)CS; (void)ldsl; (void)lane; (void)gw; (void)hmain;

    {
        PHASE_ENV();
        LAS float* scr = (LAS float*)(ldsl + wave * 16384);
        constexpr int I_GU = 176 * 16, I_DN = 32 * 44, I_AI = 96 * 16, I_SQ = 32 * 16, I_BI = 64 * 16, I_CI = 96 * 16;
        constexpr int NITEMS = 8 * I_GU + 8 * I_DN + 2 * I_AI + 2 * I_SQ + I_BI + I_SQ + I_CI + I_SQ;
        for (int it = gw; it < NITEMS; it += NGW) {
            int r = it;
            if (r < 8 * I_GU) { const int mat = r / I_GU; r %= I_GU; const int kb = r / 176, nb = r % 176, pn = nb >> 3, q = nb & 7;
                const float* src = ((q < 4) ? a.ffn_w_gate : a.ffn_w_up) + (size_t)mat * 1024 * FF + 128 * pn + 32 * (q & 3);
                transpose_item(src, FF, WGU + (size_t)mat * 5632 * 1024 + (size_t)nb * 32 * 1024, 1024, kb, scr, lane); continue; }
            r -= 8 * I_GU;
            if (r < 8 * I_DN) { const int mat = r / I_DN; r %= I_DN; const int kb = r / 32, nb = r % 32;
                transpose_item(a.ffn_w_down + (size_t)mat * FF * 1024 + 32 * nb, 1024, WDN + (size_t)mat * 1024 * FF + (size_t)nb * 32 * FF, FF, kb, scr, lane); continue; }
            r -= 8 * I_DN;
            if (r < 2 * I_AI) { const int mat = r / I_AI; r %= I_AI; const int kb = r / 96, nb = r % 96, pn = nb >> 3, q = nb & 7;
                const int scol = (pn < 8) ? ((q < 4) ? 1024 + 128 * pn + 32 * q : 2048 + 128 * pn + 32 * (q - 4)) : (nb - 64) * 32;
                transpose_item(a.a_w_in + (size_t)mat * 1024 * 3072 + scol, 3072, WAI + (size_t)mat * 3072 * 1024 + (size_t)nb * 32 * 1024, 1024, kb, scr, lane); continue; }
            r -= 2 * I_AI;
            if (r < 2 * I_SQ) { const int mat = r / I_SQ; r %= I_SQ; const int kb = r / 32, nb = r % 32;
                transpose_item(a.a_w_out + (size_t)mat * 1024 * 1024 + 32 * nb, 1024, WAO + (size_t)mat * 1024 * 1024 + (size_t)nb * 32 * 1024, 1024, kb, scr, lane); continue; }
            r -= 2 * I_SQ;
            if (r < I_BI) { const int kb = r / 64, nb = r % 64, pn = nb >> 3, q = nb & 7;
                const int scol = (q < 4) ? 128 * pn + 32 * q : 1024 + 128 * pn + 32 * (q - 4);
                transpose_item(a.b_w_in + scol, 2048, WBI + (size_t)nb * 32 * 1024, 1024, kb, scr, lane); continue; }
            r -= I_BI;
            if (r < I_SQ) { const int kb = r / 32, nb = r % 32;
                transpose_item(a.b_w_out + 32 * nb, 1024, WBO + (size_t)nb * 32 * 1024, 1024, kb, scr, lane); continue; }
            r -= I_SQ;
            if (r < I_CI) { const int kb = r / 96, nb = r % 96, pn = nb >> 3, q = nb & 7;
                const int scol = (pn < 8) ? (pn >> 2) * 1024 + 64 * (4 * (pn & 3) + (q & 3)) + 32 * (q >> 2) : 2048 + (nb - 64) * 32;
                transpose_item(a.c_w_in + scol, 3088, WCI + (size_t)nb * 32 * 1024, 1024, kb, scr, lane); continue; }
            r -= I_CI;
            { const int kb = r / 32, nb = r % 32;
                transpose_item(a.c_w_out + 32 * nb, 1024, WCO + (size_t)nb * 32 * 1024, 1024, kb, scr, lane); }
        }
        for (int i = gw * 64 + lane; i < 16 * 1024; i += NGW * 64) { const int h = i >> 10, k = i & 1023; WFt[i] = (bf16)f2bf(a.c_w_in[(size_t)k * 3088 + 3072 + h]); }
        for (int m = gw; m < MROWS; m += NGW) {
            const float* src = (m < MMAIN) ? a.x + (size_t)m * DM : a.meta + (size_t)(m - MMAIN) * DM;
            float* hc = (m < MMAIN) ? hmain + (size_t)m * DM : hmeta + (size_t)(m - MMAIN) * DM;
            rms_row(src, a.ffn_norm, XN + (size_t)m * DM, hc, lane);
        }
    }
    grid.sync();

    for (int L = 0; L < DEPTH; ++L) {
        const int mx = L % 3, mj = L / 3;
        for (int s = 0; s <= 10; ++s) {
            if ((s == 6 && mx != 2) || (s == 0 && L == 0)) continue;
            PHASE_ENV();
            if (s == 0 || s == 3 || s == 8) {
                const float* g = (s == 3) ? a.mix_norm + (size_t)L * DM : a.ffn_norm + (size_t)(L * 2 + (s == 8)) * DM;
                for (int m = gw; m < MROWS; m += NGW) {
                    const float* src = (m < MMAIN) ? hmain + (size_t)m * DM : hmeta + (size_t)(m - MMAIN) * DM;
                    rms_row(src, g, XN + (size_t)m * DM, nullptr, lane);
                }
                if (s == 3 && mx == 2) {
                    for (int i = gw; i < 2 * 2 * 112; i += NGW) { const int tsel = i / 224, rr = i % 224, b = rr / 112, j = rr % 112; const int row = b * KVROWS + (j < 48 ? j : j + 16);
                        bf16* p = (tsel ? R2 : R1) + (size_t)row * 1024; ((GAS v4u*)p)[lane * 2] = (v4u){0u, 0u, 0u, 0u}; ((GAS v4u*)p)[lane * 2 + 1] = (v4u){0u, 0u, 0u, 0u}; }
                }
            } else if (s == 1 || s == 2 || s == 4 || s == 7 || s == 9 || s == 10) {
                pg8::Gemm g; pg8::EpiAll E;
                E.mtiles_main = 64; E.O1 = R0; E.O2 = R1; E.O3 = R2; E.ldo = 1024; E.hmain = hmain; E.hmeta = hmeta; E.scale = 1.f; E.qg = a.c_q_norm; E.kg = a.c_k_norm; E.mode = 0;
                g.M = MMAIN;
                if (s == 1 || s == 9) { g.A = XN; g.Bt = WGU + (size_t)(L * 2 + (s == 9)) * 5632 * 1024; g.N = 5632; g.K = 1024; E.mode = 0; E.ldo = FF; }
                else if (s == 2 || s == 10) { g.A = R0; g.Bt = WDN + (size_t)(L * 2 + (s == 10)) * 1024 * FF; g.N = 1024; g.K = FF; E.mode = 4; E.scale = 0.5f; }
                else if (s == 4) {
                    g.A = XN; g.K = 1024;
                    if (mx == 0) { g.Bt = WAI + (size_t)mj * 3072 * 1024; g.N = 3072; E.mode = 2; }
                    else if (mx == 1) { g.Bt = WBI; g.N = 2048; E.mode = 1; }
                    else { g.Bt = WCI; g.N = 3072; E.mode = 3;
                        const int fr = lane & 15, fq = lane >> 4;
                        for (int grp = gw; grp < MROWS / 16; grp += NGW) {
                            const bf16* xp = XN + (size_t)(16 * grp + fr) * DM + 8 * fq; const bf16* wp = WFt + (size_t)fr * DM + 8 * fq;
                            f32x4 acc = {0.f, 0.f, 0.f, 0.f};
#pragma unroll 8
                            for (int k = 0; k < 32; ++k) { const bf16x8 xa = *(const GAS bf16x8*)(xp + 32 * k), wb = *(const GAS bf16x8*)(wp + 32 * k);
                                acc = __builtin_amdgcn_mfma_f32_16x16x32_bf16(xa, wb, acc, 0, 0, 0); }
                            const float bf = a.c_b_f[fr]; f32x4 o;
#pragma unroll
                            for (int r = 0; r < 4; ++r) { const float xv = acc[r] + bf; o[r] = fminf(xv, 0.f) - log1pf(expf(-fabsf(xv))); }
                            if (grp < MMAIN / 16) { const int r0 = 16 * grp, b = r0 >> 13, t0 = r0 & 8191; *(GAS f32x4*)(LF + ((size_t)(b * NH + fr) * SEQ + t0 + 4 * fq)) = o; }
                            else *(GAS f32x4*)(LFM + fr * 16 + 4 * fq) = o;
                        }
                        asm volatile("s_waitcnt vmcnt(0) lgkmcnt(0)" ::: "memory"); __syncthreads();
                    }
                }
                else { g.K = 1024; g.N = 1024; E.mode = 4; E.scale = 1.f;
                    if (mx == 0) { g.A = R2; g.Bt = WAO + (size_t)mj * 1024 * 1024; } else if (mx == 1) { g.A = R1; g.Bt = WBO; } else { g.A = R0; g.Bt = WCO; } }
                thin_gemm(ldsl, tid, vcu, g.A, g.Bt, g.K, E.mode, R0, R1, R2, hmeta, E.scale, a.c_q_norm, a.c_k_norm);
                pg8::StaticOrder S; S.init(g.M, g.N, G, bx);
#ifndef NO_GEMM
                pg8::gemm_phase<pg8::EpiAll, pg8::StaticOrder, PG8_ALIGN, PG8_SP2>(ldsl, g, S, E, tid);
#endif
            } else if (s == 5) {
                if (mx == 0) {
                    const float* cw = a.a_conv + (size_t)mj * 3 * DM + 16 * lane;
                    f32x4 w0[4], w1[4], w2[4];
#pragma unroll
                    for (int j = 0; j < 4; ++j) { w0[j] = *(const f32x4*)(cw + 4 * j); w1[j] = *(const f32x4*)(cw + DM + 4 * j); w2[j] = *(const f32x4*)(cw + 2 * DM + 4 * j); }
                    for (int r = gw; r < MROWS; r += NGW) {
                        int r1, r2;
                        if (r < MMAIN) { const int t = r & 8191; r1 = (t >= 1) ? r - 1 : MMAIN + 15; r2 = (t >= 2) ? r - 2 : MMAIN + 14 + t; }
                        else { const int p = r - MMAIN; r1 = (p >= 1) ? r - 1 : -1; r2 = (p >= 2) ? r - 2 : -1; }
                        const v4u z4 = {0u, 0u, 0u, 0u};
                        const GAS v4u* c0p = (const GAS v4u*)(R0 + (size_t)r * DM) + 2 * lane; const GAS v4u* bp = (const GAS v4u*)(R1 + (size_t)r * DM) + 2 * lane;
                        v4u x0[2], x1[2], x2[2], bb[2];
#pragma unroll
                        for (int hh = 0; hh < 2; ++hh) { x0[hh] = c0p[hh]; bb[hh] = bp[hh];
                            x1[hh] = (r1 >= 0) ? ((const GAS v4u*)(R0 + (size_t)r1 * DM) + 2 * lane)[hh] : z4; x2[hh] = (r2 >= 0) ? ((const GAS v4u*)(R0 + (size_t)r2 * DM) + 2 * lane)[hh] : z4; }
                        GAS v4u* yp = (GAS v4u*)(R2 + (size_t)r * DM) + 2 * lane;
#pragma unroll
                        for (int hh = 0; hh < 2; ++hh) { v4u o;
#pragma unroll
                            for (int e = 0; e < 4; ++e) { const int j = 2 * hh + (e >> 1), c = 2 * (e & 1);
                                const float lo = bflo(bb[hh][e]) * (w2[j][c] * bflo(x0[hh][e]) + w1[j][c] * bflo(x1[hh][e]) + w0[j][c] * bflo(x2[hh][e]));
                                const float hi = bfhi(bb[hh][e]) * (w2[j][c + 1] * bfhi(x0[hh][e]) + w1[j][c + 1] * bfhi(x1[hh][e]) + w0[j][c + 1] * bfhi(x2[hh][e]));
                                o[e] = pk2(lo, hi); }
                            yp[hh] = o; }
                    }
                } else if (mx == 1) {
#ifndef NO_CONF
                    const int c = 2 * tid;
                    f32x2 w[31];
#pragma unroll
                    for (int k = 0; k < 31; ++k) w[k] = *(const GAS f32x2*)(a.b_conv + (size_t)k * DM + c);
                    const f32x2 cb = *(const f32x2*)(a.b_conv_bias + c), lg = *(const f32x2*)(a.b_ln_g + c), lb = *(const f32x2*)(a.b_ln_b + c);
                    LAS float* red = (LAS float*)ldsl;
                    LAS float* red2 = red + 256;
                    for (int un = vcu; un < MROWS / 16; un += G) {
                        const int r0 = 16 * un; const bool meta = (r0 >= MMAIN);
                        const int p0 = meta ? 0 : 16 + (r0 & 8191); const int rowb = meta ? 0 : (r0 >> 13) * SEQ;
                        unsigned xin[46];
#pragma unroll
                        for (int j = 0; j < 46; ++j) { const int pj = p0 - 30 + j;
                            xin[j] = (pj >= 0) ? *(const GAS unsigned*)(R0 + (size_t)((pj < 16) ? MMAIN + pj : rowb + pj - 16) * DM + c) : 0u; }
                        f32x2 acc[16];
#pragma unroll
                        for (int i = 0; i < 16; ++i) acc[i] = cb;
#pragma unroll
                        for (int j = 0; j < 46; ++j) { const f32x2 xv = {bflo(xin[j]), bfhi(xin[j])};
#pragma unroll
                            for (int i = 0; i < 16; ++i) { const int k = j - i; if (k >= 0 && k <= 30) acc[i] += w[k] * xv; } }
                        float st[32];
#pragma unroll
                        for (int i = 0; i < 16; ++i) { st[2 * i] = acc[i].x + acc[i].y; st[2 * i + 1] = acc[i].x * acc[i].x + acc[i].y * acc[i].y; }
#pragma unroll
                        for (int i = 0; i < 32; ++i) st[i] = wave_sum(st[i], lane);
                        if (lane == 0) {
#pragma unroll
                            for (int i = 0; i < 8; ++i) *(LAS f32x4*)(red + wave * 32 + 4 * i) = (f32x4){st[4 * i], st[4 * i + 1], st[4 * i + 2], st[4 * i + 3]}; }
                        __syncthreads();
                        if (tid < 32) { float t = 0.f;
#pragma unroll
                            for (int wv = 0; wv < 8; ++wv) t += red[wv * 32 + tid];
                            red2[tid] = t; }
                        __syncthreads();
#pragma unroll
                        for (int i = 0; i < 16; ++i) { const f32x2 sv = *(const LAS f32x2*)(red2 + 2 * i);
                            const float mu = sv.x * (1.f / DM), var = fmaxf(sv.y * (1.f / DM) - mu * mu, 0.f), rs = 1.0f / sqrtf(var + EPS);
                            const float y0 = (acc[i].x - mu) * rs * lg.x + lb.x, y1 = (acc[i].y - mu) * rs * lg.y + lb.y;
                            *(GAS unsigned*)(R1 + (size_t)(r0 + i) * DM + c) = pk2(y0 * pg8::sigm(y0), y1 * pg8::sigm(y1)); }
                    }
#endif
                } else {
                    if (vcu < 32) {
                        const int bh = vcu, h = bh & 15; LAS float* wt = (LAS float*)ldsl;
                        float* csrow = CS + (size_t)bh * KVROWS;
                        float cm = 0.f, cmp = 0.f;
#pragma unroll
                        for (int j = 0; j < 16; ++j) { cm += LFM[h * 16 + j]; if (j == tid) cmp = cm; }
                        const float* lp = LF + (size_t)bh * SEQ + 16 * tid; float v[16];
#pragma unroll
                        for (int j = 0; j < 4; ++j) { const f32x4 q = *(const GAS f32x4*)(lp + 4 * j); v[4 * j] = q.x; v[4 * j + 1] = q.y; v[4 * j + 2] = q.z; v[4 * j + 3] = q.w; }
#pragma unroll
                        for (int j = 1; j < 16; ++j) v[j] += v[j - 1];
                        float inc = v[15];
#pragma unroll
                        for (int o = 1; o < 64; o <<= 1) { const float t = lane_get(inc, (lane - o) & 63); if (lane >= o) inc += t; }
                        if (lane == 63) wt[wave] = inc;
                        __syncthreads();
                        float off = cm + inc - v[15];
                        for (int wv = 0; wv < wave; ++wv) off += wt[wv];
#pragma unroll
                        for (int j = 0; j < 4; ++j) *(GAS f32x4*)(csrow + 128 + 16 * tid + 4 * j) = (f32x4){(off + v[4 * j]) * LOG2E, (off + v[4 * j + 1]) * LOG2E, (off + v[4 * j + 2]) * LOG2E, (off + v[4 * j + 3]) * LOG2E};
                        const float cmsh = lane_get(cmp, (lane + 16) & 63);
                        if (tid < 128) csrow[tid] = (tid >= 48 && tid < 64) ? cmsh * LOG2E : __builtin_inff();
                        __syncthreads();
                    }
                }
            } else if (s == 6) {
                const attn_body::AttnTensors AT{(const attn_body::bf16*)R0, (const attn_body::bf16*)R1, (const attn_body::bf16*)R2, (attn_body::bf16*)R0, CS};
                const attn_body::StaticOrder S(G, bx);
#ifndef NO_ATTN
                attn_body::attn_phase<attn_body::StaticOrder>((char*)lds, AT, S, tid);
#endif
                if (gw < NH) {
                    const int h = gw, q = lane & 15, dc = lane >> 4;
                    const bf16* qp = R0 + (size_t)(MMAIN + q) * DM + 64 * h + 16 * dc;
                    const v4u qa = ((const GAS v4u*)qp)[0], qb = ((const GAS v4u*)qp)[1];
                    float qv[16];
#pragma unroll
                    for (int e = 0; e < 4; ++e) { qv[2 * e] = bflo(qa[e]); qv[2 * e + 1] = bfhi(qa[e]); qv[8 + 2 * e] = bflo(qb[e]); qv[8 + 2 * e + 1] = bfhi(qb[e]); }
                    float mrun = -__builtin_inff(), l = 0.f, o[16];
#pragma unroll
                    for (int e = 0; e < 16; ++e) o[e] = 0.f;
                    for (int j = 0; j < 16; ++j) {
                        const bf16* kp = R1 + (size_t)(48 + j) * DM + 64 * h + 16 * dc; const bf16* vp = R2 + (size_t)(48 + j) * DM + 64 * h + 16 * dc;
                        const v4u ka = ((const GAS v4u*)kp)[0], kb = ((const GAS v4u*)kp)[1], va = ((const GAS v4u*)vp)[0], vb = ((const GAS v4u*)vp)[1];
                        float d = 0.f;
#pragma unroll
                        for (int e = 0; e < 4; ++e) d += qv[2 * e] * bflo(ka[e]) + qv[2 * e + 1] * bfhi(ka[e]) + qv[8 + 2 * e] * bflo(kb[e]) + qv[8 + 2 * e + 1] * bfhi(kb[e]);
                        d += lane_get(d, lane ^ 16); d += lane_get(d, lane ^ 32);
                        const float sc = d - *(const GAS float*)(CS + (size_t)h * KVROWS + 48 + j);
                        if (j <= q) { const float mn = fmaxf(mrun, sc), f = __builtin_amdgcn_exp2f(mrun - mn), p = __builtin_amdgcn_exp2f(sc - mn); l = l * f + p; mrun = mn;
#pragma unroll
                            for (int e = 0; e < 4; ++e) { o[2 * e] = o[2 * e] * f + p * bflo(va[e]); o[2 * e + 1] = o[2 * e + 1] * f + p * bfhi(va[e]); o[8 + 2 * e] = o[8 + 2 * e] * f + p * bflo(vb[e]); o[8 + 2 * e + 1] = o[8 + 2 * e + 1] * f + p * bfhi(vb[e]); } }
                    }
                    const float rl = 1.0f / l; v4u oa, ob;
#pragma unroll
                    for (int e = 0; e < 4; ++e) { oa[e] = pk2(o[2 * e] * rl, o[2 * e + 1] * rl); ob[e] = pk2(o[8 + 2 * e] * rl, o[8 + 2 * e + 1] * rl); }
                    GAS v4u* op = (GAS v4u*)(R0 + (size_t)(MMAIN + q) * DM + 64 * h + 16 * dc); op[0] = oa; op[1] = ob;
                }
            }
            grid.sync();
        }
    }
}

extern "C" void kernel_launch(void* const* d_in, const int* in_sizes, int n_in, void* d_out, int out_size, void* d_ws, size_t ws_size, hipStream_t stream) {
    static int grid = 0;
    if (grid == 0) {
        if (n_in != 21 || out_size != MMAIN * DM || ws_size < WS_END) { fprintf(stderr, "kernel_launch: unexpected shapes (n_in %d out %d ws %zu)\n", n_in, out_size, ws_size); grid = -1; return; }
        int dev = 0, cus = 0, per_cu = 0;
        hipGetDevice(&dev); hipDeviceGetAttribute(&cus, hipDeviceAttributeMultiprocessorCount, dev);
        if (hipFuncSetAttribute((const void*)fwd_megakernel, hipFuncAttributeMaxDynamicSharedMemorySize, LDS_BYTES) != hipSuccess) { fprintf(stderr, "kernel_launch: hipFuncSetAttribute failed\n"); grid = -1; return; }
        if (hipOccupancyMaxActiveBlocksPerMultiprocessor(&per_cu, (const void*)fwd_megakernel, NWAVES * 64, LDS_BYTES) != hipSuccess || per_cu < 1) { fprintf(stderr, "kernel_launch: occupancy query says %d\n", per_cu); per_cu = 1; }
        (void)hipGetLastError();
        grid = cus * 1;
        if (grid != 256) fprintf(stderr, "kernel_launch: grid %d (expected 256)\n", grid);
    }
    if (grid < 0) return;
    Args a{};
    const float** f = (const float**)&a;
    for (int i = 0; i < 21; ++i) f[i] = (const float*)d_in[i];
    a.out = (float*)d_out; a.ws = (unsigned char*)d_ws;
    void* args[] = {&a};
    hipError_t e = hipLaunchCooperativeKernel((const void*)fwd_megakernel, dim3(grid), dim3(NWAVES * 64), args, LDS_BYTES, stream);
    if (e != hipSuccess) fprintf(stderr, "cooperative launch failed: %s (grid %d)\n", hipGetErrorString(e), grid);
}
```

```cpp
#include <hip/hip_runtime.h>
#include <hip/hip_cooperative_groups.h>
#include <cstdio>
#include <cstdint>
namespace pg8 {
#define PG8_LAS __attribute__((address_space(3)))
typedef unsigned short bf16_t;
typedef short bf16x8 __attribute__((ext_vector_type(8)));
typedef float f32x4 __attribute__((ext_vector_type(4)));
typedef unsigned u32x4 __attribute__((ext_vector_type(4)));
constexpr int BM = 256, BK = 64, HALF = 128, HTB = HALF * BK * 2  , STAGE_BYTES = 8 * HTB, NXCD = 8, WGM = 8;

__host__ __device__ __forceinline__ int lds_byte(int r, int c) { const int st = (r >> 4) * 2 + (c >> 5), rr = r & 15, cc = c & 31, ob = rr * 64 + cc * 2; return st * 1024 + (ob ^ (((ob >> 9) & 1) << 5)); }
__host__ __device__ __forceinline__ void stage_rc(int b, int& R, int& C) { const int st = b / 1024, sb = b % 1024, swz = sb ^ (((sb >> 9) & 1) << 5); R = (st >> 1) * 16 + swz / 64; C = (st & 1) * 32 + (swz % 64) / 2; }
__host__ __device__ __forceinline__ int perm32(int rho) { const int n = rho >> 4, i = rho & 15; return 8 * (i >> 2) + 4 * n + (i & 3); }

struct Unit { int pm, pn; };
struct Gemm { const bf16_t* A; const bf16_t* Bt; int M, N, K; };

struct StaticOrder {
    int nM, nN, nwg, G, c;
    __host__ __device__ void init(int M, int N, int G_, int c_) { nM = M / BM; nN = N / BM; nwg = nM * nN; G = G_; c = c_; }
    __host__ __device__ bool next(int i, Unit& u) const {
        const long L = (long)i * G + c; if (L >= nwg) return false;
        int wgid = (int)L; { const int q = nwg / NXCD, r = nwg % NXCD, xcd = wgid % NXCD, off = wgid / NXCD; wgid = (xcd < r ? xcd * (q + 1) : r * (q + 1) + (xcd - r) * q) + off; }
        const int nig = WGM * nN, gid = wgid / nig, fm = gid * WGM, gsz = (nM - fm) < WGM ? (nM - fm) : WGM;
        u.pm = fm + ((wgid % nig) % gsz); u.pn = (wgid % nig) / gsz; return true;
    }
    __device__ __forceinline__ void a_ready(const Unit&) const {}
    __device__ __forceinline__ void done(const Unit&) const {}
};

__device__ __forceinline__ unsigned cvt_pk_bf16(float lo, float hi) { unsigned r; asm volatile("v_cvt_pk_bf16_f32 %0, %1, %2" : "=v"(r) : "v"(lo), "v"(hi)); return r; }
typedef float f32x2 __attribute__((ext_vector_type(2)));
__device__ __forceinline__ float sigm(float x) { return __builtin_amdgcn_rcpf(1.0f + __builtin_amdgcn_exp2f(-1.4426950408889634f * x)); }
constexpr float QK_C2 = 0.125f * 1.4426950408889634f;
#define PG8_GAS __attribute__((address_space(1)))
struct EpiAll {
    static constexpr bool PERM = true, AFTER_DRAIN = false;
    int mode;
    int mtiles_main;
    bf16_t* O1; bf16_t* O2; bf16_t* O3; int ldo;
    float* hmain; float* hmeta; float scale;
    const float* qg; const float* kg;
    __device__ __forceinline__ void operator()(const f32x4 (&acc)[2][2][4][2], const Unit& u, int wr, int wc, int fr, int fq) const {
        const int rloc_ = wr * 64 + fr;
#define EPI_LAUNDER() int rloc = rloc_; asm volatile("" : "+v"(rloc))
        if (mode <= 1 || (mode == 2 && u.pn < 8)) {
            EPI_LAUNDER();
            bf16_t* base = O1 + (size_t)(u.pm * BM + rloc) * ldo + u.pn * HALF + wc * 32 + 8 * fq;
#pragma unroll
            for (int ai = 0; ai < 2; ++ai)
#pragma unroll
                for (int m = 0; m < 4; ++m) {
                    const f32x4 a0 = acc[ai][0][m][0], a1 = acc[ai][0][m][1], b0 = acc[ai][1][m][0], b1 = acc[ai][1][m][1];
                    f32x4 r0, r1;
                    if (mode == 0) {
#pragma unroll
                        for (int i = 0; i < 4; ++i) { r0[i] = a0[i] * sigm(a0[i]) * b0[i]; r1[i] = a1[i] * sigm(a1[i]) * b1[i]; }
                    } else if (mode == 1) {
#pragma unroll
                        for (int i = 0; i < 4; ++i) { r0[i] = a0[i] * sigm(b0[i]); r1[i] = a1[i] * sigm(b1[i]); }
                    } else { r0 = a0 * b0; r1 = a1 * b1; }
                    u32x4 w; w.x = cvt_pk_bf16(r0[0], r0[1]); w.y = cvt_pk_bf16(r0[2], r0[3]); w.z = cvt_pk_bf16(r1[0], r1[1]); w.w = cvt_pk_bf16(r1[2], r1[3]);
                    *(PG8_GAS u32x4*)(base + (size_t)(ai * HALF + m * 16) * ldo) = w;
                }
        } else if (mode == 2) {
            EPI_LAUNDER();
            bf16_t* base = O2 + (size_t)(u.pm * BM + rloc) * 1024 + (u.pn - 8) * BM + wc * 32 + 8 * fq;
#pragma unroll
            for (int ai = 0; ai < 2; ++ai)
#pragma unroll
                for (int m = 0; m < 4; ++m)
#pragma unroll
                    for (int bj = 0; bj < 2; ++bj) {
                        const f32x4 v0 = acc[ai][bj][m][0], v1 = acc[ai][bj][m][1];
                        u32x4 w; w.x = cvt_pk_bf16(v0[0], v0[1]); w.y = cvt_pk_bf16(v0[2], v0[3]); w.z = cvt_pk_bf16(v1[0], v1[1]); w.w = cvt_pk_bf16(v1[2], v1[3]);
                        *(PG8_GAS u32x4*)(base + (size_t)(ai * HALF + m * 16) * 1024 + bj * HALF) = w;
                    }
        } else if (mode == 3) {
            EPI_LAUNDER();
            const int sec = u.pn >> 2;
            const bool meta = false;
            const long krow0 = meta ? 48 : (long)u.pm * BM + 128 * (1 + (u.pm >> 5));
            bf16_t* dst = (sec == 0) ? O1 + (size_t)(u.pm * BM) * 1024 : ((sec == 1) ? O2 : O3) + (size_t)krow0 * 1024;
            const bool dup = meta && sec != 0; const int rlim = dup ? 16 : 256;
            if (sec < 2) {
                const int head = 4 * (u.pn & 3) + wc;
                const int lxor16 = (fr + 16 * (fq ^ 1)) << 2, lxor32 = (fr + 16 * (fq ^ 2)) << 2;
                const float* g = (sec == 0) ? qg : kg; const float gs = (sec == 0) ? QK_C2 : 1.0f;
                f32x4 gv[2][2];
#pragma unroll
                for (int bj = 0; bj < 2; ++bj)
#pragma unroll
                    for (int n = 0; n < 2; ++n) gv[bj][n] = *(const PG8_GAS f32x4*)(g + 32 * bj + 8 * fq + 4 * n) * gs;
#pragma unroll
                for (int ai = 0; ai < 2; ++ai)
#pragma unroll
                    for (int m = 0; m < 4; ++m) {
                        float ss = 0.f;
#pragma unroll
                        for (int bj = 0; bj < 2; ++bj)
#pragma unroll
                            for (int n = 0; n < 2; ++n) { const f32x4 x = acc[ai][bj][m][n]; ss += (x[0] * x[0] + x[1] * x[1]) + (x[2] * x[2] + x[3] * x[3]); }
                        ss += __builtin_bit_cast(float, __builtin_amdgcn_ds_bpermute(lxor16, __builtin_bit_cast(int, ss))); ss += __builtin_bit_cast(float, __builtin_amdgcn_ds_bpermute(lxor32, __builtin_bit_cast(int, ss)));
                        const float rs = __builtin_amdgcn_rsqf(ss * (1.0f / 64.0f) + 1e-6f);
                        const int rl = rloc + ai * HALF + m * 16;
#pragma unroll
                        for (int bj = 0; bj < 2; ++bj) {
                            const f32x4 v0 = acc[ai][bj][m][0] * rs * gv[bj][0], v1 = acc[ai][bj][m][1] * rs * gv[bj][1];
                            u32x4 w; w.x = cvt_pk_bf16(v0[0], v0[1]); w.y = cvt_pk_bf16(v0[2], v0[3]); w.z = cvt_pk_bf16(v1[0], v1[1]); w.w = cvt_pk_bf16(v1[2], v1[3]);
                            const int col = 64 * head + 32 * bj + 8 * fq;
                            if (rl < rlim) { *(PG8_GAS u32x4*)(dst + (size_t)rl * 1024 + col) = w; if (dup) *(PG8_GAS u32x4*)(dst + (size_t)(8320 + rl) * 1024 + col) = w; }
                        }
                    }
            } else {
#pragma unroll
                for (int ai = 0; ai < 2; ++ai)
#pragma unroll
                    for (int m = 0; m < 4; ++m) {
                        const int rl = rloc + ai * HALF + m * 16;
#pragma unroll
                        for (int bj = 0; bj < 2; ++bj) {
                            const f32x4 v0 = acc[ai][bj][m][0], v1 = acc[ai][bj][m][1];
                            u32x4 w; w.x = cvt_pk_bf16(v0[0], v0[1]); w.y = cvt_pk_bf16(v0[2], v0[3]); w.z = cvt_pk_bf16(v1[0], v1[1]); w.w = cvt_pk_bf16(v1[2], v1[3]);
                            const int col = (u.pn - 8) * BM + bj * HALF + wc * 32 + 8 * fq;
                            if (rl < rlim) { *(PG8_GAS u32x4*)(dst + (size_t)rl * 1024 + col) = w; if (dup) *(PG8_GAS u32x4*)(dst + (size_t)(8320 + rl) * 1024 + col) = w; }
                        }
                    }
            }
        } else {
            EPI_LAUNDER();
            float* base = hmain + (size_t)(u.pm * BM + rloc) * 1024 + u.pn * BM + wc * 32 + 8 * fq;
            const float sc = scale;
#pragma unroll
            for (int ai = 0; ai < 2; ++ai)
#pragma unroll
                for (int m = 0; m < 4; ++m)
#pragma unroll
                    for (int bj = 0; bj < 2; ++bj) {
                        float* p = base + (size_t)(ai * HALF + m * 16) * 1024 + bj * HALF;
                        f32x4 x0 = *(const PG8_GAS f32x4*)p, x1 = *(const PG8_GAS f32x4*)(p + 4);
                        x0 += acc[ai][bj][m][0] * sc; x1 += acc[ai][bj][m][1] * sc;
                        *(PG8_GAS f32x4*)p = x0; *(PG8_GAS f32x4*)(p + 4) = x1;
                    }
        }
    }
};
template <class Epi, class Sched, bool ALIGN_EPI = false, bool SP2 = false>
__device__ __forceinline__ void gemm_phase(PG8_LAS unsigned char* lds, const Gemm g, const Sched& S, const Epi& E, const int tid_in) {
    const int tid = tid_in, wid = __builtin_amdgcn_readfirstlane(tid >> 6), lane = tid & 63, wr = wid >> 2, wc = wid & 3, fr = lane & 15, fq = lane >> 4;
    const int K = g.K, nt = K / BK;
    unsigned voffA[2], voffB[2];
#pragma unroll
    for (int i = 0; i < 2; ++i) { int R, C; stage_rc(tid * 16 + i * 8192, R, C); const int Rb = Epi::PERM ? ((R & ~31) + perm32(R & 31)) : R;
        voffA[i] = (unsigned)(R * K + C) * 2u; voffB[i] = (unsigned)(Rb * K + C) * 2u; }
    const size_t kstep = (size_t)(BK * 2);
    const size_t hstep = (size_t)HALF * K * 2;
    const size_t tstep = 2 * hstep;
    const unsigned ldsw = (unsigned)wid * 1024u;
    const int aoff = lds_byte(wr * 64 + fr, fq * 8), boff = lds_byte(wc * 32 + fr, fq * 8);
#define PG8_SA(b, h) (((b) * 2 + (h)) * HTB)
#define PG8_SB(b, h) ((4 + (b) * 2 + (h)) * HTB)
#define PG8_STAGE(bufoff, gbase, voff) do { _Pragma("unroll") for (int _i = 0; _i < 2; ++_i) \
        __builtin_amdgcn_global_load_lds((const unsigned*)((const char*)(gbase) + (voff)[_i]), (PG8_LAS unsigned*)(lds + (bufoff) + ldsw + _i * 8192), 16, 0, 0); } while (0)
#define PG8_LDA(dst, b, h) do { _Pragma("unroll") for (int m = 0; m < 4; ++m) _Pragma("unroll") for (int k = 0; k < 2; ++k) dst[m][k] = *(const PG8_LAS bf16x8*)(lds + PG8_SA(b, h) + aoff + m * 2048 + k * 1024); } while (0)
#define PG8_LDB(dst, b, h) do { _Pragma("unroll") for (int n = 0; n < 2; ++n) _Pragma("unroll") for (int k = 0; k < 2; ++k) dst[n][k] = *(const PG8_LAS bf16x8*)(lds + PG8_SB(b, h) + boff + n * 2048 + k * 1024); } while (0)
#define PG8_MMA(ai, bj, At, Bt) do { __builtin_amdgcn_s_setprio(1); _Pragma("unroll") for (int m = 0; m < 4; ++m) _Pragma("unroll") for (int n = 0; n < 2; ++n) _Pragma("unroll") for (int k = 0; k < 2; ++k) \
        acc[ai][bj][m][n] = __builtin_amdgcn_mfma_f32_16x16x32_bf16(Bt[n][k], At[m][k], acc[ai][bj][m][n], 0, 0, 0); __builtin_amdgcn_s_setprio(0); } while (0)
#define PG8_WAIT_V(n) asm volatile("s_waitcnt vmcnt(" #n ")" ::: "memory")
#define PG8_WAIT_L(n) asm volatile("s_waitcnt lgkmcnt(" #n ")" ::: "memory")
#define PG8_BAR __builtin_amdgcn_s_barrier()
#define PG8_SCHED __builtin_amdgcn_sched_barrier(0)
    Unit cur, nxt; int ui = 0;
    if (!S.next(0, cur)) return;
    f32x4 acc[2][2][4][2];
#pragma unroll
    for (int a = 0; a < 2; ++a)
#pragma unroll
        for (int b = 0; b < 2; ++b)
#pragma unroll
            for (int m = 0; m < 4; ++m)
#pragma unroll
                for (int n = 0; n < 2; ++n) acc[a][b][m][n] = (f32x4){0.f, 0.f, 0.f, 0.f};
    bf16x8 At[4][2], B0[2][2], B1[2][2];
    const char* cA = (const char*)g.A + (size_t)cur.pm * tstep; const char* cB = (const char*)g.Bt + (size_t)cur.pn * tstep;
    S.a_ready(cur);
    if constexpr (SP2) {
        PG8_STAGE(PG8_SB(0, 0), cB, voffB); PG8_STAGE(PG8_SB(0, 1), cB + hstep, voffB); PG8_STAGE(PG8_SA(0, 0), cA, voffA); PG8_STAGE(PG8_SA(0, 1), cA + hstep, voffA);
        if (wr == 1) PG8_BAR;
        PG8_WAIT_V(2); PG8_BAR;
        PG8_STAGE(PG8_SB(1, 0), cB + kstep, voffB); PG8_STAGE(PG8_SA(1, 0), cA + kstep, voffA); PG8_STAGE(PG8_SB(1, 1), cB + hstep + kstep, voffB);
        PG8_WAIT_V(6); PG8_BAR;
    } else {
        PG8_STAGE(PG8_SB(0, 0), cB, voffB); PG8_STAGE(PG8_SA(0, 0), cA, voffA); PG8_STAGE(PG8_SB(0, 1), cB + hstep, voffB); PG8_STAGE(PG8_SA(0, 1), cA + hstep, voffA);
        if (wr == 1) PG8_BAR;
        PG8_WAIT_V(4); PG8_BAR;
        PG8_STAGE(PG8_SB(1, 0), cB + kstep, voffB); PG8_STAGE(PG8_SA(1, 0), cA + kstep, voffA); PG8_STAGE(PG8_SB(1, 1), cB + hstep + kstep, voffB);
        PG8_WAIT_V(6); PG8_BAR;
    }
    for (;;) {
        const bool has_next = S.next(ui + 1, nxt);
        const char* nA = has_next ? (const char*)g.A + (size_t)nxt.pm * tstep : cA; const char* nB = has_next ? (const char*)g.Bt + (size_t)nxt.pn * tstep : cB;
        for (int t = 0; t < nt; t += 2) {
            const bool last = (t == nt - 2);
            const char* a1 = cA + (size_t)(t + 1) * kstep;
            const char* a2 = last ? nA : cA + (size_t)(t + 2) * kstep; const char* b2 = last ? nB : cB + (size_t)(t + 2) * kstep;
            const char* a3 = a2 + kstep; const char* b3 = b2 + kstep;
            if (last && has_next) S.a_ready(nxt);
            if constexpr (SP2) {
            PG8_LDB(B0, 0, 0); PG8_LDB(B1, 0, 1); PG8_SCHED; PG8_LDA(At, 0, 0); PG8_STAGE(PG8_SA(1, 1), a1 + hstep, voffA);
            PG8_WAIT_V(8); PG8_WAIT_L(0); PG8_BAR; PG8_MMA(0, 0, At, B0); PG8_MMA(0, 1, At, B1); PG8_BAR; PG8_SCHED;
            PG8_LDA(At, 0, 1); PG8_STAGE(PG8_SB(0, 0), b2, voffB); PG8_STAGE(PG8_SB(0, 1), b2 + hstep, voffB); PG8_STAGE(PG8_SA(0, 0), a2, voffA);
            PG8_WAIT_V(8); PG8_WAIT_L(0); PG8_BAR; PG8_MMA(1, 0, At, B0); PG8_MMA(1, 1, At, B1); PG8_BAR; PG8_SCHED;
            PG8_LDB(B0, 1, 0); PG8_LDB(B1, 1, 1); PG8_SCHED; PG8_LDA(At, 1, 0); PG8_STAGE(PG8_SA(0, 1), a2 + hstep, voffA);
            PG8_WAIT_V(8); PG8_WAIT_L(0); PG8_BAR; PG8_MMA(0, 0, At, B0); PG8_MMA(0, 1, At, B1); PG8_BAR; PG8_SCHED;
            PG8_LDA(At, 1, 1); PG8_STAGE(PG8_SB(1, 0), b3, voffB); PG8_STAGE(PG8_SB(1, 1), b3 + hstep, voffB); PG8_STAGE(PG8_SA(1, 0), a3, voffA);
            PG8_WAIT_V(8); PG8_WAIT_L(0); PG8_BAR; PG8_MMA(1, 0, At, B0); PG8_MMA(1, 1, At, B1); PG8_BAR; PG8_SCHED;
            } else {
            PG8_LDB(B0, 0, 0); PG8_SCHED; PG8_LDA(At, 0, 0); PG8_STAGE(PG8_SA(1, 1), a1 + hstep, voffA);
            PG8_WAIT_L(8); PG8_BAR; PG8_WAIT_L(0); PG8_MMA(0, 0, At, B0); PG8_BAR; PG8_SCHED;
            PG8_LDB(B1, 0, 1); PG8_STAGE(PG8_SB(0, 0), b2, voffB);
            PG8_BAR; PG8_WAIT_L(0); PG8_MMA(0, 1, At, B1); PG8_BAR;
            PG8_LDA(At, 0, 1); PG8_STAGE(PG8_SA(0, 0), a2, voffA);
            PG8_BAR; PG8_WAIT_L(0); PG8_MMA(1, 0, At, B0); PG8_BAR; PG8_SCHED;
            PG8_STAGE(PG8_SB(0, 1), b2 + hstep, voffB);
            PG8_WAIT_V(6); PG8_BAR; PG8_MMA(1, 1, At, B1); PG8_BAR;
            PG8_LDB(B0, 1, 0); PG8_SCHED; PG8_LDA(At, 1, 0); PG8_STAGE(PG8_SA(0, 1), a2 + hstep, voffA);
            PG8_WAIT_L(8); PG8_BAR; PG8_WAIT_L(0); PG8_MMA(0, 0, At, B0); PG8_BAR; PG8_SCHED;
            PG8_LDB(B1, 1, 1); PG8_STAGE(PG8_SB(1, 0), b3, voffB);
            PG8_BAR; PG8_WAIT_L(0); PG8_MMA(0, 1, At, B1); PG8_BAR;
            PG8_LDA(At, 1, 1); PG8_STAGE(PG8_SA(1, 0), a3, voffA);
            PG8_BAR; PG8_WAIT_L(0); PG8_MMA(1, 0, At, B0); PG8_BAR; PG8_SCHED;
            PG8_STAGE(PG8_SB(1, 1), b3 + hstep, voffB);
            PG8_WAIT_V(6); PG8_BAR; PG8_MMA(1, 1, At, B1); PG8_BAR;
            }
        }
        if constexpr (ALIGN_EPI) { if (wr == 0) PG8_BAR; }
        if constexpr (!Epi::AFTER_DRAIN) { E(acc, cur, wr, wc, fr, fq); S.done(cur); }
        if (!has_next) break;
#pragma unroll
        for (int a = 0; a < 2; ++a)
#pragma unroll
            for (int b = 0; b < 2; ++b)
#pragma unroll
                for (int m = 0; m < 4; ++m)
#pragma unroll
                    for (int n = 0; n < 2; ++n) acc[a][b][m][n] = (f32x4){0.f, 0.f, 0.f, 0.f};
        cur = nxt; cA = nA; cB = nB; ++ui;
        if constexpr (ALIGN_EPI) { if (wr == 1) PG8_BAR; }
    }
    PG8_WAIT_V(0);
    if constexpr (!ALIGN_EPI) { if (wr == 0) PG8_BAR; }
    PG8_BAR;
    if constexpr (Epi::AFTER_DRAIN) { E.fused(acc, cur, wr, wc, fr, fq, lds, wid, lane); S.done(cur); }
#undef PG8_SA
#undef PG8_SB
#undef PG8_STAGE
#undef PG8_LDA
#undef PG8_LDB
#undef PG8_MMA
#undef PG8_WAIT_V
#undef PG8_WAIT_L
#undef PG8_BAR
#undef PG8_SCHED
}
}

#ifndef PG8_SP2
#define PG8_SP2 true
#endif
#ifndef PG8_ALIGN
#define PG8_ALIGN true
#endif
#include <hip/hip_bf16.h>
#include <cmath>
namespace attn_body {
using bf16=__hip_bfloat16;
using bf16x8=__attribute__((ext_vector_type(8)))short;
using s16x4=__attribute__((ext_vector_type(4)))short;
using f32x16=__attribute__((ext_vector_type(16)))float;
using u32x4=__attribute__((ext_vector_type(4)))unsigned;
constexpr int BATCH=2,NHEAD=16,SEQ=8192,D=64,DM=NHEAD*D;
constexpr int NW=8,QBLK=32,QB=QBLK*NW,KVBLK=64,NQB=SEQ/QB; constexpr int KVPAD=128,KVROWS=SEQ+KVPAD;
constexpr int ATTN_PITCH=DM, ATTN_UNIT_ROWS=QB;
__device__ __forceinline__ int crow(int r,int hi){return (r&3)+8*(r>>2)+4*hi;}
#define SBAR() __builtin_amdgcn_sched_barrier(0)
__device__ __forceinline__ void cmask(f32x16&p0,f32x16&p1,int jb,int qrel,int hi){
  const float NEG=-INFINITY; int kb=64*jb+4*hi;
  #pragma unroll
  for(int r=0;r<16;++r){int kv=kb+(r&3)+8*(r>>2); if(kv>qrel)p0[r]=NEG; if(kv+32>qrel)p1[r]=NEG;}
}

constexpr int NSLOT=3, SLOTB=8192;
constexpr int LDS_K=0, LDS_V=NSLOT*SLOTB, LDS_WS=2*NSLOT*SLOTB, LDS_OST=LDS_WS+NW*64*4, LDS_CS=LDS_OST+NW*4096, LDS_BYTES=LDS_CS+KVROWS*4;
constexpr float C2=0.125f*1.4426950408889634f;
__device__ __forceinline__ void glds16(const void*gsrc,unsigned lds_dst){unsigned keep;
  asm volatile("s_mov_b32 %0, m0\n\ts_mov_b32 m0, %2\n\ts_nop 0\n\tglobal_load_lds_dwordx4 %1, off\n\ts_mov_b32 m0, %0":"=&s"(keep):"v"(gsrc),"s"(lds_dst):"memory");}
__device__ __forceinline__ float max3f(float a,float b,float c){float r;asm("v_max3_f32 %0, %1, %2, %3":"=v"(r):"v"(a),"v"(b),"v"(c));return r;}
__device__ __forceinline__ float max2f(float a,float b){float r;asm("v_max_f32_e32 %0, %1, %2":"=v"(r):"v"(a),"v"(b));return r;}
__device__ __forceinline__ float fadd_s(float a,float b){float r;asm("v_add_f32_e32 %0, %1, %2":"=v"(r):"v"(a),"v"(b));return r;}
__device__ __forceinline__ float fsub_s(float a,float b){float r;asm("v_sub_f32_e32 %0, %1, %2":"=v"(r):"v"(a),"v"(b));return r;}
typedef float f32x2_t __attribute__((ext_vector_type(2))); typedef __bf16 bf16x2_t __attribute__((ext_vector_type(2)));
__device__ __forceinline__ unsigned cvtpk_s(float lo,float hi){f32x2_t v={lo,hi};bf16x2_t b=__builtin_convertvector(v,bf16x2_t);return __builtin_bit_cast(unsigned,b);}
#define WAIT_BAR(N) asm volatile("s_waitcnt vmcnt(" #N ") lgkmcnt(0)\n\ts_barrier":::"memory")

__device__ __forceinline__ void qkt(f32x16&p0,f32x16&p1,const char*Kslot,const bf16x8*qr,int r32,int hi){
  const char*kb=Kslot+hi*1024+r32*16;
  #pragma unroll
  for(int d0=0;d0<4;++d0){
    const bf16x8 b0=*reinterpret_cast<const bf16x8*>(kb+d0*2048);
    const bf16x8 b1=*reinterpret_cast<const bf16x8*>(kb+d0*2048+512);
    p0=__builtin_amdgcn_mfma_f32_32x32x16_bf16(b0,qr[d0],p0,0,0,0);p1=__builtin_amdgcn_mfma_f32_32x32x16_bf16(b1,qr[d0],p1,0,0,0);}
}
typedef __attribute__((address_space(3))) const char* lds_cptr;
typedef short v4i16_t __attribute__((ext_vector_type(4))); typedef float f32x4_t __attribute__((ext_vector_type(4)));
__device__ __forceinline__ void kload8(bf16x8*kf,lds_cptr kp){
  kf[0]=*(const __attribute__((address_space(3))) bf16x8*)(kp);      kf[1]=*(const __attribute__((address_space(3))) bf16x8*)(kp+512);
  kf[2]=*(const __attribute__((address_space(3))) bf16x8*)(kp+2048); kf[3]=*(const __attribute__((address_space(3))) bf16x8*)(kp+2560);
  kf[4]=*(const __attribute__((address_space(3))) bf16x8*)(kp+4096); kf[5]=*(const __attribute__((address_space(3))) bf16x8*)(kp+4608);
  kf[6]=*(const __attribute__((address_space(3))) bf16x8*)(kp+6144); kf[7]=*(const __attribute__((address_space(3))) bf16x8*)(kp+6656);
}
__device__ __forceinline__ void kload2(bf16x8*kf,lds_cptr kp,int j){ kf[2*j]=*(const __attribute__((address_space(3))) bf16x8*)(kp+j*2048); kf[2*j+1]=*(const __attribute__((address_space(3))) bf16x8*)(kp+j*2048+512); }
__device__ __forceinline__ s16x4 vtr(lds_cptr p){ return __builtin_bit_cast(s16x4,__builtin_amdgcn_ds_read_tr16_b64_v4i16((__attribute__((address_space(3))) v4i16_t*)p)); }
__device__ __forceinline__ float rowmax(const f32x16&p0,const f32x16&p1){
  float a=max3f(p0[0],p0[1],p1[0]),b=max3f(p0[2],p0[3],p1[1]);a=max3f(a,p1[2],p1[3]);
  #pragma unroll
  for(int r=4;r<16;r+=4){a=max3f(a,p0[r],p0[r+1]);b=max3f(b,p0[r+2],p0[r+3]);a=max3f(a,p1[r],p1[r+1]);b=max3f(b,p1[r+2],p1[r+3]);}
  const float m=max2f(a,b);
  auto rr=__builtin_amdgcn_permlane32_swap(__float_as_uint(m),__float_as_uint(m),false,false);
  return max2f(__uint_as_float(rr[0]),__uint_as_float(rr[1]));
}
__device__ __forceinline__ void pv(f32x16*o,int vb,bf16x8 pa0,bf16x8 pa1,bf16x8 pa2,bf16x8 pa3){
  #pragma unroll
  for(int d0=0;d0<2;++d0){s16x4 lo[4],hi[4];
    #pragma unroll
    for(int ks=0;ks<4;++ks){
      asm volatile("ds_read_b64_tr_b16 %0,%1 offset:%c2":"=&v"(lo[ks]):"v"(vb),"i"(d0*4096+ks*1024):"memory");
      asm volatile("ds_read_b64_tr_b16 %0,%1 offset:%c2":"=&v"(hi[ks]):"v"(vb),"i"(d0*4096+ks*1024+512):"memory");}
    asm volatile("s_waitcnt lgkmcnt(0)":::"memory");SBAR();
    #define PK(k) (bf16x8){lo[k][0],lo[k][1],lo[k][2],lo[k][3],hi[k][0],hi[k][1],hi[k][2],hi[k][3]}
    o[d0]=__builtin_amdgcn_mfma_f32_32x32x16_bf16(pa0,PK(0),o[d0],0,0,0);
    o[d0]=__builtin_amdgcn_mfma_f32_32x32x16_bf16(pa1,PK(1),o[d0],0,0,0);
    o[d0]=__builtin_amdgcn_mfma_f32_32x32x16_bf16(pa2,PK(2),o[d0],0,0,0);
    o[d0]=__builtin_amdgcn_mfma_f32_32x32x16_bf16(pa3,PK(3),o[d0],0,0,0);
    #undef PK
  }
}

#ifndef ATTN_STORE16
#define ATTN_STORE16(p,v) (*(__attribute__((address_space(1))) u32x4*)(p)=(v))
#endif
template<int THRL> __device__ __forceinline__ void attn_unit(int b,int h,int qb,const bf16*Q,const bf16*__restrict__ K,const bf16*__restrict__ V,bf16*O,const float*__restrict__ CS,char*shm,const int tid_in){
  const int tid=tid_in,lane=tid&63,r32=lane&31,hi=lane>>5; const int wid=__builtin_amdgcn_readfirstlane(tid>>6);
  const long rowbase=(long)b*SEQ, kvbase=(long)b*KVROWS; const int q0=qb*QB;
  const bf16*Qw=Q+(rowbase+q0+wid*QBLK)*DM+h*D;
  const bf16*Kh=K+kvbase*DM+h*D,*Vh=V+kvbase*DM+h*D;
  const unsigned lds0=(unsigned)(uintptr_t)shm;
  float*wsf=(float*)(shm+LDS_WS)+wid*64;
  const bf16*ksrc=Kh+(long)lane*DM+wid*8;
  const bf16*vsrc=Vh+(long)(16*(wid&3)+(lane>>2))*DM+(wid>>2)*32+(lane&3)*8;
  const unsigned kdst=lds0+LDS_K+wid*1024, vdst=lds0+LDS_V+wid*1024;
  #define DMA_K(t,slot) glds16(ksrc+(long)(t)*KVBLK*DM,(unsigned)__builtin_amdgcn_readfirstlane(kdst+(slot)))
  #define DMA_V(t,slot) glds16(vsrc+(long)(t)*KVBLK*DM,(unsigned)__builtin_amdgcn_readfirstlane(vdst+(slot)))
  const int vb0=(int)(lds0+LDS_V)+((lane>>4)&1)*32+(lane&3)*8+(4*hi+((lane&15)>>2))*64;
  const char*Kbase=shm+LDS_K; bf16x8 kf[8];
  const lds_cptr shm3=(lds_cptr)shm; const lds_cptr kp0=shm3+LDS_K+hi*1024+r32*16; const lds_cptr vp0=shm3+LDS_V+((lane>>4)&1)*32+(lane&3)*8+(4*hi+((lane&15)>>2))*64;
  const int NT=(q0+QB+KVPAD)/KVBLK;
  { const float*csg=CS+(long)(b*NHEAD+h)*KVROWS; __attribute__((address_space(3))) float*csw=(__attribute__((address_space(3))) float*)((lds_cptr)shm+LDS_CS);
    for(int i=tid*4;i<NT*KVBLK;i+=NW*64*4){ const f32x4_t v=*(const __attribute__((address_space(1))) f32x4_t*)(csg+i); *(__attribute__((address_space(3))) f32x4_t*)(csw+i)=v; } }
  DMA_K(0,0);DMA_V(0,0);DMA_K(1,SLOTB);
  bf16x8 qr[4];
  #pragma unroll
  for(int d0=0;d0<4;++d0)qr[d0]=*(const __attribute__((address_space(1))) bf16x8*)(&Qw[(long)r32*DM+d0*16+hi*8]);
  float mhat=0.f,l_reg=0.f;f32x16 o[2];o[0]=f32x16{};o[1]=f32x16{};
  const __attribute__((address_space(3))) float*csl=(const __attribute__((address_space(3))) float*)((lds_cptr)shm+LDS_CS)+4*hi;
  #define BIASINIT(C0,C1,t) do{ const __attribute__((address_space(3))) float*bp_=csl+64*(t); const float nm_=-mhat; \
    _Pragma("unroll") for(int g_=0;g_<4;++g_){ const f32x4_t a_=*(const __attribute__((address_space(3))) f32x4_t*)(bp_+8*g_), b_=*(const __attribute__((address_space(3))) f32x4_t*)(bp_+32+8*g_); \
      C0[4*g_]=nm_-a_[0];C0[4*g_+1]=nm_-a_[1];C0[4*g_+2]=nm_-a_[2];C0[4*g_+3]=nm_-a_[3]; C1[4*g_]=nm_-b_[0];C1[4*g_+1]=nm_-b_[1];C1[4*g_+2]=nm_-b_[2];C1[4*g_+3]=nm_-b_[3]; } }while(0)
  const int qrel=wid*QBLK+r32;
  #define CMASK(P0,P1,t) do{int jb_=(t)-(NT-4); if(jb_>=0)cmask(P0,P1,jb_,qrel,hi);}while(0)
  bool resc=false;
  #define START(P0,P1) do{ const float rm=rowmax(P0,P1); resc=false; \
    { const float dl=rm; mhat=fadd_s(mhat,dl); \
      _Pragma("unroll") for(int r=0;r<16;++r){P0[r]=fsub_s(P0[r],dl);P1[r]=fsub_s(P1[r],dl);} \
      } \
    _Pragma("unroll") for(int r=0;r<16;++r)P0[r]=__builtin_amdgcn_exp2f(P0[r]); }while(0)
  #define RESC() do{ if(resc){ asm volatile("s_waitcnt lgkmcnt(0)":::"memory"); \
      _Pragma("unroll") for(int d_=0;d_<2;++d_) _Pragma("unroll") for(int r=0;r<16;++r)o[d_][r]*=wsf[crow(r,hi)]; } }while(0)
  f32x16 pA0,pA1,pB0,pB1;
  int sl_prev=0,sl_cur=0,sl_next=SLOTB;
  #define ROT() do{sl_prev=sl_cur;sl_cur=sl_next;sl_next=(sl_next==(NSLOT-1)*SLOTB)?0:sl_next+SLOTB;}while(0)
  DMA_K(2,2*SLOTB);
  WAIT_BAR(3);
  BIASINIT(pA0,pA1,0); qkt(pA0,pA1,Kbase,qr,r32,hi);asm volatile("s_nop 15\n\ts_nop 7":"+v"(pA0),"+v"(pA1));
  START(pA0,pA1);
  _Pragma("unroll") for(int r=0;r<16;++r)pA1[r]=__builtin_amdgcn_exp2f(pA1[r]);
  WAIT_BAR(0);
  DMA_K(3,0);DMA_V(1,SLOTB);
  ROT();
  kload8(kf,kp0+sl_cur);
  WAIT_BAR(2);
  s16x4 vlo[8],vhi[8]; u32x4 pw0,pw1,pw2,pw3;
  #define PKW(P,B) cvtpk_s(P[B],P[B+1])
  #define PAF(k) __builtin_bit_cast(bf16x8,pw##k)
  #define VFR(i) (bf16x8){vlo[i][0],vlo[i][1],vlo[i][2],vlo[i][3],vhi[i][0],vhi[i][1],vhi[i][2],vhi[i][3]}
  #define PIN(x) asm volatile("":"+v"(x))
  #define MX3(a,b,c) __builtin_fmaxf(__builtin_fmaxf((a),(b)),(c))
  #define GAPA(MF,A0,A1,A2,A3,W0,W1,PW) do{ MF; sacc+=A0; sacc+=A1; sacc+=A2; sacc+=A3; PIN(sacc); W0; W1; PIN(PW); SBAR(); }while(0)
  #define EX(v) __builtin_amdgcn_exp2f(v)
  #define GAPB(MF,X,B) do{ MF; X[B]=EX(X[B]); X[B+1]=EX(X[B+1]); X[B+2]=EX(X[B+2]); X[B+3]=EX(X[B+3]); PIN(X); SBAR(); }while(0)
  #define VRD(i) do{ vlo[i]=vtr(vp_+(((i)>>2)*4096+((i)&3)*1024)); vhi[i]=vtr(vp_+(((i)>>2)*4096+((i)&3)*1024+512)); }while(0)
  #define KRD(G,j) do{ if(G){ kload2(kf,kp0+sl_next,j); SBAR(); } }while(0)
  #define STEP(C0,C1,P0,P1,t,GK,GV,GL) do{ SBAR(); BIASINIT(C0,C1,t); SBAR(); \
    const lds_cptr vp_=vp0+sl_prev; \
    VRD(0); SBAR(); float sacc=(P0[0]+P0[1]); \
    GAPA(C0=__builtin_amdgcn_mfma_f32_32x32x16_bf16(kf[0],qr[0],C0,0,0,0), P0[2],P0[3],P0[4],P0[5],     pw0[0]=PKW(P0,0), pw0[1]=PKW(P0,2), pw0); \
    VRD(4); SBAR(); GAPA(C1=__builtin_amdgcn_mfma_f32_32x32x16_bf16(kf[1],qr[0],C1,0,0,0), P0[6],P0[7],P0[8],P0[9],     pw0[2]=PKW(P0,4), pw0[3]=PKW(P0,6), pw0); \
    VRD(1); SBAR(); GAPA(C0=__builtin_amdgcn_mfma_f32_32x32x16_bf16(kf[2],qr[1],C0,0,0,0),   P0[10],P0[11],P0[12],P0[13], pw1[0]=PKW(P0,8), pw1[1]=PKW(P0,10), pw1); \
    VRD(5); SBAR(); GAPA(C1=__builtin_amdgcn_mfma_f32_32x32x16_bf16(kf[3],qr[1],C1,0,0,0),   P0[14],P0[15],P1[0],P1[1],   pw1[2]=PKW(P0,12),pw1[3]=PKW(P0,14), pw1); \
    VRD(2); SBAR(); GAPA(C0=__builtin_amdgcn_mfma_f32_32x32x16_bf16(kf[4],qr[2],C0,0,0,0),   P1[2],P1[3],P1[4],P1[5],     pw2[0]=PKW(P1,0), pw2[1]=PKW(P1,2), pw2); \
    VRD(6); SBAR(); GAPA(C1=__builtin_amdgcn_mfma_f32_32x32x16_bf16(kf[5],qr[2],C1,0,0,0),   P1[6],P1[7],P1[8],P1[9],     pw2[2]=PKW(P1,4), pw2[3]=PKW(P1,6), pw2); \
    VRD(3); SBAR(); GAPA(C0=__builtin_amdgcn_mfma_f32_32x32x16_bf16(kf[6],qr[3],C0,0,0,0),   P1[10],P1[11],P1[12],P1[13], pw3[0]=PKW(P1,8), pw3[1]=PKW(P1,10), pw3); \
    VRD(7); SBAR(); GAPA(C1=__builtin_amdgcn_mfma_f32_32x32x16_bf16(kf[7],qr[3],C1,0,0,0),   P1[14],P1[15],0.f,0.f,       pw3[2]=PKW(P1,12),pw3[3]=PKW(P1,14), pw3); \
    l_reg+=sacc; \
    if(GK){DMA_K((t)+3,sl_cur);} if(GV){DMA_V((t)+1,sl_next);} \
    CMASK(C0,C1,t); \
    { float a=MX3(C0[0],C0[1],C1[0]),b=MX3(C0[2],C0[3],C1[1]); a=MX3(a,C1[2],C1[3]); \
      _Pragma("unroll") for(int r=4;r<16;r+=4){a=MX3(a,C0[r],C0[r+1]);b=MX3(b,C0[r+2],C0[r+3]);a=MX3(a,C1[r],C1[r+1]);b=MX3(b,C1[r+2],C1[r+3]);} \
      float rm=__builtin_fmaxf(a,b); { auto rr=__builtin_amdgcn_permlane32_swap(__float_as_uint(rm),__float_as_uint(rm),false,false); rm=__builtin_fmaxf(__uint_as_float(rr[0]),__uint_as_float(rr[1])); } \
      resc=false; \
      if(__builtin_expect(__any(rm>(float)THRL),0)){ const float dl=__builtin_fmaxf(rm,0.f); mhat+=dl; \
        _Pragma("unroll") for(int r=0;r<16;++r){C0[r]-=dl;C1[r]-=dl;} \
        const float f=__builtin_amdgcn_exp2f(-dl); l_reg*=f; if(hi==0)wsf[r32]=f; resc=true; } } \
    SBAR(); \
    GAPB(o[0]=__builtin_amdgcn_mfma_f32_32x32x16_bf16(PAF(0),VFR(0),o[0],0,0,0), C0,0); \
    GAPB(o[1]=__builtin_amdgcn_mfma_f32_32x32x16_bf16(PAF(0),VFR(4),o[1],0,0,0), C0,4); \
    KRD(GL,0); GAPB(o[0]=__builtin_amdgcn_mfma_f32_32x32x16_bf16(PAF(1),VFR(1),o[0],0,0,0), C0,8); \
    KRD(GL,1); GAPB(o[1]=__builtin_amdgcn_mfma_f32_32x32x16_bf16(PAF(1),VFR(5),o[1],0,0,0), C0,12); \
    KRD(GL,2); GAPB(o[0]=__builtin_amdgcn_mfma_f32_32x32x16_bf16(PAF(2),VFR(2),o[0],0,0,0), C1,0); \
    KRD(GL,3); GAPB(o[1]=__builtin_amdgcn_mfma_f32_32x32x16_bf16(PAF(2),VFR(6),o[1],0,0,0), C1,4); \
    GAPB(o[0]=__builtin_amdgcn_mfma_f32_32x32x16_bf16(PAF(3),VFR(3),o[0],0,0,0), C1,8); \
    GAPB(o[1]=__builtin_amdgcn_mfma_f32_32x32x16_bf16(PAF(3),VFR(7),o[1],0,0,0), C1,12); \
    }while(0)
  int t=1;
  #undef CMASK
  #define CMASK(P0,P1,t) do{}while(0)
  for(;t+5<NT;t+=2){
    STEP(pB0,pB1,pA0,pA1,t,true,true,true);     WAIT_BAR(2); RESC(); ROT();
    STEP(pA0,pA1,pB0,pB1,t+1,true,true,true);   WAIT_BAR(2); RESC(); ROT();
  }
  #undef CMASK
  #define CMASK(P0,P1,t) do{int jb_=(t)-(NT-4); if(jb_>=0)cmask(P0,P1,jb_,qrel,hi);}while(0)
  #define ENDW(tt) do{ if((tt)+3<NT){WAIT_BAR(2);} else if((tt)+2<NT){WAIT_BAR(1);} else {WAIT_BAR(0);} }while(0)
  for(;t+1<NT;t+=2){
    STEP(pB0,pB1,pA0,pA1,t,(t+3<NT),(t+1<NT),(t+1<NT));       ENDW(t);   RESC(); ROT();
    STEP(pA0,pA1,pB0,pB1,t+1,(t+4<NT),(t+2<NT),(t+2<NT));     ENDW(t+1); RESC(); ROT();
  }
  STEP(pB0,pB1,pA0,pA1,NT-1,false,false,false); RESC();
  { float sacc=pB0[0]+pB0[1]; _Pragma("unroll") for(int r=2;r<16;++r)sacc+=pB0[r]; _Pragma("unroll") for(int r=0;r<16;++r)sacc+=pB1[r]; l_reg+=sacc;
    pw0=(u32x4){PKW(pB0,0),PKW(pB0,2),PKW(pB0,4),PKW(pB0,6)};pw1=(u32x4){PKW(pB0,8),PKW(pB0,10),PKW(pB0,12),PKW(pB0,14)};pw2=(u32x4){PKW(pB1,0),PKW(pB1,2),PKW(pB1,4),PKW(pB1,6)};pw3=(u32x4){PKW(pB1,8),PKW(pB1,10),PKW(pB1,12),PKW(pB1,14)};
    SBAR(); pv(o,vb0+sl_cur,PAF(0),PAF(1),PAF(2),PAF(3)); }
  #undef PKW
  #undef PAF
  #undef VFR
  #undef PIN
  #undef MX3
  #undef GAPA
  #undef GAPB
  #undef EX
  #undef VRD
  #undef KRD
  #undef STEP
  #undef ENDW
  {auto rr=__builtin_amdgcn_permlane32_swap(__float_as_uint(l_reg),__float_as_uint(l_reg),false,false);l_reg=__uint_as_float(rr[0])+__uint_as_float(rr[1]);}
  if(hi==0)wsf[32+r32]=l_reg;asm volatile("s_waitcnt lgkmcnt(0)":::"memory");
  float rli[16];
  #pragma unroll
  for(int r=0;r<16;++r)rli[r]=__builtin_amdgcn_rcpf(wsf[32+crow(r,hi)]);
  bf16*Ow=O+(rowbase+q0+wid*QBLK)*DM+h*D;
  { bf16*stg=(bf16*)(shm+LDS_OST)+wid*2048;
    #pragma unroll
    for(int r=0;r<16;++r){const int orow=crow(r,hi);
      #pragma unroll
      for(int d0=0;d0<2;++d0)stg[orow*64+d0*32+r32]=__float2bfloat16(o[d0][r]*rli[r]);}
    asm volatile("s_waitcnt lgkmcnt(0)":::"memory");
    #pragma unroll
    for(int i=0;i<4;++i){const int row=i*8+(lane>>3),ch=lane&7; const u32x4 v=*(const u32x4*)(stg+row*64+ch*8); ATTN_STORE16(Ow+(long)row*DM+ch*8,v);} }
  asm volatile("s_waitcnt lgkmcnt(0)\n\ts_barrier":::"memory");
  #undef DMA_K
  #undef DMA_V
  #undef CMASK
  #undef START
  #undef RESC
  #undef ROT
  #undef BIASINIT
}
constexpr int ATTN_LDS_BYTES=LDS_BYTES;
struct AttnTensors { const bf16* Q; const bf16* K; const bf16* V; bf16* O; const float* CS; };
struct AttnUnit { int bh; int qb; };
struct StaticOrder {
  int vcu;
  __device__ __forceinline__ explicit StaticOrder(int grid,int block):vcu((block%8)*(grid/8)+block/8){}
  __device__ __forceinline__ bool next(int i,AttnUnit&u)const{ if(i>=4)return false; const int s=vcu&7; u.bh=vcu>>3; u.qb=(i==0)?s:(i==1)?15-s:(i==2)?16+s:31-s; return true; }
  __device__ __forceinline__ void a_ready(const AttnUnit&)const{}
  __device__ __forceinline__ void done(const AttnUnit&)const{}
};
template<class Sched,int THRL=8> __device__ __forceinline__ void attn_phase(char*lds,const AttnTensors&T,const Sched&S,const int tid_in){
  AttnUnit u;
  for(int i=0;S.next(i,u);++i){ S.a_ready(u); attn_unit<THRL>(u.bh/NHEAD,u.bh%NHEAD,u.qb,T.Q,T.K,T.V,T.O,T.CS,lds,tid_in); S.done(u); }
}
#undef SBAR
#undef WAIT_BAR
}
#define LAS __attribute__((address_space(3)))
#define XB_TMO      128
#define XB_XCNT(j)  (256  + 64 * (j))
#define XB_XSUB(j)  (1280 + 64 * (j))
#define XB_XGEN(j)  (2304 + 64 * (j))
#define XB_TOP      3328
#define XB_TOPGEN   3392
#define XCD_BAR_WORDS 3456
#define XB_SPIN_CAP (1u << 18)

__device__ __forceinline__ unsigned xb_ld(unsigned* p)              { return __hip_atomic_load(p, __ATOMIC_RELAXED, __HIP_MEMORY_SCOPE_AGENT); }
__device__ __forceinline__ unsigned xb_add(unsigned* p, unsigned v) { return __hip_atomic_fetch_add(p, v, __ATOMIC_RELAXED, __HIP_MEMORY_SCOPE_AGENT); }
__device__ __forceinline__ unsigned xb_xcc_id() { return (unsigned)__builtin_amdgcn_s_getreg((3 << 11) | 20) & 0xFu; }
#define XB_SPIN(cond, bar) do { unsigned _sp = 0; while (cond) { __builtin_amdgcn_s_sleep(1); \
    if ((++_sp & 255u) == 0u) { if (xb_ld(&(bar)[XB_TMO])) break; if (_sp > XB_SPIN_CAP) { atomicAdd(&(bar)[XB_TMO], 1u); break; } } } } while (0)

struct XcdBarrier {
    unsigned* bar; unsigned x;
    volatile LAS unsigned* st;
};

__device__ __forceinline__ XcdBarrier xcd_barrier_post(unsigned* bar, volatile LAS unsigned* st, const int tid) {
    XcdBarrier b; b.bar = bar; b.x = xb_xcc_id(); b.st = st;
    if (tid == 0) (void)xb_add(&bar[XB_XCNT(b.x)], 1u);
    return b;
}
__device__ __forceinline__ void xcd_barrier_complete(unsigned* bar, unsigned x, unsigned& nloc, unsigned& nx) {
    const unsigned G = gridDim.x * gridDim.y * gridDim.z;
    unsigned sum, cnt, mine, sp = 0u;
    for (;;) {
        sum = 0u; cnt = 0u; mine = 0u;
#pragma unroll
        for (unsigned j = 0; j < 16; ++j) { const unsigned c = xb_ld(&bar[XB_XCNT(j)]); sum += c; cnt += (c > 0u) ? 1u : 0u; mine = (j == x) ? c : mine; }
        if (sum == G) break;
        __builtin_amdgcn_s_sleep(1);
        if ((++sp & 255u) == 0u) { if (xb_ld(&bar[XB_TMO])) break; if (sp > XB_SPIN_CAP) { atomicAdd(&bar[XB_TMO], 1u); break; } }
    }
    nloc = mine > 0u ? mine : 1u; nx = cnt > 0u ? cnt : 1u;
}

__device__ __forceinline__ void xcd_barrier(const XcdBarrier& b, const int tid) {
    asm volatile("s_waitcnt vmcnt(0)" ::: "memory");
    __syncthreads();
    if (tid == 0) {
        unsigned* bar = b.bar;
        __builtin_amdgcn_s_waitcnt(0);
        unsigned nloc = b.st[0], nx = b.st[1];
        if (nloc == 0u) { xcd_barrier_complete(bar, b.x, nloc, nx); b.st[0] = nloc; b.st[1] = nx; }
        const unsigned old = xb_add(&bar[XB_XSUB(b.x)], 1u);
        const unsigned gen = old / nloc;
        if (old + 1u == (gen + 1u) * nloc) {
            __builtin_amdgcn_fence(__ATOMIC_RELEASE, "agent");
            asm volatile("s_waitcnt vmcnt(0)" ::: "memory");
            const unsigned og = xb_add(&bar[XB_TOP], 1u);
            const unsigned tg = og / nx;
            if (og + 1u == (tg + 1u) * nx) xb_add(&bar[XB_TOPGEN], 1u);
            else XB_SPIN(xb_ld(&bar[XB_TOPGEN]) == tg, bar);
            __builtin_amdgcn_fence(__ATOMIC_ACQUIRE, "agent");
            xb_add(&bar[XB_XGEN(b.x)], 1u);
            asm volatile("s_waitcnt vmcnt(0)" ::: "memory");
        } else {
            XB_SPIN(xb_ld(&bar[XB_XGEN(b.x)]) == gen, bar);
            __builtin_amdgcn_fence(__ATOMIC_ACQUIRE, "agent");
            asm volatile("s_waitcnt vmcnt(0)" ::: "memory");
        }
    }
    __syncthreads();
}
namespace cg = cooperative_groups;
constexpr int NWAVES = 8;
constexpr int DM = 1024, FF = 2816, NH = 16, SEQ = 8192, NMETA = 16, DEPTH = 4;
constexpr int MMAIN = 2 * SEQ;
constexpr int MROWS = MMAIN + NMETA;
constexpr int MPAD = 65 * 256;
constexpr int KVROWS = attn_body::KVROWS;
constexpr float EPS = 1e-6f, LOG2E = 1.4426950408889634f;

constexpr size_t MiB = 1u << 20;
constexpr size_t SZ_GU = (size_t)5632 * 1024 * 2, SZ_DN = (size_t)1024 * 2816 * 2;
constexpr size_t WS_CTL = 0, CTL_ZERO_BYTES = 65536;
constexpr size_t WS_WGU = 1 * MiB, WS_WDN = WS_WGU + 8 * SZ_GU;
constexpr size_t WS_WAI = WS_WDN + 8 * SZ_DN, WS_WAO = WS_WAI + 2 * 6 * MiB, WS_WBI = WS_WAO + 2 * 2 * MiB, WS_WBO = WS_WBI + 4 * MiB;
constexpr size_t WS_WCI = WS_WBO + 2 * MiB, WS_WCO = WS_WCI + 6 * MiB, WS_WF = WS_WCO + 2 * MiB;
constexpr size_t WS_XN = WS_WF + 1 * MiB;
constexpr size_t SZ_ROWBUF = (size_t)MPAD * 1024 * 2;
constexpr size_t WS_ACT = WS_XN + 33 * MiB;
constexpr size_t WS_HMETA = WS_ACT + 98 * MiB, WS_LF = WS_HMETA + 1 * MiB, WS_LFM = WS_LF + 1 * MiB, WS_CS = WS_LFM + 1 * MiB, WS_END = WS_CS + 2 * MiB;
static_assert(SZ_ROWBUF <= 33 * MiB && 3 * SZ_ROWBUF <= 98 * MiB && (size_t)MPAD * FF * 2 <= 98 * MiB, "ws map");

constexpr int RING_BYTES = 131072, LDS_BYTES = 147456;
static_assert(attn_body::ATTN_LDS_BYTES <= RING_BYTES, "attention LDS");
constexpr int MISC_OFF = RING_BYTES + 320;

#define GAS __attribute__((address_space(1)))
typedef unsigned short bf16;
typedef unsigned v4u __attribute__((ext_vector_type(4)));
typedef unsigned v2u __attribute__((ext_vector_type(2)));
typedef float f32x4 __attribute__((ext_vector_type(4)));
typedef float f32x2 __attribute__((ext_vector_type(2)));
typedef short bf16x8 __attribute__((ext_vector_type(8)));
#define LDS_WAIT() asm volatile("s_waitcnt lgkmcnt(0)" ::: "memory")
__device__ __forceinline__ unsigned f2bf(float f) { unsigned u = __builtin_bit_cast(unsigned, f); return (u + 0x7fffu + ((u >> 16) & 1u)) >> 16; }
__device__ __forceinline__ unsigned pk2(float lo, float hi) { return f2bf(lo) | (f2bf(hi) << 16); }
__device__ __forceinline__ float bflo(unsigned w) { return __builtin_bit_cast(float, w << 16); }
__device__ __forceinline__ float bfhi(unsigned w) { return __builtin_bit_cast(float, w & 0xffff0000u); }
__device__ __forceinline__ float lane_get(float v, int src_lane) { return __builtin_bit_cast(float, __builtin_amdgcn_ds_bpermute(src_lane << 2, __builtin_bit_cast(int, v))); }
__device__ __forceinline__ float wave_sum(float v, int lane) {
#pragma unroll
    for (int o = 1; o < 64; o <<= 1) v += lane_get(v, lane ^ o);
    return v;
}

struct Args {
    const float* x; const float* meta; const float* ffn_norm; const float* ffn_w_gate; const float* ffn_w_up; const float* ffn_w_down; const float* mix_norm;
    const float* a_w_in; const float* a_conv; const float* a_w_out;
    const float* b_w_in; const float* b_conv; const float* b_conv_bias; const float* b_ln_g; const float* b_ln_b; const float* b_w_out;
    const float* c_w_in; const float* c_b_f; const float* c_q_norm; const float* c_k_norm; const float* c_w_out;
    float* out; unsigned char* ws;
};

__device__ __forceinline__ void transpose_item(const float* src, int Nsrc, bf16* dst, int K, int kb, LAS float* scr, int lane) {
    const int k0 = 64 * kb;
#pragma unroll 8
    for (int i = 0; i < 32; ++i) { const int kk = 2 * i + (lane >> 5); scr[kk * 33 + (lane & 31)] = src[(size_t)(k0 + kk) * Nsrc + (lane & 31)]; }
    LDS_WAIT(); asm volatile("" ::: "memory");
    const int c = lane & 7;
#pragma unroll
    for (int j = 0; j < 4; ++j) { const int n = (lane >> 3) + 8 * j; const LAS float* s = scr + (8 * c) * 33 + n;
        v4u o; o.x = pk2(s[0 * 33], s[1 * 33]); o.y = pk2(s[2 * 33], s[3 * 33]); o.z = pk2(s[4 * 33], s[5 * 33]); o.w = pk2(s[6 * 33], s[7 * 33]);
        *(GAS v4u*)(dst + (size_t)n * K + k0 + 8 * c) = o; }
    LDS_WAIT(); asm volatile("" ::: "memory");
}

__device__ __forceinline__ void rms_row(const float* xrow, const float* g, bf16* orow, float* hcopy, int lane) {
    const GAS f32x4* xr = (const GAS f32x4*)xrow + lane;
    f32x4 v[4]; float s = 0.f;
#pragma unroll
    for (int j = 0; j < 4; ++j) { v[j] = xr[64 * j]; s += (v[j].x * v[j].x + v[j].y * v[j].y) + (v[j].z * v[j].z + v[j].w * v[j].w); }
    const float rs = 1.0f / sqrtf(wave_sum(s, lane) * (1.f / DM) + EPS);
    if (hcopy) { GAS f32x4* hr = (GAS f32x4*)hcopy + lane;
#pragma unroll
        for (int j = 0; j < 4; ++j) hr[64 * j] = v[j]; }
    const GAS f32x4* gr = (const GAS f32x4*)g + lane;
    GAS unsigned long long* o8 = (GAS unsigned long long*)orow + lane;
#pragma unroll
    for (int j = 0; j < 4; ++j) { const f32x4 gg = gr[64 * j]; const f32x4 y = v[j] * rs * gg;
        o8[64 * j] = (unsigned long long)pk2(y.x, y.y) | ((unsigned long long)pk2(y.z, y.w) << 32); }
}


__device__ __forceinline__ void thin_gemm(LAS unsigned char* ldsl, const int tid, const int vcu, const bf16* A, const bf16* Bt, const int K, const int mode,
                                          bf16* R0, bf16* R1, bf16* R2, float* hmeta, const float scale, const float* qg, const float* kg) {
    const int ntasks = (mode == 0) ? 176 : (mode == 2) ? 128 : (mode == 3) ? 48 : 64;
    if (vcu >= ntasks) return;
    const int lane = tid & 63, wave = __builtin_amdgcn_readfirstlane(tid >> 6), fr = lane & 15, fq = lane >> 4, task = vcu;
    int nt = 1, b0 = 0, b1 = 0, b2 = 0, b3 = 0;
    if (mode <= 1 || (mode == 2 && task < 64)) { const int f0 = 16 * task; b0 = 256 * (f0 >> 7) + (f0 & 127); b1 = b0 + 128; nt = 2; }
    else if (mode == 2) { b0 = 2048 + 16 * (task - 64); }
    else if (mode == 3) { const int sec = task >> 4, hd = task & 15; nt = 4;
        if (sec < 2) { b0 = 256 * (sec * 4 + (hd >> 2)) + 32 * (hd & 3); b1 = b0 + 16; b2 = b0 + 128; b3 = b0 + 144; }
        else { b0 = 2048 + 64 * hd; b1 = b0 + 16; b2 = b0 + 32; b3 = b0 + 48; } }
    else { b0 = 16 * task; }
    const int kw = K >> 3, ksteps = kw >> 5;
    const GAS bf16x8* ap = (const GAS bf16x8*)(A + (size_t)(MMAIN + fr) * K + wave * kw + 8 * fq);
    const GAS bf16x8* p0 = (const GAS bf16x8*)(Bt + (size_t)(b0 + fr) * K + wave * kw + 8 * fq);
    const GAS bf16x8* p1 = (const GAS bf16x8*)(Bt + (size_t)(b1 + fr) * K + wave * kw + 8 * fq);
    const GAS bf16x8* p2 = (const GAS bf16x8*)(Bt + (size_t)(b2 + fr) * K + wave * kw + 8 * fq);
    const GAS bf16x8* p3 = (const GAS bf16x8*)(Bt + (size_t)(b3 + fr) * K + wave * kw + 8 * fq);
    f32x4 c0 = {0.f, 0.f, 0.f, 0.f}, c1 = c0, c2 = c0, c3 = c0;
#pragma unroll 4
    for (int ks = 0; ks < ksteps; ++ks) {
        const bf16x8 xa = ap[4 * ks];
        c0 = __builtin_amdgcn_mfma_f32_16x16x32_bf16(p0[4 * ks], xa, c0, 0, 0, 0);
        if (nt >= 2) c1 = __builtin_amdgcn_mfma_f32_16x16x32_bf16(p1[4 * ks], xa, c1, 0, 0, 0);
        if (nt >= 4) { c2 = __builtin_amdgcn_mfma_f32_16x16x32_bf16(p2[4 * ks], xa, c2, 0, 0, 0); c3 = __builtin_amdgcn_mfma_f32_16x16x32_bf16(p3[4 * ks], xa, c3, 0, 0, 0); }
    }
    LAS f32x4* P = (LAS f32x4*)ldsl;
    P[(wave * 4 + 0) * 64 + lane] = c0; P[(wave * 4 + 1) * 64 + lane] = c1; P[(wave * 4 + 2) * 64 + lane] = c2; P[(wave * 4 + 3) * 64 + lane] = c3;
    __syncthreads();
    if (wave == 0) {
#pragma unroll
        for (int w = 1; w < 8; ++w) { c0 += P[(w * 4 + 0) * 64 + lane]; c1 += P[(w * 4 + 1) * 64 + lane]; c2 += P[(w * 4 + 2) * 64 + lane]; c3 += P[(w * 4 + 3) * 64 + lane]; }
        const size_t mrow = (size_t)(MMAIN + fr);
        if (mode <= 1 || (mode == 2 && task < 64)) {
            f32x4 r;
            if (mode == 0) {
#pragma unroll
                for (int i = 0; i < 4; ++i) r[i] = c0[i] * pg8::sigm(c0[i]) * c1[i];
            } else if (mode == 1) {
#pragma unroll
                for (int i = 0; i < 4; ++i) r[i] = c0[i] * pg8::sigm(c1[i]);
            } else r = c0 * c1;
            *(GAS v2u*)(R0 + mrow * (mode == 0 ? FF : 1024) + 16 * task + 4 * fq) = (v2u){pk2(r[0], r[1]), pk2(r[2], r[3])};
        } else if (mode == 2) {
            *(GAS v2u*)(R1 + mrow * 1024 + 16 * (task - 64) + 4 * fq) = (v2u){pk2(c0[0], c0[1]), pk2(c0[2], c0[3])};
        } else if (mode == 3) {
            const int sec = task >> 4, hd = task & 15;
            f32x4 v0 = c0, v1 = c1, v2 = c2, v3 = c3;
            if (sec < 2) {
                float ss = (c0[0] * c0[0] + c0[1] * c0[1]) + (c0[2] * c0[2] + c0[3] * c0[3]) + (c1[0] * c1[0] + c1[1] * c1[1]) + (c1[2] * c1[2] + c1[3] * c1[3])
                         + (c2[0] * c2[0] + c2[1] * c2[1]) + (c2[2] * c2[2] + c2[3] * c2[3]) + (c3[0] * c3[0] + c3[1] * c3[1]) + (c3[2] * c3[2] + c3[3] * c3[3]);
                ss += lane_get(ss, lane ^ 16); ss += lane_get(ss, lane ^ 32);
                const float rs = __builtin_amdgcn_rsqf(ss * (1.0f / 64.0f) + EPS) * ((sec == 0) ? pg8::QK_C2 : 1.0f);
                const float* g = (sec == 0) ? qg : kg;
                v0 = c0 * rs * *(const GAS f32x4*)(g + 4 * fq); v1 = c1 * rs * *(const GAS f32x4*)(g + 16 + 4 * fq); v2 = c2 * rs * *(const GAS f32x4*)(g + 32 + 4 * fq); v3 = c3 * rs * *(const GAS f32x4*)(g + 48 + 4 * fq);
            }
            const v2u w0 = {pk2(v0[0], v0[1]), pk2(v0[2], v0[3])}, w1 = {pk2(v1[0], v1[1]), pk2(v1[2], v1[3])}, w2 = {pk2(v2[0], v2[1]), pk2(v2[2], v2[3])}, w3 = {pk2(v3[0], v3[1]), pk2(v3[2], v3[3])};
            const int col = 64 * hd + 4 * fq;
            if (sec == 0) { bf16* q = R0 + mrow * 1024 + col; *(GAS v2u*)q = w0; *(GAS v2u*)(q + 16) = w1; *(GAS v2u*)(q + 32) = w2; *(GAS v2u*)(q + 48) = w3; }
            else { bf16* T = (sec == 1) ? R1 : R2;
#pragma unroll
                for (int b = 0; b < 2; ++b) { bf16* q = T + (size_t)(b * KVROWS + 48 + fr) * 1024 + col; *(GAS v2u*)q = w0; *(GAS v2u*)(q + 16) = w1; *(GAS v2u*)(q + 32) = w2; *(GAS v2u*)(q + 48) = w3; } }
        } else {
            GAS f32x4* p = (GAS f32x4*)(hmeta + (size_t)fr * 1024 + 16 * task + 4 * fq);
            *p = *p + c0 * scale;
        }
    }
    __syncthreads();
}

__global__ void __launch_bounds__(NWAVES * 64, 2) fwd_megakernel(Args a) {
    extern __shared__ __attribute__((aligned(16))) unsigned char lds[];
    cg::grid_group grid = cg::this_grid();
    const int G = gridDim.x, bx = blockIdx.x;
    const int vcu0 = (G % 8 == 0) ? (bx % 8) * (G / 8) + bx / 8 : bx;
    const int NGW = G * NWAVES;
    if (threadIdx.x < 64) ((LAS unsigned*)((LAS unsigned char*)lds + RING_BYTES))[threadIdx.x * 2] = 0u, ((LAS unsigned*)((LAS unsigned char*)lds + RING_BYTES))[threadIdx.x * 2 + 1] = 0u;
    __syncthreads();
    const int wave_s = __builtin_amdgcn_readfirstlane((int)threadIdx.x >> 6);
#define PHASE_ENV() \
    unsigned zero_ = 0u; asm volatile("" : "+s"(zero_)); int vcu = vcu0; asm volatile("" : "+s"(vcu)); \
    int tid = (wave_s << 6) | (int)__builtin_amdgcn_mbcnt_hi(~0u, __builtin_amdgcn_mbcnt_lo(~0u, zero_)); \
    const int lane = tid & 63, wave = __builtin_amdgcn_readfirstlane(tid >> 6), gw = vcu * NWAVES + wave; \
    unsigned char* ws0_ = a.ws; asm volatile("" : "+s"(ws0_)); unsigned char* const ws = (unsigned char*)(GAS unsigned char*)ws0_;     \
    float* hm0_ = a.out; asm volatile("" : "+s"(hm0_)); float* const hmain = (float*)(GAS float*)hm0_; \
    bf16* const WGU = (bf16*)(ws + WS_WGU); bf16* const WDN = (bf16*)(ws + WS_WDN); \
    bf16* const WAI = (bf16*)(ws + WS_WAI); bf16* const WAO = (bf16*)(ws + WS_WAO); bf16* const WBI = (bf16*)(ws + WS_WBI); bf16* const WBO = (bf16*)(ws + WS_WBO); \
    bf16* const WCI = (bf16*)(ws + WS_WCI); bf16* const WCO = (bf16*)(ws + WS_WCO); bf16* const WFt = (bf16*)(ws + WS_WF); \
    bf16* const XN = (bf16*)(ws + WS_XN); \
    bf16* const R0 = (bf16*)(ws + WS_ACT); bf16* const R1 = (bf16*)(ws + WS_ACT + SZ_ROWBUF); bf16* const R2 = (bf16*)(ws + WS_ACT + 2 * SZ_ROWBUF); \
    float* const hmeta = (float*)(ws + WS_HMETA); \
    float* const LF = (float*)(ws + WS_LF); float* const LFM = (float*)(ws + WS_LFM); float* const CS = (float*)(ws + WS_CS); \
    LAS unsigned char* const ldsl = (LAS unsigned char*)lds; \
    (void)WGU; (void)WDN; (void)WAI; (void)WAO; (void)WBI; (void)WBO; (void)WCI; (void)WCO; (void)WFt; (void)XN; (void)R0; (void)R1; (void)R2; (void)hmeta; (void)LF; (void)LFM; (void)CS; (void)ldsl; (void)lane; (void)gw; (void)hmain;

    {
        PHASE_ENV();
        LAS float* scr = (LAS float*)(ldsl + wave * 16384);
        constexpr int I_GU = 176 * 16, I_DN = 32 * 44, I_AI = 96 * 16, I_SQ = 32 * 16, I_BI = 64 * 16, I_CI = 96 * 16;
        constexpr int NITEMS = 8 * I_GU + 8 * I_DN + 2 * I_AI + 2 * I_SQ + I_BI + I_SQ + I_CI + I_SQ;
        for (int it = gw; it < NITEMS; it += NGW) {
            int r = it;
            if (r < 8 * I_GU) { const int mat = r / I_GU; r %= I_GU; const int kb = r / 176, nb = r % 176, pn = nb >> 3, q = nb & 7;
                const float* src = ((q < 4) ? a.ffn_w_gate : a.ffn_w_up) + (size_t)mat * 1024 * FF + 128 * pn + 32 * (q & 3);
                transpose_item(src, FF, WGU + (size_t)mat * 5632 * 1024 + (size_t)nb * 32 * 1024, 1024, kb, scr, lane); continue; }
            r -= 8 * I_GU;
            if (r < 8 * I_DN) { const int mat = r / I_DN; r %= I_DN; const int kb = r / 32, nb = r % 32;
                transpose_item(a.ffn_w_down + (size_t)mat * FF * 1024 + 32 * nb, 1024, WDN + (size_t)mat * 1024 * FF + (size_t)nb * 32 * FF, FF, kb, scr, lane); continue; }
            r -= 8 * I_DN;
            if (r < 2 * I_AI) { const int mat = r / I_AI; r %= I_AI; const int kb = r / 96, nb = r % 96, pn = nb >> 3, q = nb & 7;
                const int scol = (pn < 8) ? ((q < 4) ? 1024 + 128 * pn + 32 * q : 2048 + 128 * pn + 32 * (q - 4)) : (nb - 64) * 32;
                transpose_item(a.a_w_in + (size_t)mat * 1024 * 3072 + scol, 3072, WAI + (size_t)mat * 3072 * 1024 + (size_t)nb * 32 * 1024, 1024, kb, scr, lane); continue; }
            r -= 2 * I_AI;
            if (r < 2 * I_SQ) { const int mat = r / I_SQ; r %= I_SQ; const int kb = r / 32, nb = r % 32;
                transpose_item(a.a_w_out + (size_t)mat * 1024 * 1024 + 32 * nb, 1024, WAO + (size_t)mat * 1024 * 1024 + (size_t)nb * 32 * 1024, 1024, kb, scr, lane); continue; }
            r -= 2 * I_SQ;
            if (r < I_BI) { const int kb = r / 64, nb = r % 64, pn = nb >> 3, q = nb & 7;
                const int scol = (q < 4) ? 128 * pn + 32 * q : 1024 + 128 * pn + 32 * (q - 4);
                transpose_item(a.b_w_in + scol, 2048, WBI + (size_t)nb * 32 * 1024, 1024, kb, scr, lane); continue; }
            r -= I_BI;
            if (r < I_SQ) { const int kb = r / 32, nb = r % 32;
                transpose_item(a.b_w_out + 32 * nb, 1024, WBO + (size_t)nb * 32 * 1024, 1024, kb, scr, lane); continue; }
            r -= I_SQ;
            if (r < I_CI) { const int kb = r / 96, nb = r % 96, pn = nb >> 3, q = nb & 7;
                const int scol = (pn < 8) ? (pn >> 2) * 1024 + 64 * (4 * (pn & 3) + (q & 3)) + 32 * (q >> 2) : 2048 + (nb - 64) * 32;
                transpose_item(a.c_w_in + scol, 3088, WCI + (size_t)nb * 32 * 1024, 1024, kb, scr, lane); continue; }
            r -= I_CI;
            { const int kb = r / 32, nb = r % 32;
                transpose_item(a.c_w_out + 32 * nb, 1024, WCO + (size_t)nb * 32 * 1024, 1024, kb, scr, lane); }
        }
        for (int i = gw * 64 + lane; i < 16 * 1024; i += NGW * 64) { const int h = i >> 10, k = i & 1023; WFt[i] = (bf16)f2bf(a.c_w_in[(size_t)k * 3088 + 3072 + h]); }
        for (int m = gw; m < MROWS; m += NGW) {
            const float* src = (m < MMAIN) ? a.x + (size_t)m * DM : a.meta + (size_t)(m - MMAIN) * DM;
            float* hc = (m < MMAIN) ? hmain + (size_t)m * DM : hmeta + (size_t)(m - MMAIN) * DM;
            rms_row(src, a.ffn_norm, XN + (size_t)m * DM, hc, lane);
        }
    }
    grid.sync();
    XcdBarrier bar;
    { PHASE_ENV(); bar = xcd_barrier_post((unsigned*)(ws + WS_CTL), (volatile LAS unsigned*)(ldsl + MISC_OFF) + 8, tid); }

    for (int L = 0; L < DEPTH; ++L) {
        const int mx = L % 3, mj = L / 3;
        for (int s = 0; s <= 10; ++s) {
            if ((s == 6 && mx != 2) || (s == 0 && L == 0)) continue;
            PHASE_ENV();
            if (s == 0 || s == 3 || s == 8) {
                const float* g = (s == 3) ? a.mix_norm + (size_t)L * DM : a.ffn_norm + (size_t)(L * 2 + (s == 8)) * DM;
                for (int m = gw; m < MROWS; m += NGW) {
                    const float* src = (m < MMAIN) ? hmain + (size_t)m * DM : hmeta + (size_t)(m - MMAIN) * DM;
                    rms_row(src, g, XN + (size_t)m * DM, nullptr, lane);
                }
                if (s == 3 && mx == 2) {
                    for (int i = gw; i < 2 * 2 * 112; i += NGW) { const int tsel = i / 224, rr = i % 224, b = rr / 112, j = rr % 112; const int row = b * KVROWS + (j < 48 ? j : j + 16);
                        bf16* p = (tsel ? R2 : R1) + (size_t)row * 1024; ((GAS v4u*)p)[lane * 2] = (v4u){0u, 0u, 0u, 0u}; ((GAS v4u*)p)[lane * 2 + 1] = (v4u){0u, 0u, 0u, 0u}; }
                }
            } else if (s == 1 || s == 2 || s == 4 || s == 7 || s == 9 || s == 10) {
                pg8::Gemm g; pg8::EpiAll E;
                E.mtiles_main = 64; E.O1 = R0; E.O2 = R1; E.O3 = R2; E.ldo = 1024; E.hmain = hmain; E.hmeta = hmeta; E.scale = 1.f; E.qg = a.c_q_norm; E.kg = a.c_k_norm; E.mode = 0;
                g.M = MMAIN;
                if (s == 1 || s == 9) { g.A = XN; g.Bt = WGU + (size_t)(L * 2 + (s == 9)) * 5632 * 1024; g.N = 5632; g.K = 1024; E.mode = 0; E.ldo = FF; }
                else if (s == 2 || s == 10) { g.A = R0; g.Bt = WDN + (size_t)(L * 2 + (s == 10)) * 1024 * FF; g.N = 1024; g.K = FF; E.mode = 4; E.scale = 0.5f; }
                else if (s == 4) {
                    g.A = XN; g.K = 1024;
                    if (mx == 0) { g.Bt = WAI + (size_t)mj * 3072 * 1024; g.N = 3072; E.mode = 2; }
                    else if (mx == 1) { g.Bt = WBI; g.N = 2048; E.mode = 1; }
                    else { g.Bt = WCI; g.N = 3072; E.mode = 3;
                        const int fr = lane & 15, fq = lane >> 4;
                        for (int grp = gw; grp < MROWS / 16; grp += NGW) {
                            const bf16* xp = XN + (size_t)(16 * grp + fr) * DM + 8 * fq; const bf16* wp = WFt + (size_t)fr * DM + 8 * fq;
                            f32x4 acc = {0.f, 0.f, 0.f, 0.f};
#pragma unroll 8
                            for (int k = 0; k < 32; ++k) { const bf16x8 xa = *(const GAS bf16x8*)(xp + 32 * k), wb = *(const GAS bf16x8*)(wp + 32 * k);
                                acc = __builtin_amdgcn_mfma_f32_16x16x32_bf16(xa, wb, acc, 0, 0, 0); }
                            const float bf = a.c_b_f[fr]; f32x4 o;
#pragma unroll
                            for (int r = 0; r < 4; ++r) { const float xv = acc[r] + bf; o[r] = fminf(xv, 0.f) - log1pf(expf(-fabsf(xv))); }
                            if (grp < MMAIN / 16) { const int r0 = 16 * grp, b = r0 >> 13, t0 = r0 & 8191; *(GAS f32x4*)(LF + ((size_t)(b * NH + fr) * SEQ + t0 + 4 * fq)) = o; }
                            else *(GAS f32x4*)(LFM + fr * 16 + 4 * fq) = o;
                        }
                        asm volatile("s_waitcnt vmcnt(0) lgkmcnt(0)" ::: "memory"); __syncthreads();
                    }
                }
                else { g.K = 1024; g.N = 1024; E.mode = 4; E.scale = 1.f;
                    if (mx == 0) { g.A = R2; g.Bt = WAO + (size_t)mj * 1024 * 1024; } else if (mx == 1) { g.A = R1; g.Bt = WBO; } else { g.A = R0; g.Bt = WCO; } }
                thin_gemm(ldsl, tid, vcu, g.A, g.Bt, g.K, E.mode, R0, R1, R2, hmeta, E.scale, a.c_q_norm, a.c_k_norm);
                pg8::StaticOrder S; S.init(g.M, g.N, G, bx);
#ifndef NO_GEMM
                pg8::gemm_phase<pg8::EpiAll, pg8::StaticOrder, PG8_ALIGN, PG8_SP2>(ldsl, g, S, E, tid);
#endif
            } else if (s == 5) {
                if (mx == 0) {
                    const float* cw = a.a_conv + (size_t)mj * 3 * DM + 16 * lane;
                    f32x4 w0[4], w1[4], w2[4];
#pragma unroll
                    for (int j = 0; j < 4; ++j) { w0[j] = *(const f32x4*)(cw + 4 * j); w1[j] = *(const f32x4*)(cw + DM + 4 * j); w2[j] = *(const f32x4*)(cw + 2 * DM + 4 * j); }
                    for (int r = gw; r < MROWS; r += NGW) {
                        int r1, r2;
                        if (r < MMAIN) { const int t = r & 8191; r1 = (t >= 1) ? r - 1 : MMAIN + 15; r2 = (t >= 2) ? r - 2 : MMAIN + 14 + t; }
                        else { const int p = r - MMAIN; r1 = (p >= 1) ? r - 1 : -1; r2 = (p >= 2) ? r - 2 : -1; }
                        const v4u z4 = {0u, 0u, 0u, 0u};
                        const GAS v4u* c0p = (const GAS v4u*)(R0 + (size_t)r * DM) + 2 * lane; const GAS v4u* bp = (const GAS v4u*)(R1 + (size_t)r * DM) + 2 * lane;
                        v4u x0[2], x1[2], x2[2], bb[2];
#pragma unroll
                        for (int hh = 0; hh < 2; ++hh) { x0[hh] = c0p[hh]; bb[hh] = bp[hh];
                            x1[hh] = (r1 >= 0) ? ((const GAS v4u*)(R0 + (size_t)r1 * DM) + 2 * lane)[hh] : z4; x2[hh] = (r2 >= 0) ? ((const GAS v4u*)(R0 + (size_t)r2 * DM) + 2 * lane)[hh] : z4; }
                        GAS v4u* yp = (GAS v4u*)(R2 + (size_t)r * DM) + 2 * lane;
#pragma unroll
                        for (int hh = 0; hh < 2; ++hh) { v4u o;
#pragma unroll
                            for (int e = 0; e < 4; ++e) { const int j = 2 * hh + (e >> 1), c = 2 * (e & 1);
                                const float lo = bflo(bb[hh][e]) * (w2[j][c] * bflo(x0[hh][e]) + w1[j][c] * bflo(x1[hh][e]) + w0[j][c] * bflo(x2[hh][e]));
                                const float hi = bfhi(bb[hh][e]) * (w2[j][c + 1] * bfhi(x0[hh][e]) + w1[j][c + 1] * bfhi(x1[hh][e]) + w0[j][c + 1] * bfhi(x2[hh][e]));
                                o[e] = pk2(lo, hi); }
                            yp[hh] = o; }
                    }
                } else if (mx == 1) {
#ifndef NO_CONF
                    const int c = 2 * tid;
                    f32x2 w[31];
#pragma unroll
                    for (int k = 0; k < 31; ++k) w[k] = *(const GAS f32x2*)(a.b_conv + (size_t)k * DM + c);
                    const f32x2 cb = *(const f32x2*)(a.b_conv_bias + c), lg = *(const f32x2*)(a.b_ln_g + c), lb = *(const f32x2*)(a.b_ln_b + c);
                    LAS float* red = (LAS float*)ldsl;
                    LAS float* red2 = red + 256;
                    for (int un = vcu; un < MROWS / 16; un += G) {
                        const int r0 = 16 * un; const bool meta = (r0 >= MMAIN);
                        const int p0 = meta ? 0 : 16 + (r0 & 8191); const int rowb = meta ? 0 : (r0 >> 13) * SEQ;
                        unsigned xin[46];
#pragma unroll
                        for (int j = 0; j < 46; ++j) { const int pj = p0 - 30 + j;
                            xin[j] = (pj >= 0) ? *(const GAS unsigned*)(R0 + (size_t)((pj < 16) ? MMAIN + pj : rowb + pj - 16) * DM + c) : 0u; }
                        f32x2 acc[16];
#pragma unroll
                        for (int i = 0; i < 16; ++i) acc[i] = cb;
#pragma unroll
                        for (int j = 0; j < 46; ++j) { const f32x2 xv = {bflo(xin[j]), bfhi(xin[j])};
#pragma unroll
                            for (int i = 0; i < 16; ++i) { const int k = j - i; if (k >= 0 && k <= 30) acc[i] += w[k] * xv; } }
                        float st[32];
#pragma unroll
                        for (int i = 0; i < 16; ++i) { st[2 * i] = acc[i].x + acc[i].y; st[2 * i + 1] = acc[i].x * acc[i].x + acc[i].y * acc[i].y; }
#pragma unroll
                        for (int i = 0; i < 32; ++i) st[i] = wave_sum(st[i], lane);
                        if (lane == 0) {
#pragma unroll
                            for (int i = 0; i < 8; ++i) *(LAS f32x4*)(red + wave * 32 + 4 * i) = (f32x4){st[4 * i], st[4 * i + 1], st[4 * i + 2], st[4 * i + 3]}; }
                        __syncthreads();
                        if (tid < 32) { float t = 0.f;
#pragma unroll
                            for (int wv = 0; wv < 8; ++wv) t += red[wv * 32 + tid];
                            red2[tid] = t; }
                        __syncthreads();
#pragma unroll
                        for (int i = 0; i < 16; ++i) { const f32x2 sv = *(const LAS f32x2*)(red2 + 2 * i);
                            const float mu = sv.x * (1.f / DM), var = fmaxf(sv.y * (1.f / DM) - mu * mu, 0.f), rs = 1.0f / sqrtf(var + EPS);
                            const float y0 = (acc[i].x - mu) * rs * lg.x + lb.x, y1 = (acc[i].y - mu) * rs * lg.y + lb.y;
                            *(GAS unsigned*)(R1 + (size_t)(r0 + i) * DM + c) = pk2(y0 * pg8::sigm(y0), y1 * pg8::sigm(y1)); }
                    }
#endif
                } else {
                    if (vcu < 32) {
                        const int bh = vcu, h = bh & 15; LAS float* wt = (LAS float*)ldsl;
                        float* csrow = CS + (size_t)bh * KVROWS;
                        float cm = 0.f, cmp = 0.f;
#pragma unroll
                        for (int j = 0; j < 16; ++j) { cm += LFM[h * 16 + j]; if (j == tid) cmp = cm; }
                        const float* lp = LF + (size_t)bh * SEQ + 16 * tid; float v[16];
#pragma unroll
                        for (int j = 0; j < 4; ++j) { const f32x4 q = *(const GAS f32x4*)(lp + 4 * j); v[4 * j] = q.x; v[4 * j + 1] = q.y; v[4 * j + 2] = q.z; v[4 * j + 3] = q.w; }
#pragma unroll
                        for (int j = 1; j < 16; ++j) v[j] += v[j - 1];
                        float inc = v[15];
#pragma unroll
                        for (int o = 1; o < 64; o <<= 1) { const float t = lane_get(inc, (lane - o) & 63); if (lane >= o) inc += t; }
                        if (lane == 63) wt[wave] = inc;
                        __syncthreads();
                        float off = cm + inc - v[15];
                        for (int wv = 0; wv < wave; ++wv) off += wt[wv];
#pragma unroll
                        for (int j = 0; j < 4; ++j) *(GAS f32x4*)(csrow + 128 + 16 * tid + 4 * j) = (f32x4){(off + v[4 * j]) * LOG2E, (off + v[4 * j + 1]) * LOG2E, (off + v[4 * j + 2]) * LOG2E, (off + v[4 * j + 3]) * LOG2E};
                        const float cmsh = lane_get(cmp, (lane + 16) & 63);
                        if (tid < 128) csrow[tid] = (tid >= 48 && tid < 64) ? cmsh * LOG2E : __builtin_inff();
                        __syncthreads();
                    }
                }
            } else if (s == 6) {
                const attn_body::AttnTensors AT{(const attn_body::bf16*)R0, (const attn_body::bf16*)R1, (const attn_body::bf16*)R2, (attn_body::bf16*)R0, CS};
                const attn_body::StaticOrder S(G, bx);
#ifndef NO_ATTN
                attn_body::attn_phase<attn_body::StaticOrder>((char*)lds, AT, S, tid);
#endif
                if (gw < NH) {
                    const int h = gw, q = lane & 15, dc = lane >> 4;
                    const bf16* qp = R0 + (size_t)(MMAIN + q) * DM + 64 * h + 16 * dc;
                    const v4u qa = ((const GAS v4u*)qp)[0], qb = ((const GAS v4u*)qp)[1];
                    float qv[16];
#pragma unroll
                    for (int e = 0; e < 4; ++e) { qv[2 * e] = bflo(qa[e]); qv[2 * e + 1] = bfhi(qa[e]); qv[8 + 2 * e] = bflo(qb[e]); qv[8 + 2 * e + 1] = bfhi(qb[e]); }
                    float mrun = -__builtin_inff(), l = 0.f, o[16];
#pragma unroll
                    for (int e = 0; e < 16; ++e) o[e] = 0.f;
                    for (int j = 0; j < 16; ++j) {
                        const bf16* kp = R1 + (size_t)(48 + j) * DM + 64 * h + 16 * dc; const bf16* vp = R2 + (size_t)(48 + j) * DM + 64 * h + 16 * dc;
                        const v4u ka = ((const GAS v4u*)kp)[0], kb = ((const GAS v4u*)kp)[1], va = ((const GAS v4u*)vp)[0], vb = ((const GAS v4u*)vp)[1];
                        float d = 0.f;
#pragma unroll
                        for (int e = 0; e < 4; ++e) d += qv[2 * e] * bflo(ka[e]) + qv[2 * e + 1] * bfhi(ka[e]) + qv[8 + 2 * e] * bflo(kb[e]) + qv[8 + 2 * e + 1] * bfhi(kb[e]);
                        d += lane_get(d, lane ^ 16); d += lane_get(d, lane ^ 32);
                        const float sc = d - *(const GAS float*)(CS + (size_t)h * KVROWS + 48 + j);
                        if (j <= q) { const float mn = fmaxf(mrun, sc), f = __builtin_amdgcn_exp2f(mrun - mn), p = __builtin_amdgcn_exp2f(sc - mn); l = l * f + p; mrun = mn;
#pragma unroll
                            for (int e = 0; e < 4; ++e) { o[2 * e] = o[2 * e] * f + p * bflo(va[e]); o[2 * e + 1] = o[2 * e + 1] * f + p * bfhi(va[e]); o[8 + 2 * e] = o[8 + 2 * e] * f + p * bflo(vb[e]); o[8 + 2 * e + 1] = o[8 + 2 * e + 1] * f + p * bfhi(vb[e]); } }
                    }
                    const float rl = 1.0f / l; v4u oa, ob;
#pragma unroll
                    for (int e = 0; e < 4; ++e) { oa[e] = pk2(o[2 * e] * rl, o[2 * e + 1] * rl); ob[e] = pk2(o[8 + 2 * e] * rl, o[8 + 2 * e + 1] * rl); }
                    GAS v4u* op = (GAS v4u*)(R0 + (size_t)(MMAIN + q) * DM + 64 * h + 16 * dc); op[0] = oa; op[1] = ob;
                }
            }
            xcd_barrier(bar, tid);
        }
    }
}

extern "C" void kernel_launch(void* const* d_in, const int* in_sizes, int n_in, void* d_out, int out_size, void* d_ws, size_t ws_size, hipStream_t stream) {
    static int grid = 0;
    if (grid == 0) {
        if (n_in != 21 || out_size != MMAIN * DM || ws_size < WS_END) { fprintf(stderr, "kernel_launch: unexpected shapes (n_in %d out %d ws %zu)\n", n_in, out_size, ws_size); grid = -1; return; }
        int dev = 0, cus = 0, per_cu = 0;
        hipGetDevice(&dev); hipDeviceGetAttribute(&cus, hipDeviceAttributeMultiprocessorCount, dev);
        if (hipFuncSetAttribute((const void*)fwd_megakernel, hipFuncAttributeMaxDynamicSharedMemorySize, LDS_BYTES) != hipSuccess) { fprintf(stderr, "kernel_launch: hipFuncSetAttribute failed\n"); grid = -1; return; }
        if (hipOccupancyMaxActiveBlocksPerMultiprocessor(&per_cu, (const void*)fwd_megakernel, NWAVES * 64, LDS_BYTES) != hipSuccess || per_cu < 1) { fprintf(stderr, "kernel_launch: occupancy query says %d\n", per_cu); per_cu = 1; }
        (void)hipGetLastError();
        grid = cus * 1;
        if (grid != 256) fprintf(stderr, "kernel_launch: grid %d (expected 256)\n", grid);
    }
    if (grid < 0) return;
    if (hipMemsetAsync((char*)d_ws + WS_CTL, 0, CTL_ZERO_BYTES, stream) != hipSuccess) { fprintf(stderr, "kernel_launch: hipMemsetAsync failed\n"); return; }
    Args a{};
    const float** f = (const float**)&a;
    for (int i = 0; i < 21; ++i) f[i] = (const float*)d_in[i];
    a.out = (float*)d_out; a.ws = (unsigned char*)d_ws;
    void* args[] = {&a};
    hipError_t e = hipLaunchCooperativeKernel((const void*)fwd_megakernel, dim3(grid), dim3(NWAVES * 64), args, LDS_BYTES, stream);
    if (e != hipSuccess) fprintf(stderr, "cooperative launch failed: %s (grid %d)\n", hipGetErrorString(e), grid);
}
```

```cpp
#include <hip/hip_runtime.h>
#include <hip/hip_cooperative_groups.h>
#include <cstdio>
#include <cstdint>
namespace pg8 {
#define PG8_LAS __attribute__((address_space(3)))
typedef unsigned short bf16_t;
typedef short bf16x8 __attribute__((ext_vector_type(8)));
typedef float f32x4 __attribute__((ext_vector_type(4)));
typedef unsigned u32x4 __attribute__((ext_vector_type(4)));
constexpr int BM = 256, BK = 64, HALF = 128, HTB = HALF * BK * 2  , STAGE_BYTES = 8 * HTB, NXCD = 8, WGM = 8;

__host__ __device__ __forceinline__ int lds_byte(int r, int c) { const int st = (r >> 4) * 2 + (c >> 5), rr = r & 15, cc = c & 31, ob = rr * 64 + cc * 2; return st * 1024 + (ob ^ (((ob >> 9) & 1) << 5)); }
__host__ __device__ __forceinline__ void stage_rc(int b, int& R, int& C) { const int st = b / 1024, sb = b % 1024, swz = sb ^ (((sb >> 9) & 1) << 5); R = (st >> 1) * 16 + swz / 64; C = (st & 1) * 32 + (swz % 64) / 2; }
__host__ __device__ __forceinline__ int perm32(int rho) { const int n = rho >> 4, i = rho & 15; return 8 * (i >> 2) + 4 * n + (i & 3); }

struct Unit { int pm, pn; };
struct Gemm { const bf16_t* A; const bf16_t* Bt; int M, N, K; };

struct StaticOrder {
    int nM, nN, nwg, G, c;
    __host__ __device__ void init(int M, int N, int G_, int c_) { nM = M / BM; nN = N / BM; nwg = nM * nN; G = G_; c = c_; }
    __host__ __device__ bool next(int i, Unit& u) const {
        const long L = (long)i * G + c; if (L >= nwg) return false;
        int wgid = (int)L; { const int q = nwg / NXCD, r = nwg % NXCD, xcd = wgid % NXCD, off = wgid / NXCD; wgid = (xcd < r ? xcd * (q + 1) : r * (q + 1) + (xcd - r) * q) + off; }
        const int nig = WGM * nN, gid = wgid / nig, fm = gid * WGM, gsz = (nM - fm) < WGM ? (nM - fm) : WGM;
        u.pm = fm + ((wgid % nig) % gsz); u.pn = (wgid % nig) / gsz; return true;
    }
    __device__ __forceinline__ void a_ready(const Unit&) const {}
    __device__ __forceinline__ void done(const Unit&) const {}
};

__device__ __forceinline__ unsigned cvt_pk_bf16(float lo, float hi) { unsigned r; asm volatile("v_cvt_pk_bf16_f32 %0, %1, %2" : "=v"(r) : "v"(lo), "v"(hi)); return r; }
typedef float f32x2 __attribute__((ext_vector_type(2)));
__device__ __forceinline__ float sigm(float x) { return __builtin_amdgcn_rcpf(1.0f + __builtin_amdgcn_exp2f(-1.4426950408889634f * x)); }
constexpr float QK_C2 = 0.125f * 1.4426950408889634f;
#define PG8_GAS __attribute__((address_space(1)))
struct EpiAll {
    static constexpr bool PERM = true, AFTER_DRAIN = false;
    int mode;
    int mtiles_main;
    bf16_t* O1; bf16_t* O2; bf16_t* O3; int ldo;
    float* hmain; float* hmeta; float scale;
    const float* qg; const float* kg;
    const float* ssq;
    float* ssq_out; bf16_t* hb; PG8_LAS float* ldsp;
    __device__ __forceinline__ void operator()(const f32x4 (&acc)[2][2][4][2], const Unit& u, int wr, int wc, int fr, int fq) const {
        const int rloc_ = wr * 64 + fr;
#define EPI_LAUNDER() int rloc = rloc_; asm volatile("" : "+v"(rloc))
#define EPI_RS() float rsv[2][4]; { const float* sp_ = ssq + (size_t)(u.pm * BM + rloc) * 4; \
    _Pragma("unroll") for (int ai = 0; ai < 2; ++ai) _Pragma("unroll") for (int m = 0; m < 4; ++m) { const f32x4 s_ = *(const PG8_GAS f32x4*)(sp_ + (size_t)(ai * HALF + m * 16) * 4); \
        rsv[ai][m] = __builtin_amdgcn_rsqf(((s_[0] + s_[1]) + (s_[2] + s_[3])) * (1.0f / 1024.0f) + 1e-6f); } }
        if (mode <= 1 || (mode == 2 && u.pn < 8)) {
            EPI_LAUNDER(); EPI_RS();
            bf16_t* base = O1 + (size_t)(u.pm * BM + rloc) * ldo + u.pn * HALF + wc * 32 + 8 * fq;
#pragma unroll
            for (int ai = 0; ai < 2; ++ai)
#pragma unroll
                for (int m = 0; m < 4; ++m) {
                    const float rs_ = rsv[ai][m]; const f32x4 a0 = acc[ai][0][m][0] * rs_, a1 = acc[ai][0][m][1] * rs_, b0 = acc[ai][1][m][0] * rs_, b1 = acc[ai][1][m][1] * rs_;
                    f32x4 r0, r1;
                    if (mode == 0) {
#pragma unroll
                        for (int i = 0; i < 4; ++i) { r0[i] = a0[i] * sigm(a0[i]) * b0[i]; r1[i] = a1[i] * sigm(a1[i]) * b1[i]; }
                    } else if (mode == 1) {
#pragma unroll
                        for (int i = 0; i < 4; ++i) { r0[i] = a0[i] * sigm(b0[i]); r1[i] = a1[i] * sigm(b1[i]); }
                    } else { r0 = a0 * b0; r1 = a1 * b1; }
                    u32x4 w; w.x = cvt_pk_bf16(r0[0], r0[1]); w.y = cvt_pk_bf16(r0[2], r0[3]); w.z = cvt_pk_bf16(r1[0], r1[1]); w.w = cvt_pk_bf16(r1[2], r1[3]);
                    *(PG8_GAS u32x4*)(base + (size_t)(ai * HALF + m * 16) * ldo) = w;
                }
        } else if (mode == 2) {
            EPI_LAUNDER(); EPI_RS();
            bf16_t* base = O2 + (size_t)(u.pm * BM + rloc) * 1024 + (u.pn - 8) * BM + wc * 32 + 8 * fq;
#pragma unroll
            for (int ai = 0; ai < 2; ++ai)
#pragma unroll
                for (int m = 0; m < 4; ++m)
#pragma unroll
                    for (int bj = 0; bj < 2; ++bj) {
                        const f32x4 v0 = acc[ai][bj][m][0] * rsv[ai][m], v1 = acc[ai][bj][m][1] * rsv[ai][m];
                        u32x4 w; w.x = cvt_pk_bf16(v0[0], v0[1]); w.y = cvt_pk_bf16(v0[2], v0[3]); w.z = cvt_pk_bf16(v1[0], v1[1]); w.w = cvt_pk_bf16(v1[2], v1[3]);
                        *(PG8_GAS u32x4*)(base + (size_t)(ai * HALF + m * 16) * 1024 + bj * HALF) = w;
                    }
        } else if (mode == 3) {
            EPI_LAUNDER(); EPI_RS();
            const int sec = u.pn >> 2;
            const bool meta = false;
            const long krow0 = meta ? 48 : (long)u.pm * BM + 128 * (1 + (u.pm >> 5));
            bf16_t* dst = (sec == 0) ? O1 + (size_t)(u.pm * BM) * 1024 : ((sec == 1) ? O2 : O3) + (size_t)krow0 * 1024;
            const bool dup = meta && sec != 0; const int rlim = dup ? 16 : 256;
            if (sec < 2) {
                const int head = 4 * (u.pn & 3) + wc;
                const int lxor16 = (fr + 16 * (fq ^ 1)) << 2, lxor32 = (fr + 16 * (fq ^ 2)) << 2;
                const float* g = (sec == 0) ? qg : kg; const float gs = (sec == 0) ? QK_C2 : 1.0f;
                f32x4 gv[2][2];
#pragma unroll
                for (int bj = 0; bj < 2; ++bj)
#pragma unroll
                    for (int n = 0; n < 2; ++n) gv[bj][n] = *(const PG8_GAS f32x4*)(g + 32 * bj + 8 * fq + 4 * n) * gs;
#pragma unroll
                for (int ai = 0; ai < 2; ++ai)
#pragma unroll
                    for (int m = 0; m < 4; ++m) {
                        float ss = 0.f;
#pragma unroll
                        for (int bj = 0; bj < 2; ++bj)
#pragma unroll
                            for (int n = 0; n < 2; ++n) { const f32x4 x = acc[ai][bj][m][n] * rsv[ai][m]; ss += (x[0] * x[0] + x[1] * x[1]) + (x[2] * x[2] + x[3] * x[3]); }
                        ss += __builtin_bit_cast(float, __builtin_amdgcn_ds_bpermute(lxor16, __builtin_bit_cast(int, ss))); ss += __builtin_bit_cast(float, __builtin_amdgcn_ds_bpermute(lxor32, __builtin_bit_cast(int, ss)));
                        const float rs = __builtin_amdgcn_rsqf(ss * (1.0f / 64.0f) + 1e-6f) * rsv[ai][m];
                        const int rl = rloc + ai * HALF + m * 16;
#pragma unroll
                        for (int bj = 0; bj < 2; ++bj) {
                            const f32x4 v0 = acc[ai][bj][m][0] * rs * gv[bj][0], v1 = acc[ai][bj][m][1] * rs * gv[bj][1];
                            u32x4 w; w.x = cvt_pk_bf16(v0[0], v0[1]); w.y = cvt_pk_bf16(v0[2], v0[3]); w.z = cvt_pk_bf16(v1[0], v1[1]); w.w = cvt_pk_bf16(v1[2], v1[3]);
                            const int col = 64 * head + 32 * bj + 8 * fq;
                            if (rl < rlim) { *(PG8_GAS u32x4*)(dst + (size_t)rl * 1024 + col) = w; if (dup) *(PG8_GAS u32x4*)(dst + (size_t)(8320 + rl) * 1024 + col) = w; }
                        }
                    }
            } else {
#pragma unroll
                for (int ai = 0; ai < 2; ++ai)
#pragma unroll
                    for (int m = 0; m < 4; ++m) {
                        const int rl = rloc + ai * HALF + m * 16;
#pragma unroll
                        for (int bj = 0; bj < 2; ++bj) {
                            const f32x4 v0 = acc[ai][bj][m][0] * rsv[ai][m], v1 = acc[ai][bj][m][1] * rsv[ai][m];
                            u32x4 w; w.x = cvt_pk_bf16(v0[0], v0[1]); w.y = cvt_pk_bf16(v0[2], v0[3]); w.z = cvt_pk_bf16(v1[0], v1[1]); w.w = cvt_pk_bf16(v1[2], v1[3]);
                            const int col = (u.pn - 8) * BM + bj * HALF + wc * 32 + 8 * fq;
                            if (rl < rlim) { *(PG8_GAS u32x4*)(dst + (size_t)rl * 1024 + col) = w; if (dup) *(PG8_GAS u32x4*)(dst + (size_t)(8320 + rl) * 1024 + col) = w; }
                        }
                    }
            }
        } else {
            EPI_LAUNDER();
            float* base = hmain + (size_t)(u.pm * BM + rloc) * 1024 + u.pn * BM + wc * 32 + 8 * fq;
            bf16_t* hbase = hb + (size_t)(u.pm * BM + rloc) * 1024 + u.pn * BM + wc * 32 + 8 * fq;
            const float sc = scale; const int lx16 = (fr + 16 * (fq ^ 1)) << 2, lx32 = (fr + 16 * (fq ^ 2)) << 2;
#pragma unroll
            for (int ai = 0; ai < 2; ++ai)
#pragma unroll
                for (int m = 0; m < 4; ++m) {
                    float ps = 0.f;
#pragma unroll
                    for (int bj = 0; bj < 2; ++bj) {
                        float* p = base + (size_t)(ai * HALF + m * 16) * 1024 + bj * HALF;
                        f32x4 x0 = *(const PG8_GAS f32x4*)p, x1 = *(const PG8_GAS f32x4*)(p + 4);
                        x0 += acc[ai][bj][m][0] * sc; x1 += acc[ai][bj][m][1] * sc;
                        *(PG8_GAS f32x4*)p = x0; *(PG8_GAS f32x4*)(p + 4) = x1;
                        ps += ((x0[0] * x0[0] + x0[1] * x0[1]) + (x0[2] * x0[2] + x0[3] * x0[3])) + ((x1[0] * x1[0] + x1[1] * x1[1]) + (x1[2] * x1[2] + x1[3] * x1[3]));
                        u32x4 w; w.x = cvt_pk_bf16(x0[0], x0[1]); w.y = cvt_pk_bf16(x0[2], x0[3]); w.z = cvt_pk_bf16(x1[0], x1[1]); w.w = cvt_pk_bf16(x1[2], x1[3]);
                        *(PG8_GAS u32x4*)(hbase + (size_t)(ai * HALF + m * 16) * 1024 + bj * HALF) = w;
                    }
                    ps += __builtin_bit_cast(float, __builtin_amdgcn_ds_bpermute(lx16, __builtin_bit_cast(int, ps))); ps += __builtin_bit_cast(float, __builtin_amdgcn_ds_bpermute(lx32, __builtin_bit_cast(int, ps)));
                    if (fq == 0) ldsp[(rloc + ai * HALF + m * 16) * 4 + wc] = ps;
                }
            asm volatile("s_waitcnt lgkmcnt(0)" ::: "memory");
        }
    }
};
template <class Epi, class Sched, bool ALIGN_EPI = false, bool SP2 = false>
__device__ __forceinline__ void gemm_phase(PG8_LAS unsigned char* lds, const Gemm g, const Sched& S, const Epi& E, const int tid_in) {
    const int tid = tid_in, wid = __builtin_amdgcn_readfirstlane(tid >> 6), lane = tid & 63, wr = wid >> 2, wc = wid & 3, fr = lane & 15, fq = lane >> 4;
    const int K = g.K, nt = K / BK;
    unsigned voffA[2], voffB[2];
#pragma unroll
    for (int i = 0; i < 2; ++i) { int R, C; stage_rc(tid * 16 + i * 8192, R, C); const int Rb = Epi::PERM ? ((R & ~31) + perm32(R & 31)) : R;
        voffA[i] = (unsigned)(R * K + C) * 2u; voffB[i] = (unsigned)(Rb * K + C) * 2u; }
    const size_t kstep = (size_t)(BK * 2);
    const size_t hstep = (size_t)HALF * K * 2;
    const size_t tstep = 2 * hstep;
    const unsigned ldsw = (unsigned)wid * 1024u;
    const int aoff = lds_byte(wr * 64 + fr, fq * 8), boff = lds_byte(wc * 32 + fr, fq * 8);
#define PG8_SA(b, h) (((b) * 2 + (h)) * HTB)
#define PG8_SB(b, h) ((4 + (b) * 2 + (h)) * HTB)
#define PG8_STAGE(bufoff, gbase, voff) do { _Pragma("unroll") for (int _i = 0; _i < 2; ++_i) \
        __builtin_amdgcn_global_load_lds((const unsigned*)((const char*)(gbase) + (voff)[_i]), (PG8_LAS unsigned*)(lds + (bufoff) + ldsw + _i * 8192), 16, 0, 0); } while (0)
#define PG8_LDA(dst, b, h) do { _Pragma("unroll") for (int m = 0; m < 4; ++m) _Pragma("unroll") for (int k = 0; k < 2; ++k) dst[m][k] = *(const PG8_LAS bf16x8*)(lds + PG8_SA(b, h) + aoff + m * 2048 + k * 1024); } while (0)
#define PG8_LDB(dst, b, h) do { _Pragma("unroll") for (int n = 0; n < 2; ++n) _Pragma("unroll") for (int k = 0; k < 2; ++k) dst[n][k] = *(const PG8_LAS bf16x8*)(lds + PG8_SB(b, h) + boff + n * 2048 + k * 1024); } while (0)
#define PG8_MMA(ai, bj, At, Bt) do { __builtin_amdgcn_s_setprio(1); _Pragma("unroll") for (int m = 0; m < 4; ++m) _Pragma("unroll") for (int n = 0; n < 2; ++n) _Pragma("unroll") for (int k = 0; k < 2; ++k) \
        acc[ai][bj][m][n] = __builtin_amdgcn_mfma_f32_16x16x32_bf16(Bt[n][k], At[m][k], acc[ai][bj][m][n], 0, 0, 0); __builtin_amdgcn_s_setprio(0); } while (0)
#define PG8_WAIT_V(n) asm volatile("s_waitcnt vmcnt(" #n ")" ::: "memory")
#define PG8_WAIT_L(n) asm volatile("s_waitcnt lgkmcnt(" #n ")" ::: "memory")
#define PG8_BAR __builtin_amdgcn_s_barrier()
#define PG8_SCHED __builtin_amdgcn_sched_barrier(0)
    Unit cur, nxt; int ui = 0;
    if (!S.next(0, cur)) return;
    f32x4 acc[2][2][4][2];
#pragma unroll
    for (int a = 0; a < 2; ++a)
#pragma unroll
        for (int b = 0; b < 2; ++b)
#pragma unroll
            for (int m = 0; m < 4; ++m)
#pragma unroll
                for (int n = 0; n < 2; ++n) acc[a][b][m][n] = (f32x4){0.f, 0.f, 0.f, 0.f};
    bf16x8 At[4][2], B0[2][2], B1[2][2];
    const char* cA = (const char*)g.A + (size_t)cur.pm * tstep; const char* cB = (const char*)g.Bt + (size_t)cur.pn * tstep;
    S.a_ready(cur);
    if constexpr (SP2) {
        PG8_STAGE(PG8_SB(0, 0), cB, voffB); PG8_STAGE(PG8_SB(0, 1), cB + hstep, voffB); PG8_STAGE(PG8_SA(0, 0), cA, voffA); PG8_STAGE(PG8_SA(0, 1), cA + hstep, voffA);
        if (wr == 1) PG8_BAR;
        PG8_WAIT_V(2); PG8_BAR;
        PG8_STAGE(PG8_SB(1, 0), cB + kstep, voffB); PG8_STAGE(PG8_SA(1, 0), cA + kstep, voffA); PG8_STAGE(PG8_SB(1, 1), cB + hstep + kstep, voffB);
        PG8_WAIT_V(6); PG8_BAR;
    } else {
        PG8_STAGE(PG8_SB(0, 0), cB, voffB); PG8_STAGE(PG8_SA(0, 0), cA, voffA); PG8_STAGE(PG8_SB(0, 1), cB + hstep, voffB); PG8_STAGE(PG8_SA(0, 1), cA + hstep, voffA);
        if (wr == 1) PG8_BAR;
        PG8_WAIT_V(4); PG8_BAR;
        PG8_STAGE(PG8_SB(1, 0), cB + kstep, voffB); PG8_STAGE(PG8_SA(1, 0), cA + kstep, voffA); PG8_STAGE(PG8_SB(1, 1), cB + hstep + kstep, voffB);
        PG8_WAIT_V(6); PG8_BAR;
    }
    for (;;) {
        const bool has_next = S.next(ui + 1, nxt);
        const char* nA = has_next ? (const char*)g.A + (size_t)nxt.pm * tstep : cA; const char* nB = has_next ? (const char*)g.Bt + (size_t)nxt.pn * tstep : cB;
        for (int t = 0; t < nt; t += 2) {
            const bool last = (t == nt - 2);
            const char* a1 = cA + (size_t)(t + 1) * kstep;
            const char* a2 = last ? nA : cA + (size_t)(t + 2) * kstep; const char* b2 = last ? nB : cB + (size_t)(t + 2) * kstep;
            const char* a3 = a2 + kstep; const char* b3 = b2 + kstep;
            if (last && has_next) S.a_ready(nxt);
            if constexpr (SP2) {
            PG8_LDB(B0, 0, 0); PG8_LDB(B1, 0, 1); PG8_SCHED; PG8_LDA(At, 0, 0); PG8_STAGE(PG8_SA(1, 1), a1 + hstep, voffA);
            PG8_WAIT_V(8); PG8_WAIT_L(0); PG8_BAR; PG8_MMA(0, 0, At, B0); PG8_MMA(0, 1, At, B1); PG8_BAR; PG8_SCHED;
            PG8_LDA(At, 0, 1); PG8_STAGE(PG8_SB(0, 0), b2, voffB); PG8_STAGE(PG8_SB(0, 1), b2 + hstep, voffB); PG8_STAGE(PG8_SA(0, 0), a2, voffA);
            PG8_WAIT_V(8); PG8_WAIT_L(0); PG8_BAR; PG8_MMA(1, 0, At, B0); PG8_MMA(1, 1, At, B1); PG8_BAR; PG8_SCHED;
            PG8_LDB(B0, 1, 0); PG8_LDB(B1, 1, 1); PG8_SCHED; PG8_LDA(At, 1, 0); PG8_STAGE(PG8_SA(0, 1), a2 + hstep, voffA);
            PG8_WAIT_V(8); PG8_WAIT_L(0); PG8_BAR; PG8_MMA(0, 0, At, B0); PG8_MMA(0, 1, At, B1); PG8_BAR; PG8_SCHED;
            PG8_LDA(At, 1, 1); PG8_STAGE(PG8_SB(1, 0), b3, voffB); PG8_STAGE(PG8_SB(1, 1), b3 + hstep, voffB); PG8_STAGE(PG8_SA(1, 0), a3, voffA);
            PG8_WAIT_V(8); PG8_WAIT_L(0); PG8_BAR; PG8_MMA(1, 0, At, B0); PG8_MMA(1, 1, At, B1); PG8_BAR; PG8_SCHED;
            } else {
            PG8_LDB(B0, 0, 0); PG8_SCHED; PG8_LDA(At, 0, 0); PG8_STAGE(PG8_SA(1, 1), a1 + hstep, voffA);
            PG8_WAIT_L(8); PG8_BAR; PG8_WAIT_L(0); PG8_MMA(0, 0, At, B0); PG8_BAR; PG8_SCHED;
            PG8_LDB(B1, 0, 1); PG8_STAGE(PG8_SB(0, 0), b2, voffB);
            PG8_BAR; PG8_WAIT_L(0); PG8_MMA(0, 1, At, B1); PG8_BAR;
            PG8_LDA(At, 0, 1); PG8_STAGE(PG8_SA(0, 0), a2, voffA);
            PG8_BAR; PG8_WAIT_L(0); PG8_MMA(1, 0, At, B0); PG8_BAR; PG8_SCHED;
            PG8_STAGE(PG8_SB(0, 1), b2 + hstep, voffB);
            PG8_WAIT_V(6); PG8_BAR; PG8_MMA(1, 1, At, B1); PG8_BAR;
            PG8_LDB(B0, 1, 0); PG8_SCHED; PG8_LDA(At, 1, 0); PG8_STAGE(PG8_SA(0, 1), a2 + hstep, voffA);
            PG8_WAIT_L(8); PG8_BAR; PG8_WAIT_L(0); PG8_MMA(0, 0, At, B0); PG8_BAR; PG8_SCHED;
            PG8_LDB(B1, 1, 1); PG8_STAGE(PG8_SB(1, 0), b3, voffB);
            PG8_BAR; PG8_WAIT_L(0); PG8_MMA(0, 1, At, B1); PG8_BAR;
            PG8_LDA(At, 1, 1); PG8_STAGE(PG8_SA(1, 0), a3, voffA);
            PG8_BAR; PG8_WAIT_L(0); PG8_MMA(1, 0, At, B0); PG8_BAR; PG8_SCHED;
            PG8_STAGE(PG8_SB(1, 1), b3 + hstep, voffB);
            PG8_WAIT_V(6); PG8_BAR; PG8_MMA(1, 1, At, B1); PG8_BAR;
            }
        }
        if constexpr (ALIGN_EPI) { if (wr == 0) PG8_BAR; }
        if constexpr (!Epi::AFTER_DRAIN) { E(acc, cur, wr, wc, fr, fq); S.done(cur); }
        if (!has_next) break;
#pragma unroll
        for (int a = 0; a < 2; ++a)
#pragma unroll
            for (int b = 0; b < 2; ++b)
#pragma unroll
                for (int m = 0; m < 4; ++m)
#pragma unroll
                    for (int n = 0; n < 2; ++n) acc[a][b][m][n] = (f32x4){0.f, 0.f, 0.f, 0.f};
        cur = nxt; cA = nA; cB = nB; ++ui;
        if constexpr (ALIGN_EPI) { if (wr == 1) PG8_BAR; }
    }
    PG8_WAIT_V(0);
    if constexpr (!ALIGN_EPI) { if (wr == 0) PG8_BAR; }
    PG8_BAR;
    if constexpr (Epi::AFTER_DRAIN) { E.fused(acc, cur, wr, wc, fr, fq, lds, wid, lane); S.done(cur); }
#undef PG8_SA
#undef PG8_SB
#undef PG8_STAGE
#undef PG8_LDA
#undef PG8_LDB
#undef PG8_MMA
#undef PG8_WAIT_V
#undef PG8_WAIT_L
#undef PG8_BAR
#undef PG8_SCHED
}
}

#ifndef PG8_SP2
#define PG8_SP2 true
#endif
#ifndef PG8_ALIGN
#define PG8_ALIGN true
#endif
#include <hip/hip_bf16.h>
#include <cmath>
namespace attn_body {
using bf16=__hip_bfloat16;
using bf16x8=__attribute__((ext_vector_type(8)))short;
using s16x4=__attribute__((ext_vector_type(4)))short;
using f32x16=__attribute__((ext_vector_type(16)))float;
using u32x4=__attribute__((ext_vector_type(4)))unsigned;
constexpr int BATCH=2,NHEAD=16,SEQ=8192,D=64,DM=NHEAD*D;
constexpr int NW=8,QBLK=32,QB=QBLK*NW,KVBLK=64,NQB=SEQ/QB; constexpr int KVPAD=128,KVROWS=SEQ+KVPAD;
constexpr int ATTN_PITCH=DM, ATTN_UNIT_ROWS=QB;
__device__ __forceinline__ int crow(int r,int hi){return (r&3)+8*(r>>2)+4*hi;}
#define SBAR() __builtin_amdgcn_sched_barrier(0)
__device__ __forceinline__ void cmask(f32x16&p0,f32x16&p1,int jb,int qrel,int hi){
  const float NEG=-INFINITY; int kb=64*jb+4*hi;
  #pragma unroll
  for(int r=0;r<16;++r){int kv=kb+(r&3)+8*(r>>2); if(kv>qrel)p0[r]=NEG; if(kv+32>qrel)p1[r]=NEG;}
}

constexpr int NSLOT=3, SLOTB=8192;
constexpr int LDS_K=0, LDS_V=NSLOT*SLOTB, LDS_WS=2*NSLOT*SLOTB, LDS_OST=LDS_WS+NW*64*4, LDS_CS=LDS_OST+NW*4096, LDS_BYTES=LDS_CS+KVROWS*4;
constexpr float C2=0.125f*1.4426950408889634f;
__device__ __forceinline__ void glds16(const void*gsrc,unsigned lds_dst){unsigned keep;
  asm volatile("s_mov_b32 %0, m0\n\ts_mov_b32 m0, %2\n\ts_nop 0\n\tglobal_load_lds_dwordx4 %1, off\n\ts_mov_b32 m0, %0":"=&s"(keep):"v"(gsrc),"s"(lds_dst):"memory");}
__device__ __forceinline__ float max3f(float a,float b,float c){float r;asm("v_max3_f32 %0, %1, %2, %3":"=v"(r):"v"(a),"v"(b),"v"(c));return r;}
__device__ __forceinline__ float max2f(float a,float b){float r;asm("v_max_f32_e32 %0, %1, %2":"=v"(r):"v"(a),"v"(b));return r;}
__device__ __forceinline__ float fadd_s(float a,float b){float r;asm("v_add_f32_e32 %0, %1, %2":"=v"(r):"v"(a),"v"(b));return r;}
__device__ __forceinline__ float fsub_s(float a,float b){float r;asm("v_sub_f32_e32 %0, %1, %2":"=v"(r):"v"(a),"v"(b));return r;}
typedef float f32x2_t __attribute__((ext_vector_type(2))); typedef __bf16 bf16x2_t __attribute__((ext_vector_type(2)));
__device__ __forceinline__ unsigned cvtpk_s(float lo,float hi){f32x2_t v={lo,hi};bf16x2_t b=__builtin_convertvector(v,bf16x2_t);return __builtin_bit_cast(unsigned,b);}
#define WAIT_BAR(N) asm volatile("s_waitcnt vmcnt(" #N ") lgkmcnt(0)\n\ts_barrier":::"memory")

__device__ __forceinline__ void qkt(f32x16&p0,f32x16&p1,const char*Kslot,const bf16x8*qr,int r32,int hi){
  const char*kb=Kslot+hi*1024+r32*16;
  #pragma unroll
  for(int d0=0;d0<4;++d0){
    const bf16x8 b0=*reinterpret_cast<const bf16x8*>(kb+d0*2048);
    const bf16x8 b1=*reinterpret_cast<const bf16x8*>(kb+d0*2048+512);
    p0=__builtin_amdgcn_mfma_f32_32x32x16_bf16(b0,qr[d0],p0,0,0,0);p1=__builtin_amdgcn_mfma_f32_32x32x16_bf16(b1,qr[d0],p1,0,0,0);}
}
typedef __attribute__((address_space(3))) const char* lds_cptr;
typedef short v4i16_t __attribute__((ext_vector_type(4))); typedef float f32x4_t __attribute__((ext_vector_type(4)));
__device__ __forceinline__ void kload8(bf16x8*kf,lds_cptr kp){
  kf[0]=*(const __attribute__((address_space(3))) bf16x8*)(kp);      kf[1]=*(const __attribute__((address_space(3))) bf16x8*)(kp+512);
  kf[2]=*(const __attribute__((address_space(3))) bf16x8*)(kp+2048); kf[3]=*(const __attribute__((address_space(3))) bf16x8*)(kp+2560);
  kf[4]=*(const __attribute__((address_space(3))) bf16x8*)(kp+4096); kf[5]=*(const __attribute__((address_space(3))) bf16x8*)(kp+4608);
  kf[6]=*(const __attribute__((address_space(3))) bf16x8*)(kp+6144); kf[7]=*(const __attribute__((address_space(3))) bf16x8*)(kp+6656);
}
__device__ __forceinline__ void kload2(bf16x8*kf,lds_cptr kp,int j){ kf[2*j]=*(const __attribute__((address_space(3))) bf16x8*)(kp+j*2048); kf[2*j+1]=*(const __attribute__((address_space(3))) bf16x8*)(kp+j*2048+512); }
__device__ __forceinline__ s16x4 vtr(lds_cptr p){ return __builtin_bit_cast(s16x4,__builtin_amdgcn_ds_read_tr16_b64_v4i16((__attribute__((address_space(3))) v4i16_t*)p)); }
__device__ __forceinline__ float rowmax(const f32x16&p0,const f32x16&p1){
  float a=max3f(p0[0],p0[1],p1[0]),b=max3f(p0[2],p0[3],p1[1]);a=max3f(a,p1[2],p1[3]);
  #pragma unroll
  for(int r=4;r<16;r+=4){a=max3f(a,p0[r],p0[r+1]);b=max3f(b,p0[r+2],p0[r+3]);a=max3f(a,p1[r],p1[r+1]);b=max3f(b,p1[r+2],p1[r+3]);}
  const float m=max2f(a,b);
  auto rr=__builtin_amdgcn_permlane32_swap(__float_as_uint(m),__float_as_uint(m),false,false);
  return max2f(__uint_as_float(rr[0]),__uint_as_float(rr[1]));
}
__device__ __forceinline__ void pv(f32x16*o,int vb,bf16x8 pa0,bf16x8 pa1,bf16x8 pa2,bf16x8 pa3){
  #pragma unroll
  for(int d0=0;d0<2;++d0){s16x4 lo[4],hi[4];
    #pragma unroll
    for(int ks=0;ks<4;++ks){
      asm volatile("ds_read_b64_tr_b16 %0,%1 offset:%c2":"=&v"(lo[ks]):"v"(vb),"i"(d0*4096+ks*1024):"memory");
      asm volatile("ds_read_b64_tr_b16 %0,%1 offset:%c2":"=&v"(hi[ks]):"v"(vb),"i"(d0*4096+ks*1024+512):"memory");}
    asm volatile("s_waitcnt lgkmcnt(0)":::"memory");SBAR();
    #define PK(k) (bf16x8){lo[k][0],lo[k][1],lo[k][2],lo[k][3],hi[k][0],hi[k][1],hi[k][2],hi[k][3]}
    o[d0]=__builtin_amdgcn_mfma_f32_32x32x16_bf16(pa0,PK(0),o[d0],0,0,0);
    o[d0]=__builtin_amdgcn_mfma_f32_32x32x16_bf16(pa1,PK(1),o[d0],0,0,0);
    o[d0]=__builtin_amdgcn_mfma_f32_32x32x16_bf16(pa2,PK(2),o[d0],0,0,0);
    o[d0]=__builtin_amdgcn_mfma_f32_32x32x16_bf16(pa3,PK(3),o[d0],0,0,0);
    #undef PK
  }
}

#ifndef ATTN_STORE16
#define ATTN_STORE16(p,v) (*(__attribute__((address_space(1))) u32x4*)(p)=(v))
#endif
template<int THRL> __device__ __forceinline__ void attn_unit(int b,int h,int qb,const bf16*Q,const bf16*__restrict__ K,const bf16*__restrict__ V,bf16*O,const float*__restrict__ CS,char*shm,const int tid_in){
  const int tid=tid_in,lane=tid&63,r32=lane&31,hi=lane>>5; const int wid=__builtin_amdgcn_readfirstlane(tid>>6);
  const long rowbase=(long)b*SEQ, kvbase=(long)b*KVROWS; const int q0=qb*QB;
  const bf16*Qw=Q+(rowbase+q0+wid*QBLK)*DM+h*D;
  const bf16*Kh=K+kvbase*DM+h*D,*Vh=V+kvbase*DM+h*D;
  const unsigned lds0=(unsigned)(uintptr_t)shm;
  float*wsf=(float*)(shm+LDS_WS)+wid*64;
  const bf16*ksrc=Kh+(long)lane*DM+wid*8;
  const bf16*vsrc=Vh+(long)(16*(wid&3)+(lane>>2))*DM+(wid>>2)*32+(lane&3)*8;
  const unsigned kdst=lds0+LDS_K+wid*1024, vdst=lds0+LDS_V+wid*1024;
  #define DMA_K(t,slot) glds16(ksrc+(long)(t)*KVBLK*DM,(unsigned)__builtin_amdgcn_readfirstlane(kdst+(slot)))
  #define DMA_V(t,slot) glds16(vsrc+(long)(t)*KVBLK*DM,(unsigned)__builtin_amdgcn_readfirstlane(vdst+(slot)))
  const int vb0=(int)(lds0+LDS_V)+((lane>>4)&1)*32+(lane&3)*8+(4*hi+((lane&15)>>2))*64;
  const char*Kbase=shm+LDS_K; bf16x8 kf[8];
  const lds_cptr shm3=(lds_cptr)shm; const lds_cptr kp0=shm3+LDS_K+hi*1024+r32*16; const lds_cptr vp0=shm3+LDS_V+((lane>>4)&1)*32+(lane&3)*8+(4*hi+((lane&15)>>2))*64;
  const int NT=(q0+QB+KVPAD)/KVBLK;
  { const float*csg=CS+(long)(b*NHEAD+h)*KVROWS; __attribute__((address_space(3))) float*csw=(__attribute__((address_space(3))) float*)((lds_cptr)shm+LDS_CS);
    for(int i=tid*4;i<NT*KVBLK;i+=NW*64*4){ const f32x4_t v=*(const __attribute__((address_space(1))) f32x4_t*)(csg+i); *(__attribute__((address_space(3))) f32x4_t*)(csw+i)=v; } }
  DMA_K(0,0);DMA_V(0,0);DMA_K(1,SLOTB);
  bf16x8 qr[4];
  #pragma unroll
  for(int d0=0;d0<4;++d0)qr[d0]=*(const __attribute__((address_space(1))) bf16x8*)(&Qw[(long)r32*DM+d0*16+hi*8]);
  float mhat=0.f,l_reg=0.f;f32x16 o[2];o[0]=f32x16{};o[1]=f32x16{};
  const __attribute__((address_space(3))) float*csl=(const __attribute__((address_space(3))) float*)((lds_cptr)shm+LDS_CS)+4*hi;
  #define BIASINIT(C0,C1,t) do{ const __attribute__((address_space(3))) float*bp_=csl+64*(t); const float nm_=-mhat; \
    _Pragma("unroll") for(int g_=0;g_<4;++g_){ const f32x4_t a_=*(const __attribute__((address_space(3))) f32x4_t*)(bp_+8*g_), b_=*(const __attribute__((address_space(3))) f32x4_t*)(bp_+32+8*g_); \
      C0[4*g_]=nm_-a_[0];C0[4*g_+1]=nm_-a_[1];C0[4*g_+2]=nm_-a_[2];C0[4*g_+3]=nm_-a_[3]; C1[4*g_]=nm_-b_[0];C1[4*g_+1]=nm_-b_[1];C1[4*g_+2]=nm_-b_[2];C1[4*g_+3]=nm_-b_[3]; } }while(0)
  const int qrel=wid*QBLK+r32;
  #define CMASK(P0,P1,t) do{int jb_=(t)-(NT-4); if(jb_>=0)cmask(P0,P1,jb_,qrel,hi);}while(0)
  bool resc=false;
  #define START(P0,P1) do{ const float rm=rowmax(P0,P1); resc=false; \
    { const float dl=rm; mhat=fadd_s(mhat,dl); \
      _Pragma("unroll") for(int r=0;r<16;++r){P0[r]=fsub_s(P0[r],dl);P1[r]=fsub_s(P1[r],dl);} \
      } \
    _Pragma("unroll") for(int r=0;r<16;++r)P0[r]=__builtin_amdgcn_exp2f(P0[r]); }while(0)
  #define RESC() do{ if(resc){ asm volatile("s_waitcnt lgkmcnt(0)":::"memory"); \
      _Pragma("unroll") for(int d_=0;d_<2;++d_) _Pragma("unroll") for(int r=0;r<16;++r)o[d_][r]*=wsf[crow(r,hi)]; } }while(0)
  f32x16 pA0,pA1,pB0,pB1;
  int sl_prev=0,sl_cur=0,sl_next=SLOTB;
  #define ROT() do{sl_prev=sl_cur;sl_cur=sl_next;sl_next=(sl_next==(NSLOT-1)*SLOTB)?0:sl_next+SLOTB;}while(0)
  DMA_K(2,2*SLOTB);
  WAIT_BAR(3);
  BIASINIT(pA0,pA1,0); qkt(pA0,pA1,Kbase,qr,r32,hi);asm volatile("s_nop 15\n\ts_nop 7":"+v"(pA0),"+v"(pA1));
  START(pA0,pA1);
  _Pragma("unroll") for(int r=0;r<16;++r)pA1[r]=__builtin_amdgcn_exp2f(pA1[r]);
  WAIT_BAR(0);
  DMA_K(3,0);DMA_V(1,SLOTB);
  ROT();
  kload8(kf,kp0+sl_cur);
  WAIT_BAR(2);
  s16x4 vlo[8],vhi[8]; u32x4 pw0,pw1,pw2,pw3;
  #define PKW(P,B) cvtpk_s(P[B],P[B+1])
  #define PAF(k) __builtin_bit_cast(bf16x8,pw##k)
  #define VFR(i) (bf16x8){vlo[i][0],vlo[i][1],vlo[i][2],vlo[i][3],vhi[i][0],vhi[i][1],vhi[i][2],vhi[i][3]}
  #define PIN(x) asm volatile("":"+v"(x))
  #define MX3(a,b,c) __builtin_fmaxf(__builtin_fmaxf((a),(b)),(c))
  #define GAPA(MF,A0,A1,A2,A3,W0,W1,PW) do{ MF; sacc+=A0; sacc+=A1; sacc+=A2; sacc+=A3; PIN(sacc); W0; W1; PIN(PW); SBAR(); }while(0)
  #define EX(v) __builtin_amdgcn_exp2f(v)
  #define GAPB(MF,X,B) do{ MF; X[B]=EX(X[B]); X[B+1]=EX(X[B+1]); X[B+2]=EX(X[B+2]); X[B+3]=EX(X[B+3]); PIN(X); SBAR(); }while(0)
  #define VRD(i) do{ vlo[i]=vtr(vp_+(((i)>>2)*4096+((i)&3)*1024)); vhi[i]=vtr(vp_+(((i)>>2)*4096+((i)&3)*1024+512)); }while(0)
  #define KRD(G,j) do{ if(G){ kload2(kf,kp0+sl_next,j); SBAR(); } }while(0)
  #define STEP(C0,C1,P0,P1,t,GK,GV,GL) do{ SBAR(); BIASINIT(C0,C1,t); SBAR(); \
    const lds_cptr vp_=vp0+sl_prev; \
    VRD(0); SBAR(); float sacc=(P0[0]+P0[1]); \
    GAPA(C0=__builtin_amdgcn_mfma_f32_32x32x16_bf16(kf[0],qr[0],C0,0,0,0), P0[2],P0[3],P0[4],P0[5],     pw0[0]=PKW(P0,0), pw0[1]=PKW(P0,2), pw0); \
    VRD(4); SBAR(); GAPA(C1=__builtin_amdgcn_mfma_f32_32x32x16_bf16(kf[1],qr[0],C1,0,0,0), P0[6],P0[7],P0[8],P0[9],     pw0[2]=PKW(P0,4), pw0[3]=PKW(P0,6), pw0); \
    VRD(1); SBAR(); GAPA(C0=__builtin_amdgcn_mfma_f32_32x32x16_bf16(kf[2],qr[1],C0,0,0,0),   P0[10],P0[11],P0[12],P0[13], pw1[0]=PKW(P0,8), pw1[1]=PKW(P0,10), pw1); \
    VRD(5); SBAR(); GAPA(C1=__builtin_amdgcn_mfma_f32_32x32x16_bf16(kf[3],qr[1],C1,0,0,0),   P0[14],P0[15],P1[0],P1[1],   pw1[2]=PKW(P0,12),pw1[3]=PKW(P0,14), pw1); \
    VRD(2); SBAR(); GAPA(C0=__builtin_amdgcn_mfma_f32_32x32x16_bf16(kf[4],qr[2],C0,0,0,0),   P1[2],P1[3],P1[4],P1[5],     pw2[0]=PKW(P1,0), pw2[1]=PKW(P1,2), pw2); \
    VRD(6); SBAR(); GAPA(C1=__builtin_amdgcn_mfma_f32_32x32x16_bf16(kf[5],qr[2],C1,0,0,0),   P1[6],P1[7],P1[8],P1[9],     pw2[2]=PKW(P1,4), pw2[3]=PKW(P1,6), pw2); \
    VRD(3); SBAR(); GAPA(C0=__builtin_amdgcn_mfma_f32_32x32x16_bf16(kf[6],qr[3],C0,0,0,0),   P1[10],P1[11],P1[12],P1[13], pw3[0]=PKW(P1,8), pw3[1]=PKW(P1,10), pw3); \
    VRD(7); SBAR(); GAPA(C1=__builtin_amdgcn_mfma_f32_32x32x16_bf16(kf[7],qr[3],C1,0,0,0),   P1[14],P1[15],0.f,0.f,       pw3[2]=PKW(P1,12),pw3[3]=PKW(P1,14), pw3); \
    l_reg+=sacc; \
    if(GK){DMA_K((t)+3,sl_cur);} if(GV){DMA_V((t)+1,sl_next);} \
    CMASK(C0,C1,t); \
    { float a=MX3(C0[0],C0[1],C1[0]),b=MX3(C0[2],C0[3],C1[1]); a=MX3(a,C1[2],C1[3]); \
      _Pragma("unroll") for(int r=4;r<16;r+=4){a=MX3(a,C0[r],C0[r+1]);b=MX3(b,C0[r+2],C0[r+3]);a=MX3(a,C1[r],C1[r+1]);b=MX3(b,C1[r+2],C1[r+3]);} \
      float rm=__builtin_fmaxf(a,b); { auto rr=__builtin_amdgcn_permlane32_swap(__float_as_uint(rm),__float_as_uint(rm),false,false); rm=__builtin_fmaxf(__uint_as_float(rr[0]),__uint_as_float(rr[1])); } \
      resc=false; \
      if(__builtin_expect(__any(rm>(float)THRL),0)){ const float dl=__builtin_fmaxf(rm,0.f); mhat+=dl; \
        _Pragma("unroll") for(int r=0;r<16;++r){C0[r]-=dl;C1[r]-=dl;} \
        const float f=__builtin_amdgcn_exp2f(-dl); l_reg*=f; if(hi==0)wsf[r32]=f; resc=true; } } \
    SBAR(); \
    GAPB(o[0]=__builtin_amdgcn_mfma_f32_32x32x16_bf16(PAF(0),VFR(0),o[0],0,0,0), C0,0); \
    GAPB(o[1]=__builtin_amdgcn_mfma_f32_32x32x16_bf16(PAF(0),VFR(4),o[1],0,0,0), C0,4); \
    KRD(GL,0); GAPB(o[0]=__builtin_amdgcn_mfma_f32_32x32x16_bf16(PAF(1),VFR(1),o[0],0,0,0), C0,8); \
    KRD(GL,1); GAPB(o[1]=__builtin_amdgcn_mfma_f32_32x32x16_bf16(PAF(1),VFR(5),o[1],0,0,0), C0,12); \
    KRD(GL,2); GAPB(o[0]=__builtin_amdgcn_mfma_f32_32x32x16_bf16(PAF(2),VFR(2),o[0],0,0,0), C1,0); \
    KRD(GL,3); GAPB(o[1]=__builtin_amdgcn_mfma_f32_32x32x16_bf16(PAF(2),VFR(6),o[1],0,0,0), C1,4); \
    GAPB(o[0]=__builtin_amdgcn_mfma_f32_32x32x16_bf16(PAF(3),VFR(3),o[0],0,0,0), C1,8); \
    GAPB(o[1]=__builtin_amdgcn_mfma_f32_32x32x16_bf16(PAF(3),VFR(7),o[1],0,0,0), C1,12); \
    }while(0)
  int t=1;
  #undef CMASK
  #define CMASK(P0,P1,t) do{}while(0)
  for(;t+5<NT;t+=2){
    STEP(pB0,pB1,pA0,pA1,t,true,true,true);     WAIT_BAR(2); RESC(); ROT();
    STEP(pA0,pA1,pB0,pB1,t+1,true,true,true);   WAIT_BAR(2); RESC(); ROT();
  }
  #undef CMASK
  #define CMASK(P0,P1,t) do{int jb_=(t)-(NT-4); if(jb_>=0)cmask(P0,P1,jb_,qrel,hi);}while(0)
  #define ENDW(tt) do{ if((tt)+3<NT){WAIT_BAR(2);} else if((tt)+2<NT){WAIT_BAR(1);} else {WAIT_BAR(0);} }while(0)
  for(;t+1<NT;t+=2){
    STEP(pB0,pB1,pA0,pA1,t,(t+3<NT),(t+1<NT),(t+1<NT));       ENDW(t);   RESC(); ROT();
    STEP(pA0,pA1,pB0,pB1,t+1,(t+4<NT),(t+2<NT),(t+2<NT));     ENDW(t+1); RESC(); ROT();
  }
  STEP(pB0,pB1,pA0,pA1,NT-1,false,false,false); RESC();
  { float sacc=pB0[0]+pB0[1]; _Pragma("unroll") for(int r=2;r<16;++r)sacc+=pB0[r]; _Pragma("unroll") for(int r=0;r<16;++r)sacc+=pB1[r]; l_reg+=sacc;
    pw0=(u32x4){PKW(pB0,0),PKW(pB0,2),PKW(pB0,4),PKW(pB0,6)};pw1=(u32x4){PKW(pB0,8),PKW(pB0,10),PKW(pB0,12),PKW(pB0,14)};pw2=(u32x4){PKW(pB1,0),PKW(pB1,2),PKW(pB1,4),PKW(pB1,6)};pw3=(u32x4){PKW(pB1,8),PKW(pB1,10),PKW(pB1,12),PKW(pB1,14)};
    SBAR(); pv(o,vb0+sl_cur,PAF(0),PAF(1),PAF(2),PAF(3)); }
  #undef PKW
  #undef PAF
  #undef VFR
  #undef PIN
  #undef MX3
  #undef GAPA
  #undef GAPB
  #undef EX
  #undef VRD
  #undef KRD
  #undef STEP
  #undef ENDW
  {auto rr=__builtin_amdgcn_permlane32_swap(__float_as_uint(l_reg),__float_as_uint(l_reg),false,false);l_reg=__uint_as_float(rr[0])+__uint_as_float(rr[1]);}
  if(hi==0)wsf[32+r32]=l_reg;asm volatile("s_waitcnt lgkmcnt(0)":::"memory");
  float rli[16];
  #pragma unroll
  for(int r=0;r<16;++r)rli[r]=__builtin_amdgcn_rcpf(wsf[32+crow(r,hi)]);
  bf16*Ow=O+(rowbase+q0+wid*QBLK)*DM+h*D;
  { bf16*stg=(bf16*)(shm+LDS_OST)+wid*2048;
    #pragma unroll
    for(int r=0;r<16;++r){const int orow=crow(r,hi);
      #pragma unroll
      for(int d0=0;d0<2;++d0)stg[orow*64+d0*32+r32]=__float2bfloat16(o[d0][r]*rli[r]);}
    asm volatile("s_waitcnt lgkmcnt(0)":::"memory");
    #pragma unroll
    for(int i=0;i<4;++i){const int row=i*8+(lane>>3),ch=lane&7; const u32x4 v=*(const u32x4*)(stg+row*64+ch*8); ATTN_STORE16(Ow+(long)row*DM+ch*8,v);} }
  asm volatile("s_waitcnt lgkmcnt(0)\n\ts_barrier":::"memory");
  #undef DMA_K
  #undef DMA_V
  #undef CMASK
  #undef START
  #undef RESC
  #undef ROT
  #undef BIASINIT
}
constexpr int ATTN_LDS_BYTES=LDS_BYTES;
struct AttnTensors { const bf16* Q; const bf16* K; const bf16* V; bf16* O; const float* CS; };
struct AttnUnit { int bh; int qb; };
struct StaticOrder {
  int vcu;
  __device__ __forceinline__ explicit StaticOrder(int grid,int block):vcu((block%8)*(grid/8)+block/8){}
  __device__ __forceinline__ bool next(int i,AttnUnit&u)const{ if(i>=4)return false; const int s=vcu&7; u.bh=vcu>>3; u.qb=(i==0)?s:(i==1)?15-s:(i==2)?16+s:31-s; return true; }
  __device__ __forceinline__ void a_ready(const AttnUnit&)const{}
  __device__ __forceinline__ void done(const AttnUnit&)const{}
};
template<class Sched,int THRL=8> __device__ __forceinline__ void attn_phase(char*lds,const AttnTensors&T,const Sched&S,const int tid_in){
  AttnUnit u;
  for(int i=0;S.next(i,u);++i){ S.a_ready(u); attn_unit<THRL>(u.bh/NHEAD,u.bh%NHEAD,u.qb,T.Q,T.K,T.V,T.O,T.CS,lds,tid_in); S.done(u); }
}
#undef SBAR
#undef WAIT_BAR
}
#define LAS __attribute__((address_space(3)))
#define XB_TMO      128
#define XB_XCNT(j)  (256  + 64 * (j))
#define XB_XSUB(j)  (1280 + 64 * (j))
#define XB_XGEN(j)  (2304 + 64 * (j))
#define XB_TOP      3328
#define XB_TOPGEN   3392
#define XCD_BAR_WORDS 3456
#define XB_SPIN_CAP (1u << 18)

__device__ __forceinline__ unsigned xb_ld(unsigned* p)              { return __hip_atomic_load(p, __ATOMIC_RELAXED, __HIP_MEMORY_SCOPE_AGENT); }
__device__ __forceinline__ unsigned xb_add(unsigned* p, unsigned v) { return __hip_atomic_fetch_add(p, v, __ATOMIC_RELAXED, __HIP_MEMORY_SCOPE_AGENT); }
__device__ __forceinline__ unsigned xb_xcc_id() { return (unsigned)__builtin_amdgcn_s_getreg((3 << 11) | 20) & 0xFu; }
#define XB_SPIN(cond, bar) do { unsigned _sp = 0; while (cond) { __builtin_amdgcn_s_sleep(1); \
    if ((++_sp & 255u) == 0u) { if (xb_ld(&(bar)[XB_TMO])) break; if (_sp > XB_SPIN_CAP) { atomicAdd(&(bar)[XB_TMO], 1u); break; } } } } while (0)

struct XcdBarrier {
    unsigned* bar; unsigned x;
    volatile LAS unsigned* st;
};

__device__ __forceinline__ XcdBarrier xcd_barrier_post(unsigned* bar, volatile LAS unsigned* st, const int tid) {
    XcdBarrier b; b.bar = bar; b.x = xb_xcc_id(); b.st = st;
    if (tid == 0) (void)xb_add(&bar[XB_XCNT(b.x)], 1u);
    return b;
}
__device__ __forceinline__ void xcd_barrier_complete(unsigned* bar, unsigned x, unsigned& nloc, unsigned& nx) {
    const unsigned G = gridDim.x * gridDim.y * gridDim.z;
    unsigned sum, cnt, mine, sp = 0u;
    for (;;) {
        sum = 0u; cnt = 0u; mine = 0u;
#pragma unroll
        for (unsigned j = 0; j < 16; ++j) { const unsigned c = xb_ld(&bar[XB_XCNT(j)]); sum += c; cnt += (c > 0u) ? 1u : 0u; mine = (j == x) ? c : mine; }
        if (sum == G) break;
        __builtin_amdgcn_s_sleep(1);
        if ((++sp & 255u) == 0u) { if (xb_ld(&bar[XB_TMO])) break; if (sp > XB_SPIN_CAP) { atomicAdd(&bar[XB_TMO], 1u); break; } }
    }
    nloc = mine > 0u ? mine : 1u; nx = cnt > 0u ? cnt : 1u;
}

__device__ __forceinline__ void xcd_barrier(const XcdBarrier& b, const int tid) {
    asm volatile("s_waitcnt vmcnt(0)" ::: "memory");
    __syncthreads();
    if (tid == 0) {
        unsigned* bar = b.bar;
        __builtin_amdgcn_s_waitcnt(0);
        unsigned nloc = b.st[0], nx = b.st[1];
        if (nloc == 0u) { xcd_barrier_complete(bar, b.x, nloc, nx); b.st[0] = nloc; b.st[1] = nx; }
        const unsigned old = xb_add(&bar[XB_XSUB(b.x)], 1u);
        const unsigned gen = old / nloc;
        if (old + 1u == (gen + 1u) * nloc) {
            __builtin_amdgcn_fence(__ATOMIC_RELEASE, "agent");
            asm volatile("s_waitcnt vmcnt(0)" ::: "memory");
            const unsigned og = xb_add(&bar[XB_TOP], 1u);
            const unsigned tg = og / nx;
            if (og + 1u == (tg + 1u) * nx) xb_add(&bar[XB_TOPGEN], 1u);
            else XB_SPIN(xb_ld(&bar[XB_TOPGEN]) == tg, bar);
            __builtin_amdgcn_fence(__ATOMIC_ACQUIRE, "agent");
            xb_add(&bar[XB_XGEN(b.x)], 1u);
            asm volatile("s_waitcnt vmcnt(0)" ::: "memory");
        } else {
            XB_SPIN(xb_ld(&bar[XB_XGEN(b.x)]) == gen, bar);
            __builtin_amdgcn_fence(__ATOMIC_ACQUIRE, "agent");
            asm volatile("s_waitcnt vmcnt(0)" ::: "memory");
        }
    }
    __syncthreads();
}
namespace cg = cooperative_groups;
constexpr int NWAVES = 8;
constexpr int DM = 1024, FF = 2816, NH = 16, SEQ = 8192, NMETA = 16, DEPTH = 4;
constexpr int MMAIN = 2 * SEQ;
constexpr int MROWS = MMAIN + NMETA;
constexpr int MPAD = 65 * 256;
constexpr int KVROWS = attn_body::KVROWS;
constexpr float EPS = 1e-6f, LOG2E = 1.4426950408889634f;

constexpr size_t MiB = 1u << 20;
constexpr size_t SZ_GU = (size_t)5632 * 1024 * 2, SZ_DN = (size_t)1024 * 2816 * 2;
constexpr size_t WS_CTL = 0, CTL_ZERO_BYTES = 65536;
constexpr size_t WS_WGU = 1 * MiB, WS_WDN = WS_WGU + 8 * SZ_GU;
constexpr size_t WS_WAI = WS_WDN + 8 * SZ_DN, WS_WAO = WS_WAI + 2 * 6 * MiB, WS_WBI = WS_WAO + 2 * 2 * MiB, WS_WBO = WS_WBI + 4 * MiB;
constexpr size_t WS_WCI = WS_WBO + 2 * MiB, WS_WCO = WS_WCI + 6 * MiB, WS_WF = WS_WCO + 2 * MiB;
constexpr size_t WS_XN = WS_WF + 1 * MiB;
constexpr size_t SZ_ROWBUF = (size_t)MPAD * 1024 * 2;
constexpr size_t WS_ACT = WS_XN + 33 * MiB;
constexpr size_t WS_HMETA = WS_ACT + 98 * MiB, WS_LF = WS_HMETA + 1 * MiB, WS_LFM = WS_LF + 1 * MiB, WS_CS = WS_LFM + 1 * MiB, WS_SSQ = WS_CS + 2 * MiB, WS_SSQM = WS_SSQ + 1 * MiB, WS_END = WS_SSQM + 1 * MiB;
static_assert(SZ_ROWBUF <= 33 * MiB && 3 * SZ_ROWBUF <= 98 * MiB && (size_t)MPAD * FF * 2 <= 98 * MiB, "ws map");

constexpr int RING_BYTES = 131072, LDS_BYTES = 147456;
static_assert(attn_body::ATTN_LDS_BYTES <= RING_BYTES, "attention LDS");
constexpr int MISC_OFF = RING_BYTES + 320;

#define GAS __attribute__((address_space(1)))
typedef unsigned short bf16;
typedef unsigned v4u __attribute__((ext_vector_type(4)));
typedef unsigned v2u __attribute__((ext_vector_type(2)));
typedef float f32x4 __attribute__((ext_vector_type(4)));
typedef float f32x2 __attribute__((ext_vector_type(2)));
typedef short bf16x8 __attribute__((ext_vector_type(8)));
#define LDS_WAIT() asm volatile("s_waitcnt lgkmcnt(0)" ::: "memory")
__device__ __forceinline__ unsigned f2bf(float f) { unsigned u = __builtin_bit_cast(unsigned, f); return (u + 0x7fffu + ((u >> 16) & 1u)) >> 16; }
__device__ __forceinline__ unsigned pk2(float lo, float hi) { return f2bf(lo) | (f2bf(hi) << 16); }
__device__ __forceinline__ float bflo(unsigned w) { return __builtin_bit_cast(float, w << 16); }
__device__ __forceinline__ float bfhi(unsigned w) { return __builtin_bit_cast(float, w & 0xffff0000u); }
__device__ __forceinline__ float lane_get(float v, int src_lane) { return __builtin_bit_cast(float, __builtin_amdgcn_ds_bpermute(src_lane << 2, __builtin_bit_cast(int, v))); }
__device__ __forceinline__ float wave_sum(float v, int lane) {
#pragma unroll
    for (int o = 1; o < 64; o <<= 1) v += lane_get(v, lane ^ o);
    return v;
}

struct Args {
    const float* x; const float* meta; const float* ffn_norm; const float* ffn_w_gate; const float* ffn_w_up; const float* ffn_w_down; const float* mix_norm;
    const float* a_w_in; const float* a_conv; const float* a_w_out;
    const float* b_w_in; const float* b_conv; const float* b_conv_bias; const float* b_ln_g; const float* b_ln_b; const float* b_w_out;
    const float* c_w_in; const float* c_b_f; const float* c_q_norm; const float* c_k_norm; const float* c_w_out;
    float* out; unsigned char* ws;
};

__device__ __forceinline__ void transpose_item(const float* src, int Nsrc, bf16* dst, int K, int kb, LAS float* scr, int lane, const float* gain = nullptr) {
    const int k0 = 64 * kb;
#pragma unroll 8
    for (int i = 0; i < 32; ++i) { const int kk = 2 * i + (lane >> 5); scr[kk * 33 + (lane & 31)] = src[(size_t)(k0 + kk) * Nsrc + (lane & 31)] * (gain ? gain[k0 + kk] : 1.0f); }
    LDS_WAIT(); asm volatile("" ::: "memory");
    const int c = lane & 7;
#pragma unroll
    for (int j = 0; j < 4; ++j) { const int n = (lane >> 3) + 8 * j; const LAS float* s = scr + (8 * c) * 33 + n;
        v4u o; o.x = pk2(s[0 * 33], s[1 * 33]); o.y = pk2(s[2 * 33], s[3 * 33]); o.z = pk2(s[4 * 33], s[5 * 33]); o.w = pk2(s[6 * 33], s[7 * 33]);
        *(GAS v4u*)(dst + (size_t)n * K + k0 + 8 * c) = o; }
    LDS_WAIT(); asm volatile("" ::: "memory");
}

__device__ __forceinline__ float hb_row(const float* xrow, bf16* orow, float* hcopy, int lane) {
    const GAS f32x4* xr = (const GAS f32x4*)xrow + lane;
    f32x4 v[4]; float s = 0.f;
#pragma unroll
    for (int j = 0; j < 4; ++j) { v[j] = xr[64 * j]; s += (v[j].x * v[j].x + v[j].y * v[j].y) + (v[j].z * v[j].z + v[j].w * v[j].w); }
    GAS f32x4* hr = (GAS f32x4*)hcopy + lane;
#pragma unroll
    for (int j = 0; j < 4; ++j) hr[64 * j] = v[j];
    GAS unsigned long long* o8 = (GAS unsigned long long*)orow + lane;
#pragma unroll
    for (int j = 0; j < 4; ++j) o8[64 * j] = (unsigned long long)pk2(v[j].x, v[j].y) | ((unsigned long long)pk2(v[j].z, v[j].w) << 32);
    return wave_sum(s, lane);
}

__device__ __forceinline__ void thin_gemm(LAS unsigned char* ldsl, const int tid, const int vcu, const bf16* A, const bf16* Bt, const int K, const int mode,
                                          bf16* R0, bf16* R1, bf16* R2, float* hmeta, const float scale, const float* qg, const float* kg, float* SSQM, bf16* HB) {
    const int ntasks = (mode == 0) ? 176 : (mode == 2) ? 128 : (mode == 3) ? 48 : 64;
    if (vcu >= ntasks) return;
    const int lane = tid & 63, wave = __builtin_amdgcn_readfirstlane(tid >> 6), fr = lane & 15, fq = lane >> 4, task = vcu;
    int nt = 1, b0 = 0, b1 = 0, b2 = 0, b3 = 0;
    if (mode <= 1 || (mode == 2 && task < 64)) { const int f0 = 16 * task; b0 = 256 * (f0 >> 7) + (f0 & 127); b1 = b0 + 128; nt = 2; }
    else if (mode == 2) { b0 = 2048 + 16 * (task - 64); }
    else if (mode == 3) { const int sec = task >> 4, hd = task & 15; nt = 4;
        if (sec < 2) { b0 = 256 * (sec * 4 + (hd >> 2)) + 32 * (hd & 3); b1 = b0 + 16; b2 = b0 + 128; b3 = b0 + 144; }
        else { b0 = 2048 + 64 * hd; b1 = b0 + 16; b2 = b0 + 32; b3 = b0 + 48; } }
    else { b0 = 16 * task; }
    const int kw = K >> 3, ksteps = kw >> 5;
    const GAS bf16x8* ap = (const GAS bf16x8*)(A + (size_t)(MMAIN + fr) * K + wave * kw + 8 * fq);
    const GAS bf16x8* p0 = (const GAS bf16x8*)(Bt + (size_t)(b0 + fr) * K + wave * kw + 8 * fq);
    const GAS bf16x8* p1 = (const GAS bf16x8*)(Bt + (size_t)(b1 + fr) * K + wave * kw + 8 * fq);
    const GAS bf16x8* p2 = (const GAS bf16x8*)(Bt + (size_t)(b2 + fr) * K + wave * kw + 8 * fq);
    const GAS bf16x8* p3 = (const GAS bf16x8*)(Bt + (size_t)(b3 + fr) * K + wave * kw + 8 * fq);
    f32x4 c0 = {0.f, 0.f, 0.f, 0.f}, c1 = c0, c2 = c0, c3 = c0;
#pragma unroll 4
    for (int ks = 0; ks < ksteps; ++ks) {
        const bf16x8 xa = ap[4 * ks];
        c0 = __builtin_amdgcn_mfma_f32_16x16x32_bf16(p0[4 * ks], xa, c0, 0, 0, 0);
        if (nt >= 2) c1 = __builtin_amdgcn_mfma_f32_16x16x32_bf16(p1[4 * ks], xa, c1, 0, 0, 0);
        if (nt >= 4) { c2 = __builtin_amdgcn_mfma_f32_16x16x32_bf16(p2[4 * ks], xa, c2, 0, 0, 0); c3 = __builtin_amdgcn_mfma_f32_16x16x32_bf16(p3[4 * ks], xa, c3, 0, 0, 0); }
    }
    LAS f32x4* P = (LAS f32x4*)ldsl;
    P[(wave * 4 + 0) * 64 + lane] = c0; P[(wave * 4 + 1) * 64 + lane] = c1; P[(wave * 4 + 2) * 64 + lane] = c2; P[(wave * 4 + 3) * 64 + lane] = c3;
    __syncthreads();
    if (wave == 0) {
#pragma unroll
        for (int w = 1; w < 8; ++w) { c0 += P[(w * 4 + 0) * 64 + lane]; c1 += P[(w * 4 + 1) * 64 + lane]; c2 += P[(w * 4 + 2) * 64 + lane]; c3 += P[(w * 4 + 3) * 64 + lane]; }
        const size_t mrow = (size_t)(MMAIN + fr);
        if (mode != 4) {
            float t = 0.f;
#pragma unroll
            for (int i = 0; i < 16; ++i) { const f32x4 q4 = *(const GAS f32x4*)(SSQM + fr * 64 + 4 * i); t += (q4.x + q4.y) + (q4.z + q4.w); }
            const float rsm = __builtin_amdgcn_rsqf(t * (1.f / DM) + EPS); c0 *= rsm; c1 *= rsm; c2 *= rsm; c3 *= rsm;
        }
        if (mode <= 1 || (mode == 2 && task < 64)) {
            f32x4 r;
            if (mode == 0) {
#pragma unroll
                for (int i = 0; i < 4; ++i) r[i] = c0[i] * pg8::sigm(c0[i]) * c1[i];
            } else if (mode == 1) {
#pragma unroll
                for (int i = 0; i < 4; ++i) r[i] = c0[i] * pg8::sigm(c1[i]);
            } else r = c0 * c1;
            *(GAS v2u*)(R0 + mrow * (mode == 0 ? FF : 1024) + 16 * task + 4 * fq) = (v2u){pk2(r[0], r[1]), pk2(r[2], r[3])};
        } else if (mode == 2) {
            *(GAS v2u*)(R1 + mrow * 1024 + 16 * (task - 64) + 4 * fq) = (v2u){pk2(c0[0], c0[1]), pk2(c0[2], c0[3])};
        } else if (mode == 3) {
            const int sec = task >> 4, hd = task & 15;
            f32x4 v0 = c0, v1 = c1, v2 = c2, v3 = c3;
            if (sec < 2) {
                float ss = (c0[0] * c0[0] + c0[1] * c0[1]) + (c0[2] * c0[2] + c0[3] * c0[3]) + (c1[0] * c1[0] + c1[1] * c1[1]) + (c1[2] * c1[2] + c1[3] * c1[3])
                         + (c2[0] * c2[0] + c2[1] * c2[1]) + (c2[2] * c2[2] + c2[3] * c2[3]) + (c3[0] * c3[0] + c3[1] * c3[1]) + (c3[2] * c3[2] + c3[3] * c3[3]);
                ss += lane_get(ss, lane ^ 16); ss += lane_get(ss, lane ^ 32);
                const float rs = __builtin_amdgcn_rsqf(ss * (1.0f / 64.0f) + EPS) * ((sec == 0) ? pg8::QK_C2 : 1.0f);
                const float* g = (sec == 0) ? qg : kg;
                v0 = c0 * rs * *(const GAS f32x4*)(g + 4 * fq); v1 = c1 * rs * *(const GAS f32x4*)(g + 16 + 4 * fq); v2 = c2 * rs * *(const GAS f32x4*)(g + 32 + 4 * fq); v3 = c3 * rs * *(const GAS f32x4*)(g + 48 + 4 * fq);
            }
            const v2u w0 = {pk2(v0[0], v0[1]), pk2(v0[2], v0[3])}, w1 = {pk2(v1[0], v1[1]), pk2(v1[2], v1[3])}, w2 = {pk2(v2[0], v2[1]), pk2(v2[2], v2[3])}, w3 = {pk2(v3[0], v3[1]), pk2(v3[2], v3[3])};
            const int col = 64 * hd + 4 * fq;
            if (sec == 0) { bf16* q = R0 + mrow * 1024 + col; *(GAS v2u*)q = w0; *(GAS v2u*)(q + 16) = w1; *(GAS v2u*)(q + 32) = w2; *(GAS v2u*)(q + 48) = w3; }
            else { bf16* T = (sec == 1) ? R1 : R2;
#pragma unroll
                for (int b = 0; b < 2; ++b) { bf16* q = T + (size_t)(b * KVROWS + 48 + fr) * 1024 + col; *(GAS v2u*)q = w0; *(GAS v2u*)(q + 16) = w1; *(GAS v2u*)(q + 32) = w2; *(GAS v2u*)(q + 48) = w3; } }
        } else {
            GAS f32x4* p = (GAS f32x4*)(hmeta + (size_t)fr * 1024 + 16 * task + 4 * fq);
            const f32x4 hn = *p + c0 * scale; *p = hn;
            *(GAS v2u*)(HB + mrow * 1024 + 16 * task + 4 * fq) = (v2u){pk2(hn[0], hn[1]), pk2(hn[2], hn[3])};
            float ps = (hn[0] * hn[0] + hn[1] * hn[1]) + (hn[2] * hn[2] + hn[3] * hn[3]); ps += lane_get(ps, lane ^ 16); ps += lane_get(ps, lane ^ 32);
            if (fq == 0) SSQM[fr * 64 + task] = ps;
        }
    }
    __syncthreads();
}

__global__ void __launch_bounds__(NWAVES * 64, 2) fwd_megakernel(Args a) {
    extern __shared__ __attribute__((aligned(16))) unsigned char lds[];
    cg::grid_group grid = cg::this_grid();
    const int G = gridDim.x, bx = blockIdx.x;
    const int vcu0 = (G % 8 == 0) ? (bx % 8) * (G / 8) + bx / 8 : bx;
    const int NGW = G * NWAVES;
    if (threadIdx.x < 64) ((LAS unsigned*)((LAS unsigned char*)lds + RING_BYTES))[threadIdx.x * 2] = 0u, ((LAS unsigned*)((LAS unsigned char*)lds + RING_BYTES))[threadIdx.x * 2 + 1] = 0u;
    __syncthreads();
    const int wave_s = __builtin_amdgcn_readfirstlane((int)threadIdx.x >> 6);
#define PHASE_ENV() \
    unsigned zero_ = 0u; asm volatile("" : "+s"(zero_)); int vcu = vcu0; asm volatile("" : "+s"(vcu)); \
    int tid = (wave_s << 6) | (int)__builtin_amdgcn_mbcnt_hi(~0u, __builtin_amdgcn_mbcnt_lo(~0u, zero_)); \
    const int lane = tid & 63, wave = __builtin_amdgcn_readfirstlane(tid >> 6), gw = vcu * NWAVES + wave; \
    unsigned char* ws0_ = a.ws; asm volatile("" : "+s"(ws0_)); unsigned char* const ws = (unsigned char*)(GAS unsigned char*)ws0_;     \
    float* hm0_ = a.out; asm volatile("" : "+s"(hm0_)); float* const hmain = (float*)(GAS float*)hm0_; \
    bf16* const WGU = (bf16*)(ws + WS_WGU); bf16* const WDN = (bf16*)(ws + WS_WDN); \
    bf16* const WAI = (bf16*)(ws + WS_WAI); bf16* const WAO = (bf16*)(ws + WS_WAO); bf16* const WBI = (bf16*)(ws + WS_WBI); bf16* const WBO = (bf16*)(ws + WS_WBO); \
    bf16* const WCI = (bf16*)(ws + WS_WCI); bf16* const WCO = (bf16*)(ws + WS_WCO); bf16* const WFt = (bf16*)(ws + WS_WF); \
    bf16* const XN = (bf16*)(ws + WS_XN); \
    bf16* const R0 = (bf16*)(ws + WS_ACT); bf16* const R1 = (bf16*)(ws + WS_ACT + SZ_ROWBUF); bf16* const R2 = (bf16*)(ws + WS_ACT + 2 * SZ_ROWBUF); \
    float* const hmeta = (float*)(ws + WS_HMETA); \
    float* const LF = (float*)(ws + WS_LF); float* const LFM = (float*)(ws + WS_LFM); float* const CS = (float*)(ws + WS_CS); \
    float* const SSQ = (float*)(ws + WS_SSQ); float* const SSQM = (float*)(ws + WS_SSQM); (void)SSQ; (void)SSQM; \
    LAS unsigned char* const ldsl = (LAS unsigned char*)lds; \
    (void)WGU; (void)WDN; (void)WAI; (void)WAO; (void)WBI; (void)WBO; (void)WCI; (void)WCO; (void)WFt; (void)XN; (void)R0; (void)R1; (void)R2; (void)hmeta; (void)LF; (void)LFM; (void)CS; (void)ldsl; (void)lane; (void)gw; (void)hmain;

    {
        PHASE_ENV();
        LAS float* scr = (LAS float*)(ldsl + wave * 16384);
        constexpr int I_GU = 176 * 16, I_DN = 32 * 44, I_AI = 96 * 16, I_SQ = 32 * 16, I_BI = 64 * 16, I_CI = 96 * 16;
        constexpr int NITEMS = 8 * I_GU + 8 * I_DN + 2 * I_AI + 2 * I_SQ + I_BI + I_SQ + I_CI + I_SQ;
        for (int it = gw; it < NITEMS; it += NGW) {
            int r = it;
            if (r < 8 * I_GU) { const int mat = r / I_GU; r %= I_GU; const int kb = r / 176, nb = r % 176, pn = nb >> 3, q = nb & 7;
                const float* src = ((q < 4) ? a.ffn_w_gate : a.ffn_w_up) + (size_t)mat * 1024 * FF + 128 * pn + 32 * (q & 3);
                transpose_item(src, FF, WGU + (size_t)mat * 5632 * 1024 + (size_t)nb * 32 * 1024, 1024, kb, scr, lane, a.ffn_norm + (size_t)mat * DM); continue; }
            r -= 8 * I_GU;
            if (r < 8 * I_DN) { const int mat = r / I_DN; r %= I_DN; const int kb = r / 32, nb = r % 32;
                transpose_item(a.ffn_w_down + (size_t)mat * FF * 1024 + 32 * nb, 1024, WDN + (size_t)mat * 1024 * FF + (size_t)nb * 32 * FF, FF, kb, scr, lane); continue; }
            r -= 8 * I_DN;
            if (r < 2 * I_AI) { const int mat = r / I_AI; r %= I_AI; const int kb = r / 96, nb = r % 96, pn = nb >> 3, q = nb & 7;
                const int scol = (pn < 8) ? ((q < 4) ? 1024 + 128 * pn + 32 * q : 2048 + 128 * pn + 32 * (q - 4)) : (nb - 64) * 32;
                transpose_item(a.a_w_in + (size_t)mat * 1024 * 3072 + scol, 3072, WAI + (size_t)mat * 3072 * 1024 + (size_t)nb * 32 * 1024, 1024, kb, scr, lane, a.mix_norm + (size_t)(3 * mat) * DM); continue; }
            r -= 2 * I_AI;
            if (r < 2 * I_SQ) { const int mat = r / I_SQ; r %= I_SQ; const int kb = r / 32, nb = r % 32;
                transpose_item(a.a_w_out + (size_t)mat * 1024 * 1024 + 32 * nb, 1024, WAO + (size_t)mat * 1024 * 1024 + (size_t)nb * 32 * 1024, 1024, kb, scr, lane); continue; }
            r -= 2 * I_SQ;
            if (r < I_BI) { const int kb = r / 64, nb = r % 64, pn = nb >> 3, q = nb & 7;
                const int scol = (q < 4) ? 128 * pn + 32 * q : 1024 + 128 * pn + 32 * (q - 4);
                transpose_item(a.b_w_in + scol, 2048, WBI + (size_t)nb * 32 * 1024, 1024, kb, scr, lane, a.mix_norm + (size_t)1 * DM); continue; }
            r -= I_BI;
            if (r < I_SQ) { const int kb = r / 32, nb = r % 32;
                transpose_item(a.b_w_out + 32 * nb, 1024, WBO + (size_t)nb * 32 * 1024, 1024, kb, scr, lane); continue; }
            r -= I_SQ;
            if (r < I_CI) { const int kb = r / 96, nb = r % 96, pn = nb >> 3, q = nb & 7;
                const int scol = (pn < 8) ? (pn >> 2) * 1024 + 64 * (4 * (pn & 3) + (q & 3)) + 32 * (q >> 2) : 2048 + (nb - 64) * 32;
                transpose_item(a.c_w_in + scol, 3088, WCI + (size_t)nb * 32 * 1024, 1024, kb, scr, lane, a.mix_norm + (size_t)2 * DM); continue; }
            r -= I_CI;
            { const int kb = r / 32, nb = r % 32;
                transpose_item(a.c_w_out + 32 * nb, 1024, WCO + (size_t)nb * 32 * 1024, 1024, kb, scr, lane); }
        }
        for (int i = gw * 64 + lane; i < 16 * 1024; i += NGW * 64) { const int h = i >> 10, k = i & 1023; WFt[i] = (bf16)f2bf(a.c_w_in[(size_t)k * 3088 + 3072 + h] * a.mix_norm[2 * DM + k]); }
        for (int m = gw; m < MROWS; m += NGW) {
            const float* src = (m < MMAIN) ? a.x + (size_t)m * DM : a.meta + (size_t)(m - MMAIN) * DM;
            float* hc = (m < MMAIN) ? hmain + (size_t)m * DM : hmeta + (size_t)(m - MMAIN) * DM;
            const float ss = hb_row(src, XN + (size_t)m * DM, hc, lane);
            if (m < MMAIN) { if (lane < 4) SSQ[(size_t)m * 4 + lane] = (lane == 0) ? ss : 0.f; } else SSQM[(m - MMAIN) * 64 + lane] = (lane == 0) ? ss : 0.f;
        }
    }
    grid.sync();
    XcdBarrier bar;
    { PHASE_ENV(); bar = xcd_barrier_post((unsigned*)(ws + WS_CTL), (volatile LAS unsigned*)(ldsl + MISC_OFF) + 8, tid); }

    for (int L = 0; L < DEPTH; ++L) {
        const int mx = L % 3, mj = L / 3;
        for (int s = 0; s <= 10; ++s) {
            if ((s == 6 && mx != 2) || s == 0 || s == 3 || s == 8) continue;
            PHASE_ENV();
            if (s == 0 || s == 3 || s == 8) {
                continue;
            } else if (s == 1 || s == 2 || s == 4 || s == 7 || s == 9 || s == 10) {
                pg8::Gemm g; pg8::EpiAll E;
                E.mtiles_main = 64; E.O1 = R0; E.O2 = R1; E.O3 = R2; E.ldo = 1024; E.hmain = hmain; E.hmeta = hmeta; E.scale = 1.f; E.qg = a.c_q_norm; E.kg = a.c_k_norm; E.mode = 0;
                E.ssq = SSQ; E.ssq_out = SSQ; E.hb = XN; E.ldsp = (LAS float*)(ldsl + RING_BYTES + 1024);
                g.M = MMAIN;
                if (s == 1 || s == 9) { g.A = XN; g.Bt = WGU + (size_t)(L * 2 + (s == 9)) * 5632 * 1024; g.N = 5632; g.K = 1024; E.mode = 0; E.ldo = FF; }
                else if (s == 2 || s == 10) { g.A = R0; g.Bt = WDN + (size_t)(L * 2 + (s == 10)) * 1024 * FF; g.N = 1024; g.K = FF; E.mode = 4; E.scale = 0.5f; }
                else if (s == 4) {
                    g.A = XN; g.K = 1024;
                    if (mx == 0) { g.Bt = WAI + (size_t)mj * 3072 * 1024; g.N = 3072; E.mode = 2; }
                    else if (mx == 1) { g.Bt = WBI; g.N = 2048; E.mode = 1; }
                    else { g.Bt = WCI; g.N = 3072; E.mode = 3;
                    for (int i = gw; i < 2 * 2 * 112; i += NGW) { const int tsel = i / 224, rr = i % 224, b = rr / 112, j = rr % 112; const int row = b * KVROWS + (j < 48 ? j : j + 16);
                        bf16* p = (tsel ? R2 : R1) + (size_t)row * 1024; ((GAS v4u*)p)[lane * 2] = (v4u){zero_, zero_, zero_, zero_}; ((GAS v4u*)p)[lane * 2 + 1] = (v4u){zero_, zero_, zero_, zero_}; }
                        const int fr = lane & 15, fq = lane >> 4;
                        for (int grp = gw; grp < MROWS / 16; grp += NGW) {
                            const bf16* xp = XN + (size_t)(16 * grp + fr) * DM + 8 * fq; const bf16* wp = WFt + (size_t)fr * DM + 8 * fq;
                            f32x4 acc = {0.f, 0.f, 0.f, 0.f};
#pragma unroll 8
                            for (int k = 0; k < 32; ++k) { const bf16x8 xa = *(const GAS bf16x8*)(xp + 32 * k), wb = *(const GAS bf16x8*)(wp + 32 * k);
                                acc = __builtin_amdgcn_mfma_f32_16x16x32_bf16(xa, wb, acc, 0, 0, 0); }
                            const float bf = a.c_b_f[fr]; f32x4 o; float rsr[4];
                            if (grp < MMAIN / 16) {
#pragma unroll
                                for (int r = 0; r < 4; ++r) { const f32x4 q4 = *(const GAS f32x4*)(SSQ + (size_t)(16 * grp + 4 * fq + r) * 4); rsr[r] = __builtin_amdgcn_rsqf(((q4.x + q4.y) + (q4.z + q4.w)) * (1.f / DM) + EPS); }
                            } else {
#pragma unroll
                                for (int r = 0; r < 4; ++r) { float t = 0.f; for (int i = 0; i < 16; ++i) { const f32x4 q4 = *(const GAS f32x4*)(SSQM + (4 * fq + r) * 64 + 4 * i); t += (q4.x + q4.y) + (q4.z + q4.w); } rsr[r] = __builtin_amdgcn_rsqf(t * (1.f / DM) + EPS); }
                            }
#pragma unroll
                            for (int r = 0; r < 4; ++r) { const float xv = acc[r] * rsr[r] + bf; o[r] = fminf(xv, 0.f) - log1pf(expf(-fabsf(xv))); }
                            if (grp < MMAIN / 16) { const int r0 = 16 * grp, b = r0 >> 13, t0 = r0 & 8191; *(GAS f32x4*)(LF + ((size_t)(b * NH + fr) * SEQ + t0 + 4 * fq)) = o; }
                            else *(GAS f32x4*)(LFM + fr * 16 + 4 * fq) = o;
                        }
                        asm volatile("s_waitcnt vmcnt(0) lgkmcnt(0)" ::: "memory"); __syncthreads();
                    }
                }
                else { g.K = 1024; g.N = 1024; E.mode = 4; E.scale = 1.f;
                    if (mx == 0) { g.A = R2; g.Bt = WAO + (size_t)mj * 1024 * 1024; } else if (mx == 1) { g.A = R1; g.Bt = WBO; } else { g.A = R0; g.Bt = WCO; } }
                thin_gemm(ldsl, tid, vcu, g.A, g.Bt, g.K, E.mode, R0, R1, R2, hmeta, E.scale, a.c_q_norm, a.c_k_norm, SSQM, XN);
                pg8::StaticOrder S; S.init(g.M, g.N, G, bx);
#ifndef NO_GEMM
                pg8::gemm_phase<pg8::EpiAll, pg8::StaticOrder, PG8_ALIGN, PG8_SP2>(ldsl, g, S, E, tid);
#endif
                if (E.mode == 4) {
                    pg8::Unit u0; if (S.next(0, u0) && tid < 256) { const f32x4 p4 = *(const LAS f32x4*)(E.ldsp + tid * 4); SSQ[(size_t)(u0.pm * 256 + tid) * 4 + u0.pn] = (p4.x + p4.y) + (p4.z + p4.w); }
                }
            } else if (s == 5) {
                if (mx == 0) {
                    const float* cw = a.a_conv + (size_t)mj * 3 * DM + 16 * lane;
                    f32x4 w0[4], w1[4], w2[4];
#pragma unroll
                    for (int j = 0; j < 4; ++j) { w0[j] = *(const f32x4*)(cw + 4 * j); w1[j] = *(const f32x4*)(cw + DM + 4 * j); w2[j] = *(const f32x4*)(cw + 2 * DM + 4 * j); }
                    for (int r = gw; r < MROWS; r += NGW) {
                        int r1, r2;
                        if (r < MMAIN) { const int t = r & 8191; r1 = (t >= 1) ? r - 1 : MMAIN + 15; r2 = (t >= 2) ? r - 2 : MMAIN + 14 + t; }
                        else { const int p = r - MMAIN; r1 = (p >= 1) ? r - 1 : -1; r2 = (p >= 2) ? r - 2 : -1; }
                        const v4u z4 = {0u, 0u, 0u, 0u};
                        const GAS v4u* c0p = (const GAS v4u*)(R0 + (size_t)r * DM) + 2 * lane; const GAS v4u* bp = (const GAS v4u*)(R1 + (size_t)r * DM) + 2 * lane;
                        v4u x0[2], x1[2], x2[2], bb[2];
#pragma unroll
                        for (int hh = 0; hh < 2; ++hh) { x0[hh] = c0p[hh]; bb[hh] = bp[hh];
                            x1[hh] = (r1 >= 0) ? ((const GAS v4u*)(R0 + (size_t)r1 * DM) + 2 * lane)[hh] : z4; x2[hh] = (r2 >= 0) ? ((const GAS v4u*)(R0 + (size_t)r2 * DM) + 2 * lane)[hh] : z4; }
                        GAS v4u* yp = (GAS v4u*)(R2 + (size_t)r * DM) + 2 * lane;
#pragma unroll
                        for (int hh = 0; hh < 2; ++hh) { v4u o;
#pragma unroll
                            for (int e = 0; e < 4; ++e) { const int j = 2 * hh + (e >> 1), c = 2 * (e & 1);
                                const float lo = bflo(bb[hh][e]) * (w2[j][c] * bflo(x0[hh][e]) + w1[j][c] * bflo(x1[hh][e]) + w0[j][c] * bflo(x2[hh][e]));
                                const float hi = bfhi(bb[hh][e]) * (w2[j][c + 1] * bfhi(x0[hh][e]) + w1[j][c + 1] * bfhi(x1[hh][e]) + w0[j][c + 1] * bfhi(x2[hh][e]));
                                o[e] = pk2(lo, hi); }
                            yp[hh] = o; }
                    }
                } else if (mx == 1) {
#ifndef NO_CONF
                    const int c = 2 * tid;
                    f32x2 w[31];
#pragma unroll
                    for (int k = 0; k < 31; ++k) w[k] = *(const GAS f32x2*)(a.b_conv + (size_t)k * DM + c);
                    const f32x2 cb = *(const f32x2*)(a.b_conv_bias + c), lg = *(const f32x2*)(a.b_ln_g + c), lb = *(const f32x2*)(a.b_ln_b + c);
                    LAS float* red = (LAS float*)ldsl;
                    LAS float* red2 = red + 256;
                    for (int un = vcu; un < MROWS / 16; un += G) {
                        const int r0 = 16 * un; const bool meta = (r0 >= MMAIN);
                        const int p0 = meta ? 0 : 16 + (r0 & 8191); const int rowb = meta ? 0 : (r0 >> 13) * SEQ;
                        unsigned xin[46];
#pragma unroll
                        for (int j = 0; j < 46; ++j) { const int pj = p0 - 30 + j;
                            xin[j] = (pj >= 0) ? *(const GAS unsigned*)(R0 + (size_t)((pj < 16) ? MMAIN + pj : rowb + pj - 16) * DM + c) : 0u; }
                        f32x2 acc[16];
#pragma unroll
                        for (int i = 0; i < 16; ++i) acc[i] = cb;
#pragma unroll
                        for (int j = 0; j < 46; ++j) { const f32x2 xv = {bflo(xin[j]), bfhi(xin[j])};
#pragma unroll
                            for (int i = 0; i < 16; ++i) { const int k = j - i; if (k >= 0 && k <= 30) acc[i] += w[k] * xv; } }
                        float st[32];
#pragma unroll
                        for (int i = 0; i < 16; ++i) { st[2 * i] = acc[i].x + acc[i].y; st[2 * i + 1] = acc[i].x * acc[i].x + acc[i].y * acc[i].y; }
#pragma unroll
                        for (int i = 0; i < 32; ++i) st[i] = wave_sum(st[i], lane);
                        if (lane == 0) {
#pragma unroll
                            for (int i = 0; i < 8; ++i) *(LAS f32x4*)(red + wave * 32 + 4 * i) = (f32x4){st[4 * i], st[4 * i + 1], st[4 * i + 2], st[4 * i + 3]}; }
                        __syncthreads();
                        if (tid < 32) { float t = 0.f;
#pragma unroll
                            for (int wv = 0; wv < 8; ++wv) t += red[wv * 32 + tid];
                            red2[tid] = t; }
                        __syncthreads();
#pragma unroll
                        for (int i = 0; i < 16; ++i) { const f32x2 sv = *(const LAS f32x2*)(red2 + 2 * i);
                            const float mu = sv.x * (1.f / DM), var = fmaxf(sv.y * (1.f / DM) - mu * mu, 0.f), rs = 1.0f / sqrtf(var + EPS);
                            const float y0 = (acc[i].x - mu) * rs * lg.x + lb.x, y1 = (acc[i].y - mu) * rs * lg.y + lb.y;
                            *(GAS unsigned*)(R1 + (size_t)(r0 + i) * DM + c) = pk2(y0 * pg8::sigm(y0), y1 * pg8::sigm(y1)); }
                    }
#endif
                } else {
                    if (vcu < 32) {
                        const int bh = vcu, h = bh & 15; LAS float* wt = (LAS float*)ldsl;
                        float* csrow = CS + (size_t)bh * KVROWS;
                        float cm = 0.f, cmp = 0.f;
#pragma unroll
                        for (int j = 0; j < 16; ++j) { cm += LFM[h * 16 + j]; if (j == tid) cmp = cm; }
                        const float* lp = LF + (size_t)bh * SEQ + 16 * tid; float v[16];
#pragma unroll
                        for (int j = 0; j < 4; ++j) { const f32x4 q = *(const GAS f32x4*)(lp + 4 * j); v[4 * j] = q.x; v[4 * j + 1] = q.y; v[4 * j + 2] = q.z; v[4 * j + 3] = q.w; }
#pragma unroll
                        for (int j = 1; j < 16; ++j) v[j] += v[j - 1];
                        float inc = v[15];
#pragma unroll
                        for (int o = 1; o < 64; o <<= 1) { const float t = lane_get(inc, (lane - o) & 63); if (lane >= o) inc += t; }
                        if (lane == 63) wt[wave] = inc;
                        __syncthreads();
                        float off = cm + inc - v[15];
                        for (int wv = 0; wv < wave; ++wv) off += wt[wv];
#pragma unroll
                        for (int j = 0; j < 4; ++j) *(GAS f32x4*)(csrow + 128 + 16 * tid + 4 * j) = (f32x4){(off + v[4 * j]) * LOG2E, (off + v[4 * j + 1]) * LOG2E, (off + v[4 * j + 2]) * LOG2E, (off + v[4 * j + 3]) * LOG2E};
                        const float cmsh = lane_get(cmp, (lane + 16) & 63);
                        if (tid < 128) csrow[tid] = (tid >= 48 && tid < 64) ? cmsh * LOG2E : __builtin_inff();
                        __syncthreads();
                    }
                }
            } else if (s == 6) {
                const attn_body::AttnTensors AT{(const attn_body::bf16*)R0, (const attn_body::bf16*)R1, (const attn_body::bf16*)R2, (attn_body::bf16*)R0, CS};
                const attn_body::StaticOrder S(G, bx);
#ifndef NO_ATTN
                attn_body::attn_phase<attn_body::StaticOrder>((char*)lds, AT, S, tid);
#endif
                if (gw < NH) {
                    const int h = gw, q = lane & 15, dc = lane >> 4;
                    const bf16* qp = R0 + (size_t)(MMAIN + q) * DM + 64 * h + 16 * dc;
                    const v4u qa = ((const GAS v4u*)qp)[0], qb = ((const GAS v4u*)qp)[1];
                    float qv[16];
#pragma unroll
                    for (int e = 0; e < 4; ++e) { qv[2 * e] = bflo(qa[e]); qv[2 * e + 1] = bfhi(qa[e]); qv[8 + 2 * e] = bflo(qb[e]); qv[8 + 2 * e + 1] = bfhi(qb[e]); }
                    float mrun = -__builtin_inff(), l = 0.f, o[16];
#pragma unroll
                    for (int e = 0; e < 16; ++e) o[e] = 0.f;
                    for (int j = 0; j < 16; ++j) {
                        const bf16* kp = R1 + (size_t)(48 + j) * DM + 64 * h + 16 * dc; const bf16* vp = R2 + (size_t)(48 + j) * DM + 64 * h + 16 * dc;
                        const v4u ka = ((const GAS v4u*)kp)[0], kb = ((const GAS v4u*)kp)[1], va = ((const GAS v4u*)vp)[0], vb = ((const GAS v4u*)vp)[1];
                        float d = 0.f;
#pragma unroll
                        for (int e = 0; e < 4; ++e) d += qv[2 * e] * bflo(ka[e]) + qv[2 * e + 1] * bfhi(ka[e]) + qv[8 + 2 * e] * bflo(kb[e]) + qv[8 + 2 * e + 1] * bfhi(kb[e]);
                        d += lane_get(d, lane ^ 16); d += lane_get(d, lane ^ 32);
                        const float sc = d - *(const GAS float*)(CS + (size_t)h * KVROWS + 48 + j);
                        if (j <= q) { const float mn = fmaxf(mrun, sc), f = __builtin_amdgcn_exp2f(mrun - mn), p = __builtin_amdgcn_exp2f(sc - mn); l = l * f + p; mrun = mn;
#pragma unroll
                            for (int e = 0; e < 4; ++e) { o[2 * e] = o[2 * e] * f + p * bflo(va[e]); o[2 * e + 1] = o[2 * e + 1] * f + p * bfhi(va[e]); o[8 + 2 * e] = o[8 + 2 * e] * f + p * bflo(vb[e]); o[8 + 2 * e + 1] = o[8 + 2 * e + 1] * f + p * bfhi(vb[e]); } }
                    }
                    const float rl = 1.0f / l; v4u oa, ob;
#pragma unroll
                    for (int e = 0; e < 4; ++e) { oa[e] = pk2(o[2 * e] * rl, o[2 * e + 1] * rl); ob[e] = pk2(o[8 + 2 * e] * rl, o[8 + 2 * e + 1] * rl); }
                    GAS v4u* op = (GAS v4u*)(R0 + (size_t)(MMAIN + q) * DM + 64 * h + 16 * dc); op[0] = oa; op[1] = ob;
                }
            }
            xcd_barrier(bar, tid);
        }
    }
}

extern "C" void kernel_launch(void* const* d_in, const int* in_sizes, int n_in, void* d_out, int out_size, void* d_ws, size_t ws_size, hipStream_t stream) {
    static int grid = 0;
    if (grid == 0) {
        if (n_in != 21 || out_size != MMAIN * DM || ws_size < WS_END) { fprintf(stderr, "kernel_launch: unexpected shapes (n_in %d out %d ws %zu)\n", n_in, out_size, ws_size); grid = -1; return; }
        int dev = 0, cus = 0, per_cu = 0;
        hipGetDevice(&dev); hipDeviceGetAttribute(&cus, hipDeviceAttributeMultiprocessorCount, dev);
        if (hipFuncSetAttribute((const void*)fwd_megakernel, hipFuncAttributeMaxDynamicSharedMemorySize, LDS_BYTES) != hipSuccess) { fprintf(stderr, "kernel_launch: hipFuncSetAttribute failed\n"); grid = -1; return; }
        if (hipOccupancyMaxActiveBlocksPerMultiprocessor(&per_cu, (const void*)fwd_megakernel, NWAVES * 64, LDS_BYTES) != hipSuccess || per_cu < 1) { fprintf(stderr, "kernel_launch: occupancy query says %d\n", per_cu); per_cu = 1; }
        (void)hipGetLastError();
        grid = cus * 1;
        if (grid != 256) fprintf(stderr, "kernel_launch: grid %d (expected 256)\n", grid);
    }
    if (grid < 0) return;
    if (hipMemsetAsync((char*)d_ws + WS_CTL, 0, CTL_ZERO_BYTES, stream) != hipSuccess) { fprintf(stderr, "kernel_launch: hipMemsetAsync failed\n"); return; }
    Args a{};
    const float** f = (const float**)&a;
    for (int i = 0; i < 21; ++i) f[i] = (const float*)d_in[i];
    a.out = (float*)d_out; a.ws = (unsigned char*)d_ws;
    void* args[] = {&a};
    hipError_t e = hipLaunchCooperativeKernel((const void*)fwd_megakernel, dim3(grid), dim3(NWAVES * 64), args, LDS_BYTES, stream);
    if (e != hipSuccess) fprintf(stderr, "cooperative launch failed: %s (grid %d)\n", hipGetErrorString(e), grid);
}
```

```cpp
#include <hip/hip_runtime.h>
#include <hip/hip_cooperative_groups.h>
#include <cstdio>
#include <cstdint>
namespace pg8 {
#define PG8_LAS __attribute__((address_space(3)))
typedef unsigned short bf16_t;
typedef short bf16x8 __attribute__((ext_vector_type(8)));
typedef float f32x4 __attribute__((ext_vector_type(4)));
typedef unsigned u32x4 __attribute__((ext_vector_type(4)));
constexpr int BM = 256, BK = 64, HALF = 128, HTB = HALF * BK * 2  , STAGE_BYTES = 8 * HTB, NXCD = 8, WGM = 8;

__host__ __device__ __forceinline__ int lds_byte(int r, int c) { const int st = (r >> 4) * 2 + (c >> 5), rr = r & 15, cc = c & 31, ob = rr * 64 + cc * 2; return st * 1024 + (ob ^ (((ob >> 9) & 1) << 5)); }
__host__ __device__ __forceinline__ void stage_rc(int b, int& R, int& C) { const int st = b / 1024, sb = b % 1024, swz = sb ^ (((sb >> 9) & 1) << 5); R = (st >> 1) * 16 + swz / 64; C = (st & 1) * 32 + (swz % 64) / 2; }
__host__ __device__ __forceinline__ int perm32(int rho) { const int n = rho >> 4, i = rho & 15; return 8 * (i >> 2) + 4 * n + (i & 3); }

struct Unit { int pm, pn; };
struct Gemm { const bf16_t* A; const bf16_t* Bt; int M, N, K; };

struct StaticOrder {
    int nM, nN, nwg, G, c;
    __host__ __device__ void init(int M, int N, int G_, int c_) { nM = M / BM; nN = N / BM; nwg = nM * nN; G = G_; c = c_; }
    __host__ __device__ bool next(int i, Unit& u) const {
        const long L = (long)i * G + c; if (L >= nwg) return false;
        int wgid = (int)L; { const int q = nwg / NXCD, r = nwg % NXCD, xcd = wgid % NXCD, off = wgid / NXCD; wgid = (xcd < r ? xcd * (q + 1) : r * (q + 1) + (xcd - r) * q) + off; }
        const int nig = WGM * nN, gid = wgid / nig, fm = gid * WGM, gsz = (nM - fm) < WGM ? (nM - fm) : WGM;
        u.pm = fm + ((wgid % nig) % gsz); u.pn = (wgid % nig) / gsz; return true;
    }
    __device__ __forceinline__ void a_ready(const Unit&) const {}
    __device__ __forceinline__ void done(const Unit&) const {}
};

__device__ __forceinline__ unsigned cvt_pk_bf16(float lo, float hi) { unsigned r; asm volatile("v_cvt_pk_bf16_f32 %0, %1, %2" : "=v"(r) : "v"(lo), "v"(hi)); return r; }
typedef float f32x2 __attribute__((ext_vector_type(2)));
__device__ __forceinline__ float sigm(float x) { return __builtin_amdgcn_rcpf(1.0f + __builtin_amdgcn_exp2f(-1.4426950408889634f * x)); }
constexpr float QK_C2 = 0.125f * 1.4426950408889634f;
#define PG8_GAS __attribute__((address_space(1)))
struct EpiAll {
    static constexpr bool PERM = true, AFTER_DRAIN = false;
    int mode;
    int mtiles_main;
    bf16_t* O1; bf16_t* O2; bf16_t* O3; int ldo;
    float* hmain; float* hmeta; float scale;
    const float* qg; const float* kg;
    const PG8_LAS float* rsl;
    const float* ssq;
    float* ssq_out; bf16_t* hb; float* fout; PG8_LAS float* ldsp;
    __device__ __forceinline__ void operator()(const f32x4 (&acc)[2][2][4][2], const Unit& u, int wr, int wc, int fr, int fq, int ui) const {
        const int rloc_ = wr * 64 + fr;
#define EPI_LAUNDER() int rloc = rloc_; asm volatile("" : "+v"(rloc))
#define EPI_RS() float rsv[2][4]; { const PG8_LAS float* sp_ = rsl + ui * 256 + rloc;     \
    _Pragma("unroll") for (int ai = 0; ai < 2; ++ai) _Pragma("unroll") for (int m = 0; m < 4; ++m) rsv[ai][m] = sp_[ai * HALF + m * 16]; }
        if (mode <= 1 || (mode == 2 && u.pn < 8)) {
            EPI_LAUNDER(); EPI_RS();
            bf16_t* base = O1 + (size_t)(u.pm * BM + rloc) * ldo + u.pn * HALF + wc * 32 + 8 * fq;
#pragma unroll
            for (int ai = 0; ai < 2; ++ai)
#pragma unroll
                for (int m = 0; m < 4; ++m) {
                    const float rs_ = rsv[ai][m]; const f32x4 a0 = acc[ai][0][m][0] * rs_, a1 = acc[ai][0][m][1] * rs_, b0 = acc[ai][1][m][0] * rs_, b1 = acc[ai][1][m][1] * rs_;
                    f32x4 r0, r1;
                    if (mode == 0) {
#pragma unroll
                        for (int i = 0; i < 4; ++i) { r0[i] = a0[i] * sigm(a0[i]) * b0[i]; r1[i] = a1[i] * sigm(a1[i]) * b1[i]; }
                    } else if (mode == 1) {
#pragma unroll
                        for (int i = 0; i < 4; ++i) { r0[i] = a0[i] * sigm(b0[i]); r1[i] = a1[i] * sigm(b1[i]); }
                    } else { r0 = a0 * b0; r1 = a1 * b1; }
                    u32x4 w; w.x = cvt_pk_bf16(r0[0], r0[1]); w.y = cvt_pk_bf16(r0[2], r0[3]); w.z = cvt_pk_bf16(r1[0], r1[1]); w.w = cvt_pk_bf16(r1[2], r1[3]);
                    __builtin_nontemporal_store(w, (PG8_GAS u32x4*)(base + (size_t)(ai * HALF + m * 16) * ldo));
                }
        } else if (mode == 2) {
            EPI_LAUNDER(); EPI_RS();
            bf16_t* base = O2 + (size_t)(u.pm * BM + rloc) * 1024 + (u.pn - 8) * BM + wc * 32 + 8 * fq;
#pragma unroll
            for (int ai = 0; ai < 2; ++ai)
#pragma unroll
                for (int m = 0; m < 4; ++m)
#pragma unroll
                    for (int bj = 0; bj < 2; ++bj) {
                        const f32x4 v0 = acc[ai][bj][m][0] * rsv[ai][m], v1 = acc[ai][bj][m][1] * rsv[ai][m];
                        u32x4 w; w.x = cvt_pk_bf16(v0[0], v0[1]); w.y = cvt_pk_bf16(v0[2], v0[3]); w.z = cvt_pk_bf16(v1[0], v1[1]); w.w = cvt_pk_bf16(v1[2], v1[3]);
                        __builtin_nontemporal_store(w, (PG8_GAS u32x4*)(base + (size_t)(ai * HALF + m * 16) * 1024 + bj * HALF));
                    }
        } else if (mode == 3) {
            EPI_LAUNDER(); EPI_RS();
            const int sec = u.pn >> 2;
            const bool meta = false;
            const long krow0 = meta ? 48 : (long)u.pm * BM + 128 * (1 + (u.pm >> 5));
            bf16_t* dst = (sec == 0) ? O1 + (size_t)(u.pm * BM) * 1024 : ((sec == 1) ? O2 : O3) + (size_t)krow0 * 1024;
            const bool dup = meta && sec != 0; const int rlim = dup ? 16 : 256;
            if (sec < 2) {
                const int head = 4 * (u.pn & 3) + wc;
                const int lxor16 = (fr + 16 * (fq ^ 1)) << 2, lxor32 = (fr + 16 * (fq ^ 2)) << 2;
                const float* g = (sec == 0) ? qg : kg; const float gs = (sec == 0) ? QK_C2 : 1.0f;
                f32x4 gv[2][2];
#pragma unroll
                for (int bj = 0; bj < 2; ++bj)
#pragma unroll
                    for (int n = 0; n < 2; ++n) gv[bj][n] = *(const PG8_GAS f32x4*)(g + 32 * bj + 8 * fq + 4 * n) * gs;
#pragma unroll
                for (int ai = 0; ai < 2; ++ai)
#pragma unroll
                    for (int m = 0; m < 4; ++m) {
                        float ss = 0.f;
#pragma unroll
                        for (int bj = 0; bj < 2; ++bj)
#pragma unroll
                            for (int n = 0; n < 2; ++n) { const f32x4 x = acc[ai][bj][m][n] * rsv[ai][m]; ss += (x[0] * x[0] + x[1] * x[1]) + (x[2] * x[2] + x[3] * x[3]); }
                        ss += __builtin_bit_cast(float, __builtin_amdgcn_ds_bpermute(lxor16, __builtin_bit_cast(int, ss))); ss += __builtin_bit_cast(float, __builtin_amdgcn_ds_bpermute(lxor32, __builtin_bit_cast(int, ss)));
                        const float rs = __builtin_amdgcn_rsqf(ss * (1.0f / 64.0f) + 1e-6f) * rsv[ai][m];
                        const int rl = rloc + ai * HALF + m * 16;
#pragma unroll
                        for (int bj = 0; bj < 2; ++bj) {
                            const f32x4 v0 = acc[ai][bj][m][0] * rs * gv[bj][0], v1 = acc[ai][bj][m][1] * rs * gv[bj][1];
                            u32x4 w; w.x = cvt_pk_bf16(v0[0], v0[1]); w.y = cvt_pk_bf16(v0[2], v0[3]); w.z = cvt_pk_bf16(v1[0], v1[1]); w.w = cvt_pk_bf16(v1[2], v1[3]);
                            const int col = 64 * head + 32 * bj + 8 * fq;
                            if (rl < rlim) { __builtin_nontemporal_store(w, (PG8_GAS u32x4*)(dst + (size_t)rl * 1024 + col)); if (dup) __builtin_nontemporal_store(w, (PG8_GAS u32x4*)(dst + (size_t)(8320 + rl) * 1024 + col)); }
                        }
                    }
            } else {
#pragma unroll
                for (int ai = 0; ai < 2; ++ai)
#pragma unroll
                    for (int m = 0; m < 4; ++m) {
                        const int rl = rloc + ai * HALF + m * 16;
#pragma unroll
                        for (int bj = 0; bj < 2; ++bj) {
                            const f32x4 v0 = acc[ai][bj][m][0] * rsv[ai][m], v1 = acc[ai][bj][m][1] * rsv[ai][m];
                            u32x4 w; w.x = cvt_pk_bf16(v0[0], v0[1]); w.y = cvt_pk_bf16(v0[2], v0[3]); w.z = cvt_pk_bf16(v1[0], v1[1]); w.w = cvt_pk_bf16(v1[2], v1[3]);
                            const int col = (u.pn - 8) * BM + bj * HALF + wc * 32 + 8 * fq;
                            if (rl < rlim) { __builtin_nontemporal_store(w, (PG8_GAS u32x4*)(dst + (size_t)rl * 1024 + col)); if (dup) __builtin_nontemporal_store(w, (PG8_GAS u32x4*)(dst + (size_t)(8320 + rl) * 1024 + col)); }
                        }
                    }
            }
        } else {
            EPI_LAUNDER();
            bf16_t* hbase = hb + (size_t)(u.pm * BM + rloc) * 1024 + u.pn * BM + wc * 32 + 8 * fq;
            float* fbase = fout ? fout + (size_t)(u.pm * BM + rloc) * 1024 + u.pn * BM + wc * 32 + 8 * fq : nullptr;
            const float sc = scale; const int lx16 = (fr + 16 * (fq ^ 1)) << 2, lx32 = (fr + 16 * (fq ^ 2)) << 2;
#pragma unroll
            for (int ai = 0; ai < 2; ++ai) {
                u32x4 hx[4][2];
#pragma unroll
                for (int m = 0; m < 4; ++m)
#pragma unroll
                    for (int bj = 0; bj < 2; ++bj) hx[m][bj] = *(const PG8_GAS u32x4*)(hbase + (size_t)(ai * HALF + m * 16) * 1024 + bj * HALF);
                asm volatile("" ::: "memory");
#pragma unroll
                for (int m = 0; m < 4; ++m) {
                    float ps = 0.f;
#pragma unroll
                    for (int bj = 0; bj < 2; ++bj) {
                        const u32x4 hw = hx[m][bj];
                        f32x4 x0 = {__builtin_bit_cast(float, hw.x << 16), __builtin_bit_cast(float, hw.x & 0xffff0000u), __builtin_bit_cast(float, hw.y << 16), __builtin_bit_cast(float, hw.y & 0xffff0000u)};
                        f32x4 x1 = {__builtin_bit_cast(float, hw.z << 16), __builtin_bit_cast(float, hw.z & 0xffff0000u), __builtin_bit_cast(float, hw.w << 16), __builtin_bit_cast(float, hw.w & 0xffff0000u)};
                        x0 += acc[ai][bj][m][0] * sc; x1 += acc[ai][bj][m][1] * sc;
                        if (fbase) { float* p = fbase + (size_t)(ai * HALF + m * 16) * 1024 + bj * HALF; *(PG8_GAS f32x4*)p = x0; *(PG8_GAS f32x4*)(p + 4) = x1; }
                        ps += ((x0[0] * x0[0] + x0[1] * x0[1]) + (x0[2] * x0[2] + x0[3] * x0[3])) + ((x1[0] * x1[0] + x1[1] * x1[1]) + (x1[2] * x1[2] + x1[3] * x1[3]));
                        u32x4 w; w.x = cvt_pk_bf16(x0[0], x0[1]); w.y = cvt_pk_bf16(x0[2], x0[3]); w.z = cvt_pk_bf16(x1[0], x1[1]); w.w = cvt_pk_bf16(x1[2], x1[3]);
                        if (!fbase) __builtin_nontemporal_store(w, (PG8_GAS u32x4*)(hbase + (size_t)(ai * HALF + m * 16) * 1024 + bj * HALF));
                    }
                    ps += __builtin_bit_cast(float, __builtin_amdgcn_ds_bpermute(lx16, __builtin_bit_cast(int, ps))); ps += __builtin_bit_cast(float, __builtin_amdgcn_ds_bpermute(lx32, __builtin_bit_cast(int, ps)));
                    if (fq == 0) ldsp[(rloc + ai * HALF + m * 16) * 4 + wc] = ps;
                }
            }
            asm volatile("s_waitcnt lgkmcnt(0)" ::: "memory");
        }
    }
};
template <class Epi, class Sched, bool ALIGN_EPI = false, bool SP2 = false>
__device__ __forceinline__ void gemm_phase(PG8_LAS unsigned char* lds, const Gemm g, const Sched& S, const Epi& E, const int tid_in) {
    const int tid = tid_in, wid = __builtin_amdgcn_readfirstlane(tid >> 6), lane = tid & 63, wr = wid >> 2, wc = wid & 3, fr = lane & 15, fq = lane >> 4;
    const int K = g.K, nt = K / BK;
    unsigned voffA[2], voffB[2];
#pragma unroll
    for (int i = 0; i < 2; ++i) { int R, C; stage_rc(tid * 16 + i * 8192, R, C); const int Rb = Epi::PERM ? ((R & ~31) + perm32(R & 31)) : R;
        voffA[i] = (unsigned)(R * K + C) * 2u; voffB[i] = (unsigned)(Rb * K + C) * 2u; }
    const size_t kstep = (size_t)(BK * 2);
    const size_t hstep = (size_t)HALF * K * 2;
    const size_t tstep = 2 * hstep;
    const unsigned ldsw = (unsigned)wid * 1024u;
    const int aoff = lds_byte(wr * 64 + fr, fq * 8), boff = lds_byte(wc * 32 + fr, fq * 8);
#define PG8_SA(b, h) (((b) * 2 + (h)) * HTB)
#define PG8_SB(b, h) ((4 + (b) * 2 + (h)) * HTB)
#define PG8_STAGE(bufoff, gbase, voff) do { _Pragma("unroll") for (int _i = 0; _i < 2; ++_i) \
        __builtin_amdgcn_global_load_lds((const unsigned*)((const char*)(gbase) + (voff)[_i]), (PG8_LAS unsigned*)(lds + (bufoff) + ldsw + _i * 8192), 16, 0, 0); } while (0)
#define PG8_LDA(dst, b, h) do { _Pragma("unroll") for (int m = 0; m < 4; ++m) _Pragma("unroll") for (int k = 0; k < 2; ++k) dst[m][k] = *(const PG8_LAS bf16x8*)(lds + PG8_SA(b, h) + aoff + m * 2048 + k * 1024); } while (0)
#define PG8_LDB(dst, b, h) do { _Pragma("unroll") for (int n = 0; n < 2; ++n) _Pragma("unroll") for (int k = 0; k < 2; ++k) dst[n][k] = *(const PG8_LAS bf16x8*)(lds + PG8_SB(b, h) + boff + n * 2048 + k * 1024); } while (0)
#define PG8_MMA(ai, bj, At, Bt) do { __builtin_amdgcn_s_setprio(1); _Pragma("unroll") for (int m = 0; m < 4; ++m) _Pragma("unroll") for (int n = 0; n < 2; ++n) _Pragma("unroll") for (int k = 0; k < 2; ++k) \
        acc[ai][bj][m][n] = __builtin_amdgcn_mfma_f32_16x16x32_bf16(Bt[n][k], At[m][k], acc[ai][bj][m][n], 0, 0, 0); __builtin_amdgcn_s_setprio(0); } while (0)
#define PG8_WAIT_V(n) asm volatile("s_waitcnt vmcnt(" #n ")" ::: "memory")
#define PG8_WAIT_L(n) asm volatile("s_waitcnt lgkmcnt(" #n ")" ::: "memory")
#define PG8_BAR __builtin_amdgcn_s_barrier()
#define PG8_SCHED __builtin_amdgcn_sched_barrier(0)
    Unit cur, nxt; int ui = 0;
    if (!S.next(0, cur)) return;
    f32x4 acc[2][2][4][2];
#pragma unroll
    for (int a = 0; a < 2; ++a)
#pragma unroll
        for (int b = 0; b < 2; ++b)
#pragma unroll
            for (int m = 0; m < 4; ++m)
#pragma unroll
                for (int n = 0; n < 2; ++n) acc[a][b][m][n] = (f32x4){0.f, 0.f, 0.f, 0.f};
    bf16x8 At[4][2], B0[2][2], B1[2][2];
    const char* cA = (const char*)g.A + (size_t)cur.pm * tstep; const char* cB = (const char*)g.Bt + (size_t)cur.pn * tstep;
    S.a_ready(cur);
    if constexpr (SP2) {
        PG8_STAGE(PG8_SB(0, 0), cB, voffB); PG8_STAGE(PG8_SB(0, 1), cB + hstep, voffB); PG8_STAGE(PG8_SA(0, 0), cA, voffA); PG8_STAGE(PG8_SA(0, 1), cA + hstep, voffA);
        if (wr == 1) PG8_BAR;
        PG8_WAIT_V(2); PG8_BAR;
        PG8_STAGE(PG8_SB(1, 0), cB + kstep, voffB); PG8_STAGE(PG8_SA(1, 0), cA + kstep, voffA); PG8_STAGE(PG8_SB(1, 1), cB + hstep + kstep, voffB);
        PG8_WAIT_V(6); PG8_BAR;
    } else {
        PG8_STAGE(PG8_SB(0, 0), cB, voffB); PG8_STAGE(PG8_SA(0, 0), cA, voffA); PG8_STAGE(PG8_SB(0, 1), cB + hstep, voffB); PG8_STAGE(PG8_SA(0, 1), cA + hstep, voffA);
        if (wr == 1) PG8_BAR;
        PG8_WAIT_V(4); PG8_BAR;
        PG8_STAGE(PG8_SB(1, 0), cB + kstep, voffB); PG8_STAGE(PG8_SA(1, 0), cA + kstep, voffA); PG8_STAGE(PG8_SB(1, 1), cB + hstep + kstep, voffB);
        PG8_WAIT_V(6); PG8_BAR;
    }
    for (;;) {
        const bool has_next = S.next(ui + 1, nxt);
        const char* nA = has_next ? (const char*)g.A + (size_t)nxt.pm * tstep : cA; const char* nB = has_next ? (const char*)g.Bt + (size_t)nxt.pn * tstep : cB;
        for (int t = 0; t < nt; t += 2) {
            const bool last = (t == nt - 2);
            const char* a1 = cA + (size_t)(t + 1) * kstep;
            const char* a2 = last ? nA : cA + (size_t)(t + 2) * kstep; const char* b2 = last ? nB : cB + (size_t)(t + 2) * kstep;
            const char* a3 = a2 + kstep; const char* b3 = b2 + kstep;
            if (last && has_next) S.a_ready(nxt);
            if constexpr (SP2) {
            PG8_LDB(B0, 0, 0); PG8_LDB(B1, 0, 1); PG8_SCHED; PG8_LDA(At, 0, 0); PG8_STAGE(PG8_SA(1, 1), a1 + hstep, voffA);
            PG8_WAIT_V(8); PG8_WAIT_L(0); PG8_BAR; PG8_MMA(0, 0, At, B0); PG8_MMA(0, 1, At, B1); PG8_BAR; PG8_SCHED;
            PG8_LDA(At, 0, 1); PG8_STAGE(PG8_SB(0, 0), b2, voffB); PG8_STAGE(PG8_SB(0, 1), b2 + hstep, voffB); PG8_STAGE(PG8_SA(0, 0), a2, voffA);
            PG8_WAIT_V(8); PG8_WAIT_L(0); PG8_BAR; PG8_MMA(1, 0, At, B0); PG8_MMA(1, 1, At, B1); PG8_BAR; PG8_SCHED;
            PG8_LDB(B0, 1, 0); PG8_LDB(B1, 1, 1); PG8_SCHED; PG8_LDA(At, 1, 0); PG8_STAGE(PG8_SA(0, 1), a2 + hstep, voffA);
            PG8_WAIT_V(8); PG8_WAIT_L(0); PG8_BAR; PG8_MMA(0, 0, At, B0); PG8_MMA(0, 1, At, B1); PG8_BAR; PG8_SCHED;
            PG8_LDA(At, 1, 1); PG8_STAGE(PG8_SB(1, 0), b3, voffB); PG8_STAGE(PG8_SB(1, 1), b3 + hstep, voffB); PG8_STAGE(PG8_SA(1, 0), a3, voffA);
            PG8_WAIT_V(8); PG8_WAIT_L(0); PG8_BAR; PG8_MMA(1, 0, At, B0); PG8_MMA(1, 1, At, B1); PG8_BAR; PG8_SCHED;
            } else {
            PG8_LDB(B0, 0, 0); PG8_SCHED; PG8_LDA(At, 0, 0); PG8_STAGE(PG8_SA(1, 1), a1 + hstep, voffA);
            PG8_WAIT_L(8); PG8_BAR; PG8_WAIT_L(0); PG8_MMA(0, 0, At, B0); PG8_BAR; PG8_SCHED;
            PG8_LDB(B1, 0, 1); PG8_STAGE(PG8_SB(0, 0), b2, voffB);
            PG8_BAR; PG8_WAIT_L(0); PG8_MMA(0, 1, At, B1); PG8_BAR;
            PG8_LDA(At, 0, 1); PG8_STAGE(PG8_SA(0, 0), a2, voffA);
            PG8_BAR; PG8_WAIT_L(0); PG8_MMA(1, 0, At, B0); PG8_BAR; PG8_SCHED;
            PG8_STAGE(PG8_SB(0, 1), b2 + hstep, voffB);
            PG8_WAIT_V(6); PG8_BAR; PG8_MMA(1, 1, At, B1); PG8_BAR;
            PG8_LDB(B0, 1, 0); PG8_SCHED; PG8_LDA(At, 1, 0); PG8_STAGE(PG8_SA(0, 1), a2 + hstep, voffA);
            PG8_WAIT_L(8); PG8_BAR; PG8_WAIT_L(0); PG8_MMA(0, 0, At, B0); PG8_BAR; PG8_SCHED;
            PG8_LDB(B1, 1, 1); PG8_STAGE(PG8_SB(1, 0), b3, voffB);
            PG8_BAR; PG8_WAIT_L(0); PG8_MMA(0, 1, At, B1); PG8_BAR;
            PG8_LDA(At, 1, 1); PG8_STAGE(PG8_SA(1, 0), a3, voffA);
            PG8_BAR; PG8_WAIT_L(0); PG8_MMA(1, 0, At, B0); PG8_BAR; PG8_SCHED;
            PG8_STAGE(PG8_SB(1, 1), b3 + hstep, voffB);
            PG8_WAIT_V(6); PG8_BAR; PG8_MMA(1, 1, At, B1); PG8_BAR;
            }
        }
        if constexpr (ALIGN_EPI) { if (wr == 0) PG8_BAR; }
        if constexpr (!Epi::AFTER_DRAIN) { E(acc, cur, wr, wc, fr, fq, ui); S.done(cur); }
        if (!has_next) break;
#pragma unroll
        for (int a = 0; a < 2; ++a)
#pragma unroll
            for (int b = 0; b < 2; ++b)
#pragma unroll
                for (int m = 0; m < 4; ++m)
#pragma unroll
                    for (int n = 0; n < 2; ++n) acc[a][b][m][n] = (f32x4){0.f, 0.f, 0.f, 0.f};
        cur = nxt; cA = nA; cB = nB; ++ui;
        if constexpr (ALIGN_EPI) { if (wr == 1) PG8_BAR; }
    }
    PG8_WAIT_V(0);
    if constexpr (!ALIGN_EPI) { if (wr == 0) PG8_BAR; }
    PG8_BAR;
    if constexpr (Epi::AFTER_DRAIN) { E.fused(acc, cur, wr, wc, fr, fq, lds, wid, lane); S.done(cur); }
#undef PG8_SA
#undef PG8_SB
#undef PG8_STAGE
#undef PG8_LDA
#undef PG8_LDB
#undef PG8_MMA
#undef PG8_WAIT_V
#undef PG8_WAIT_L
#undef PG8_BAR
#undef PG8_SCHED
}
}

#ifndef PG8_SP2
#define PG8_SP2 true
#endif
#ifndef PG8_ALIGN
#define PG8_ALIGN true
#endif
#include <hip/hip_bf16.h>
#include <cmath>
namespace attn_body {
using bf16=__hip_bfloat16;
using bf16x8=__attribute__((ext_vector_type(8)))short;
using s16x4=__attribute__((ext_vector_type(4)))short;
using f32x16=__attribute__((ext_vector_type(16)))float;
using u32x4=__attribute__((ext_vector_type(4)))unsigned;
constexpr int BATCH=2,NHEAD=16,SEQ=8192,D=64,DM=NHEAD*D;
constexpr int NW=8,QBLK=32,QB=QBLK*NW,KVBLK=64,NQB=SEQ/QB; constexpr int KVPAD=128,KVROWS=SEQ+KVPAD;
constexpr int ATTN_PITCH=DM, ATTN_UNIT_ROWS=QB;
__device__ __forceinline__ int crow(int r,int hi){return (r&3)+8*(r>>2)+4*hi;}
#define SBAR() __builtin_amdgcn_sched_barrier(0)
__device__ __forceinline__ void cmask(f32x16&p0,f32x16&p1,int jb,int qrel,int hi){
  const float NEG=-INFINITY; int kb=64*jb+4*hi;
  #pragma unroll
  for(int r=0;r<16;++r){int kv=kb+(r&3)+8*(r>>2); if(kv>qrel)p0[r]=NEG; if(kv+32>qrel)p1[r]=NEG;}
}

constexpr int NSLOT=3, SLOTB=8192;
constexpr int LDS_K=0, LDS_V=NSLOT*SLOTB, LDS_WS=2*NSLOT*SLOTB, LDS_OST=LDS_WS+NW*64*4, LDS_CS=LDS_OST+NW*4096, LDS_BYTES=LDS_CS+KVROWS*4;
constexpr float C2=0.125f*1.4426950408889634f;
__device__ __forceinline__ void glds16(const void*gsrc,unsigned lds_dst){unsigned keep;
  asm volatile("s_mov_b32 %0, m0\n\ts_mov_b32 m0, %2\n\ts_nop 0\n\tglobal_load_lds_dwordx4 %1, off\n\ts_mov_b32 m0, %0":"=&s"(keep):"v"(gsrc),"s"(lds_dst):"memory");}
__device__ __forceinline__ float max3f(float a,float b,float c){float r;asm("v_max3_f32 %0, %1, %2, %3":"=v"(r):"v"(a),"v"(b),"v"(c));return r;}
__device__ __forceinline__ float max2f(float a,float b){float r;asm("v_max_f32_e32 %0, %1, %2":"=v"(r):"v"(a),"v"(b));return r;}
__device__ __forceinline__ float fadd_s(float a,float b){float r;asm("v_add_f32_e32 %0, %1, %2":"=v"(r):"v"(a),"v"(b));return r;}
__device__ __forceinline__ float fsub_s(float a,float b){float r;asm("v_sub_f32_e32 %0, %1, %2":"=v"(r):"v"(a),"v"(b));return r;}
typedef float f32x2_t __attribute__((ext_vector_type(2))); typedef __bf16 bf16x2_t __attribute__((ext_vector_type(2)));
__device__ __forceinline__ unsigned cvtpk_s(float lo,float hi){f32x2_t v={lo,hi};bf16x2_t b=__builtin_convertvector(v,bf16x2_t);return __builtin_bit_cast(unsigned,b);}
#define WAIT_BAR(N) asm volatile("s_waitcnt vmcnt(" #N ") lgkmcnt(0)\n\ts_barrier":::"memory")

__device__ __forceinline__ void qkt(f32x16&p0,f32x16&p1,const char*Kslot,const bf16x8*qr,int r32,int hi){
  const char*kb=Kslot+hi*1024+r32*16;
  #pragma unroll
  for(int d0=0;d0<4;++d0){
    const bf16x8 b0=*reinterpret_cast<const bf16x8*>(kb+d0*2048);
    const bf16x8 b1=*reinterpret_cast<const bf16x8*>(kb+d0*2048+512);
    p0=__builtin_amdgcn_mfma_f32_32x32x16_bf16(b0,qr[d0],p0,0,0,0);p1=__builtin_amdgcn_mfma_f32_32x32x16_bf16(b1,qr[d0],p1,0,0,0);}
}
typedef __attribute__((address_space(3))) const char* lds_cptr;
typedef short v4i16_t __attribute__((ext_vector_type(4))); typedef float f32x4_t __attribute__((ext_vector_type(4)));
__device__ __forceinline__ void kload8(bf16x8*kf,lds_cptr kp){
  kf[0]=*(const __attribute__((address_space(3))) bf16x8*)(kp);      kf[1]=*(const __attribute__((address_space(3))) bf16x8*)(kp+512);
  kf[2]=*(const __attribute__((address_space(3))) bf16x8*)(kp+2048); kf[3]=*(const __attribute__((address_space(3))) bf16x8*)(kp+2560);
  kf[4]=*(const __attribute__((address_space(3))) bf16x8*)(kp+4096); kf[5]=*(const __attribute__((address_space(3))) bf16x8*)(kp+4608);
  kf[6]=*(const __attribute__((address_space(3))) bf16x8*)(kp+6144); kf[7]=*(const __attribute__((address_space(3))) bf16x8*)(kp+6656);
}
__device__ __forceinline__ void kload2(bf16x8*kf,lds_cptr kp,int j){ kf[2*j]=*(const __attribute__((address_space(3))) bf16x8*)(kp+j*2048); kf[2*j+1]=*(const __attribute__((address_space(3))) bf16x8*)(kp+j*2048+512); }
__device__ __forceinline__ s16x4 vtr(lds_cptr p){ return __builtin_bit_cast(s16x4,__builtin_amdgcn_ds_read_tr16_b64_v4i16((__attribute__((address_space(3))) v4i16_t*)p)); }
__device__ __forceinline__ float rowmax(const f32x16&p0,const f32x16&p1){
  float a=max3f(p0[0],p0[1],p1[0]),b=max3f(p0[2],p0[3],p1[1]);a=max3f(a,p1[2],p1[3]);
  #pragma unroll
  for(int r=4;r<16;r+=4){a=max3f(a,p0[r],p0[r+1]);b=max3f(b,p0[r+2],p0[r+3]);a=max3f(a,p1[r],p1[r+1]);b=max3f(b,p1[r+2],p1[r+3]);}
  const float m=max2f(a,b);
  auto rr=__builtin_amdgcn_permlane32_swap(__float_as_uint(m),__float_as_uint(m),false,false);
  return max2f(__uint_as_float(rr[0]),__uint_as_float(rr[1]));
}
__device__ __forceinline__ void pv(f32x16*o,int vb,bf16x8 pa0,bf16x8 pa1,bf16x8 pa2,bf16x8 pa3){
  #pragma unroll
  for(int d0=0;d0<2;++d0){s16x4 lo[4],hi[4];
    #pragma unroll
    for(int ks=0;ks<4;++ks){
      asm volatile("ds_read_b64_tr_b16 %0,%1 offset:%c2":"=&v"(lo[ks]):"v"(vb),"i"(d0*4096+ks*1024):"memory");
      asm volatile("ds_read_b64_tr_b16 %0,%1 offset:%c2":"=&v"(hi[ks]):"v"(vb),"i"(d0*4096+ks*1024+512):"memory");}
    asm volatile("s_waitcnt lgkmcnt(0)":::"memory");SBAR();
    #define PK(k) (bf16x8){lo[k][0],lo[k][1],lo[k][2],lo[k][3],hi[k][0],hi[k][1],hi[k][2],hi[k][3]}
    o[d0]=__builtin_amdgcn_mfma_f32_32x32x16_bf16(pa0,PK(0),o[d0],0,0,0);
    o[d0]=__builtin_amdgcn_mfma_f32_32x32x16_bf16(pa1,PK(1),o[d0],0,0,0);
    o[d0]=__builtin_amdgcn_mfma_f32_32x32x16_bf16(pa2,PK(2),o[d0],0,0,0);
    o[d0]=__builtin_amdgcn_mfma_f32_32x32x16_bf16(pa3,PK(3),o[d0],0,0,0);
    #undef PK
  }
}

#ifndef ATTN_STORE16
#define ATTN_STORE16(p,v) (*(__attribute__((address_space(1))) u32x4*)(p)=(v))
#endif
template<int THRL> __device__ __forceinline__ void attn_unit(int b,int h,int qb,const bf16*Q,const bf16*__restrict__ K,const bf16*__restrict__ V,bf16*O,const float*__restrict__ CS,char*shm,const int tid_in){
  const int tid=tid_in,lane=tid&63,r32=lane&31,hi=lane>>5; const int wid=__builtin_amdgcn_readfirstlane(tid>>6);
  const long rowbase=(long)b*SEQ, kvbase=(long)b*KVROWS; const int q0=qb*QB;
  const bf16*Qw=Q+(rowbase+q0+wid*QBLK)*DM+h*D;
  const bf16*Kh=K+kvbase*DM+h*D,*Vh=V+kvbase*DM+h*D;
  const unsigned lds0=(unsigned)(uintptr_t)shm;
  float*wsf=(float*)(shm+LDS_WS)+wid*64;
  const bf16*ksrc=Kh+(long)lane*DM+wid*8;
  const bf16*vsrc=Vh+(long)(16*(wid&3)+(lane>>2))*DM+(wid>>2)*32+(lane&3)*8;
  const unsigned kdst=lds0+LDS_K+wid*1024, vdst=lds0+LDS_V+wid*1024;
  #define DMA_K(t,slot) glds16(ksrc+(long)(t)*KVBLK*DM,(unsigned)__builtin_amdgcn_readfirstlane(kdst+(slot)))
  #define DMA_V(t,slot) glds16(vsrc+(long)(t)*KVBLK*DM,(unsigned)__builtin_amdgcn_readfirstlane(vdst+(slot)))
  const int vb0=(int)(lds0+LDS_V)+((lane>>4)&1)*32+(lane&3)*8+(4*hi+((lane&15)>>2))*64;
  const char*Kbase=shm+LDS_K; bf16x8 kf[8];
  const lds_cptr shm3=(lds_cptr)shm; const lds_cptr kp0=shm3+LDS_K+hi*1024+r32*16; const lds_cptr vp0=shm3+LDS_V+((lane>>4)&1)*32+(lane&3)*8+(4*hi+((lane&15)>>2))*64;
  const int NT=(q0+QB+KVPAD)/KVBLK;
  DMA_K(0,0);DMA_V(0,0);DMA_K(1,SLOTB);
  bf16x8 qr[4];
  #pragma unroll
  for(int d0=0;d0<4;++d0)qr[d0]=*(const __attribute__((address_space(1))) bf16x8*)(&Qw[(long)r32*DM+d0*16+hi*8]);
  float mhat=0.f,l_reg=0.f;f32x16 o[2];o[0]=f32x16{};o[1]=f32x16{};
  const __attribute__((address_space(3))) float*csl=(const __attribute__((address_space(3))) float*)((lds_cptr)shm+LDS_CS)+4*hi;
  #define BIASINIT(C0,C1,t) do{ const __attribute__((address_space(3))) float*bp_=csl+64*(t); const float nm_=-mhat; \
    _Pragma("unroll") for(int g_=0;g_<4;++g_){ const f32x4_t a_=*(const __attribute__((address_space(3))) f32x4_t*)(bp_+8*g_), b_=*(const __attribute__((address_space(3))) f32x4_t*)(bp_+32+8*g_); \
      C0[4*g_]=nm_-a_[0];C0[4*g_+1]=nm_-a_[1];C0[4*g_+2]=nm_-a_[2];C0[4*g_+3]=nm_-a_[3]; C1[4*g_]=nm_-b_[0];C1[4*g_+1]=nm_-b_[1];C1[4*g_+2]=nm_-b_[2];C1[4*g_+3]=nm_-b_[3]; } }while(0)
  #define BIASLOAD(C0,C1,t) do{ const __attribute__((address_space(3))) float*bp_=csl+64*(t); \
    _Pragma("unroll") for(int g_=0;g_<4;++g_){ const f32x4_t a_=*(const __attribute__((address_space(3))) f32x4_t*)(bp_+8*g_), b_=*(const __attribute__((address_space(3))) f32x4_t*)(bp_+32+8*g_); \
      C0[4*g_]=a_[0];C0[4*g_+1]=a_[1];C0[4*g_+2]=a_[2];C0[4*g_+3]=a_[3]; C1[4*g_]=b_[0];C1[4*g_+1]=b_[1];C1[4*g_+2]=b_[2];C1[4*g_+3]=b_[3]; } }while(0)
  const int qrel=wid*QBLK+r32;
  #define CMASK(P0,P1,t) do{int jb_=(t)-(NT-4); if(jb_>=0)cmask(P0,P1,jb_,qrel,hi);}while(0)
  bool resc=false;
  #define START(P0,P1) do{ const float rm=rowmax(P0,P1); resc=false; \
    { const float dl=rm; mhat=fadd_s(mhat,dl); \
      _Pragma("unroll") for(int r=0;r<16;++r){P0[r]=fsub_s(P0[r],dl);P1[r]=fsub_s(P1[r],dl);} \
      } \
    _Pragma("unroll") for(int r=0;r<16;++r)P0[r]=__builtin_amdgcn_exp2f(P0[r]); }while(0)
  #define RESC() do{ if(resc){ asm volatile("s_waitcnt lgkmcnt(0)":::"memory"); \
      _Pragma("unroll") for(int d_=0;d_<2;++d_) _Pragma("unroll") for(int r=0;r<16;++r)o[d_][r]*=wsf[crow(r,hi)]; } }while(0)
  f32x16 pA0,pA1,pB0,pB1;
  int sl_prev=0,sl_cur=0,sl_next=SLOTB;
  #define ROT() do{sl_prev=sl_cur;sl_cur=sl_next;sl_next=(sl_next==(NSLOT-1)*SLOTB)?0:sl_next+SLOTB;}while(0)
  DMA_K(2,2*SLOTB);
  WAIT_BAR(3);
  BIASINIT(pA0,pA1,0); qkt(pA0,pA1,Kbase,qr,r32,hi);asm volatile("s_nop 15\n\ts_nop 7":"+v"(pA0),"+v"(pA1));
  START(pA0,pA1);
  _Pragma("unroll") for(int r=0;r<16;++r)pA1[r]=__builtin_amdgcn_exp2f(pA1[r]);
  WAIT_BAR(0);
  DMA_K(3,0);DMA_V(1,SLOTB);
  ROT();
  kload8(kf,kp0+sl_cur);
  WAIT_BAR(2);
  s16x4 vlo[8],vhi[8]; u32x4 pw0,pw1,pw2,pw3;
  #define PKW(P,B) cvtpk_s(P[B],P[B+1])
  #define PAF(k) __builtin_bit_cast(bf16x8,pw##k)
  #define VFR(i) (bf16x8){vlo[i][0],vlo[i][1],vlo[i][2],vlo[i][3],vhi[i][0],vhi[i][1],vhi[i][2],vhi[i][3]}
  #define PIN(x) asm volatile("":"+v"(x))
  #define MX3(a,b,c) __builtin_fmaxf(__builtin_fmaxf((a),(b)),(c))
  #define GAPA(MF,A0,A1,A2,A3,W0,W1,PW) do{ MF; sacc+=A0; sacc+=A1; sacc+=A2; sacc+=A3; PIN(sacc); W0; W1; PIN(PW); SBAR(); }while(0)
  #define EX(v) __builtin_amdgcn_exp2f(v)
  #define GAPB(MF,X,B,NX) do{ MF; X[B]=EX(X[B]); X[B+1]=EX(X[B+1]); X[B+2]=EX(X[B+2]); X[B+3]=EX(X[B+3]); NX[B]=fsub_s(nm_,NX[B]); NX[B+1]=fsub_s(nm_,NX[B+1]); NX[B+2]=fsub_s(nm_,NX[B+2]); NX[B+3]=fsub_s(nm_,NX[B+3]); PIN(X); PIN(NX); SBAR(); }while(0)
  #define VRD(i) do{ vlo[i]=vtr(vp_+(((i)>>2)*4096+((i)&3)*1024)); vhi[i]=vtr(vp_+(((i)>>2)*4096+((i)&3)*1024+512)); }while(0)
  #define KRD(G,j) do{ if(G){ kload2(kf,kp0+sl_next,j); SBAR(); } }while(0)
  #define STEP(C0,C1,P0,P1,t,GK,GV,GL) do{ SBAR(); \
    const lds_cptr vp_=vp0+sl_prev; \
    VRD(0); SBAR(); float sacc=(P0[0]+P0[1]); \
    GAPA(C0=__builtin_amdgcn_mfma_f32_32x32x16_bf16(kf[0],qr[0],C0,0,0,0), P0[2],P0[3],P0[4],P0[5],     pw0[0]=PKW(P0,0), pw0[1]=PKW(P0,2), pw0); \
    VRD(4); SBAR(); GAPA(C1=__builtin_amdgcn_mfma_f32_32x32x16_bf16(kf[1],qr[0],C1,0,0,0), P0[6],P0[7],P0[8],P0[9],     pw0[2]=PKW(P0,4), pw0[3]=PKW(P0,6), pw0); \
    VRD(1); SBAR(); GAPA(C0=__builtin_amdgcn_mfma_f32_32x32x16_bf16(kf[2],qr[1],C0,0,0,0),   P0[10],P0[11],P0[12],P0[13], pw1[0]=PKW(P0,8), pw1[1]=PKW(P0,10), pw1); \
    VRD(5); SBAR(); GAPA(C1=__builtin_amdgcn_mfma_f32_32x32x16_bf16(kf[3],qr[1],C1,0,0,0),   P0[14],P0[15],P1[0],P1[1],   pw1[2]=PKW(P0,12),pw1[3]=PKW(P0,14), pw1); \
    VRD(2); SBAR(); GAPA(C0=__builtin_amdgcn_mfma_f32_32x32x16_bf16(kf[4],qr[2],C0,0,0,0),   P1[2],P1[3],P1[4],P1[5],     pw2[0]=PKW(P1,0), pw2[1]=PKW(P1,2), pw2); \
    VRD(6); SBAR(); GAPA(C1=__builtin_amdgcn_mfma_f32_32x32x16_bf16(kf[5],qr[2],C1,0,0,0),   P1[6],P1[7],P1[8],P1[9],     pw2[2]=PKW(P1,4), pw2[3]=PKW(P1,6), pw2); \
    VRD(3); SBAR(); GAPA(C0=__builtin_amdgcn_mfma_f32_32x32x16_bf16(kf[6],qr[3],C0,0,0,0),   P1[10],P1[11],P1[12],P1[13], pw3[0]=PKW(P1,8), pw3[1]=PKW(P1,10), pw3); \
    VRD(7); SBAR(); GAPA(C1=__builtin_amdgcn_mfma_f32_32x32x16_bf16(kf[7],qr[3],C1,0,0,0),   P1[14],P1[15],0.f,0.f,       pw3[2]=PKW(P1,12),pw3[3]=PKW(P1,14), pw3); \
    l_reg+=sacc; \
    BIASLOAD(P0,P1,(t)+1); \
    if(GK){DMA_K((t)+3,sl_cur);} if(GV){DMA_V((t)+1,sl_next);} \
    CMASK(C0,C1,t); \
    { float a=MX3(C0[0],C0[1],C1[0]),b=MX3(C0[2],C0[3],C1[1]); a=MX3(a,C1[2],C1[3]); \
      _Pragma("unroll") for(int r=4;r<16;r+=4){a=MX3(a,C0[r],C0[r+1]);b=MX3(b,C0[r+2],C0[r+3]);a=MX3(a,C1[r],C1[r+1]);b=MX3(b,C1[r+2],C1[r+3]);} \
      float rm=__builtin_fmaxf(a,b); { auto rr=__builtin_amdgcn_permlane32_swap(__float_as_uint(rm),__float_as_uint(rm),false,false); rm=__builtin_fmaxf(__uint_as_float(rr[0]),__uint_as_float(rr[1])); } \
      resc=false; \
      if(__builtin_expect(__any(rm>(float)THRL),0)){ const float dl=__builtin_fmaxf(rm,0.f); mhat+=dl; \
        _Pragma("unroll") for(int r=0;r<16;++r){C0[r]-=dl;C1[r]-=dl;} \
        const float f=__builtin_amdgcn_exp2f(-dl); l_reg*=f; if(hi==0)wsf[r32]=f; resc=true; } } \
    SBAR(); const float nm_=-mhat; \
    GAPB(o[0]=__builtin_amdgcn_mfma_f32_32x32x16_bf16(PAF(0),VFR(0),o[0],0,0,0), C0,0,P0); \
    GAPB(o[1]=__builtin_amdgcn_mfma_f32_32x32x16_bf16(PAF(0),VFR(4),o[1],0,0,0), C0,4,P0); \
    KRD(GL,0); GAPB(o[0]=__builtin_amdgcn_mfma_f32_32x32x16_bf16(PAF(1),VFR(1),o[0],0,0,0), C0,8,P0); \
    KRD(GL,1); GAPB(o[1]=__builtin_amdgcn_mfma_f32_32x32x16_bf16(PAF(1),VFR(5),o[1],0,0,0), C0,12,P0); \
    KRD(GL,2); GAPB(o[0]=__builtin_amdgcn_mfma_f32_32x32x16_bf16(PAF(2),VFR(2),o[0],0,0,0), C1,0,P1); \
    KRD(GL,3); GAPB(o[1]=__builtin_amdgcn_mfma_f32_32x32x16_bf16(PAF(2),VFR(6),o[1],0,0,0), C1,4,P1); \
    GAPB(o[0]=__builtin_amdgcn_mfma_f32_32x32x16_bf16(PAF(3),VFR(3),o[0],0,0,0), C1,8,P1); \
    GAPB(o[1]=__builtin_amdgcn_mfma_f32_32x32x16_bf16(PAF(3),VFR(7),o[1],0,0,0), C1,12,P1); \
    }while(0)
  BIASINIT(pB0,pB1,1);
  int t=1;
  #undef CMASK
  #define CMASK(P0,P1,t) do{}while(0)
  for(;t+5<NT;t+=2){
    STEP(pB0,pB1,pA0,pA1,t,true,true,true);     WAIT_BAR(2); RESC(); ROT();
    STEP(pA0,pA1,pB0,pB1,t+1,true,true,true);   WAIT_BAR(2); RESC(); ROT();
  }
  #undef CMASK
  #define CMASK(P0,P1,t) do{int jb_=(t)-(NT-4); if(jb_>=0)cmask(P0,P1,jb_,qrel,hi);}while(0)
  #define ENDW(tt) do{ if((tt)+3<NT){WAIT_BAR(2);} else if((tt)+2<NT){WAIT_BAR(1);} else {WAIT_BAR(0);} }while(0)
  for(;t+1<NT;t+=2){
    STEP(pB0,pB1,pA0,pA1,t,(t+3<NT),(t+1<NT),(t+1<NT));       ENDW(t);   RESC(); ROT();
    STEP(pA0,pA1,pB0,pB1,t+1,(t+4<NT),(t+2<NT),(t+2<NT));     ENDW(t+1); RESC(); ROT();
  }
  STEP(pB0,pB1,pA0,pA1,NT-1,false,false,false); RESC();
  { float sacc=pB0[0]+pB0[1]; _Pragma("unroll") for(int r=2;r<16;++r)sacc+=pB0[r]; _Pragma("unroll") for(int r=0;r<16;++r)sacc+=pB1[r]; l_reg+=sacc;
    pw0=(u32x4){PKW(pB0,0),PKW(pB0,2),PKW(pB0,4),PKW(pB0,6)};pw1=(u32x4){PKW(pB0,8),PKW(pB0,10),PKW(pB0,12),PKW(pB0,14)};pw2=(u32x4){PKW(pB1,0),PKW(pB1,2),PKW(pB1,4),PKW(pB1,6)};pw3=(u32x4){PKW(pB1,8),PKW(pB1,10),PKW(pB1,12),PKW(pB1,14)};
    SBAR(); pv(o,vb0+sl_cur,PAF(0),PAF(1),PAF(2),PAF(3)); }
  #undef PKW
  #undef PAF
  #undef VFR
  #undef PIN
  #undef MX3
  #undef GAPA
  #undef GAPB
  #undef EX
  #undef VRD
  #undef KRD
  #undef STEP
  #undef ENDW
  {auto rr=__builtin_amdgcn_permlane32_swap(__float_as_uint(l_reg),__float_as_uint(l_reg),false,false);l_reg=__uint_as_float(rr[0])+__uint_as_float(rr[1]);}
  if(hi==0)wsf[32+r32]=l_reg;asm volatile("s_waitcnt lgkmcnt(0)":::"memory");
  float rli[16];
  #pragma unroll
  for(int r=0;r<16;++r)rli[r]=__builtin_amdgcn_rcpf(wsf[32+crow(r,hi)]);
  bf16*Ow=O+(rowbase+q0+wid*QBLK)*DM+h*D;
  { bf16*stg=(bf16*)(shm+LDS_OST)+wid*2048;
    #pragma unroll
    for(int r=0;r<16;++r){const int orow=crow(r,hi);
      #pragma unroll
      for(int d0=0;d0<2;++d0)stg[orow*64+d0*32+r32]=__float2bfloat16(o[d0][r]*rli[r]);}
    asm volatile("s_waitcnt lgkmcnt(0)":::"memory");
    #pragma unroll
    for(int i=0;i<4;++i){const int row=i*8+(lane>>3),ch=lane&7; const u32x4 v=*(const u32x4*)(stg+row*64+ch*8); ATTN_STORE16(Ow+(long)row*DM+ch*8,v);} }
  asm volatile("s_waitcnt lgkmcnt(0)\n\ts_barrier":::"memory");
  #undef DMA_K
  #undef DMA_V
  #undef CMASK
  #undef START
  #undef RESC
  #undef ROT
  #undef BIASINIT
  #undef BIASLOAD
}
constexpr int ATTN_LDS_BYTES=LDS_BYTES;
struct AttnTensors { const bf16* Q; const bf16* K; const bf16* V; bf16* O; const float* CS; };
struct AttnUnit { int bh; int qb; };
struct StaticOrder {
  int vcu;
  __device__ __forceinline__ explicit StaticOrder(int grid,int block):vcu((block%8)*(grid/8)+block/8){}
  __device__ __forceinline__ bool next(int i,AttnUnit&u)const{ if(i>=4)return false; const int s=vcu&7; u.bh=vcu>>3; u.qb=(i==0)?s:(i==1)?15-s:(i==2)?16+s:31-s; return true; }
  __device__ __forceinline__ void a_ready(const AttnUnit&)const{}
  __device__ __forceinline__ void done(const AttnUnit&)const{}
};
template<class Sched,int THRL=96> __device__ __forceinline__ void attn_phase(char*lds,const AttnTensors&T,const Sched&S,const int tid_in){
  AttnUnit u;
  for(int i=0;S.next(i,u);++i){ S.a_ready(u); attn_unit<THRL>(u.bh/NHEAD,u.bh%NHEAD,u.qb,T.Q,T.K,T.V,T.O,T.CS,lds,tid_in); S.done(u); }
}
#undef SBAR
#undef WAIT_BAR
}
#define LAS __attribute__((address_space(3)))
#define XB_TMO      128
#define XB_XCNT(j)  (256  + 64 * (j))
#define XB_XSUB(j)  (1280 + 64 * (j))
#define XB_XGEN(j)  (2304 + 64 * (j))
#define XB_TOP      3328
#define XB_TOPGEN   3392
#define XCD_BAR_WORDS 3456
#define XB_SPIN_CAP (1u << 18)

__device__ __forceinline__ unsigned xb_ld(unsigned* p)              { return __hip_atomic_load(p, __ATOMIC_RELAXED, __HIP_MEMORY_SCOPE_AGENT); }
__device__ __forceinline__ unsigned xb_add(unsigned* p, unsigned v) { return __hip_atomic_fetch_add(p, v, __ATOMIC_RELAXED, __HIP_MEMORY_SCOPE_AGENT); }
__device__ __forceinline__ unsigned xb_xcc_id() { return (unsigned)__builtin_amdgcn_s_getreg((3 << 11) | 20) & 0xFu; }
#define XB_SPIN(cond, bar) do { unsigned _sp = 0; while (cond) { __builtin_amdgcn_s_sleep(1); \
    if ((++_sp & 255u) == 0u) { if (xb_ld(&(bar)[XB_TMO])) break; if (_sp > XB_SPIN_CAP) { atomicAdd(&(bar)[XB_TMO], 1u); break; } } } } while (0)

struct XcdBarrier {
    unsigned* bar; unsigned x;
    volatile LAS unsigned* st;
};

__device__ __forceinline__ XcdBarrier xcd_barrier_post(unsigned* bar, volatile LAS unsigned* st, const int tid) {
    XcdBarrier b; b.bar = bar; b.x = xb_xcc_id(); b.st = st;
    if (tid == 0) (void)xb_add(&bar[XB_XCNT(b.x)], 1u);
    return b;
}
__device__ __forceinline__ void xcd_barrier_complete(unsigned* bar, unsigned x, unsigned& nloc, unsigned& nx) {
    const unsigned G = gridDim.x * gridDim.y * gridDim.z;
    unsigned sum, cnt, mine, sp = 0u;
    for (;;) {
        sum = 0u; cnt = 0u; mine = 0u;
#pragma unroll
        for (unsigned j = 0; j < 16; ++j) { const unsigned c = xb_ld(&bar[XB_XCNT(j)]); sum += c; cnt += (c > 0u) ? 1u : 0u; mine = (j == x) ? c : mine; }
        if (sum == G) break;
        __builtin_amdgcn_s_sleep(1);
        if ((++sp & 255u) == 0u) { if (xb_ld(&bar[XB_TMO])) break; if (sp > XB_SPIN_CAP) { atomicAdd(&bar[XB_TMO], 1u); break; } }
    }
    nloc = mine > 0u ? mine : 1u; nx = cnt > 0u ? cnt : 1u;
}

__device__ __forceinline__ void xcd_barrier(const XcdBarrier& b, const int tid) {
    asm volatile("s_waitcnt vmcnt(0)" ::: "memory");
    __syncthreads();
    if (tid == 0) {
        unsigned* bar = b.bar; asm volatile("" : "+s"(bar)); unsigned bx_ = (unsigned)__builtin_amdgcn_readfirstlane((int)b.x); asm volatile("" : "+s"(bx_));
        __builtin_amdgcn_s_waitcnt(0);
        unsigned nloc = b.st[0], nx = b.st[1];
        if (nloc == 0u) { xcd_barrier_complete(bar, bx_, nloc, nx); b.st[0] = nloc; b.st[1] = nx; }
        const unsigned old = xb_add(&bar[XB_XSUB(bx_)], 1u);
        const unsigned gen = old / nloc;
        if (old + 1u == (gen + 1u) * nloc) {
            __builtin_amdgcn_fence(__ATOMIC_RELEASE, "agent");
            asm volatile("s_waitcnt vmcnt(0)" ::: "memory");
            const unsigned og = xb_add(&bar[XB_TOP], 1u);
            const unsigned tg = og / nx;
            if (og + 1u == (tg + 1u) * nx) xb_add(&bar[XB_TOPGEN], 1u);
            else XB_SPIN(xb_ld(&bar[XB_TOPGEN]) == tg, bar);
            __builtin_amdgcn_fence(__ATOMIC_ACQUIRE, "agent");
            xb_add(&bar[XB_XGEN(bx_)], 1u);
            asm volatile("s_waitcnt vmcnt(0)" ::: "memory");
        } else {
            XB_SPIN(xb_ld(&bar[XB_XGEN(bx_)]) == gen, bar);
            __builtin_amdgcn_fence(__ATOMIC_ACQUIRE, "agent");
            asm volatile("s_waitcnt vmcnt(0)" ::: "memory");
        }
    }
    __syncthreads();
}
namespace cg = cooperative_groups;
constexpr int NWAVES = 8;
constexpr int DM = 1024, FF = 2816, NH = 16, SEQ = 8192, NMETA = 16, DEPTH = 4;
constexpr int MMAIN = 2 * SEQ;
constexpr int MROWS = MMAIN + NMETA;
constexpr int MPAD = 65 * 256;
constexpr int KVROWS = attn_body::KVROWS;
constexpr float EPS = 1e-6f, LOG2E = 1.4426950408889634f;

constexpr size_t MiB = 1u << 20;
constexpr size_t SZ_GU = (size_t)5632 * 1024 * 2, SZ_DN = (size_t)1024 * 2816 * 2;
constexpr size_t WS_CTL = 0, CTL_ZERO_BYTES = 65536;
constexpr size_t WS_WGU = 1 * MiB, WS_WDN = WS_WGU + 8 * SZ_GU;
constexpr size_t WS_WAI = WS_WDN + 8 * SZ_DN, WS_WAO = WS_WAI + 2 * 6 * MiB, WS_WBI = WS_WAO + 2 * 2 * MiB, WS_WBO = WS_WBI + 4 * MiB;
constexpr size_t WS_WCI = WS_WBO + 2 * MiB, WS_WCO = WS_WCI + 6 * MiB, WS_WF = WS_WCO + 2 * MiB;
constexpr size_t WS_XN = WS_WF + 1 * MiB;
constexpr size_t SZ_ROWBUF = (size_t)MPAD * 1024 * 2;
constexpr size_t WS_ACT = WS_XN + 33 * MiB;
constexpr size_t WS_HMETA = WS_ACT + 98 * MiB, WS_LF = WS_HMETA + 1 * MiB, WS_LFM = WS_LF + 1 * MiB, WS_CS = WS_LFM + 1 * MiB, WS_SSQ = WS_CS + 2 * MiB, WS_SSQM = WS_SSQ + 1 * MiB, WS_END = WS_SSQM + 1 * MiB;
static_assert(SZ_ROWBUF <= 33 * MiB && 3 * SZ_ROWBUF <= 98 * MiB && (size_t)MPAD * FF * 2 <= 98 * MiB, "ws map");

constexpr int RING_BYTES = 131072, LDS_BYTES = 147456;
static_assert(attn_body::ATTN_LDS_BYTES <= RING_BYTES, "attention LDS");
constexpr int MISC_OFF = RING_BYTES + 320;

#define GAS __attribute__((address_space(1)))
typedef unsigned short bf16;
typedef unsigned v4u __attribute__((ext_vector_type(4)));
typedef unsigned v2u __attribute__((ext_vector_type(2)));
typedef float f32x4 __attribute__((ext_vector_type(4)));
typedef float f32x2 __attribute__((ext_vector_type(2)));
typedef short bf16x8 __attribute__((ext_vector_type(8)));
#define LDS_WAIT() asm volatile("s_waitcnt lgkmcnt(0)" ::: "memory")
__device__ __forceinline__ unsigned f2bf(float f) { unsigned u = __builtin_bit_cast(unsigned, f); return (u + 0x7fffu + ((u >> 16) & 1u)) >> 16; }
__device__ __forceinline__ unsigned pk2(float lo, float hi) { return f2bf(lo) | (f2bf(hi) << 16); }
__device__ __forceinline__ float bflo(unsigned w) { return __builtin_bit_cast(float, w << 16); }
__device__ __forceinline__ float bfhi(unsigned w) { return __builtin_bit_cast(float, w & 0xffff0000u); }
__device__ __forceinline__ float lane_get(float v, int src_lane) { return __builtin_bit_cast(float, __builtin_amdgcn_ds_bpermute(src_lane << 2, __builtin_bit_cast(int, v))); }
__device__ __forceinline__ float wave_sum(float v, int lane) {
#pragma unroll
    for (int o = 1; o < 64; o <<= 1) v += lane_get(v, lane ^ o);
    return v;
}

struct Args {
    const float* x; const float* meta; const float* ffn_norm; const float* ffn_w_gate; const float* ffn_w_up; const float* ffn_w_down; const float* mix_norm;
    const float* a_w_in; const float* a_conv; const float* a_w_out;
    const float* b_w_in; const float* b_conv; const float* b_conv_bias; const float* b_ln_g; const float* b_ln_b; const float* b_w_out;
    const float* c_w_in; const float* c_b_f; const float* c_q_norm; const float* c_k_norm; const float* c_w_out;
    float* out; unsigned char* ws;
};

__device__ __forceinline__ void transpose_item(const float* src, int Nsrc, bf16* dst, int K, int kb, LAS float* scr, int lane, const float* gain = nullptr) {
    const int k0 = 64 * kb;
    const GAS float* sp = (const GAS float*)src + (size_t)(k0 + (lane >> 5)) * Nsrc + (lane & 31);
    float v[32];
#pragma unroll
    for (int i = 0; i < 32; ++i) v[i] = sp[(size_t)(2 * i) * Nsrc];
    const int c = lane & 7;
    f32x4 g0 = {1.f, 1.f, 1.f, 1.f}, g1 = g0;
    if (gain) { g0 = *(const GAS f32x4*)(gain + k0 + 8 * c); g1 = *(const GAS f32x4*)(gain + k0 + 8 * c + 4); }
#pragma unroll
    for (int i = 0; i < 32; ++i) scr[(2 * i + (lane >> 5)) * 33 + (lane & 31)] = v[i];
    LDS_WAIT(); asm volatile("" ::: "memory");
#pragma unroll
    for (int j = 0; j < 4; ++j) { const int n = (lane >> 3) + 8 * j; const LAS float* s = scr + (8 * c) * 33 + n;
        v4u o; o.x = pk2(s[0 * 33] * g0.x, s[1 * 33] * g0.y); o.y = pk2(s[2 * 33] * g0.z, s[3 * 33] * g0.w); o.z = pk2(s[4 * 33] * g1.x, s[5 * 33] * g1.y); o.w = pk2(s[6 * 33] * g1.z, s[7 * 33] * g1.w);
        *(GAS v4u*)(dst + (size_t)n * K + k0 + 8 * c) = o; }
    LDS_WAIT(); asm volatile("" ::: "memory");
}

__device__ __forceinline__ float hb_row(const float* xrow, bf16* orow, int lane) {
    const GAS f32x4* xr = (const GAS f32x4*)xrow + lane;
    f32x4 v[4]; float s = 0.f;
#pragma unroll
    for (int j = 0; j < 4; ++j) { v[j] = xr[64 * j]; s += (v[j].x * v[j].x + v[j].y * v[j].y) + (v[j].z * v[j].z + v[j].w * v[j].w); }
    GAS unsigned long long* o8 = (GAS unsigned long long*)orow + lane;
#pragma unroll
    for (int j = 0; j < 4; ++j) o8[64 * j] = (unsigned long long)pk2(v[j].x, v[j].y) | ((unsigned long long)pk2(v[j].z, v[j].w) << 32);
    return wave_sum(s, lane);
}

constexpr int I_GU = 176 * 16, I_DN = 32 * 44, I_AI = 96 * 16, I_SQ = 32 * 16, I_BI = 64 * 16, I_CI = 96 * 16;
constexpr int I_FFN = 2 * I_GU + 2 * I_DN, I_MIXBASE = 8 * I_GU + 8 * I_DN;
static_assert(I_CI == I_AI, "conv_nv");
__device__ __forceinline__ int conv_nv(int L) { return I_FFN + ((L == 1) ? I_BI + I_SQ : I_AI + I_SQ); }
__device__ __forceinline__ int conv_item(int L, int v) {
    if (v < 2 * I_GU) return 2 * L * I_GU + v;
    if (v < I_FFN) return 8 * I_GU + 2 * L * I_DN + (v - 2 * I_GU);
    const int w = v - I_FFN;
    if (L == 0) return (w < I_AI) ? I_MIXBASE + w : I_MIXBASE + 2 * I_AI + (w - I_AI);
    if (L == 3) return (w < I_AI) ? I_MIXBASE + I_AI + w : I_MIXBASE + 2 * I_AI + I_SQ + (w - I_AI);
    if (L == 1) return I_MIXBASE + 2 * I_AI + 2 * I_SQ + w;
    return I_MIXBASE + 2 * I_AI + 2 * I_SQ + I_BI + I_SQ + w;
}
#define CONVERT_BODY \
            int r = it; \
            if (r < 8 * I_GU) { const int mat = r / I_GU; r %= I_GU; const int kb = r / 176, nb = r % 176, pn = nb >> 3, q = nb & 7; \
                const float* src = ((q < 4) ? a.ffn_w_gate : a.ffn_w_up) + (size_t)mat * 1024 * FF + 128 * pn + 32 * (q & 3); \
                transpose_item(src, FF, WGU + (size_t)mat * 5632 * 1024 + (size_t)nb * 32 * 1024, 1024, kb, scr, lane, a.ffn_norm + (size_t)mat * DM); continue; } \
            r -= 8 * I_GU; \
            if (r < 8 * I_DN) { const int mat = r / I_DN; r %= I_DN; const int kb = r / 32, nb = r % 32; \
                transpose_item(a.ffn_w_down + (size_t)mat * FF * 1024 + 32 * nb, 1024, WDN + (size_t)mat * 1024 * FF + (size_t)nb * 32 * FF, FF, kb, scr, lane); continue; } \
            r -= 8 * I_DN; \
            if (r < 2 * I_AI) { const int mat = r / I_AI; r %= I_AI; const int kb = r / 96, nb = r % 96, pn = nb >> 3, q = nb & 7; \
                const int scol = (pn < 8) ? ((q < 4) ? 1024 + 128 * pn + 32 * q : 2048 + 128 * pn + 32 * (q - 4)) : (nb - 64) * 32; \
                transpose_item(a.a_w_in + (size_t)mat * 1024 * 3072 + scol, 3072, WAI + (size_t)mat * 3072 * 1024 + (size_t)nb * 32 * 1024, 1024, kb, scr, lane, a.mix_norm + (size_t)(3 * mat) * DM); continue; } \
            r -= 2 * I_AI; \
            if (r < 2 * I_SQ) { const int mat = r / I_SQ; r %= I_SQ; const int kb = r / 32, nb = r % 32; \
                transpose_item(a.a_w_out + (size_t)mat * 1024 * 1024 + 32 * nb, 1024, WAO + (size_t)mat * 1024 * 1024 + (size_t)nb * 32 * 1024, 1024, kb, scr, lane); continue; } \
            r -= 2 * I_SQ; \
            if (r < I_BI) { const int kb = r / 64, nb = r % 64, pn = nb >> 3, q = nb & 7; \
                const int scol = (q < 4) ? 128 * pn + 32 * q : 1024 + 128 * pn + 32 * (q - 4); \
                transpose_item(a.b_w_in + scol, 2048, WBI + (size_t)nb * 32 * 1024, 1024, kb, scr, lane, a.mix_norm + (size_t)1 * DM); continue; } \
            r -= I_BI; \
            if (r < I_SQ) { const int kb = r / 32, nb = r % 32; \
                transpose_item(a.b_w_out + 32 * nb, 1024, WBO + (size_t)nb * 32 * 1024, 1024, kb, scr, lane); continue; } \
            r -= I_SQ; \
            if (r < I_CI) { const int kb = r / 96, nb = r % 96, pn = nb >> 3, q = nb & 7; \
                const int scol = (pn < 8) ? (pn >> 2) * 1024 + 64 * (4 * (pn & 3) + (q & 3)) + 32 * (q >> 2) : 2048 + (nb - 64) * 32; \
                transpose_item(a.c_w_in + scol, 3088, WCI + (size_t)nb * 32 * 1024, 1024, kb, scr, lane, a.mix_norm + (size_t)2 * DM); continue; } \
            r -= I_CI; \
            { const int kb = r / 32, nb = r % 32; \
                transpose_item(a.c_w_out + 32 * nb, 1024, WCO + (size_t)nb * 32 * 1024, 1024, kb, scr, lane); }

__device__ __forceinline__ void thin_gemm(LAS unsigned char* ldsl, const int tid, const int task, const bf16* A, const bf16* Bt, const int K, const int mode,
                                          bf16* R0, bf16* R1, bf16* R2, float* hmeta, const float scale, const float* qg, const float* kg, float* SSQM, bf16* HB) {
    const int ntasks = (mode == 0) ? 176 : (mode == 2) ? 128 : (mode == 3) ? 48 : 64;
    if (task < 0 || task >= ntasks) return;
    v2u ho_pre = {0u, 0u}; if (mode == 4) ho_pre = *(const GAS v2u*)(HB + (size_t)(MMAIN + (tid & 15)) * 1024 + 16 * task + 4 * ((tid & 63) >> 4));
    float rsm_t = 0.f;
    if (mode != 4) {
#pragma unroll
        for (int i = 0; i < 16; ++i) { const f32x4 q4 = *(const GAS f32x4*)(SSQM + (tid & 15) * 64 + 4 * i); rsm_t += (q4.x + q4.y) + (q4.z + q4.w); } }
    const int lane = tid & 63, wave = __builtin_amdgcn_readfirstlane(tid >> 6), fr = lane & 15, fq = lane >> 4;
    int nt = 1, b0 = 0, b1 = 0, b2 = 0, b3 = 0;
    if (mode <= 1 || (mode == 2 && task < 64)) { const int f0 = 16 * task; b0 = 256 * (f0 >> 7) + (f0 & 127); b1 = b0 + 128; nt = 2; }
    else if (mode == 2) { b0 = 2048 + 16 * (task - 64); }
    else if (mode == 3) { const int sec = task >> 4, hd = task & 15; nt = 4;
        if (sec < 2) { b0 = 256 * (sec * 4 + (hd >> 2)) + 32 * (hd & 3); b1 = b0 + 16; b2 = b0 + 128; b3 = b0 + 144; }
        else { b0 = 2048 + 64 * hd; b1 = b0 + 16; b2 = b0 + 32; b3 = b0 + 48; } }
    else { b0 = 16 * task; }
    const int kw = K >> 3, ksteps = kw >> 5;
    const GAS bf16x8* ap = (const GAS bf16x8*)(A + (size_t)(MMAIN + fr) * K + wave * kw + 8 * fq);
    const GAS bf16x8* p0 = (const GAS bf16x8*)(Bt + (size_t)(b0 + fr) * K + wave * kw + 8 * fq);
    const GAS bf16x8* p1 = (const GAS bf16x8*)(Bt + (size_t)(b1 + fr) * K + wave * kw + 8 * fq);
    const GAS bf16x8* p2 = (const GAS bf16x8*)(Bt + (size_t)(b2 + fr) * K + wave * kw + 8 * fq);
    const GAS bf16x8* p3 = (const GAS bf16x8*)(Bt + (size_t)(b3 + fr) * K + wave * kw + 8 * fq);
    f32x4 c0 = {0.f, 0.f, 0.f, 0.f}, c1 = c0, c2 = c0, c3 = c0;
    if (ksteps > 4) {
        bf16x8 xa[11], wb[11];
#pragma unroll
        for (int ks = 0; ks < 11; ++ks) { xa[ks] = ap[4 * ks]; wb[ks] = p0[4 * ks]; }
#pragma unroll
        for (int ks = 0; ks < 11; ++ks) c0 = __builtin_amdgcn_mfma_f32_16x16x32_bf16(wb[ks], xa[ks], c0, 0, 0, 0);
    } else {
#pragma unroll 4
    for (int ks = 0; ks < ksteps; ++ks) {
        const bf16x8 xa = ap[4 * ks];
        c0 = __builtin_amdgcn_mfma_f32_16x16x32_bf16(p0[4 * ks], xa, c0, 0, 0, 0);
        if (nt >= 2) c1 = __builtin_amdgcn_mfma_f32_16x16x32_bf16(p1[4 * ks], xa, c1, 0, 0, 0);
        if (nt >= 4) { c2 = __builtin_amdgcn_mfma_f32_16x16x32_bf16(p2[4 * ks], xa, c2, 0, 0, 0); c3 = __builtin_amdgcn_mfma_f32_16x16x32_bf16(p3[4 * ks], xa, c3, 0, 0, 0); }
    }
    }
    LAS f32x4* P = (LAS f32x4*)ldsl;
    P[(wave * 4 + 0) * 64 + lane] = c0; P[(wave * 4 + 1) * 64 + lane] = c1; P[(wave * 4 + 2) * 64 + lane] = c2; P[(wave * 4 + 3) * 64 + lane] = c3;
    __syncthreads();
    if (wave == 0) {
#pragma unroll
        for (int w = 1; w < 8; ++w) { c0 += P[(w * 4 + 0) * 64 + lane]; c1 += P[(w * 4 + 1) * 64 + lane]; c2 += P[(w * 4 + 2) * 64 + lane]; c3 += P[(w * 4 + 3) * 64 + lane]; }
        const size_t mrow = (size_t)(MMAIN + fr);
        if (mode != 4) { const float rsm = __builtin_amdgcn_rsqf(rsm_t * (1.f / DM) + EPS); c0 *= rsm; c1 *= rsm; c2 *= rsm; c3 *= rsm; }
        if (mode <= 1 || (mode == 2 && task < 64)) {
            f32x4 r;
            if (mode == 0) {
#pragma unroll
                for (int i = 0; i < 4; ++i) r[i] = c0[i] * pg8::sigm(c0[i]) * c1[i];
            } else if (mode == 1) {
#pragma unroll
                for (int i = 0; i < 4; ++i) r[i] = c0[i] * pg8::sigm(c1[i]);
            } else r = c0 * c1;
            *(GAS v2u*)(R0 + mrow * (mode == 0 ? FF : 1024) + 16 * task + 4 * fq) = (v2u){pk2(r[0], r[1]), pk2(r[2], r[3])};
        } else if (mode == 2) {
            *(GAS v2u*)(R1 + mrow * 1024 + 16 * (task - 64) + 4 * fq) = (v2u){pk2(c0[0], c0[1]), pk2(c0[2], c0[3])};
        } else if (mode == 3) {
            const int sec = task >> 4, hd = task & 15;
            f32x4 v0 = c0, v1 = c1, v2 = c2, v3 = c3;
            if (sec < 2) {
                float ss = (c0[0] * c0[0] + c0[1] * c0[1]) + (c0[2] * c0[2] + c0[3] * c0[3]) + (c1[0] * c1[0] + c1[1] * c1[1]) + (c1[2] * c1[2] + c1[3] * c1[3])
                         + (c2[0] * c2[0] + c2[1] * c2[1]) + (c2[2] * c2[2] + c2[3] * c2[3]) + (c3[0] * c3[0] + c3[1] * c3[1]) + (c3[2] * c3[2] + c3[3] * c3[3]);
                ss += lane_get(ss, lane ^ 16); ss += lane_get(ss, lane ^ 32);
                const float rs = __builtin_amdgcn_rsqf(ss * (1.0f / 64.0f) + EPS) * ((sec == 0) ? pg8::QK_C2 : 1.0f);
                const float* g = (sec == 0) ? qg : kg;
                v0 = c0 * rs * *(const GAS f32x4*)(g + 4 * fq); v1 = c1 * rs * *(const GAS f32x4*)(g + 16 + 4 * fq); v2 = c2 * rs * *(const GAS f32x4*)(g + 32 + 4 * fq); v3 = c3 * rs * *(const GAS f32x4*)(g + 48 + 4 * fq);
            }
            const v2u w0 = {pk2(v0[0], v0[1]), pk2(v0[2], v0[3])}, w1 = {pk2(v1[0], v1[1]), pk2(v1[2], v1[3])}, w2 = {pk2(v2[0], v2[1]), pk2(v2[2], v2[3])}, w3 = {pk2(v3[0], v3[1]), pk2(v3[2], v3[3])};
            const int col = 64 * hd + 4 * fq;
            if (sec == 0) { bf16* q = R0 + mrow * 1024 + col; *(GAS v2u*)q = w0; *(GAS v2u*)(q + 16) = w1; *(GAS v2u*)(q + 32) = w2; *(GAS v2u*)(q + 48) = w3; }
            else { bf16* T = (sec == 1) ? R1 : R2;
#pragma unroll
                for (int b = 0; b < 2; ++b) { bf16* q = T + (size_t)(b * KVROWS + 48 + fr) * 1024 + col; *(GAS v2u*)q = w0; *(GAS v2u*)(q + 16) = w1; *(GAS v2u*)(q + 32) = w2; *(GAS v2u*)(q + 48) = w3; } }
        } else {
            const v2u ho = ho_pre;
            const f32x4 hn = (f32x4){bflo(ho.x), bfhi(ho.x), bflo(ho.y), bfhi(ho.y)} + c0 * scale;
            *(GAS v2u*)(HB + mrow * 1024 + 16 * task + 4 * fq) = (v2u){pk2(hn[0], hn[1]), pk2(hn[2], hn[3])};
            float ps = (hn[0] * hn[0] + hn[1] * hn[1]) + (hn[2] * hn[2] + hn[3] * hn[3]); ps += lane_get(ps, lane ^ 16); ps += lane_get(ps, lane ^ 32);
            if (fq == 0) SSQM[fr * 64 + task] = ps;
        }
    }
    __syncthreads();
}

__global__ void __launch_bounds__(NWAVES * 64, 2) fwd_megakernel(Args a_unused) {
    extern __shared__ __attribute__((aligned(16))) unsigned char lds[];
    cg::grid_group grid = cg::this_grid();
    const int G = gridDim.x, bx = blockIdx.x;
    const int vcu0 = (G % 8 == 0) ? (bx % 8) * (G / 8) + bx / 8 : bx;
    const int NGW = G * NWAVES;
    if (threadIdx.x < 64) ((LAS unsigned*)((LAS unsigned char*)lds + RING_BYTES))[threadIdx.x * 2] = 0u, ((LAS unsigned*)((LAS unsigned char*)lds + RING_BYTES))[threadIdx.x * 2 + 1] = 0u;
    __syncthreads();
    const int wave_s = __builtin_amdgcn_readfirstlane((int)threadIdx.x >> 6);
#define PHASE_ENV() \
    const __attribute__((address_space(4))) Args* kap_ = (const __attribute__((address_space(4))) Args*)__builtin_amdgcn_kernarg_segment_ptr(); asm volatile("" : "+s"(kap_)); \
    const __attribute__((address_space(4))) Args& a = *kap_;     \
    unsigned zero_ = 0u; asm volatile("" : "+s"(zero_)); int vcu = vcu0; asm volatile("" : "+s"(vcu)); \
    int tid = (wave_s << 6) | (int)__builtin_amdgcn_mbcnt_hi(~0u, __builtin_amdgcn_mbcnt_lo(~0u, zero_)); \
    const int lane = tid & 63, wave = __builtin_amdgcn_readfirstlane(tid >> 6), gw = vcu * NWAVES + wave; \
    unsigned char* ws0_ = a.ws; asm volatile("" : "+s"(ws0_)); unsigned char* const ws = (unsigned char*)(GAS unsigned char*)ws0_;     \
    float* hm0_ = a.out; asm volatile("" : "+s"(hm0_)); float* const hmain = (float*)(GAS float*)hm0_; \
    bf16* const WGU = (bf16*)(ws + WS_WGU); bf16* const WDN = (bf16*)(ws + WS_WDN); \
    bf16* const WAI = (bf16*)(ws + WS_WAI); bf16* const WAO = (bf16*)(ws + WS_WAO); bf16* const WBI = (bf16*)(ws + WS_WBI); bf16* const WBO = (bf16*)(ws + WS_WBO); \
    bf16* const WCI = (bf16*)(ws + WS_WCI); bf16* const WCO = (bf16*)(ws + WS_WCO); bf16* const WFt = (bf16*)(ws + WS_WF); \
    bf16* const XN = (bf16*)(ws + WS_XN); \
    bf16* const R0 = (bf16*)(ws + WS_ACT); bf16* const R1 = (bf16*)(ws + WS_ACT + SZ_ROWBUF); bf16* const R2 = (bf16*)(ws + WS_ACT + 2 * SZ_ROWBUF); \
    float* const hmeta = (float*)(ws + WS_HMETA); \
    float* const LF = (float*)(ws + WS_LF); float* const LFM = (float*)(ws + WS_LFM); float* const CS = (float*)(ws + WS_CS); \
    float* const SSQ = (float*)(ws + WS_SSQ); float* const SSQM = (float*)(ws + WS_SSQM); (void)SSQ; (void)SSQM; \
    LAS unsigned char* const ldsl = (LAS unsigned char*)lds; \
    (void)WGU; (void)WDN; (void)WAI; (void)WAO; (void)WBI; (void)WBO; (void)WCI; (void)WCO; (void)WFt; (void)XN; (void)R0; (void)R1; (void)R2; (void)hmeta; (void)LF; (void)LFM; (void)CS; (void)ldsl; (void)lane; (void)gw; (void)hmain;

#ifdef PROBE_SEL
    LAS unsigned long long* const TS = (LAS unsigned long long*)((LAS unsigned char*)lds + RING_BYTES + 12288);
    if (threadIdx.x == 0) { for (int c = 0; c < 8; ++c) TS[c] = 0; TS[8] = __builtin_amdgcn_s_memrealtime(); }
#endif
    XcdBarrier bar;
    { PHASE_ENV(); bar = xcd_barrier_post((unsigned*)(ws + WS_CTL), (volatile LAS unsigned*)(ldsl + MISC_OFF) + 8, tid); }
    {
        PHASE_ENV();
        LAS float* scr = (LAS float*)(ldsl + wave * 16384);
        for (int v = gw; v < conv_nv(0); v += NGW) { const int it = conv_item(0, v);
            CONVERT_BODY
        }
        for (int i = gw * 64 + lane; i < 16 * 1024; i += NGW * 64) { const int h = i >> 10, k = i & 1023; WFt[i] = (bf16)f2bf(a.c_w_in[(size_t)k * 3088 + 3072 + h] * a.mix_norm[2 * DM + k]); }
        for (int m0 = gw; m0 < MROWS; m0 += 2 * NGW) {
            const int m1 = m0 + NGW; const bool has1 = (m1 < MROWS);
            const float* s0 = (m0 < MMAIN) ? a.x + (size_t)m0 * DM : a.meta + (size_t)(m0 - MMAIN) * DM;
            const float* s1 = !has1 ? s0 : (m1 < MMAIN) ? a.x + (size_t)m1 * DM : a.meta + (size_t)(m1 - MMAIN) * DM;
            f32x4 va[4], vb[4];
#pragma unroll
            for (int j = 0; j < 4; ++j) { va[j] = ((const GAS f32x4*)s0 + lane)[64 * j]; vb[j] = ((const GAS f32x4*)s1 + lane)[64 * j]; }
#pragma unroll
            for (int half = 0; half < 2; ++half) {
                if (half == 1 && !has1) break;
                const int m = half ? m1 : m0; float ssl = 0.f;
                GAS unsigned long long* o8 = (GAS unsigned long long*)(XN + (size_t)m * DM) + lane;
#pragma unroll
                for (int j = 0; j < 4; ++j) { const f32x4 v = half ? vb[j] : va[j]; ssl += (v.x * v.x + v.y * v.y) + (v.z * v.z + v.w * v.w);
                    o8[64 * j] = (unsigned long long)pk2(v.x, v.y) | ((unsigned long long)pk2(v.z, v.w) << 32); }
                const float ss = wave_sum(ssl, lane);
                if (m < MMAIN) { if (lane < 4) SSQ[(size_t)m * 4 + lane] = (lane == 0) ? ss : 0.f; } else SSQM[(m - MMAIN) * 64 + lane] = (lane == 0) ? ss : 0.f;
            }
        }
    }
    { PHASE_ENV(); if (ws == nullptr) grid.sync();
      xcd_barrier(bar, tid); }
#ifdef PROBE_SEL
    { PHASE_ENV(); if (tid == 0) { TS[9] = __builtin_amdgcn_s_memrealtime(); TS[0] = TS[9] - TS[8]; } }
#endif
    for (int L = 0; L < DEPTH; ++L) {
        const int mx = L % 3, mj = L / 3;
        for (int s = 0; s <= 10; ++s) {
            if ((s == 6 && mx != 2) || (s == 5 && mx == 2) || s == 0 || s == 3 || s == 8) continue;
#ifdef PROBE_REP
            const int pcat = (s == 1 || s == 9) ? 1 : (s == 2 || s == 10 || s == 7) ? 2 : (s == 4) ? 4 : (s == 5) ? 8 : 16; const int nrep = (PROBE_REP & pcat) ? 2 : 1;
#else
            const int nrep = 1;
#endif
            for (int rp = 0; rp < nrep; ++rp) {
            const bool dry = (rp + 1 < nrep); (void)dry;
            PHASE_ENV();
            if (s == 0 || s == 3 || s == 8) {
                continue;
            } else if (s == 1 || s == 2 || s == 4 || s == 7 || s == 9 || s == 10) {
                pg8::Gemm g; pg8::EpiAll E;
                E.mtiles_main = 64; E.O1 = R0; E.O2 = R1; E.O3 = R2; E.ldo = 1024; E.hmain = hmain; E.hmeta = hmeta; E.scale = 1.f; E.qg = a.c_q_norm; E.kg = a.c_k_norm; E.mode = 0;
                E.ssq = SSQ; E.ssq_out = SSQ; E.hb = XN; E.fout = (L == DEPTH - 1 && s == 10 && !dry) ? hmain : nullptr; E.ldsp = (LAS float*)(ldsl + RING_BYTES + 1024); E.rsl = (const LAS float*)(ldsl + RING_BYTES + 5120);
                g.M = MMAIN;
                if (s == 1 || s == 9) { g.A = XN; g.Bt = WGU + (size_t)(L * 2 + (s == 9)) * 5632 * 1024; g.N = 5632; g.K = 1024; E.mode = 0; E.ldo = FF; }
                else if (s == 2 || s == 10) { g.A = R0; g.Bt = WDN + (size_t)(L * 2 + (s == 10)) * 1024 * FF; g.N = 1024; g.K = FF; E.mode = 4; E.scale = dry ? 0.f : 0.5f; }
                else if (s == 4) {
                    g.A = XN; g.K = 1024;
                    if (mx == 0) { g.Bt = WAI + (size_t)mj * 3072 * 1024; g.N = 3072; E.mode = 2; }
                    else if (mx == 1) { g.Bt = WBI; g.N = 2048; E.mode = 1; }
                    else { g.Bt = WCI; g.N = 3072; E.mode = 3;
                    for (int i = gw; i < 2 * 2 * 112; i += NGW) { const int tsel = i / 224, rr = i % 224, b = rr / 112, j = rr % 112; const int row = b * KVROWS + (j < 48 ? j : j + 16);
                        bf16* p = (tsel ? R2 : R1) + (size_t)row * 1024; ((GAS v4u*)p)[lane * 2] = (v4u){zero_, zero_, zero_, zero_}; ((GAS v4u*)p)[lane * 2 + 1] = (v4u){zero_, zero_, zero_, zero_}; }
                        const int fr = lane & 15, fq = lane >> 4;
                        for (int grp = gw; grp < MROWS / 16; grp += NGW) {
                            const bf16* xp = XN + (size_t)(16 * grp + fr) * DM + 8 * fq; const bf16* wp = WFt + (size_t)fr * DM + 8 * fq;
                            f32x4 acc = {0.f, 0.f, 0.f, 0.f};
#pragma unroll 16
                            for (int k = 0; k < 32; ++k) { const bf16x8 xa = *(const GAS bf16x8*)(xp + 32 * k), wb = *(const GAS bf16x8*)(wp + 32 * k);
                                acc = __builtin_amdgcn_mfma_f32_16x16x32_bf16(xa, wb, acc, 0, 0, 0); }
                            const float bf = a.c_b_f[fr]; f32x4 o; float rsr[4];
                            if (grp < MMAIN / 16) {
#pragma unroll
                                for (int r = 0; r < 4; ++r) { const f32x4 q4 = *(const GAS f32x4*)(SSQ + (size_t)(16 * grp + 4 * fq + r) * 4); rsr[r] = __builtin_amdgcn_rsqf(((q4.x + q4.y) + (q4.z + q4.w)) * (1.f / DM) + EPS); }
                            } else {
#pragma unroll
                                for (int r = 0; r < 4; ++r) { float t = 0.f; for (int i = 0; i < 16; ++i) { const f32x4 q4 = *(const GAS f32x4*)(SSQM + (4 * fq + r) * 64 + 4 * i); t += (q4.x + q4.y) + (q4.z + q4.w); } rsr[r] = __builtin_amdgcn_rsqf(t * (1.f / DM) + EPS); }
                            }
#pragma unroll
                            for (int r = 0; r < 4; ++r) { const float xv = acc[r] * rsr[r] + bf; o[r] = fminf(xv, 0.f) - log1pf(expf(-fabsf(xv))); }
                            if (grp < MMAIN / 16) { const int r0 = 16 * grp, b = r0 >> 13, t0 = r0 & 8191; *(GAS f32x4*)(LF + ((size_t)(b * NH + fr) * SEQ + t0 + 4 * fq)) = o; }
                            else *(GAS f32x4*)(LFM + fr * 16 + 4 * fq) = o;
                        }
                        asm volatile("s_waitcnt vmcnt(0) lgkmcnt(0)" ::: "memory"); __syncthreads();
                    }
                }
                else { g.K = 1024; g.N = 1024; E.mode = 4; E.scale = dry ? 0.f : 1.f;
                    if (mx == 0) { g.A = R2; g.Bt = WAO + (size_t)mj * 1024 * 1024; } else if (mx == 1) { g.A = R1; g.Bt = WBO; } else { g.A = R0; g.Bt = WCO; } }
                pg8::StaticOrder S; S.init(g.M, g.N, G, bx);
                f32x4 rs_q[3] = {{0.f, 0.f, 0.f, 0.f}, {0.f, 0.f, 0.f, 0.f}, {0.f, 0.f, 0.f, 0.f}}; bool rs_has[3] = {false, false, false};
                if (E.mode != 4) { pg8::Unit uu{0, 0};
#pragma unroll
                    for (int j = 0; j < 3; ++j) { const int i = (tid >> 8) + 2 * j; rs_has[j] = S.next(i, uu); if (rs_has[j]) rs_q[j] = *(const GAS f32x4*)(SSQ + (size_t)(uu.pm * 256 + (tid & 255)) * 4); } }
                for (int rep2 = 0; rep2 < 2; ++rep2) { const int task = (E.mode == 0) ? ((bx >= 128) ? bx - 128 + 128 * rep2 : -1) : (rep2 == 0 ? vcu : -1);
                    thin_gemm(ldsl, tid, task, g.A, g.Bt, g.K, E.mode, R0, R1, R2, hmeta, E.scale, a.c_q_norm, a.c_k_norm, SSQM, XN); }
                if (E.mode != 4) {
                    LAS float* rsl = (LAS float*)(ldsl + RING_BYTES + 5120);
#pragma unroll
                    for (int j = 0; j < 3; ++j) { const int i = (tid >> 8) + 2 * j; if (rs_has[j]) rsl[i * 256 + (tid & 255)] = __builtin_amdgcn_rsqf(((rs_q[j].x + rs_q[j].y) + (rs_q[j].z + rs_q[j].w)) * (1.f / DM) + EPS); }
                }
#ifndef NO_GEMM
                pg8::gemm_phase<pg8::EpiAll, pg8::StaticOrder, PG8_ALIGN, PG8_SP2>(ldsl, g, S, E, tid);
#endif
                if ((s == 1 || s == 9) && L + 1 < DEPTH && bx >= 128 && !dry) {
                    LAS float* scr = (LAS float*)(ldsl + wave * 16384);
                    const int nv = conv_nv(L + 1), lo = (s == 1) ? 0 : nv / 2, hi = (s == 1) ? nv / 2 : nv;
                    for (int v = lo + (bx - 128) * NWAVES + wave; v < hi; v += 128 * NWAVES) { const int it = conv_item(L + 1, v);
                        CONVERT_BODY
                    }
                }
                if (E.mode == 4) {
                    const int pm0 = 8 * (bx & 7) + ((bx >> 3) & 7), pn0 = bx >> 6;
                    if (G == 256 && tid < 256) { const f32x4 p4 = *(const LAS f32x4*)(E.ldsp + tid * 4); SSQ[(size_t)(pm0 * 256 + tid) * 4 + pn0] = (p4.x + p4.y) + (p4.z + p4.w); }
                }
            } else if (s == 5) {
                if (mx == 0) {
                    const float* cw = a.a_conv + (size_t)mj * 3 * DM + 16 * lane;
                    f32x4 w0[4], w1[4], w2[4];
#pragma unroll
                    for (int j = 0; j < 4; ++j) { w0[j] = *(const f32x4*)(cw + 4 * j); w1[j] = *(const f32x4*)(cw + DM + 4 * j); w2[j] = *(const f32x4*)(cw + 2 * DM + 4 * j); }
                    for (int blk = gw; blk < MROWS / 4; blk += NGW) {
                        const bool mainb = (blk < MMAIN / 4); const int r0 = mainb ? 4 * blk : MMAIN + 4 * (blk - MMAIN / 4);
                        int rm1, rm2;
                        if (mainb) { const int t0 = r0 & 8191; rm1 = (t0 >= 1) ? r0 - 1 : MMAIN + 15; rm2 = (t0 >= 2) ? r0 - 2 : MMAIN + 14; }
                        else { const int p0 = r0 - MMAIN; rm1 = (p0 >= 1) ? r0 - 1 : -1; rm2 = (p0 >= 2) ? r0 - 2 : -1; }
                        const v4u z4 = {0u, 0u, 0u, 0u};
                        v4u xw[6][2], bb[4][2];
#pragma unroll
                        for (int hh = 0; hh < 2; ++hh) {
                            xw[0][hh] = (rm2 >= 0) ? ((const GAS v4u*)(R0 + (size_t)rm2 * DM) + 2 * lane)[hh] : z4; xw[1][hh] = (rm1 >= 0) ? ((const GAS v4u*)(R0 + (size_t)rm1 * DM) + 2 * lane)[hh] : z4;
#pragma unroll
                            for (int i = 0; i < 4; ++i) { xw[2 + i][hh] = ((const GAS v4u*)(R0 + (size_t)(r0 + i) * DM) + 2 * lane)[hh]; bb[i][hh] = ((const GAS v4u*)(R1 + (size_t)(r0 + i) * DM) + 2 * lane)[hh]; } }
#pragma unroll
                        for (int i = 0; i < 4; ++i) { GAS v4u* yp = (GAS v4u*)(R2 + (size_t)(r0 + i) * DM) + 2 * lane;
#pragma unroll
                            for (int hh = 0; hh < 2; ++hh) { v4u o;
#pragma unroll
                                for (int e = 0; e < 4; ++e) { const int j = 2 * hh + (e >> 1), c = 2 * (e & 1);
                                    const float lo = bflo(bb[i][hh][e]) * (w2[j][c] * bflo(xw[2 + i][hh][e]) + w1[j][c] * bflo(xw[1 + i][hh][e]) + w0[j][c] * bflo(xw[i][hh][e]));
                                    const float hi = bfhi(bb[i][hh][e]) * (w2[j][c + 1] * bfhi(xw[2 + i][hh][e]) + w1[j][c + 1] * bfhi(xw[1 + i][hh][e]) + w0[j][c + 1] * bfhi(xw[i][hh][e]));
                                    o[e] = pk2(lo, hi); }
                                yp[hh] = o; } }
                    }
                } else if (mx == 1) {
#ifndef NO_CONF
                    const int c = 2 * tid;
                    f32x2 w[31];
#pragma unroll
                    for (int k = 0; k < 31; ++k) w[k] = *(const GAS f32x2*)(a.b_conv + (size_t)k * DM + c);
                    const f32x2 cb = *(const f32x2*)(a.b_conv_bias + c), lg = *(const f32x2*)(a.b_ln_g + c), lb = *(const f32x2*)(a.b_ln_b + c);
                    LAS float* red = (LAS float*)ldsl;
                    LAS float* red2 = red + 256;
                    for (int un = vcu; un < MROWS / 16; un += G) {
                        const int r0 = 16 * un; const bool meta = (r0 >= MMAIN);
                        const int p0 = meta ? 0 : 16 + (r0 & 8191); const int rowb = meta ? 0 : (r0 >> 13) * SEQ;
                        unsigned xin[46];
#pragma unroll
                        for (int j = 0; j < 46; ++j) { const int pj = p0 - 30 + j;
                            xin[j] = (pj >= 0) ? *(const GAS unsigned*)(R0 + (size_t)((pj < 16) ? MMAIN + pj : rowb + pj - 16) * DM + c) : 0u; }
                        f32x2 acc[16];
#pragma unroll
                        for (int i = 0; i < 16; ++i) acc[i] = cb;
#pragma unroll
                        for (int j = 0; j < 46; ++j) { const f32x2 xv = {bflo(xin[j]), bfhi(xin[j])};
#pragma unroll
                            for (int i = 0; i < 16; ++i) { const int k = j - i; if (k >= 0 && k <= 30) acc[i] += w[k] * xv; } }
                        float st[32];
#pragma unroll
                        for (int i = 0; i < 16; ++i) { st[2 * i] = acc[i].x + acc[i].y; st[2 * i + 1] = acc[i].x * acc[i].x + acc[i].y * acc[i].y; }
#pragma unroll
                        for (int i = 0; i < 32; ++i) st[i] = wave_sum(st[i], lane);
                        if (lane == 0) {
#pragma unroll
                            for (int i = 0; i < 8; ++i) *(LAS f32x4*)(red + wave * 32 + 4 * i) = (f32x4){st[4 * i], st[4 * i + 1], st[4 * i + 2], st[4 * i + 3]}; }
                        __syncthreads();
                        if (tid < 32) { float t = 0.f;
#pragma unroll
                            for (int wv = 0; wv < 8; ++wv) t += red[wv * 32 + tid];
                            red2[tid] = t; }
                        __syncthreads();
#pragma unroll
                        for (int i = 0; i < 16; ++i) { const f32x2 sv = *(const LAS f32x2*)(red2 + 2 * i);
                            const float mu = sv.x * (1.f / DM), var = fmaxf(sv.y * (1.f / DM) - mu * mu, 0.f), rs = 1.0f / sqrtf(var + EPS);
                            const float y0 = (acc[i].x - mu) * rs * lg.x + lb.x, y1 = (acc[i].y - mu) * rs * lg.y + lb.y;
                            *(GAS unsigned*)(R1 + (size_t)(r0 + i) * DM + c) = pk2(y0 * pg8::sigm(y0), y1 * pg8::sigm(y1)); }
                    }
#endif
                } else {
                }
            } else if (s == 6) {
                {
                        const int bh = vcu >> 3, h = bh & 15; LAS float* wt = (LAS float*)ldsl;
                        LAS float* csrow = (LAS float*)(ldsl + attn_body::LDS_CS);
                        float cm = 0.f, cmp = 0.f;
#pragma unroll
                        for (int j = 0; j < 16; ++j) { cm += LFM[h * 16 + j]; if (j == tid) cmp = cm; }
                        const float* lp = LF + (size_t)bh * SEQ + 16 * tid; float v[16];
#pragma unroll
                        for (int j = 0; j < 4; ++j) { const f32x4 q = *(const GAS f32x4*)(lp + 4 * j); v[4 * j] = q.x; v[4 * j + 1] = q.y; v[4 * j + 2] = q.z; v[4 * j + 3] = q.w; }
#pragma unroll
                        for (int j = 1; j < 16; ++j) v[j] += v[j - 1];
                        float inc = v[15];
#pragma unroll
                        for (int o = 1; o < 64; o <<= 1) { const float t = lane_get(inc, (lane - o) & 63); if (lane >= o) inc += t; }
                        if (lane == 63) wt[wave] = inc;
                        __syncthreads();
                        float off = cm + inc - v[15];
                        for (int wv = 0; wv < wave; ++wv) off += wt[wv];
#pragma unroll
                        for (int j = 0; j < 4; ++j) *(LAS f32x4*)(csrow + 128 + 16 * tid + 4 * j) = (f32x4){(off + v[4 * j]) * LOG2E, (off + v[4 * j + 1]) * LOG2E, (off + v[4 * j + 2]) * LOG2E, (off + v[4 * j + 3]) * LOG2E};
                        const float cmsh = lane_get(cmp, (lane + 16) & 63);
                        if (tid < 128) csrow[tid] = (tid >= 48 && tid < 64) ? cmsh * LOG2E : __builtin_inff();
                        __syncthreads();
                }
                const attn_body::AttnTensors AT{(const attn_body::bf16*)R0, (const attn_body::bf16*)R1, (const attn_body::bf16*)R2, (attn_body::bf16*)(dry ? (bf16*)(ws + WS_END) : R0), CS};
                const attn_body::StaticOrder S(G, bx);
#ifndef NO_ATTN
                attn_body::attn_phase<attn_body::StaticOrder>((char*)lds, AT, S, tid);
#endif
                }
                if (s == 6 && !dry) {
                PHASE_ENV();
                if (gw < NH) {
                    const int h = gw, q = lane & 15, dc = lane >> 4;
                    const bf16* qp = R0 + (size_t)(MMAIN + q) * DM + 64 * h + 16 * dc;
                    const v4u qa = ((const GAS v4u*)qp)[0], qb = ((const GAS v4u*)qp)[1];
                    float qv[16];
#pragma unroll
                    for (int e = 0; e < 4; ++e) { qv[2 * e] = bflo(qa[e]); qv[2 * e + 1] = bfhi(qa[e]); qv[8 + 2 * e] = bflo(qb[e]); qv[8 + 2 * e + 1] = bfhi(qb[e]); }
                    float sc[16], cbm[16]; { float run = 0.f;
#pragma unroll
                        for (int j = 0; j < 16; ++j) { run += *(const GAS float*)(LFM + h * 16 + j); cbm[j] = run * LOG2E; } }
#pragma unroll
                    for (int jb = 0; jb < 16; jb += 8) {
                        v4u ka[8], kb[8]; float cb[8];
#pragma unroll
                        for (int j = 0; j < 8; ++j) { const bf16* kp = R1 + (size_t)(48 + jb + j) * DM + 64 * h + 16 * dc; ka[j] = ((const GAS v4u*)kp)[0]; kb[j] = ((const GAS v4u*)kp)[1];
                            cb[j] = cbm[jb + j]; }
#pragma unroll
                        for (int j = 0; j < 8; ++j) { float d = 0.f;
#pragma unroll
                            for (int e = 0; e < 4; ++e) d += qv[2 * e] * bflo(ka[j][e]) + qv[2 * e + 1] * bfhi(ka[j][e]) + qv[8 + 2 * e] * bflo(kb[j][e]) + qv[8 + 2 * e + 1] * bfhi(kb[j][e]);
                            d += lane_get(d, lane ^ 16); d += lane_get(d, lane ^ 32);
                            sc[jb + j] = (jb + j <= q) ? d - cb[j] : -__builtin_inff(); }
                    }
                    float mrun = sc[0];
#pragma unroll
                    for (int j = 1; j < 16; ++j) mrun = fmaxf(mrun, sc[j]);
                    float l = 0.f, o[16];
#pragma unroll
                    for (int e = 0; e < 16; ++e) o[e] = 0.f;
#pragma unroll
                    for (int jb = 0; jb < 16; jb += 8) {
                        v4u va[8], vb[8];
#pragma unroll
                        for (int j = 0; j < 8; ++j) { const bf16* vp = R2 + (size_t)(48 + jb + j) * DM + 64 * h + 16 * dc; va[j] = ((const GAS v4u*)vp)[0]; vb[j] = ((const GAS v4u*)vp)[1]; }
#pragma unroll
                        for (int j = 0; j < 8; ++j) { const float p = __builtin_amdgcn_exp2f(sc[jb + j] - mrun); l += p;
#pragma unroll
                            for (int e = 0; e < 4; ++e) { o[2 * e] += p * bflo(va[j][e]); o[2 * e + 1] += p * bfhi(va[j][e]); o[8 + 2 * e] += p * bflo(vb[j][e]); o[8 + 2 * e + 1] += p * bfhi(vb[j][e]); } }
                    }
                    const float rl = 1.0f / l; v4u oa, ob;
#pragma unroll
                    for (int e = 0; e < 4; ++e) { oa[e] = pk2(o[2 * e] * rl, o[2 * e + 1] * rl); ob[e] = pk2(o[8 + 2 * e] * rl, o[8 + 2 * e + 1] * rl); }
                    GAS v4u* op = (GAS v4u*)(R0 + (size_t)(MMAIN + q) * DM + 64 * h + 16 * dc); op[0] = oa; op[1] = ob;
                }
            }
            { PHASE_ENV();
            xcd_barrier(bar, tid);
#ifdef PROBE_SEL
            if (tid == 0) { const unsigned long long tn = __builtin_amdgcn_s_memrealtime(); const int cat = (s == 1 || s == 9) ? 1 : (s == 2 || s == 10) ? 2 : (s == 4) ? 3 : (s == 5) ? 4 : (s == 6) ? 5 : 6;
              TS[cat] += tn - TS[9]; TS[9] = tn; }
#endif
            }
            }
        }
    }
#ifdef PROBE_SEL
    { PHASE_ENV(); if (bx == 0 && tid == 0) { const unsigned long long t0 = __builtin_amdgcn_s_memrealtime(), span = 4ull * TS[PROBE_SEL];
        while (__builtin_amdgcn_s_memrealtime() - t0 < span) __builtin_amdgcn_s_sleep(8); } }
#endif
}

extern "C" void kernel_launch(void* const* d_in, const int* in_sizes, int n_in, void* d_out, int out_size, void* d_ws, size_t ws_size, hipStream_t stream) {
    static int grid = 0;
    if (grid == 0) {
        if (n_in != 21 || out_size != MMAIN * DM || ws_size < WS_END + SZ_ROWBUF) { fprintf(stderr, "kernel_launch: unexpected shapes (n_in %d out %d ws %zu)\n", n_in, out_size, ws_size); grid = -1; return; }
        int dev = 0, cus = 0, per_cu = 0;
        hipGetDevice(&dev); hipDeviceGetAttribute(&cus, hipDeviceAttributeMultiprocessorCount, dev);
        if (hipFuncSetAttribute((const void*)fwd_megakernel, hipFuncAttributeMaxDynamicSharedMemorySize, LDS_BYTES) != hipSuccess) { fprintf(stderr, "kernel_launch: hipFuncSetAttribute failed\n"); grid = -1; return; }
        if (hipOccupancyMaxActiveBlocksPerMultiprocessor(&per_cu, (const void*)fwd_megakernel, NWAVES * 64, LDS_BYTES) != hipSuccess || per_cu < 1) { fprintf(stderr, "kernel_launch: occupancy query says %d\n", per_cu); per_cu = 1; }
        (void)hipGetLastError();
        grid = cus * 1;
        if (grid != 256) fprintf(stderr, "kernel_launch: grid %d (expected 256)\n", grid);
    }
    if (grid < 0) return;
    if (hipMemsetAsync((char*)d_ws + WS_CTL, 0, CTL_ZERO_BYTES, stream) != hipSuccess) { fprintf(stderr, "kernel_launch: hipMemsetAsync failed\n"); return; }
    Args a{};
    const float** f = (const float**)&a;
    for (int i = 0; i < 21; ++i) f[i] = (const float*)d_in[i];
    a.out = (float*)d_out; a.ws = (unsigned char*)d_ws;
    void* args[] = {&a};
    hipError_t e = hipLaunchCooperativeKernel((const void*)fwd_megakernel, dim3(grid), dim3(NWAVES * 64), args, LDS_BYTES, stream);
    if (e != hipSuccess) fprintf(stderr, "cooperative launch failed: %s (grid %d)\n", hipGetErrorString(e), grid);
}
```

```cpp
#include <hip/hip_runtime.h>
#include <hip/hip_cooperative_groups.h>
#include <cstdio>
#include <cstdint>
namespace pg8 {
#define PG8_LAS __attribute__((address_space(3)))
typedef unsigned short bf16_t;
typedef short bf16x8 __attribute__((ext_vector_type(8)));
typedef float f32x4 __attribute__((ext_vector_type(4)));
typedef unsigned u32x4 __attribute__((ext_vector_type(4)));
constexpr int BM = 256, BK = 64, HALF = 128, HTB = HALF * BK * 2  , STAGE_BYTES = 8 * HTB, NXCD = 8, WGM = 8;

__host__ __device__ __forceinline__ int lds_byte(int r, int c) { const int st = (r >> 4) * 2 + (c >> 5), rr = r & 15, cc = c & 31, ob = rr * 64 + cc * 2; return st * 1024 + (ob ^ (((ob >> 9) & 1) << 5)); }
__host__ __device__ __forceinline__ void stage_rc(int b, int& R, int& C) { const int st = b / 1024, sb = b % 1024, swz = sb ^ (((sb >> 9) & 1) << 5); R = (st >> 1) * 16 + swz / 64; C = (st & 1) * 32 + (swz % 64) / 2; }
__host__ __device__ __forceinline__ int perm32(int rho) { const int n = rho >> 4, i = rho & 15; return 8 * (i >> 2) + 4 * n + (i & 3); }

struct Unit { int pm, pn; };
struct Gemm { const bf16_t* A; const bf16_t* Bt; int M, N, K; };

struct StaticOrder {
    int nM, nN, nwg, G, c;
    __host__ __device__ void init(int M, int N, int G_, int c_) { nM = M / BM; nN = N / BM; nwg = nM * nN; G = G_; c = c_; }
    __host__ __device__ bool next(int i, Unit& u) const {
        const long L = (long)i * G + c; if (L >= nwg) return false;
        int wgid = (int)L; { const int q = nwg / NXCD, r = nwg % NXCD, xcd = wgid % NXCD, off = wgid / NXCD; wgid = (xcd < r ? xcd * (q + 1) : r * (q + 1) + (xcd - r) * q) + off; }
        const int nig = WGM * nN, gid = wgid / nig, fm = gid * WGM, gsz = (nM - fm) < WGM ? (nM - fm) : WGM;
        u.pm = fm + ((wgid % nig) % gsz); u.pn = (wgid % nig) / gsz; return true;
    }
    __device__ __forceinline__ void a_ready(const Unit&) const {}
    __device__ __forceinline__ void done(const Unit&) const {}
};

__device__ __forceinline__ unsigned cvt_pk_bf16(float lo, float hi) { unsigned r; asm volatile("v_cvt_pk_bf16_f32 %0, %1, %2" : "=v"(r) : "v"(lo), "v"(hi)); return r; }
typedef float f32x2 __attribute__((ext_vector_type(2)));
__device__ __forceinline__ float sigm(float x) { return __builtin_amdgcn_rcpf(1.0f + __builtin_amdgcn_exp2f(-1.4426950408889634f * x)); }
constexpr float QK_C2 = 0.125f * 1.4426950408889634f;
#define PG8_GAS __attribute__((address_space(1)))
struct EpiAll {
    static constexpr bool PERM = true, AFTER_DRAIN = false;
    int mode;
    int mtiles_main;
    bf16_t* O1; bf16_t* O2; bf16_t* O3; int ldo;
    float* hmain; float* hmeta; float scale;
    const float* qg; const float* kg;
    const PG8_LAS float* rsl;
    const float* ssq;
    float* ssq_out; bf16_t* hb; float* fout; PG8_LAS float* ldsp;
    __device__ __forceinline__ void operator()(const f32x4 (&acc)[2][2][4][2], const Unit& u, int wr, int wc, int fr, int fq, int ui) const {
        const int rloc_ = wr * 64 + fr;
#define EPI_LAUNDER() int rloc = rloc_; asm volatile("" : "+v"(rloc))
#define EPI_RS() float rsv[2][4]; { const PG8_LAS float* sp_ = rsl + ui * 256 + rloc;     \
    _Pragma("unroll") for (int ai = 0; ai < 2; ++ai) _Pragma("unroll") for (int m = 0; m < 4; ++m) rsv[ai][m] = sp_[ai * HALF + m * 16]; }
        if (mode <= 1 || (mode == 2 && u.pn < 8)) {
            EPI_LAUNDER(); EPI_RS();
            bf16_t* base = O1 + (size_t)(u.pm * BM + rloc) * ldo + u.pn * HALF + wc * 32 + 8 * fq;
#pragma unroll
            for (int ai = 0; ai < 2; ++ai)
#pragma unroll
                for (int m = 0; m < 4; ++m) {
                    const float rs_ = rsv[ai][m]; const f32x4 a0 = acc[ai][0][m][0] * rs_, a1 = acc[ai][0][m][1] * rs_, b0 = acc[ai][1][m][0] * rs_, b1 = acc[ai][1][m][1] * rs_;
                    f32x4 r0, r1;
                    if (mode == 0) {
#pragma unroll
                        for (int i = 0; i < 4; ++i) { r0[i] = a0[i] * sigm(a0[i]) * b0[i]; r1[i] = a1[i] * sigm(a1[i]) * b1[i]; }
                    } else if (mode == 1) {
#pragma unroll
                        for (int i = 0; i < 4; ++i) { r0[i] = a0[i] * sigm(b0[i]); r1[i] = a1[i] * sigm(b1[i]); }
                    } else { r0 = a0 * b0; r1 = a1 * b1; }
                    u32x4 w; w.x = cvt_pk_bf16(r0[0], r0[1]); w.y = cvt_pk_bf16(r0[2], r0[3]); w.z = cvt_pk_bf16(r1[0], r1[1]); w.w = cvt_pk_bf16(r1[2], r1[3]);
                    *(PG8_GAS u32x4*)(base + (size_t)(ai * HALF + m * 16) * ldo) = w;
                }
        } else if (mode == 2) {
            EPI_LAUNDER(); EPI_RS();
            bf16_t* base = O2 + (size_t)(u.pm * BM + rloc) * 1024 + (u.pn - 8) * BM + wc * 32 + 8 * fq;
#pragma unroll
            for (int ai = 0; ai < 2; ++ai)
#pragma unroll
                for (int m = 0; m < 4; ++m)
#pragma unroll
                    for (int bj = 0; bj < 2; ++bj) {
                        const f32x4 v0 = acc[ai][bj][m][0] * rsv[ai][m], v1 = acc[ai][bj][m][1] * rsv[ai][m];
                        u32x4 w; w.x = cvt_pk_bf16(v0[0], v0[1]); w.y = cvt_pk_bf16(v0[2], v0[3]); w.z = cvt_pk_bf16(v1[0], v1[1]); w.w = cvt_pk_bf16(v1[2], v1[3]);
                        *(PG8_GAS u32x4*)(base + (size_t)(ai * HALF + m * 16) * 1024 + bj * HALF) = w;
                    }
        } else if (mode == 3) {
            EPI_LAUNDER(); EPI_RS();
            const int sec = u.pn >> 2;
            const bool meta = false;
            const long krow0 = meta ? 48 : (long)u.pm * BM + 128 * (1 + (u.pm >> 5));
            bf16_t* dst = (sec == 0) ? O1 + (size_t)(u.pm * BM) * 1024 : ((sec == 1) ? O2 : O3) + (size_t)krow0 * 1024;
            const bool dup = meta && sec != 0; const int rlim = dup ? 16 : 256;
            if (sec < 2) {
                const int head = 4 * (u.pn & 3) + wc;
                const int lxor16 = (fr + 16 * (fq ^ 1)) << 2, lxor32 = (fr + 16 * (fq ^ 2)) << 2;
                const float* g = (sec == 0) ? qg : kg; const float gs = (sec == 0) ? QK_C2 : 1.0f;
                f32x4 gv[2][2];
#pragma unroll
                for (int bj = 0; bj < 2; ++bj)
#pragma unroll
                    for (int n = 0; n < 2; ++n) gv[bj][n] = *(const PG8_GAS f32x4*)(g + 32 * bj + 8 * fq + 4 * n) * gs;
#pragma unroll
                for (int ai = 0; ai < 2; ++ai)
#pragma unroll
                    for (int m = 0; m < 4; ++m) {
                        float ss = 0.f;
#pragma unroll
                        for (int bj = 0; bj < 2; ++bj)
#pragma unroll
                            for (int n = 0; n < 2; ++n) { const f32x4 x = acc[ai][bj][m][n] * rsv[ai][m]; ss += (x[0] * x[0] + x[1] * x[1]) + (x[2] * x[2] + x[3] * x[3]); }
                        ss += __builtin_bit_cast(float, __builtin_amdgcn_ds_bpermute(lxor16, __builtin_bit_cast(int, ss))); ss += __builtin_bit_cast(float, __builtin_amdgcn_ds_bpermute(lxor32, __builtin_bit_cast(int, ss)));
                        const float rs = __builtin_amdgcn_rsqf(ss * (1.0f / 64.0f) + 1e-6f) * rsv[ai][m];
                        const int rl = rloc + ai * HALF + m * 16;
#pragma unroll
                        for (int bj = 0; bj < 2; ++bj) {
                            const f32x4 v0 = acc[ai][bj][m][0] * rs * gv[bj][0], v1 = acc[ai][bj][m][1] * rs * gv[bj][1];
                            u32x4 w; w.x = cvt_pk_bf16(v0[0], v0[1]); w.y = cvt_pk_bf16(v0[2], v0[3]); w.z = cvt_pk_bf16(v1[0], v1[1]); w.w = cvt_pk_bf16(v1[2], v1[3]);
                            const int col = 64 * head + 32 * bj + 8 * fq;
                            if (rl < rlim) { *(PG8_GAS u32x4*)(dst + (size_t)rl * 1024 + col) = w; if (dup) *(PG8_GAS u32x4*)(dst + (size_t)(8320 + rl) * 1024 + col) = w; }
                        }
                    }
            } else {
#pragma unroll
                for (int ai = 0; ai < 2; ++ai)
#pragma unroll
                    for (int m = 0; m < 4; ++m) {
                        const int rl = rloc + ai * HALF + m * 16;
#pragma unroll
                        for (int bj = 0; bj < 2; ++bj) {
                            const f32x4 v0 = acc[ai][bj][m][0] * rsv[ai][m], v1 = acc[ai][bj][m][1] * rsv[ai][m];
                            u32x4 w; w.x = cvt_pk_bf16(v0[0], v0[1]); w.y = cvt_pk_bf16(v0[2], v0[3]); w.z = cvt_pk_bf16(v1[0], v1[1]); w.w = cvt_pk_bf16(v1[2], v1[3]);
                            const int col = (u.pn - 8) * BM + bj * HALF + wc * 32 + 8 * fq;
                            if (rl < rlim) { *(PG8_GAS u32x4*)(dst + (size_t)rl * 1024 + col) = w; if (dup) *(PG8_GAS u32x4*)(dst + (size_t)(8320 + rl) * 1024 + col) = w; }
                        }
                    }
            }
        } else {
            EPI_LAUNDER();
            bf16_t* hbase = hb + (size_t)(u.pm * BM + rloc) * 1024 + u.pn * BM + wc * 32 + 8 * fq;
            float* fbase = fout ? fout + (size_t)(u.pm * BM + rloc) * 1024 + u.pn * BM + wc * 32 + 8 * fq : nullptr;
            const float sc = scale; const int lx16 = (fr + 16 * (fq ^ 1)) << 2, lx32 = (fr + 16 * (fq ^ 2)) << 2;
#pragma unroll
            for (int ai = 0; ai < 2; ++ai) {
                u32x4 hx[4][2];
#pragma unroll
                for (int m = 0; m < 4; ++m)
#pragma unroll
                    for (int bj = 0; bj < 2; ++bj) hx[m][bj] = *(const PG8_GAS u32x4*)(hbase + (size_t)(ai * HALF + m * 16) * 1024 + bj * HALF);
                asm volatile("" ::: "memory");
#pragma unroll
                for (int m = 0; m < 4; ++m) {
                    float ps = 0.f;
#pragma unroll
                    for (int bj = 0; bj < 2; ++bj) {
                        const u32x4 hw = hx[m][bj];
                        f32x4 x0 = {__builtin_bit_cast(float, hw.x << 16), __builtin_bit_cast(float, hw.x & 0xffff0000u), __builtin_bit_cast(float, hw.y << 16), __builtin_bit_cast(float, hw.y & 0xffff0000u)};
                        f32x4 x1 = {__builtin_bit_cast(float, hw.z << 16), __builtin_bit_cast(float, hw.z & 0xffff0000u), __builtin_bit_cast(float, hw.w << 16), __builtin_bit_cast(float, hw.w & 0xffff0000u)};
                        x0 += acc[ai][bj][m][0] * sc; x1 += acc[ai][bj][m][1] * sc;
                        if (fbase) { float* p = fbase + (size_t)(ai * HALF + m * 16) * 1024 + bj * HALF; *(PG8_GAS f32x4*)p = x0; *(PG8_GAS f32x4*)(p + 4) = x1; }
                        ps += ((x0[0] * x0[0] + x0[1] * x0[1]) + (x0[2] * x0[2] + x0[3] * x0[3])) + ((x1[0] * x1[0] + x1[1] * x1[1]) + (x1[2] * x1[2] + x1[3] * x1[3]));
                        u32x4 w; w.x = cvt_pk_bf16(x0[0], x0[1]); w.y = cvt_pk_bf16(x0[2], x0[3]); w.z = cvt_pk_bf16(x1[0], x1[1]); w.w = cvt_pk_bf16(x1[2], x1[3]);
                        if (!fbase) *(PG8_GAS u32x4*)(hbase + (size_t)(ai * HALF + m * 16) * 1024 + bj * HALF) = w;
                    }
                    ps += __builtin_bit_cast(float, __builtin_amdgcn_ds_bpermute(lx16, __builtin_bit_cast(int, ps))); ps += __builtin_bit_cast(float, __builtin_amdgcn_ds_bpermute(lx32, __builtin_bit_cast(int, ps)));
                    if (fq == 0) ldsp[(rloc + ai * HALF + m * 16) * 4 + wc] = ps;
                }
            }
            asm volatile("s_waitcnt lgkmcnt(0)" ::: "memory");
        }
    }
};
template <class Epi, class Sched, bool ALIGN_EPI = false, bool SP2 = false>
__device__ __forceinline__ void gemm_phase(PG8_LAS unsigned char* lds, const Gemm g, const Sched& S, const Epi& E, const int tid_in) {
    const int tid = tid_in, wid = __builtin_amdgcn_readfirstlane(tid >> 6), lane = tid & 63, wr = wid >> 2, wc = wid & 3, fr = lane & 15, fq = lane >> 4;
    const int K = g.K, nt = K / BK;
    unsigned voffA[2], voffB[2];
#pragma unroll
    for (int i = 0; i < 2; ++i) { int R, C; stage_rc(tid * 16 + i * 8192, R, C); const int Rb = Epi::PERM ? ((R & ~31) + perm32(R & 31)) : R;
        voffA[i] = (unsigned)(R * K + C) * 2u; voffB[i] = (unsigned)(Rb * K + C) * 2u; }
    const size_t kstep = (size_t)(BK * 2);
    const size_t hstep = (size_t)HALF * K * 2;
    const size_t tstep = 2 * hstep;
    const unsigned ldsw = (unsigned)wid * 1024u;
    const int aoff = lds_byte(wr * 64 + fr, fq * 8), boff = lds_byte(wc * 32 + fr, fq * 8);
#define PG8_SA(b, h) (((b) * 2 + (h)) * HTB)
#define PG8_SB(b, h) ((4 + (b) * 2 + (h)) * HTB)
#define PG8_STAGE(bufoff, gbase, voff) do { _Pragma("unroll") for (int _i = 0; _i < 2; ++_i) \
        __builtin_amdgcn_global_load_lds((const unsigned*)((const char*)(gbase) + (voff)[_i]), (PG8_LAS unsigned*)(lds + (bufoff) + ldsw + _i * 8192), 16, 0, 0); } while (0)
#define PG8_LDA(dst, b, h) do { _Pragma("unroll") for (int m = 0; m < 4; ++m) _Pragma("unroll") for (int k = 0; k < 2; ++k) dst[m][k] = *(const PG8_LAS bf16x8*)(lds + PG8_SA(b, h) + aoff + m * 2048 + k * 1024); } while (0)
#define PG8_LDB(dst, b, h) do { _Pragma("unroll") for (int n = 0; n < 2; ++n) _Pragma("unroll") for (int k = 0; k < 2; ++k) dst[n][k] = *(const PG8_LAS bf16x8*)(lds + PG8_SB(b, h) + boff + n * 2048 + k * 1024); } while (0)
#define PG8_MMA(ai, bj, At, Bt) do { __builtin_amdgcn_s_setprio(1); _Pragma("unroll") for (int m = 0; m < 4; ++m) _Pragma("unroll") for (int n = 0; n < 2; ++n) _Pragma("unroll") for (int k = 0; k < 2; ++k) \
        acc[ai][bj][m][n] = __builtin_amdgcn_mfma_f32_16x16x32_bf16(Bt[n][k], At[m][k], acc[ai][bj][m][n], 0, 0, 0); __builtin_amdgcn_s_setprio(0); } while (0)
#define PG8_WAIT_V(n) asm volatile("s_waitcnt vmcnt(" #n ")" ::: "memory")
#define PG8_WAIT_L(n) asm volatile("s_waitcnt lgkmcnt(" #n ")" ::: "memory")
#define PG8_BAR __builtin_amdgcn_s_barrier()
#define PG8_SCHED __builtin_amdgcn_sched_barrier(0)
    Unit cur, nxt; int ui = 0;
    if (!S.next(0, cur)) return;
    f32x4 acc[2][2][4][2];
#pragma unroll
    for (int a = 0; a < 2; ++a)
#pragma unroll
        for (int b = 0; b < 2; ++b)
#pragma unroll
            for (int m = 0; m < 4; ++m)
#pragma unroll
                for (int n = 0; n < 2; ++n) acc[a][b][m][n] = (f32x4){0.f, 0.f, 0.f, 0.f};
    bf16x8 At[4][2], B0[2][2], B1[2][2];
    const char* cA = (const char*)g.A + (size_t)cur.pm * tstep; const char* cB = (const char*)g.Bt + (size_t)cur.pn * tstep;
    S.a_ready(cur);
    if constexpr (SP2) {
        PG8_STAGE(PG8_SB(0, 0), cB, voffB); PG8_STAGE(PG8_SB(0, 1), cB + hstep, voffB); PG8_STAGE(PG8_SA(0, 0), cA, voffA); PG8_STAGE(PG8_SA(0, 1), cA + hstep, voffA);
        if (wr == 1) PG8_BAR;
        PG8_WAIT_V(2); PG8_BAR;
        PG8_STAGE(PG8_SB(1, 0), cB + kstep, voffB); PG8_STAGE(PG8_SA(1, 0), cA + kstep, voffA); PG8_STAGE(PG8_SB(1, 1), cB + hstep + kstep, voffB);
        PG8_WAIT_V(6); PG8_BAR;
    } else {
        PG8_STAGE(PG8_SB(0, 0), cB, voffB); PG8_STAGE(PG8_SA(0, 0), cA, voffA); PG8_STAGE(PG8_SB(0, 1), cB + hstep, voffB); PG8_STAGE(PG8_SA(0, 1), cA + hstep, voffA);
        if (wr == 1) PG8_BAR;
        PG8_WAIT_V(4); PG8_BAR;
        PG8_STAGE(PG8_SB(1, 0), cB + kstep, voffB); PG8_STAGE(PG8_SA(1, 0), cA + kstep, voffA); PG8_STAGE(PG8_SB(1, 1), cB + hstep + kstep, voffB);
        PG8_WAIT_V(6); PG8_BAR;
    }
    for (;;) {
        const bool has_next = S.next(ui + 1, nxt);
        const char* nA = has_next ? (const char*)g.A + (size_t)nxt.pm * tstep : cA; const char* nB = has_next ? (const char*)g.Bt + (size_t)nxt.pn * tstep : cB;
        for (int t = 0; t < nt; t += 2) {
            const bool last = (t == nt - 2);
            const char* a1 = cA + (size_t)(t + 1) * kstep;
            const char* a2 = last ? nA : cA + (size_t)(t + 2) * kstep; const char* b2 = last ? nB : cB + (size_t)(t + 2) * kstep;
            const char* a3 = a2 + kstep; const char* b3 = b2 + kstep;
            if (last && has_next) S.a_ready(nxt);
            if constexpr (SP2) {
            PG8_LDB(B0, 0, 0); PG8_LDB(B1, 0, 1); PG8_SCHED; PG8_LDA(At, 0, 0); PG8_STAGE(PG8_SA(1, 1), a1 + hstep, voffA);
            PG8_WAIT_V(8); PG8_WAIT_L(0); PG8_BAR; PG8_MMA(0, 0, At, B0); PG8_MMA(0, 1, At, B1); PG8_BAR; PG8_SCHED;
            PG8_LDA(At, 0, 1); PG8_STAGE(PG8_SB(0, 0), b2, voffB); PG8_STAGE(PG8_SB(0, 1), b2 + hstep, voffB); PG8_STAGE(PG8_SA(0, 0), a2, voffA);
            PG8_WAIT_V(8); PG8_WAIT_L(0); PG8_BAR; PG8_MMA(1, 0, At, B0); PG8_MMA(1, 1, At, B1); PG8_BAR; PG8_SCHED;
            PG8_LDB(B0, 1, 0); PG8_LDB(B1, 1, 1); PG8_SCHED; PG8_LDA(At, 1, 0); PG8_STAGE(PG8_SA(0, 1), a2 + hstep, voffA);
            PG8_WAIT_V(8); PG8_WAIT_L(0); PG8_BAR; PG8_MMA(0, 0, At, B0); PG8_MMA(0, 1, At, B1); PG8_BAR; PG8_SCHED;
            PG8_LDA(At, 1, 1); PG8_STAGE(PG8_SB(1, 0), b3, voffB); PG8_STAGE(PG8_SB(1, 1), b3 + hstep, voffB); PG8_STAGE(PG8_SA(1, 0), a3, voffA);
            PG8_WAIT_V(8); PG8_WAIT_L(0); PG8_BAR; PG8_MMA(1, 0, At, B0); PG8_MMA(1, 1, At, B1); PG8_BAR; PG8_SCHED;
            } else {
            PG8_LDB(B0, 0, 0); PG8_SCHED; PG8_LDA(At, 0, 0); PG8_STAGE(PG8_SA(1, 1), a1 + hstep, voffA);
            PG8_WAIT_L(8); PG8_BAR; PG8_WAIT_L(0); PG8_MMA(0, 0, At, B0); PG8_BAR; PG8_SCHED;
            PG8_LDB(B1, 0, 1); PG8_STAGE(PG8_SB(0, 0), b2, voffB);
            PG8_BAR; PG8_WAIT_L(0); PG8_MMA(0, 1, At, B1); PG8_BAR;
            PG8_LDA(At, 0, 1); PG8_STAGE(PG8_SA(0, 0), a2, voffA);
            PG8_BAR; PG8_WAIT_L(0); PG8_MMA(1, 0, At, B0); PG8_BAR; PG8_SCHED;
            PG8_STAGE(PG8_SB(0, 1), b2 + hstep, voffB);
            PG8_WAIT_V(6); PG8_BAR; PG8_MMA(1, 1, At, B1); PG8_BAR;
            PG8_LDB(B0, 1, 0); PG8_SCHED; PG8_LDA(At, 1, 0); PG8_STAGE(PG8_SA(0, 1), a2 + hstep, voffA);
            PG8_WAIT_L(8); PG8_BAR; PG8_WAIT_L(0); PG8_MMA(0, 0, At, B0); PG8_BAR; PG8_SCHED;
            PG8_LDB(B1, 1, 1); PG8_STAGE(PG8_SB(1, 0), b3, voffB);
            PG8_BAR; PG8_WAIT_L(0); PG8_MMA(0, 1, At, B1); PG8_BAR;
            PG8_LDA(At, 1, 1); PG8_STAGE(PG8_SA(1, 0), a3, voffA);
            PG8_BAR; PG8_WAIT_L(0); PG8_MMA(1, 0, At, B0); PG8_BAR; PG8_SCHED;
            PG8_STAGE(PG8_SB(1, 1), b3 + hstep, voffB);
            PG8_WAIT_V(6); PG8_BAR; PG8_MMA(1, 1, At, B1); PG8_BAR;
            }
        }
        if constexpr (ALIGN_EPI) { if (wr == 0) PG8_BAR; }
        if constexpr (!Epi::AFTER_DRAIN) { E(acc, cur, wr, wc, fr, fq, ui); S.done(cur); }
        if (!has_next) break;
#pragma unroll
        for (int a = 0; a < 2; ++a)
#pragma unroll
            for (int b = 0; b < 2; ++b)
#pragma unroll
                for (int m = 0; m < 4; ++m)
#pragma unroll
                    for (int n = 0; n < 2; ++n) acc[a][b][m][n] = (f32x4){0.f, 0.f, 0.f, 0.f};
        cur = nxt; cA = nA; cB = nB; ++ui;
        if constexpr (ALIGN_EPI) { if (wr == 1) PG8_BAR; }
    }
    PG8_WAIT_V(0);
    if constexpr (!ALIGN_EPI) { if (wr == 0) PG8_BAR; }
    PG8_BAR;
    if constexpr (Epi::AFTER_DRAIN) { E.fused(acc, cur, wr, wc, fr, fq, lds, wid, lane); S.done(cur); }
#undef PG8_SA
#undef PG8_SB
#undef PG8_STAGE
#undef PG8_LDA
#undef PG8_LDB
#undef PG8_MMA
#undef PG8_WAIT_V
#undef PG8_WAIT_L
#undef PG8_BAR
#undef PG8_SCHED
}
}

#ifndef PG8_SP2
#define PG8_SP2 true
#endif
#ifndef PG8_ALIGN
#define PG8_ALIGN true
#endif
#include <hip/hip_bf16.h>
#include <cmath>
namespace attn_body {
using bf16=__hip_bfloat16;
using bf16x8=__attribute__((ext_vector_type(8)))short;
using s16x4=__attribute__((ext_vector_type(4)))short;
using f32x16=__attribute__((ext_vector_type(16)))float;
using u32x4=__attribute__((ext_vector_type(4)))unsigned;
constexpr int BATCH=2,NHEAD=16,SEQ=8192,D=64,DM=NHEAD*D;
constexpr int NW=8,QBLK=32,QB=QBLK*NW,KVBLK=64,NQB=SEQ/QB; constexpr int KVPAD=128,KVROWS=SEQ+KVPAD;
constexpr int ATTN_PITCH=DM, ATTN_UNIT_ROWS=QB;
__device__ __forceinline__ int crow(int r,int hi){return (r&3)+8*(r>>2)+4*hi;}
#define SBAR() __builtin_amdgcn_sched_barrier(0)
__device__ __forceinline__ void cmask(f32x16&p0,f32x16&p1,int jb,int qrel,int hi){
  const float NEG=-INFINITY; int kb=64*jb+4*hi;
  #pragma unroll
  for(int r=0;r<16;++r){int kv=kb+(r&3)+8*(r>>2); if(kv>qrel)p0[r]=NEG; if(kv+32>qrel)p1[r]=NEG;}
}

constexpr int NSLOT=3, SLOTB=8192;
constexpr int LDS_K=0, LDS_V=NSLOT*SLOTB, LDS_WS=2*NSLOT*SLOTB, LDS_OST=LDS_WS+NW*64*4, LDS_CS=LDS_OST+NW*4096, LDS_BYTES=LDS_CS+KVROWS*4;
constexpr float C2=0.125f*1.4426950408889634f;
__device__ __forceinline__ void glds16(const void*gsrc,unsigned lds_dst){unsigned keep;
  asm volatile("s_mov_b32 %0, m0\n\ts_mov_b32 m0, %2\n\ts_nop 0\n\tglobal_load_lds_dwordx4 %1, off\n\ts_mov_b32 m0, %0":"=&s"(keep):"v"(gsrc),"s"(lds_dst):"memory");}
__device__ __forceinline__ float max3f(float a,float b,float c){float r;asm("v_max3_f32 %0, %1, %2, %3":"=v"(r):"v"(a),"v"(b),"v"(c));return r;}
__device__ __forceinline__ float max2f(float a,float b){float r;asm("v_max_f32_e32 %0, %1, %2":"=v"(r):"v"(a),"v"(b));return r;}
__device__ __forceinline__ float fadd_s(float a,float b){float r;asm("v_add_f32_e32 %0, %1, %2":"=v"(r):"v"(a),"v"(b));return r;}
__device__ __forceinline__ float fsub_s(float a,float b){float r;asm("v_sub_f32_e32 %0, %1, %2":"=v"(r):"v"(a),"v"(b));return r;}
typedef float f32x2_t __attribute__((ext_vector_type(2))); typedef __bf16 bf16x2_t __attribute__((ext_vector_type(2)));
__device__ __forceinline__ unsigned cvtpk_s(float lo,float hi){f32x2_t v={lo,hi};bf16x2_t b=__builtin_convertvector(v,bf16x2_t);return __builtin_bit_cast(unsigned,b);}
#define WAIT_BAR(N) asm volatile("s_waitcnt vmcnt(" #N ") lgkmcnt(0)\n\ts_barrier":::"memory")

__device__ __forceinline__ void qkt(f32x16&p0,f32x16&p1,const char*Kslot,const bf16x8*qr,int r32,int hi){
  const char*kb=Kslot+hi*1024+r32*16;
  #pragma unroll
  for(int d0=0;d0<4;++d0){
    const bf16x8 b0=*reinterpret_cast<const bf16x8*>(kb+d0*2048);
    const bf16x8 b1=*reinterpret_cast<const bf16x8*>(kb+d0*2048+512);
    p0=__builtin_amdgcn_mfma_f32_32x32x16_bf16(b0,qr[d0],p0,0,0,0);p1=__builtin_amdgcn_mfma_f32_32x32x16_bf16(b1,qr[d0],p1,0,0,0);}
}
typedef __attribute__((address_space(3))) const char* lds_cptr;
typedef short v4i16_t __attribute__((ext_vector_type(4))); typedef float f32x4_t __attribute__((ext_vector_type(4)));
__device__ __forceinline__ void kload8(bf16x8*kf,lds_cptr kp){
  kf[0]=*(const __attribute__((address_space(3))) bf16x8*)(kp);      kf[1]=*(const __attribute__((address_space(3))) bf16x8*)(kp+512);
  kf[2]=*(const __attribute__((address_space(3))) bf16x8*)(kp+2048); kf[3]=*(const __attribute__((address_space(3))) bf16x8*)(kp+2560);
  kf[4]=*(const __attribute__((address_space(3))) bf16x8*)(kp+4096); kf[5]=*(const __attribute__((address_space(3))) bf16x8*)(kp+4608);
  kf[6]=*(const __attribute__((address_space(3))) bf16x8*)(kp+6144); kf[7]=*(const __attribute__((address_space(3))) bf16x8*)(kp+6656);
}
__device__ __forceinline__ void kload2(bf16x8*kf,lds_cptr kp,int j){ kf[2*j]=*(const __attribute__((address_space(3))) bf16x8*)(kp+j*2048); kf[2*j+1]=*(const __attribute__((address_space(3))) bf16x8*)(kp+j*2048+512); }
__device__ __forceinline__ s16x4 vtr(lds_cptr p){ return __builtin_bit_cast(s16x4,__builtin_amdgcn_ds_read_tr16_b64_v4i16((__attribute__((address_space(3))) v4i16_t*)p)); }
__device__ __forceinline__ float rowmax(const f32x16&p0,const f32x16&p1){
  float a=max3f(p0[0],p0[1],p1[0]),b=max3f(p0[2],p0[3],p1[1]);a=max3f(a,p1[2],p1[3]);
  #pragma unroll
  for(int r=4;r<16;r+=4){a=max3f(a,p0[r],p0[r+1]);b=max3f(b,p0[r+2],p0[r+3]);a=max3f(a,p1[r],p1[r+1]);b=max3f(b,p1[r+2],p1[r+3]);}
  const float m=max2f(a,b);
  auto rr=__builtin_amdgcn_permlane32_swap(__float_as_uint(m),__float_as_uint(m),false,false);
  return max2f(__uint_as_float(rr[0]),__uint_as_float(rr[1]));
}
__device__ __forceinline__ void pv(f32x16*o,int vb,bf16x8 pa0,bf16x8 pa1,bf16x8 pa2,bf16x8 pa3){
  #pragma unroll
  for(int d0=0;d0<2;++d0){s16x4 lo[4],hi[4];
    #pragma unroll
    for(int ks=0;ks<4;++ks){
      asm volatile("ds_read_b64_tr_b16 %0,%1 offset:%c2":"=&v"(lo[ks]):"v"(vb),"i"(d0*4096+ks*1024):"memory");
      asm volatile("ds_read_b64_tr_b16 %0,%1 offset:%c2":"=&v"(hi[ks]):"v"(vb),"i"(d0*4096+ks*1024+512):"memory");}
    asm volatile("s_waitcnt lgkmcnt(0)":::"memory");SBAR();
    #define PK(k) (bf16x8){lo[k][0],lo[k][1],lo[k][2],lo[k][3],hi[k][0],hi[k][1],hi[k][2],hi[k][3]}
    o[d0]=__builtin_amdgcn_mfma_f32_32x32x16_bf16(pa0,PK(0),o[d0],0,0,0);
    o[d0]=__builtin_amdgcn_mfma_f32_32x32x16_bf16(pa1,PK(1),o[d0],0,0,0);
    o[d0]=__builtin_amdgcn_mfma_f32_32x32x16_bf16(pa2,PK(2),o[d0],0,0,0);
    o[d0]=__builtin_amdgcn_mfma_f32_32x32x16_bf16(pa3,PK(3),o[d0],0,0,0);
    #undef PK
  }
}

#ifndef ATTN_STORE16
#define ATTN_STORE16(p,v) (*(__attribute__((address_space(1))) u32x4*)(p)=(v))
#endif
template<int THRL> __device__ __forceinline__ void attn_unit(int b,int h,int qb,const bf16*Q,const bf16*__restrict__ K,const bf16*__restrict__ V,bf16*O,const float*__restrict__ CS,char*shm,const int tid_in){
  const int tid=tid_in,lane=tid&63,r32=lane&31,hi=lane>>5; const int wid=__builtin_amdgcn_readfirstlane(tid>>6);
  const long rowbase=(long)b*SEQ, kvbase=(long)b*KVROWS; const int q0=qb*QB;
  const bf16*Qw=Q+(rowbase+q0+wid*QBLK)*DM+h*D;
  const bf16*Kh=K+kvbase*DM+h*D,*Vh=V+kvbase*DM+h*D;
  const unsigned lds0=(unsigned)(uintptr_t)shm;
  float*wsf=(float*)(shm+LDS_WS)+wid*64;
  const bf16*ksrc=Kh+(long)lane*DM+wid*8;
  const bf16*vsrc=Vh+(long)(16*(wid&3)+(lane>>2))*DM+(wid>>2)*32+(lane&3)*8;
  const unsigned kdst=lds0+LDS_K+wid*1024, vdst=lds0+LDS_V+wid*1024;
  #define DMA_K(t,slot) glds16(ksrc+(long)(t)*KVBLK*DM,(unsigned)__builtin_amdgcn_readfirstlane(kdst+(slot)))
  #define DMA_V(t,slot) glds16(vsrc+(long)(t)*KVBLK*DM,(unsigned)__builtin_amdgcn_readfirstlane(vdst+(slot)))
  const int vb0=(int)(lds0+LDS_V)+((lane>>4)&1)*32+(lane&3)*8+(4*hi+((lane&15)>>2))*64;
  const char*Kbase=shm+LDS_K; bf16x8 kf[8];
  const lds_cptr shm3=(lds_cptr)shm; const lds_cptr kp0=shm3+LDS_K+hi*1024+r32*16; const lds_cptr vp0=shm3+LDS_V+((lane>>4)&1)*32+(lane&3)*8+(4*hi+((lane&15)>>2))*64;
  const int NT=(q0+QB+KVPAD)/KVBLK;
  DMA_K(0,0);DMA_V(0,0);DMA_K(1,SLOTB);
  bf16x8 qr[4];
  #pragma unroll
  for(int d0=0;d0<4;++d0)qr[d0]=*(const __attribute__((address_space(1))) bf16x8*)(&Qw[(long)r32*DM+d0*16+hi*8]);
  float mhat=0.f,l_reg=0.f;f32x16 o[2];o[0]=f32x16{};o[1]=f32x16{};
  const __attribute__((address_space(3))) float*csl=(const __attribute__((address_space(3))) float*)((lds_cptr)shm+LDS_CS)+4*hi;
  #define BIASINIT(C0,C1,t) do{ const __attribute__((address_space(3))) float*bp_=csl+64*(t); const float nm_=-mhat; \
    _Pragma("unroll") for(int g_=0;g_<4;++g_){ const f32x4_t a_=*(const __attribute__((address_space(3))) f32x4_t*)(bp_+8*g_), b_=*(const __attribute__((address_space(3))) f32x4_t*)(bp_+32+8*g_); \
      C0[4*g_]=nm_-a_[0];C0[4*g_+1]=nm_-a_[1];C0[4*g_+2]=nm_-a_[2];C0[4*g_+3]=nm_-a_[3]; C1[4*g_]=nm_-b_[0];C1[4*g_+1]=nm_-b_[1];C1[4*g_+2]=nm_-b_[2];C1[4*g_+3]=nm_-b_[3]; } }while(0)
  #define BIASLOAD(C0,C1,t) do{ const __attribute__((address_space(3))) float*bp_=csl+64*(t); \
    _Pragma("unroll") for(int g_=0;g_<4;++g_){ const f32x4_t a_=*(const __attribute__((address_space(3))) f32x4_t*)(bp_+8*g_), b_=*(const __attribute__((address_space(3))) f32x4_t*)(bp_+32+8*g_); \
      C0[4*g_]=a_[0];C0[4*g_+1]=a_[1];C0[4*g_+2]=a_[2];C0[4*g_+3]=a_[3]; C1[4*g_]=b_[0];C1[4*g_+1]=b_[1];C1[4*g_+2]=b_[2];C1[4*g_+3]=b_[3]; } }while(0)
  const int qrel=wid*QBLK+r32;
  #define CMASK(P0,P1,t) do{int jb_=(t)-(NT-4); if(jb_>=0)cmask(P0,P1,jb_,qrel,hi);}while(0)
  bool resc=false;
  #define START(P0,P1) do{ const float rm=rowmax(P0,P1); resc=false; \
    { const float dl=rm; mhat=fadd_s(mhat,dl); \
      _Pragma("unroll") for(int r=0;r<16;++r){P0[r]=fsub_s(P0[r],dl);P1[r]=fsub_s(P1[r],dl);} \
      } \
    _Pragma("unroll") for(int r=0;r<16;++r)P0[r]=__builtin_amdgcn_exp2f(P0[r]); }while(0)
  #define RESC() do{ if(resc){ asm volatile("s_waitcnt lgkmcnt(0)":::"memory"); \
      _Pragma("unroll") for(int d_=0;d_<2;++d_) _Pragma("unroll") for(int r=0;r<16;++r)o[d_][r]*=wsf[crow(r,hi)]; } }while(0)
  f32x16 pA0,pA1,pB0,pB1;
  int sl_prev=0,sl_cur=0,sl_next=SLOTB;
  #define ROT() do{sl_prev=sl_cur;sl_cur=sl_next;sl_next=(sl_next==(NSLOT-1)*SLOTB)?0:sl_next+SLOTB;}while(0)
  DMA_K(2,2*SLOTB);
  WAIT_BAR(3);
  BIASINIT(pA0,pA1,0); qkt(pA0,pA1,Kbase,qr,r32,hi);asm volatile("s_nop 15\n\ts_nop 7":"+v"(pA0),"+v"(pA1));
  START(pA0,pA1);
  _Pragma("unroll") for(int r=0;r<16;++r)pA1[r]=__builtin_amdgcn_exp2f(pA1[r]);
  WAIT_BAR(0);
  DMA_K(3,0);DMA_V(1,SLOTB);
  ROT();
  kload8(kf,kp0+sl_cur);
  WAIT_BAR(2);
  s16x4 vlo[8],vhi[8]; u32x4 pw0,pw1,pw2,pw3;
  #define PKW(P,B) cvtpk_s(P[B],P[B+1])
  #define PAF(k) __builtin_bit_cast(bf16x8,pw##k)
  #define VFR(i) (bf16x8){vlo[i][0],vlo[i][1],vlo[i][2],vlo[i][3],vhi[i][0],vhi[i][1],vhi[i][2],vhi[i][3]}
  #define PIN(x) asm volatile("":"+v"(x))
  #define MX3(a,b,c) __builtin_fmaxf(__builtin_fmaxf((a),(b)),(c))
  #define GAPA(MF,A0,A1,A2,A3,W0,W1,PW) do{ MF; sacc+=A0; sacc+=A1; sacc+=A2; sacc+=A3; PIN(sacc); W0; W1; PIN(PW); SBAR(); }while(0)
  #define EX(v) __builtin_amdgcn_exp2f(v)
  #define GAPB(MF,X,B,NX) do{ MF; X[B]=EX(X[B]); X[B+1]=EX(X[B+1]); X[B+2]=EX(X[B+2]); X[B+3]=EX(X[B+3]); NX[B]=fsub_s(nm_,NX[B]); NX[B+1]=fsub_s(nm_,NX[B+1]); NX[B+2]=fsub_s(nm_,NX[B+2]); NX[B+3]=fsub_s(nm_,NX[B+3]); PIN(X); PIN(NX); SBAR(); }while(0)
  #define VRD(i) do{ vlo[i]=vtr(vp_+(((i)>>2)*4096+((i)&3)*1024)); vhi[i]=vtr(vp_+(((i)>>2)*4096+((i)&3)*1024+512)); }while(0)
  #define KRD(G,j) do{ if(G){ kload2(kf,kp0+sl_next,j); SBAR(); } }while(0)
  #define STEP(C0,C1,P0,P1,t,GK,GV,GL) do{ SBAR(); \
    const lds_cptr vp_=vp0+sl_prev; \
    VRD(0); SBAR(); float sacc=(P0[0]+P0[1]); \
    GAPA(C0=__builtin_amdgcn_mfma_f32_32x32x16_bf16(kf[0],qr[0],C0,0,0,0), P0[2],P0[3],P0[4],P0[5],     pw0[0]=PKW(P0,0), pw0[1]=PKW(P0,2), pw0); \
    VRD(4); SBAR(); GAPA(C1=__builtin_amdgcn_mfma_f32_32x32x16_bf16(kf[1],qr[0],C1,0,0,0), P0[6],P0[7],P0[8],P0[9],     pw0[2]=PKW(P0,4), pw0[3]=PKW(P0,6), pw0); \
    VRD(1); SBAR(); GAPA(C0=__builtin_amdgcn_mfma_f32_32x32x16_bf16(kf[2],qr[1],C0,0,0,0),   P0[10],P0[11],P0[12],P0[13], pw1[0]=PKW(P0,8), pw1[1]=PKW(P0,10), pw1); \
    VRD(5); SBAR(); GAPA(C1=__builtin_amdgcn_mfma_f32_32x32x16_bf16(kf[3],qr[1],C1,0,0,0),   P0[14],P0[15],P1[0],P1[1],   pw1[2]=PKW(P0,12),pw1[3]=PKW(P0,14), pw1); \
    VRD(2); SBAR(); GAPA(C0=__builtin_amdgcn_mfma_f32_32x32x16_bf16(kf[4],qr[2],C0,0,0,0),   P1[2],P1[3],P1[4],P1[5],     pw2[0]=PKW(P1,0), pw2[1]=PKW(P1,2), pw2); \
    VRD(6); SBAR(); GAPA(C1=__builtin_amdgcn_mfma_f32_32x32x16_bf16(kf[5],qr[2],C1,0,0,0),   P1[6],P1[7],P1[8],P1[9],     pw2[2]=PKW(P1,4), pw2[3]=PKW(P1,6), pw2); \
    VRD(3); SBAR(); GAPA(C0=__builtin_amdgcn_mfma_f32_32x32x16_bf16(kf[6],qr[3],C0,0,0,0),   P1[10],P1[11],P1[12],P1[13], pw3[0]=PKW(P1,8), pw3[1]=PKW(P1,10), pw3); \
    VRD(7); SBAR(); GAPA(C1=__builtin_amdgcn_mfma_f32_32x32x16_bf16(kf[7],qr[3],C1,0,0,0),   P1[14],P1[15],0.f,0.f,       pw3[2]=PKW(P1,12),pw3[3]=PKW(P1,14), pw3); \
    l_reg+=sacc; \
    BIASLOAD(P0,P1,(t)+1); \
    if(GK){DMA_K((t)+3,sl_cur);} if(GV){DMA_V((t)+1,sl_next);} \
    CMASK(C0,C1,t); \
    { float a=MX3(C0[0],C0[1],C1[0]),b=MX3(C0[2],C0[3],C1[1]); a=MX3(a,C1[2],C1[3]); \
      _Pragma("unroll") for(int r=4;r<16;r+=4){a=MX3(a,C0[r],C0[r+1]);b=MX3(b,C0[r+2],C0[r+3]);a=MX3(a,C1[r],C1[r+1]);b=MX3(b,C1[r+2],C1[r+3]);} \
      float rm=__builtin_fmaxf(a,b); { auto rr=__builtin_amdgcn_permlane32_swap(__float_as_uint(rm),__float_as_uint(rm),false,false); rm=__builtin_fmaxf(__uint_as_float(rr[0]),__uint_as_float(rr[1])); } \
      resc=false; \
      if(__builtin_expect(__any(rm>(float)THRL),0)){ const float dl=__builtin_fmaxf(rm,0.f); mhat+=dl; \
        _Pragma("unroll") for(int r=0;r<16;++r){C0[r]-=dl;C1[r]-=dl;} \
        const float f=__builtin_amdgcn_exp2f(-dl); l_reg*=f; if(hi==0)wsf[r32]=f; resc=true; } } \
    SBAR(); const float nm_=-mhat; \
    GAPB(o[0]=__builtin_amdgcn_mfma_f32_32x32x16_bf16(PAF(0),VFR(0),o[0],0,0,0), C0,0,P0); \
    GAPB(o[1]=__builtin_amdgcn_mfma_f32_32x32x16_bf16(PAF(0),VFR(4),o[1],0,0,0), C0,4,P0); \
    KRD(GL,0); GAPB(o[0]=__builtin_amdgcn_mfma_f32_32x32x16_bf16(PAF(1),VFR(1),o[0],0,0,0), C0,8,P0); \
    KRD(GL,1); GAPB(o[1]=__builtin_amdgcn_mfma_f32_32x32x16_bf16(PAF(1),VFR(5),o[1],0,0,0), C0,12,P0); \
    KRD(GL,2); GAPB(o[0]=__builtin_amdgcn_mfma_f32_32x32x16_bf16(PAF(2),VFR(2),o[0],0,0,0), C1,0,P1); \
    KRD(GL,3); GAPB(o[1]=__builtin_amdgcn_mfma_f32_32x32x16_bf16(PAF(2),VFR(6),o[1],0,0,0), C1,4,P1); \
    GAPB(o[0]=__builtin_amdgcn_mfma_f32_32x32x16_bf16(PAF(3),VFR(3),o[0],0,0,0), C1,8,P1); \
    GAPB(o[1]=__builtin_amdgcn_mfma_f32_32x32x16_bf16(PAF(3),VFR(7),o[1],0,0,0), C1,12,P1); \
    }while(0)
  BIASINIT(pB0,pB1,1);
  int t=1;
  #undef CMASK
  #define CMASK(P0,P1,t) do{}while(0)
  for(;t+5<NT;t+=2){
    STEP(pB0,pB1,pA0,pA1,t,true,true,true);     WAIT_BAR(2); RESC(); ROT();
    STEP(pA0,pA1,pB0,pB1,t+1,true,true,true);   WAIT_BAR(2); RESC(); ROT();
  }
  #undef CMASK
  #define CMASK(P0,P1,t) do{int jb_=(t)-(NT-4); if(jb_>=0)cmask(P0,P1,jb_,qrel,hi);}while(0)
  #define ENDW(tt) do{ if((tt)+3<NT){WAIT_BAR(2);} else if((tt)+2<NT){WAIT_BAR(1);} else {WAIT_BAR(0);} }while(0)
  for(;t+1<NT;t+=2){
    STEP(pB0,pB1,pA0,pA1,t,(t+3<NT),(t+1<NT),(t+1<NT));       ENDW(t);   RESC(); ROT();
    STEP(pA0,pA1,pB0,pB1,t+1,(t+4<NT),(t+2<NT),(t+2<NT));     ENDW(t+1); RESC(); ROT();
  }
  STEP(pB0,pB1,pA0,pA1,NT-1,false,false,false); RESC();
  { float sacc=pB0[0]+pB0[1]; _Pragma("unroll") for(int r=2;r<16;++r)sacc+=pB0[r]; _Pragma("unroll") for(int r=0;r<16;++r)sacc+=pB1[r]; l_reg+=sacc;
    pw0=(u32x4){PKW(pB0,0),PKW(pB0,2),PKW(pB0,4),PKW(pB0,6)};pw1=(u32x4){PKW(pB0,8),PKW(pB0,10),PKW(pB0,12),PKW(pB0,14)};pw2=(u32x4){PKW(pB1,0),PKW(pB1,2),PKW(pB1,4),PKW(pB1,6)};pw3=(u32x4){PKW(pB1,8),PKW(pB1,10),PKW(pB1,12),PKW(pB1,14)};
    SBAR(); pv(o,vb0+sl_cur,PAF(0),PAF(1),PAF(2),PAF(3)); }
  #undef PKW
  #undef PAF
  #undef VFR
  #undef PIN
  #undef MX3
  #undef GAPA
  #undef GAPB
  #undef EX
  #undef VRD
  #undef KRD
  #undef STEP
  #undef ENDW
  {auto rr=__builtin_amdgcn_permlane32_swap(__float_as_uint(l_reg),__float_as_uint(l_reg),false,false);l_reg=__uint_as_float(rr[0])+__uint_as_float(rr[1]);}
  if(hi==0)wsf[32+r32]=l_reg;asm volatile("s_waitcnt lgkmcnt(0)":::"memory");
  float rli[16];
  #pragma unroll
  for(int r=0;r<16;++r)rli[r]=__builtin_amdgcn_rcpf(wsf[32+crow(r,hi)]);
  bf16*Ow=O+(rowbase+q0+wid*QBLK)*DM+h*D;
  { bf16*stg=(bf16*)(shm+LDS_OST)+wid*2048;
    #pragma unroll
    for(int r=0;r<16;++r){const int orow=crow(r,hi);
      #pragma unroll
      for(int d0=0;d0<2;++d0)stg[orow*64+d0*32+r32]=__float2bfloat16(o[d0][r]*rli[r]);}
    asm volatile("s_waitcnt lgkmcnt(0)":::"memory");
    #pragma unroll
    for(int i=0;i<4;++i){const int row=i*8+(lane>>3),ch=lane&7; const u32x4 v=*(const u32x4*)(stg+row*64+ch*8); ATTN_STORE16(Ow+(long)row*DM+ch*8,v);} }
  asm volatile("s_waitcnt lgkmcnt(0)\n\ts_barrier":::"memory");
  #undef DMA_K
  #undef DMA_V
  #undef CMASK
  #undef START
  #undef RESC
  #undef ROT
  #undef BIASINIT
  #undef BIASLOAD
}
constexpr int ATTN_LDS_BYTES=LDS_BYTES;
struct AttnTensors { const bf16* Q; const bf16* K; const bf16* V; bf16* O; const float* CS; };
struct AttnUnit { int bh; int qb; };
struct StaticOrder {
  int vcu;
  __device__ __forceinline__ explicit StaticOrder(int grid,int block):vcu((block%8)*(grid/8)+block/8){}
  __device__ __forceinline__ bool next(int i,AttnUnit&u)const{ if(i>=4)return false; const int s=vcu&7; u.bh=vcu>>3; u.qb=(i==0)?s:(i==1)?15-s:(i==2)?16+s:31-s; return true; }
  __device__ __forceinline__ void a_ready(const AttnUnit&)const{}
  __device__ __forceinline__ void done(const AttnUnit&)const{}
};
template<class Sched,int THRL=96> __device__ __forceinline__ void attn_phase(char*lds,const AttnTensors&T,const Sched&S,const int tid_in){
  AttnUnit u;
  for(int i=0;S.next(i,u);++i){ S.a_ready(u); attn_unit<THRL>(u.bh/NHEAD,u.bh%NHEAD,u.qb,T.Q,T.K,T.V,T.O,T.CS,lds,tid_in); S.done(u); }
}
#undef SBAR
#undef WAIT_BAR
}
#define LAS __attribute__((address_space(3)))
#define XB_TMO      128
#define XB_XCNT(j)  (256  + 64 * (j))
#define XB_XSUB(j)  (1280 + 64 * (j))
#define XB_XGEN(j)  (2304 + 64 * (j))
#define XB_TOP      3328
#define XB_TOPGEN   3392
#define XCD_BAR_WORDS 3456
#define XB_SPIN_CAP (1u << 18)

__device__ __forceinline__ unsigned xb_ld(unsigned* p)              { return __hip_atomic_load(p, __ATOMIC_RELAXED, __HIP_MEMORY_SCOPE_AGENT); }
__device__ __forceinline__ unsigned xb_add(unsigned* p, unsigned v) { return __hip_atomic_fetch_add(p, v, __ATOMIC_RELAXED, __HIP_MEMORY_SCOPE_AGENT); }
__device__ __forceinline__ unsigned xb_xcc_id() { return (unsigned)__builtin_amdgcn_s_getreg((3 << 11) | 20) & 0xFu; }
#define XB_SPIN(cond, bar) do { unsigned _sp = 0; while (cond) { __builtin_amdgcn_s_sleep(1); \
    if ((++_sp & 255u) == 0u) { if (xb_ld(&(bar)[XB_TMO])) break; if (_sp > XB_SPIN_CAP) { atomicAdd(&(bar)[XB_TMO], 1u); break; } } } } while (0)

struct XcdBarrier {
    unsigned* bar; unsigned x;
    volatile LAS unsigned* st;
};

__device__ __forceinline__ XcdBarrier xcd_barrier_post(unsigned* bar, volatile LAS unsigned* st, const int tid) {
    XcdBarrier b; b.bar = bar; b.x = xb_xcc_id(); b.st = st;
    if (tid == 0) (void)xb_add(&bar[XB_XCNT(b.x)], 1u);
    return b;
}
__device__ __forceinline__ void xcd_barrier_complete(unsigned* bar, unsigned x, unsigned& nloc, unsigned& nx) {
    const unsigned G = gridDim.x * gridDim.y * gridDim.z;
    unsigned sum, cnt, mine, sp = 0u;
    for (;;) {
        sum = 0u; cnt = 0u; mine = 0u;
#pragma unroll
        for (unsigned j = 0; j < 16; ++j) { const unsigned c = xb_ld(&bar[XB_XCNT(j)]); sum += c; cnt += (c > 0u) ? 1u : 0u; mine = (j == x) ? c : mine; }
        if (sum == G) break;
        __builtin_amdgcn_s_sleep(1);
        if ((++sp & 255u) == 0u) { if (xb_ld(&bar[XB_TMO])) break; if (sp > XB_SPIN_CAP) { atomicAdd(&bar[XB_TMO], 1u); break; } }
    }
    nloc = mine > 0u ? mine : 1u; nx = cnt > 0u ? cnt : 1u;
}

__device__ __forceinline__ void xcd_barrier(const XcdBarrier& b, const int tid) {
    asm volatile("s_waitcnt vmcnt(0)" ::: "memory");
    __syncthreads();
    if (tid == 0) {
        unsigned* bar = b.bar; asm volatile("" : "+s"(bar)); unsigned bx_ = (unsigned)__builtin_amdgcn_readfirstlane((int)b.x); asm volatile("" : "+s"(bx_));
        __builtin_amdgcn_s_waitcnt(0);
        unsigned nloc = b.st[0], nx = b.st[1];
        if (nloc == 0u) { xcd_barrier_complete(bar, bx_, nloc, nx); b.st[0] = nloc; b.st[1] = nx; }
        const unsigned old = xb_add(&bar[XB_XSUB(bx_)], 1u);
        const unsigned gen = old / nloc;
        if (old + 1u == (gen + 1u) * nloc) {
            __builtin_amdgcn_fence(__ATOMIC_RELEASE, "agent");
            asm volatile("s_waitcnt vmcnt(0)" ::: "memory");
            const unsigned og = xb_add(&bar[XB_TOP], 1u);
            const unsigned tg = og / nx;
            if (og + 1u == (tg + 1u) * nx) xb_add(&bar[XB_TOPGEN], 1u);
            else XB_SPIN(xb_ld(&bar[XB_TOPGEN]) == tg, bar);
            __builtin_amdgcn_fence(__ATOMIC_ACQUIRE, "agent");
            xb_add(&bar[XB_XGEN(bx_)], 1u);
            asm volatile("s_waitcnt vmcnt(0)" ::: "memory");
        } else {
            XB_SPIN(xb_ld(&bar[XB_XGEN(bx_)]) == gen, bar);
            __builtin_amdgcn_fence(__ATOMIC_ACQUIRE, "agent");
            asm volatile("s_waitcnt vmcnt(0)" ::: "memory");
        }
    }
    __syncthreads();
}
namespace cg = cooperative_groups;
constexpr int NWAVES = 8;
constexpr int DM = 1024, FF = 2816, NH = 16, SEQ = 8192, NMETA = 16, DEPTH = 4;
constexpr int MMAIN = 2 * SEQ;
constexpr int MROWS = MMAIN + NMETA;
constexpr int MPAD = 65 * 256;
constexpr int KVROWS = attn_body::KVROWS;
constexpr float EPS = 1e-6f, LOG2E = 1.4426950408889634f;

constexpr size_t MiB = 1u << 20;
constexpr size_t SZ_GU = (size_t)5632 * 1024 * 2, SZ_DN = (size_t)1024 * 2816 * 2;
constexpr size_t WS_CTL = 0, CTL_ZERO_BYTES = 65536;
constexpr size_t WS_WGU = 1 * MiB, WS_WDN = WS_WGU + 8 * SZ_GU;
constexpr size_t WS_WAI = WS_WDN + 8 * SZ_DN, WS_WAO = WS_WAI + 2 * 6 * MiB, WS_WBI = WS_WAO + 2 * 2 * MiB, WS_WBO = WS_WBI + 4 * MiB;
constexpr size_t WS_WCI = WS_WBO + 2 * MiB, WS_WCO = WS_WCI + 6 * MiB, WS_WF = WS_WCO + 2 * MiB;
constexpr size_t WS_XN = WS_WF + 1 * MiB;
constexpr size_t SZ_ROWBUF = (size_t)MPAD * 1024 * 2;
constexpr size_t WS_ACT = WS_XN + 33 * MiB;
constexpr size_t WS_HMETA = WS_ACT + 98 * MiB, WS_LF = WS_HMETA + 1 * MiB, WS_LFM = WS_LF + 1 * MiB, WS_CS = WS_LFM + 1 * MiB, WS_SSQ = WS_CS + 2 * MiB, WS_SSQM = WS_SSQ + 1 * MiB, WS_END = WS_SSQM + 1 * MiB;
static_assert(SZ_ROWBUF <= 33 * MiB && 3 * SZ_ROWBUF <= 98 * MiB && (size_t)MPAD * FF * 2 <= 98 * MiB, "ws map");

constexpr int RING_BYTES = 131072, LDS_BYTES = 147456;
static_assert(attn_body::ATTN_LDS_BYTES <= RING_BYTES, "attention LDS");
constexpr int MISC_OFF = RING_BYTES + 320;

#define GAS __attribute__((address_space(1)))
typedef unsigned short bf16;
typedef unsigned v4u __attribute__((ext_vector_type(4)));
typedef unsigned v2u __attribute__((ext_vector_type(2)));
typedef float f32x4 __attribute__((ext_vector_type(4)));
typedef float f32x2 __attribute__((ext_vector_type(2)));
typedef short bf16x8 __attribute__((ext_vector_type(8)));
#define LDS_WAIT() asm volatile("s_waitcnt lgkmcnt(0)" ::: "memory")
__device__ __forceinline__ unsigned f2bf(float f) { unsigned u = __builtin_bit_cast(unsigned, f); return (u + 0x7fffu + ((u >> 16) & 1u)) >> 16; }
__device__ __forceinline__ unsigned pk2(float lo, float hi) { return f2bf(lo) | (f2bf(hi) << 16); }
__device__ __forceinline__ float bflo(unsigned w) { return __builtin_bit_cast(float, w << 16); }
__device__ __forceinline__ float bfhi(unsigned w) { return __builtin_bit_cast(float, w & 0xffff0000u); }
__device__ __forceinline__ float lane_get(float v, int src_lane) { return __builtin_bit_cast(float, __builtin_amdgcn_ds_bpermute(src_lane << 2, __builtin_bit_cast(int, v))); }
__device__ __forceinline__ float wave_sum(float v, int lane) {
#pragma unroll
    for (int o = 1; o < 64; o <<= 1) v += lane_get(v, lane ^ o);
    return v;
}

struct Args {
    const float* x; const float* meta; const float* ffn_norm; const float* ffn_w_gate; const float* ffn_w_up; const float* ffn_w_down; const float* mix_norm;
    const float* a_w_in; const float* a_conv; const float* a_w_out;
    const float* b_w_in; const float* b_conv; const float* b_conv_bias; const float* b_ln_g; const float* b_ln_b; const float* b_w_out;
    const float* c_w_in; const float* c_b_f; const float* c_q_norm; const float* c_k_norm; const float* c_w_out;
    float* out; unsigned char* ws;
};

__device__ __forceinline__ void transpose_item(const float* src, int Nsrc, bf16* dst, int K, int kb, LAS float* scr, int lane, const float* gain = nullptr) {
    const int k0 = 64 * kb;
    const GAS float* sp = (const GAS float*)src + (size_t)(k0 + (lane >> 5)) * Nsrc + (lane & 31);
    float v[32];
#pragma unroll
    for (int i = 0; i < 32; ++i) v[i] = sp[(size_t)(2 * i) * Nsrc];
    const int c = lane & 7;
    f32x4 g0 = {1.f, 1.f, 1.f, 1.f}, g1 = g0;
    if (gain) { g0 = *(const GAS f32x4*)(gain + k0 + 8 * c); g1 = *(const GAS f32x4*)(gain + k0 + 8 * c + 4); }
#pragma unroll
    for (int i = 0; i < 32; ++i) scr[(2 * i + (lane >> 5)) * 33 + (lane & 31)] = v[i];
    LDS_WAIT(); asm volatile("" ::: "memory");
#pragma unroll
    for (int j = 0; j < 4; ++j) { const int n = (lane >> 3) + 8 * j; const LAS float* s = scr + (8 * c) * 33 + n;
        v4u o; o.x = pk2(s[0 * 33] * g0.x, s[1 * 33] * g0.y); o.y = pk2(s[2 * 33] * g0.z, s[3 * 33] * g0.w); o.z = pk2(s[4 * 33] * g1.x, s[5 * 33] * g1.y); o.w = pk2(s[6 * 33] * g1.z, s[7 * 33] * g1.w);
        *(GAS v4u*)(dst + (size_t)n * K + k0 + 8 * c) = o; }
    LDS_WAIT(); asm volatile("" ::: "memory");
}

__device__ __forceinline__ float hb_row(const float* xrow, bf16* orow, int lane) {
    const GAS f32x4* xr = (const GAS f32x4*)xrow + lane;
    f32x4 v[4]; float s = 0.f;
#pragma unroll
    for (int j = 0; j < 4; ++j) { v[j] = xr[64 * j]; s += (v[j].x * v[j].x + v[j].y * v[j].y) + (v[j].z * v[j].z + v[j].w * v[j].w); }
    GAS unsigned long long* o8 = (GAS unsigned long long*)orow + lane;
#pragma unroll
    for (int j = 0; j < 4; ++j) o8[64 * j] = (unsigned long long)pk2(v[j].x, v[j].y) | ((unsigned long long)pk2(v[j].z, v[j].w) << 32);
    return wave_sum(s, lane);
}

constexpr int I_GU = 176 * 16, I_DN = 32 * 44, I_AI = 96 * 16, I_SQ = 32 * 16, I_BI = 64 * 16, I_CI = 96 * 16;
constexpr int I_FFN = 2 * I_GU + 2 * I_DN, I_MIXBASE = 8 * I_GU + 8 * I_DN;
static_assert(I_CI == I_AI, "conv_nv");
__device__ __forceinline__ int conv_nv(int L) { return I_FFN + ((L == 1) ? I_BI + I_SQ : I_AI + I_SQ); }
__device__ __forceinline__ int conv_item(int L, int v) {
    if (v < 2 * I_GU) return 2 * L * I_GU + v;
    if (v < I_FFN) return 8 * I_GU + 2 * L * I_DN + (v - 2 * I_GU);
    const int w = v - I_FFN;
    if (L == 0) return (w < I_AI) ? I_MIXBASE + w : I_MIXBASE + 2 * I_AI + (w - I_AI);
    if (L == 3) return (w < I_AI) ? I_MIXBASE + I_AI + w : I_MIXBASE + 2 * I_AI + I_SQ + (w - I_AI);
    if (L == 1) return I_MIXBASE + 2 * I_AI + 2 * I_SQ + w;
    return I_MIXBASE + 2 * I_AI + 2 * I_SQ + I_BI + I_SQ + w;
}
#define CONVERT_BODY \
            int r = it; \
            if (r < 8 * I_GU) { const int mat = r / I_GU; r %= I_GU; const int kb = r / 176, nb = r % 176, pn = nb >> 3, q = nb & 7; \
                const float* src = ((q < 4) ? a.ffn_w_gate : a.ffn_w_up) + (size_t)mat * 1024 * FF + 128 * pn + 32 * (q & 3); \
                transpose_item(src, FF, WGU + (size_t)mat * 5632 * 1024 + (size_t)nb * 32 * 1024, 1024, kb, scr, lane, a.ffn_norm + (size_t)mat * DM); continue; } \
            r -= 8 * I_GU; \
            if (r < 8 * I_DN) { const int mat = r / I_DN; r %= I_DN; const int kb = r / 32, nb = r % 32; \
                transpose_item(a.ffn_w_down + (size_t)mat * FF * 1024 + 32 * nb, 1024, WDN + (size_t)mat * 1024 * FF + (size_t)nb * 32 * FF, FF, kb, scr, lane); continue; } \
            r -= 8 * I_DN; \
            if (r < 2 * I_AI) { const int mat = r / I_AI; r %= I_AI; const int kb = r / 96, nb = r % 96, pn = nb >> 3, q = nb & 7; \
                const int scol = (pn < 8) ? ((q < 4) ? 1024 + 128 * pn + 32 * q : 2048 + 128 * pn + 32 * (q - 4)) : (nb - 64) * 32; \
                transpose_item(a.a_w_in + (size_t)mat * 1024 * 3072 + scol, 3072, WAI + (size_t)mat * 3072 * 1024 + (size_t)nb * 32 * 1024, 1024, kb, scr, lane, a.mix_norm + (size_t)(3 * mat) * DM); continue; } \
            r -= 2 * I_AI; \
            if (r < 2 * I_SQ) { const int mat = r / I_SQ; r %= I_SQ; const int kb = r / 32, nb = r % 32; \
                transpose_item(a.a_w_out + (size_t)mat * 1024 * 1024 + 32 * nb, 1024, WAO + (size_t)mat * 1024 * 1024 + (size_t)nb * 32 * 1024, 1024, kb, scr, lane); continue; } \
            r -= 2 * I_SQ; \
            if (r < I_BI) { const int kb = r / 64, nb = r % 64, pn = nb >> 3, q = nb & 7; \
                const int scol = (q < 4) ? 128 * pn + 32 * q : 1024 + 128 * pn + 32 * (q - 4); \
                transpose_item(a.b_w_in + scol, 2048, WBI + (size_t)nb * 32 * 1024, 1024, kb, scr, lane, a.mix_norm + (size_t)1 * DM); continue; } \
            r -= I_BI; \
            if (r < I_SQ) { const int kb = r / 32, nb = r % 32; \
                transpose_item(a.b_w_out + 32 * nb, 1024, WBO + (size_t)nb * 32 * 1024, 1024, kb, scr, lane); continue; } \
            r -= I_SQ; \
            if (r < I_CI) { const int kb = r / 96, nb = r % 96, pn = nb >> 3, q = nb & 7; \
                const int scol = (pn < 8) ? (pn >> 2) * 1024 + 64 * (4 * (pn & 3) + (q & 3)) + 32 * (q >> 2) : 2048 + (nb - 64) * 32; \
                transpose_item(a.c_w_in + scol, 3088, WCI + (size_t)nb * 32 * 1024, 1024, kb, scr, lane, a.mix_norm + (size_t)2 * DM); continue; } \
            r -= I_CI; \
            { const int kb = r / 32, nb = r % 32; \
                transpose_item(a.c_w_out + 32 * nb, 1024, WCO + (size_t)nb * 32 * 1024, 1024, kb, scr, lane); }

__device__ __forceinline__ void thin_gemm(LAS unsigned char* ldsl, const int tid, const int task, const bf16* A, const bf16* Bt, const int K, const int mode,
                                          bf16* R0, bf16* R1, bf16* R2, float* hmeta, const float scale, const float* qg, const float* kg, float* SSQM, bf16* HB) {
    const int ntasks = (mode == 0) ? 176 : (mode == 2) ? 128 : (mode == 3) ? 48 : 64;
    if (task < 0 || task >= ntasks) return;
    v2u ho_pre = {0u, 0u}; if (mode == 4) ho_pre = *(const GAS v2u*)(HB + (size_t)(MMAIN + (tid & 15)) * 1024 + 16 * task + 4 * ((tid & 63) >> 4));
    float rsm_t = 0.f;
    if (mode != 4) {
#pragma unroll
        for (int i = 0; i < 16; ++i) { const f32x4 q4 = *(const GAS f32x4*)(SSQM + (tid & 15) * 64 + 4 * i); rsm_t += (q4.x + q4.y) + (q4.z + q4.w); } }
    const int lane = tid & 63, wave = __builtin_amdgcn_readfirstlane(tid >> 6), fr = lane & 15, fq = lane >> 4;
    int nt = 1, b0 = 0, b1 = 0, b2 = 0, b3 = 0;
    if (mode <= 1 || (mode == 2 && task < 64)) { const int f0 = 16 * task; b0 = 256 * (f0 >> 7) + (f0 & 127); b1 = b0 + 128; nt = 2; }
    else if (mode == 2) { b0 = 2048 + 16 * (task - 64); }
    else if (mode == 3) { const int sec = task >> 4, hd = task & 15; nt = 4;
        if (sec < 2) { b0 = 256 * (sec * 4 + (hd >> 2)) + 32 * (hd & 3); b1 = b0 + 16; b2 = b0 + 128; b3 = b0 + 144; }
        else { b0 = 2048 + 64 * hd; b1 = b0 + 16; b2 = b0 + 32; b3 = b0 + 48; } }
    else { b0 = 16 * task; }
    const int kw = K >> 3, ksteps = kw >> 5;
    const GAS bf16x8* ap = (const GAS bf16x8*)(A + (size_t)(MMAIN + fr) * K + wave * kw + 8 * fq);
    const GAS bf16x8* p0 = (const GAS bf16x8*)(Bt + (size_t)(b0 + fr) * K + wave * kw + 8 * fq);
    const GAS bf16x8* p1 = (const GAS bf16x8*)(Bt + (size_t)(b1 + fr) * K + wave * kw + 8 * fq);
    const GAS bf16x8* p2 = (const GAS bf16x8*)(Bt + (size_t)(b2 + fr) * K + wave * kw + 8 * fq);
    const GAS bf16x8* p3 = (const GAS bf16x8*)(Bt + (size_t)(b3 + fr) * K + wave * kw + 8 * fq);
    f32x4 c0 = {0.f, 0.f, 0.f, 0.f}, c1 = c0, c2 = c0, c3 = c0;
    if (ksteps > 4) {
        bf16x8 xa[11], wb[11];
#pragma unroll
        for (int ks = 0; ks < 11; ++ks) { xa[ks] = ap[4 * ks]; wb[ks] = p0[4 * ks]; }
#pragma unroll
        for (int ks = 0; ks < 11; ++ks) c0 = __builtin_amdgcn_mfma_f32_16x16x32_bf16(wb[ks], xa[ks], c0, 0, 0, 0);
    } else {
#pragma unroll 4
    for (int ks = 0; ks < ksteps; ++ks) {
        const bf16x8 xa = ap[4 * ks];
        c0 = __builtin_amdgcn_mfma_f32_16x16x32_bf16(p0[4 * ks], xa, c0, 0, 0, 0);
        if (nt >= 2) c1 = __builtin_amdgcn_mfma_f32_16x16x32_bf16(p1[4 * ks], xa, c1, 0, 0, 0);
        if (nt >= 4) { c2 = __builtin_amdgcn_mfma_f32_16x16x32_bf16(p2[4 * ks], xa, c2, 0, 0, 0); c3 = __builtin_amdgcn_mfma_f32_16x16x32_bf16(p3[4 * ks], xa, c3, 0, 0, 0); }
    }
    }
    LAS f32x4* P = (LAS f32x4*)ldsl;
    P[(wave * 4 + 0) * 64 + lane] = c0; P[(wave * 4 + 1) * 64 + lane] = c1; P[(wave * 4 + 2) * 64 + lane] = c2; P[(wave * 4 + 3) * 64 + lane] = c3;
    __syncthreads();
    if (wave == 0) {
#pragma unroll
        for (int w = 1; w < 8; ++w) { c0 += P[(w * 4 + 0) * 64 + lane]; c1 += P[(w * 4 + 1) * 64 + lane]; c2 += P[(w * 4 + 2) * 64 + lane]; c3 += P[(w * 4 + 3) * 64 + lane]; }
        const size_t mrow = (size_t)(MMAIN + fr);
        if (mode != 4) { const float rsm = __builtin_amdgcn_rsqf(rsm_t * (1.f / DM) + EPS); c0 *= rsm; c1 *= rsm; c2 *= rsm; c3 *= rsm; }
        if (mode <= 1 || (mode == 2 && task < 64)) {
            f32x4 r;
            if (mode == 0) {
#pragma unroll
                for (int i = 0; i < 4; ++i) r[i] = c0[i] * pg8::sigm(c0[i]) * c1[i];
            } else if (mode == 1) {
#pragma unroll
                for (int i = 0; i < 4; ++i) r[i] = c0[i] * pg8::sigm(c1[i]);
            } else r = c0 * c1;
            *(GAS v2u*)(R0 + mrow * (mode == 0 ? FF : 1024) + 16 * task + 4 * fq) = (v2u){pk2(r[0], r[1]), pk2(r[2], r[3])};
        } else if (mode == 2) {
            *(GAS v2u*)(R1 + mrow * 1024 + 16 * (task - 64) + 4 * fq) = (v2u){pk2(c0[0], c0[1]), pk2(c0[2], c0[3])};
        } else if (mode == 3) {
            const int sec = task >> 4, hd = task & 15;
            f32x4 v0 = c0, v1 = c1, v2 = c2, v3 = c3;
            if (sec < 2) {
                float ss = (c0[0] * c0[0] + c0[1] * c0[1]) + (c0[2] * c0[2] + c0[3] * c0[3]) + (c1[0] * c1[0] + c1[1] * c1[1]) + (c1[2] * c1[2] + c1[3] * c1[3])
                         + (c2[0] * c2[0] + c2[1] * c2[1]) + (c2[2] * c2[2] + c2[3] * c2[3]) + (c3[0] * c3[0] + c3[1] * c3[1]) + (c3[2] * c3[2] + c3[3] * c3[3]);
                ss += lane_get(ss, lane ^ 16); ss += lane_get(ss, lane ^ 32);
                const float rs = __builtin_amdgcn_rsqf(ss * (1.0f / 64.0f) + EPS) * ((sec == 0) ? pg8::QK_C2 : 1.0f);
                const float* g = (sec == 0) ? qg : kg;
                v0 = c0 * rs * *(const GAS f32x4*)(g + 4 * fq); v1 = c1 * rs * *(const GAS f32x4*)(g + 16 + 4 * fq); v2 = c2 * rs * *(const GAS f32x4*)(g + 32 + 4 * fq); v3 = c3 * rs * *(const GAS f32x4*)(g + 48 + 4 * fq);
            }
            const v2u w0 = {pk2(v0[0], v0[1]), pk2(v0[2], v0[3])}, w1 = {pk2(v1[0], v1[1]), pk2(v1[2], v1[3])}, w2 = {pk2(v2[0], v2[1]), pk2(v2[2], v2[3])}, w3 = {pk2(v3[0], v3[1]), pk2(v3[2], v3[3])};
            const int col = 64 * hd + 4 * fq;
            if (sec == 0) { bf16* q = R0 + mrow * 1024 + col; *(GAS v2u*)q = w0; *(GAS v2u*)(q + 16) = w1; *(GAS v2u*)(q + 32) = w2; *(GAS v2u*)(q + 48) = w3; }
            else { bf16* T = (sec == 1) ? R1 : R2;
#pragma unroll
                for (int b = 0; b < 2; ++b) { bf16* q = T + (size_t)(b * KVROWS + 48 + fr) * 1024 + col; *(GAS v2u*)q = w0; *(GAS v2u*)(q + 16) = w1; *(GAS v2u*)(q + 32) = w2; *(GAS v2u*)(q + 48) = w3; } }
        } else {
            const v2u ho = ho_pre;
            const f32x4 hn = (f32x4){bflo(ho.x), bfhi(ho.x), bflo(ho.y), bfhi(ho.y)} + c0 * scale;
            *(GAS v2u*)(HB + mrow * 1024 + 16 * task + 4 * fq) = (v2u){pk2(hn[0], hn[1]), pk2(hn[2], hn[3])};
            float ps = (hn[0] * hn[0] + hn[1] * hn[1]) + (hn[2] * hn[2] + hn[3] * hn[3]); ps += lane_get(ps, lane ^ 16); ps += lane_get(ps, lane ^ 32);
            if (fq == 0) SSQM[fr * 64 + task] = ps;
        }
    }
    __syncthreads();
}

__global__ void __launch_bounds__(NWAVES * 64, 2) fwd_megakernel(Args a_unused) {
    extern __shared__ __attribute__((aligned(16))) unsigned char lds[];
    cg::grid_group grid = cg::this_grid();
    const int G = gridDim.x, bx = blockIdx.x;
    const int vcu0 = (G % 8 == 0) ? (bx % 8) * (G / 8) + bx / 8 : bx;
    const int NGW = G * NWAVES;
    if (threadIdx.x < 64) ((LAS unsigned*)((LAS unsigned char*)lds + RING_BYTES))[threadIdx.x * 2] = 0u, ((LAS unsigned*)((LAS unsigned char*)lds + RING_BYTES))[threadIdx.x * 2 + 1] = 0u;
    __syncthreads();
    const int wave_s = __builtin_amdgcn_readfirstlane((int)threadIdx.x >> 6);
#define PHASE_ENV() \
    const __attribute__((address_space(4))) Args* kap_ = (const __attribute__((address_space(4))) Args*)__builtin_amdgcn_kernarg_segment_ptr(); asm volatile("" : "+s"(kap_)); \
    const __attribute__((address_space(4))) Args& a = *kap_;     \
    unsigned zero_ = 0u; asm volatile("" : "+s"(zero_)); int vcu = vcu0; asm volatile("" : "+s"(vcu)); \
    int tid = (wave_s << 6) | (int)__builtin_amdgcn_mbcnt_hi(~0u, __builtin_amdgcn_mbcnt_lo(~0u, zero_)); \
    const int lane = tid & 63, wave = __builtin_amdgcn_readfirstlane(tid >> 6), gw = vcu * NWAVES + wave; \
    unsigned char* ws0_ = a.ws; asm volatile("" : "+s"(ws0_)); unsigned char* const ws = (unsigned char*)(GAS unsigned char*)ws0_;     \
    float* hm0_ = a.out; asm volatile("" : "+s"(hm0_)); float* const hmain = (float*)(GAS float*)hm0_; \
    bf16* const WGU = (bf16*)(ws + WS_WGU); bf16* const WDN = (bf16*)(ws + WS_WDN); \
    bf16* const WAI = (bf16*)(ws + WS_WAI); bf16* const WAO = (bf16*)(ws + WS_WAO); bf16* const WBI = (bf16*)(ws + WS_WBI); bf16* const WBO = (bf16*)(ws + WS_WBO); \
    bf16* const WCI = (bf16*)(ws + WS_WCI); bf16* const WCO = (bf16*)(ws + WS_WCO); bf16* const WFt = (bf16*)(ws + WS_WF); \
    bf16* const XN = (bf16*)(ws + WS_XN); \
    bf16* const R0 = (bf16*)(ws + WS_ACT); bf16* const R1 = (bf16*)(ws + WS_ACT + SZ_ROWBUF); bf16* const R2 = (bf16*)(ws + WS_ACT + 2 * SZ_ROWBUF); \
    float* const hmeta = (float*)(ws + WS_HMETA); \
    float* const LF = (float*)(ws + WS_LF); float* const LFM = (float*)(ws + WS_LFM); float* const CS = (float*)(ws + WS_CS); \
    float* const SSQ = (float*)(ws + WS_SSQ); float* const SSQM = (float*)(ws + WS_SSQM); (void)SSQ; (void)SSQM; \
    LAS unsigned char* const ldsl = (LAS unsigned char*)lds; \
    (void)WGU; (void)WDN; (void)WAI; (void)WAO; (void)WBI; (void)WBO; (void)WCI; (void)WCO; (void)WFt; (void)XN; (void)R0; (void)R1; (void)R2; (void)hmeta; (void)LF; (void)LFM; (void)CS; (void)ldsl; (void)lane; (void)gw; (void)hmain;

#ifdef PROBE_SEL
    LAS unsigned long long* const TS = (LAS unsigned long long*)((LAS unsigned char*)lds + RING_BYTES + 12288);
    if (threadIdx.x == 0) { for (int c = 0; c < 8; ++c) TS[c] = 0; TS[8] = __builtin_amdgcn_s_memrealtime(); }
#endif
    XcdBarrier bar;
    { PHASE_ENV(); bar = xcd_barrier_post((unsigned*)(ws + WS_CTL), (volatile LAS unsigned*)(ldsl + MISC_OFF) + 8, tid); }
    {
        PHASE_ENV();
        LAS float* scr = (LAS float*)(ldsl + wave * 16384);
        for (int v = gw; v < conv_nv(0); v += NGW) { const int it = conv_item(0, v);
            CONVERT_BODY
        }
        for (int i = gw * 64 + lane; i < 16 * 1024; i += NGW * 64) { const int h = i >> 10, k = i & 1023; WFt[i] = (bf16)f2bf(a.c_w_in[(size_t)k * 3088 + 3072 + h] * a.mix_norm[2 * DM + k]); }
        for (int m0 = gw; m0 < MROWS; m0 += 2 * NGW) {
            const int m1 = m0 + NGW; const bool has1 = (m1 < MROWS);
            const float* s0 = (m0 < MMAIN) ? a.x + (size_t)m0 * DM : a.meta + (size_t)(m0 - MMAIN) * DM;
            const float* s1 = !has1 ? s0 : (m1 < MMAIN) ? a.x + (size_t)m1 * DM : a.meta + (size_t)(m1 - MMAIN) * DM;
            f32x4 va[4], vb[4];
#pragma unroll
            for (int j = 0; j < 4; ++j) { va[j] = ((const GAS f32x4*)s0 + lane)[64 * j]; vb[j] = ((const GAS f32x4*)s1 + lane)[64 * j]; }
#pragma unroll
            for (int half = 0; half < 2; ++half) {
                if (half == 1 && !has1) break;
                const int m = half ? m1 : m0; float ssl = 0.f;
                GAS unsigned long long* o8 = (GAS unsigned long long*)(XN + (size_t)m * DM) + lane;
#pragma unroll
                for (int j = 0; j < 4; ++j) { const f32x4 v = half ? vb[j] : va[j]; ssl += (v.x * v.x + v.y * v.y) + (v.z * v.z + v.w * v.w);
                    o8[64 * j] = (unsigned long long)pk2(v.x, v.y) | ((unsigned long long)pk2(v.z, v.w) << 32); }
                const float ss = wave_sum(ssl, lane);
                if (m < MMAIN) { if (lane < 4) SSQ[(size_t)m * 4 + lane] = (lane == 0) ? ss : 0.f; } else SSQM[(m - MMAIN) * 64 + lane] = (lane == 0) ? ss : 0.f;
            }
        }
    }
    { PHASE_ENV(); if (ws == nullptr) grid.sync();
      xcd_barrier(bar, tid); }
#ifdef PROBE_SEL
    { PHASE_ENV(); if (tid == 0) { TS[9] = __builtin_amdgcn_s_memrealtime(); TS[0] = TS[9] - TS[8]; } }
#endif
    for (int L = 0; L < DEPTH; ++L) {
        const int mx = L % 3, mj = L / 3;
        for (int s = 0; s <= 10; ++s) {
            if ((s == 6 && mx != 2) || (s == 5 && mx == 2) || s == 0 || s == 3 || s == 8) continue;
#ifdef PROBE_REP
            const int pcat = (s == 1 || s == 9) ? 1 : (s == 2 || s == 10 || s == 7) ? 2 : (s == 4) ? 4 : (s == 5) ? 8 : 16; const int nrep = (PROBE_REP & pcat) ? 2 : 1;
#else
            const int nrep = 1;
#endif
            for (int rp = 0; rp < nrep; ++rp) {
            const bool dry = (rp + 1 < nrep); (void)dry;
            PHASE_ENV();
            if (s == 0 || s == 3 || s == 8) {
                continue;
            } else if (s == 1 || s == 2 || s == 4 || s == 7 || s == 9 || s == 10) {
                pg8::Gemm g; pg8::EpiAll E;
                E.mtiles_main = 64; E.O1 = R0; E.O2 = R1; E.O3 = R2; E.ldo = 1024; E.hmain = hmain; E.hmeta = hmeta; E.scale = 1.f; E.qg = a.c_q_norm; E.kg = a.c_k_norm; E.mode = 0;
                E.ssq = SSQ; E.ssq_out = SSQ; E.hb = XN; E.fout = (L == DEPTH - 1 && s == 10 && !dry) ? hmain : nullptr; E.ldsp = (LAS float*)(ldsl + RING_BYTES + 1024); E.rsl = (const LAS float*)(ldsl + RING_BYTES + 5120);
                g.M = MMAIN;
                if (s == 1 || s == 9) { g.A = XN; g.Bt = WGU + (size_t)(L * 2 + (s == 9)) * 5632 * 1024; g.N = 5632; g.K = 1024; E.mode = 0; E.ldo = FF; }
                else if (s == 2 || s == 10) { g.A = R0; g.Bt = WDN + (size_t)(L * 2 + (s == 10)) * 1024 * FF; g.N = 1024; g.K = FF; E.mode = 4; E.scale = dry ? 0.f : 0.5f; }
                else if (s == 4) {
                    g.A = XN; g.K = 1024;
                    if (mx == 0) { g.Bt = WAI + (size_t)mj * 3072 * 1024; g.N = 3072; E.mode = 2; }
                    else if (mx == 1) { g.Bt = WBI; g.N = 2048; E.mode = 1; }
                    else { g.Bt = WCI; g.N = 3072; E.mode = 3;
                    for (int i = gw; i < 2 * 2 * 112; i += NGW) { const int tsel = i / 224, rr = i % 224, b = rr / 112, j = rr % 112; const int row = b * KVROWS + (j < 48 ? j : j + 16);
                        bf16* p = (tsel ? R2 : R1) + (size_t)row * 1024; ((GAS v4u*)p)[lane * 2] = (v4u){zero_, zero_, zero_, zero_}; ((GAS v4u*)p)[lane * 2 + 1] = (v4u){zero_, zero_, zero_, zero_}; }
                        const int fr = lane & 15, fq = lane >> 4;
                        for (int grp = gw; grp < MROWS / 16; grp += NGW) {
                            const bf16* xp = XN + (size_t)(16 * grp + fr) * DM + 8 * fq; const bf16* wp = WFt + (size_t)fr * DM + 8 * fq;
                            f32x4 acc = {0.f, 0.f, 0.f, 0.f};
#pragma unroll 16
                            for (int k = 0; k < 32; ++k) { const bf16x8 xa = *(const GAS bf16x8*)(xp + 32 * k), wb = *(const GAS bf16x8*)(wp + 32 * k);
                                acc = __builtin_amdgcn_mfma_f32_16x16x32_bf16(xa, wb, acc, 0, 0, 0); }
                            const float bf = a.c_b_f[fr]; f32x4 o; float rsr[4];
                            if (grp < MMAIN / 16) {
#pragma unroll
                                for (int r = 0; r < 4; ++r) { const f32x4 q4 = *(const GAS f32x4*)(SSQ + (size_t)(16 * grp + 4 * fq + r) * 4); rsr[r] = __builtin_amdgcn_rsqf(((q4.x + q4.y) + (q4.z + q4.w)) * (1.f / DM) + EPS); }
                            } else {
#pragma unroll
                                for (int r = 0; r < 4; ++r) { float t = 0.f; for (int i = 0; i < 16; ++i) { const f32x4 q4 = *(const GAS f32x4*)(SSQM + (4 * fq + r) * 64 + 4 * i); t += (q4.x + q4.y) + (q4.z + q4.w); } rsr[r] = __builtin_amdgcn_rsqf(t * (1.f / DM) + EPS); }
                            }
#pragma unroll
                            for (int r = 0; r < 4; ++r) { const float xv = acc[r] * rsr[r] + bf; o[r] = fminf(xv, 0.f) - log1pf(expf(-fabsf(xv))); }
                            if (grp < MMAIN / 16) { const int r0 = 16 * grp, b = r0 >> 13, t0 = r0 & 8191; *(GAS f32x4*)(LF + ((size_t)(b * NH + fr) * SEQ + t0 + 4 * fq)) = o; }
                            else *(GAS f32x4*)(LFM + fr * 16 + 4 * fq) = o;
                        }
                        asm volatile("s_waitcnt vmcnt(0) lgkmcnt(0)" ::: "memory"); __syncthreads();
                    }
                }
                else { g.K = 1024; g.N = 1024; E.mode = 4; E.scale = dry ? 0.f : 1.f;
                    if (mx == 0) { g.A = R2; g.Bt = WAO + (size_t)mj * 1024 * 1024; } else if (mx == 1) { g.A = R1; g.Bt = WBO; } else { g.A = R0; g.Bt = WCO; } }
                pg8::StaticOrder S; S.init(g.M, g.N, G, bx);
                f32x4 rs_q[3] = {{0.f, 0.f, 0.f, 0.f}, {0.f, 0.f, 0.f, 0.f}, {0.f, 0.f, 0.f, 0.f}}; bool rs_has[3] = {false, false, false};
                if (E.mode != 4) { pg8::Unit uu{0, 0};
#pragma unroll
                    for (int j = 0; j < 3; ++j) { const int i = (tid >> 8) + 2 * j; rs_has[j] = S.next(i, uu); if (rs_has[j]) rs_q[j] = *(const GAS f32x4*)(SSQ + (size_t)(uu.pm * 256 + (tid & 255)) * 4); } }
                for (int rep2 = 0; rep2 < 2; ++rep2) { const int task = (E.mode == 0) ? ((bx >= 128) ? bx - 128 + 128 * rep2 : -1) : (rep2 == 0 ? vcu : -1);
                    thin_gemm(ldsl, tid, task, g.A, g.Bt, g.K, E.mode, R0, R1, R2, hmeta, E.scale, a.c_q_norm, a.c_k_norm, SSQM, XN); }
                if (E.mode != 4) {
                    LAS float* rsl = (LAS float*)(ldsl + RING_BYTES + 5120);
#pragma unroll
                    for (int j = 0; j < 3; ++j) { const int i = (tid >> 8) + 2 * j; if (rs_has[j]) rsl[i * 256 + (tid & 255)] = __builtin_amdgcn_rsqf(((rs_q[j].x + rs_q[j].y) + (rs_q[j].z + rs_q[j].w)) * (1.f / DM) + EPS); }
                }
                if ((s == 1 || s == 9) && L + 1 < DEPTH && bx >= 128 && !dry) {
                    LAS float* scr = (LAS float*)(ldsl + wave * 16384);
                    const int nv = conv_nv(L + 1), lo = (s == 1) ? 0 : nv / 2, hi = (s == 1) ? nv / 2 : nv;
                    for (int v = lo + (bx - 128) * NWAVES + wave; v < hi; v += 128 * NWAVES) { const int it = conv_item(L + 1, v);
                        CONVERT_BODY
                    }
                }
                asm volatile("s_waitcnt vmcnt(0) lgkmcnt(0)" ::: "memory"); __syncthreads();
#ifndef NO_GEMM
                pg8::gemm_phase<pg8::EpiAll, pg8::StaticOrder, PG8_ALIGN, PG8_SP2>(ldsl, g, S, E, tid);
#endif
                if (E.mode == 4) {
                    const int pm0 = 8 * (bx & 7) + ((bx >> 3) & 7), pn0 = bx >> 6;
                    if (G == 256 && tid < 256) { const f32x4 p4 = *(const LAS f32x4*)(E.ldsp + tid * 4); SSQ[(size_t)(pm0 * 256 + tid) * 4 + pn0] = (p4.x + p4.y) + (p4.z + p4.w); }
                }
            } else if (s == 5) {
                if (mx == 0) {
                    const float* cw = a.a_conv + (size_t)mj * 3 * DM + 16 * lane;
                    f32x4 w0[4], w1[4], w2[4];
#pragma unroll
                    for (int j = 0; j < 4; ++j) { w0[j] = *(const f32x4*)(cw + 4 * j); w1[j] = *(const f32x4*)(cw + DM + 4 * j); w2[j] = *(const f32x4*)(cw + 2 * DM + 4 * j); }
                    for (int blk = gw; blk < MROWS / 4; blk += NGW) {
                        const bool mainb = (blk < MMAIN / 4); const int r0 = mainb ? 4 * blk : MMAIN + 4 * (blk - MMAIN / 4);
                        int rm1, rm2;
                        if (mainb) { const int t0 = r0 & 8191; rm1 = (t0 >= 1) ? r0 - 1 : MMAIN + 15; rm2 = (t0 >= 2) ? r0 - 2 : MMAIN + 14; }
                        else { const int p0 = r0 - MMAIN; rm1 = (p0 >= 1) ? r0 - 1 : -1; rm2 = (p0 >= 2) ? r0 - 2 : -1; }
                        const v4u z4 = {0u, 0u, 0u, 0u};
                        v4u xw[6][2], bb[4][2];
#pragma unroll
                        for (int hh = 0; hh < 2; ++hh) {
                            xw[0][hh] = (rm2 >= 0) ? ((const GAS v4u*)(R0 + (size_t)rm2 * DM) + 2 * lane)[hh] : z4; xw[1][hh] = (rm1 >= 0) ? ((const GAS v4u*)(R0 + (size_t)rm1 * DM) + 2 * lane)[hh] : z4;
#pragma unroll
                            for (int i = 0; i < 4; ++i) { xw[2 + i][hh] = ((const GAS v4u*)(R0 + (size_t)(r0 + i) * DM) + 2 * lane)[hh]; bb[i][hh] = ((const GAS v4u*)(R1 + (size_t)(r0 + i) * DM) + 2 * lane)[hh]; } }
#pragma unroll
                        for (int i = 0; i < 4; ++i) { GAS v4u* yp = (GAS v4u*)(R2 + (size_t)(r0 + i) * DM) + 2 * lane;
#pragma unroll
                            for (int hh = 0; hh < 2; ++hh) { v4u o;
#pragma unroll
                                for (int e = 0; e < 4; ++e) { const int j = 2 * hh + (e >> 1), c = 2 * (e & 1);
                                    const float lo = bflo(bb[i][hh][e]) * (w2[j][c] * bflo(xw[2 + i][hh][e]) + w1[j][c] * bflo(xw[1 + i][hh][e]) + w0[j][c] * bflo(xw[i][hh][e]));
                                    const float hi = bfhi(bb[i][hh][e]) * (w2[j][c + 1] * bfhi(xw[2 + i][hh][e]) + w1[j][c + 1] * bfhi(xw[1 + i][hh][e]) + w0[j][c + 1] * bfhi(xw[i][hh][e]));
                                    o[e] = pk2(lo, hi); }
                                yp[hh] = o; } }
                    }
                } else if (mx == 1) {
#ifndef NO_CONF
                    const int c = 2 * tid;
                    f32x2 w[31];
#pragma unroll
                    for (int k = 0; k < 31; ++k) w[k] = *(const GAS f32x2*)(a.b_conv + (size_t)k * DM + c);
                    const f32x2 cb = *(const f32x2*)(a.b_conv_bias + c), lg = *(const f32x2*)(a.b_ln_g + c), lb = *(const f32x2*)(a.b_ln_b + c);
                    LAS float* red = (LAS float*)ldsl;
                    LAS float* red2 = red + 256;
                    for (int un = vcu; un < MROWS / 16; un += G) {
                        const int r0 = 16 * un; const bool meta = (r0 >= MMAIN);
                        const int p0 = meta ? 0 : 16 + (r0 & 8191); const int rowb = meta ? 0 : (r0 >> 13) * SEQ;
                        unsigned xin[46];
#pragma unroll
                        for (int j = 0; j < 46; ++j) { const int pj = p0 - 30 + j;
                            xin[j] = (pj >= 0) ? *(const GAS unsigned*)(R0 + (size_t)((pj < 16) ? MMAIN + pj : rowb + pj - 16) * DM + c) : 0u; }
                        f32x2 acc[16];
#pragma unroll
                        for (int i = 0; i < 16; ++i) acc[i] = cb;
#pragma unroll
                        for (int j = 0; j < 46; ++j) { const f32x2 xv = {bflo(xin[j]), bfhi(xin[j])};
#pragma unroll
                            for (int i = 0; i < 16; ++i) { const int k = j - i; if (k >= 0 && k <= 30) acc[i] += w[k] * xv; } }
                        float st[32];
#pragma unroll
                        for (int i = 0; i < 16; ++i) { st[2 * i] = acc[i].x + acc[i].y; st[2 * i + 1] = acc[i].x * acc[i].x + acc[i].y * acc[i].y; }
#pragma unroll
                        for (int i = 0; i < 32; ++i) st[i] = wave_sum(st[i], lane);
                        if (lane == 0) {
#pragma unroll
                            for (int i = 0; i < 8; ++i) *(LAS f32x4*)(red + wave * 32 + 4 * i) = (f32x4){st[4 * i], st[4 * i + 1], st[4 * i + 2], st[4 * i + 3]}; }
                        __syncthreads();
                        if (tid < 32) { float t = 0.f;
#pragma unroll
                            for (int wv = 0; wv < 8; ++wv) t += red[wv * 32 + tid];
                            red2[tid] = t; }
                        __syncthreads();
#pragma unroll
                        for (int i = 0; i < 16; ++i) { const f32x2 sv = *(const LAS f32x2*)(red2 + 2 * i);
                            const float mu = sv.x * (1.f / DM), var = fmaxf(sv.y * (1.f / DM) - mu * mu, 0.f), rs = 1.0f / sqrtf(var + EPS);
                            const float y0 = (acc[i].x - mu) * rs * lg.x + lb.x, y1 = (acc[i].y - mu) * rs * lg.y + lb.y;
                            *(GAS unsigned*)(R1 + (size_t)(r0 + i) * DM + c) = pk2(y0 * pg8::sigm(y0), y1 * pg8::sigm(y1)); }
                    }
#endif
                } else {
                }
            } else if (s == 6) {
                {
                        const int bh = vcu >> 3, h = bh & 15; LAS float* wt = (LAS float*)ldsl;
                        LAS float* csrow = (LAS float*)(ldsl + attn_body::LDS_CS);
                        float cm = 0.f, cmp = 0.f;
#pragma unroll
                        for (int j = 0; j < 16; ++j) { cm += LFM[h * 16 + j]; if (j == tid) cmp = cm; }
                        const float* lp = LF + (size_t)bh * SEQ + 16 * tid; float v[16];
#pragma unroll
                        for (int j = 0; j < 4; ++j) { const f32x4 q = *(const GAS f32x4*)(lp + 4 * j); v[4 * j] = q.x; v[4 * j + 1] = q.y; v[4 * j + 2] = q.z; v[4 * j + 3] = q.w; }
#pragma unroll
                        for (int j = 1; j < 16; ++j) v[j] += v[j - 1];
                        float inc = v[15];
#pragma unroll
                        for (int o = 1; o < 64; o <<= 1) { const float t = lane_get(inc, (lane - o) & 63); if (lane >= o) inc += t; }
                        if (lane == 63) wt[wave] = inc;
                        __syncthreads();
                        float off = cm + inc - v[15];
                        for (int wv = 0; wv < wave; ++wv) off += wt[wv];
#pragma unroll
                        for (int j = 0; j < 4; ++j) *(LAS f32x4*)(csrow + 128 + 16 * tid + 4 * j) = (f32x4){(off + v[4 * j]) * LOG2E, (off + v[4 * j + 1]) * LOG2E, (off + v[4 * j + 2]) * LOG2E, (off + v[4 * j + 3]) * LOG2E};
                        const float cmsh = lane_get(cmp, (lane + 16) & 63);
                        if (tid < 128) csrow[tid] = (tid >= 48 && tid < 64) ? cmsh * LOG2E : __builtin_inff();
                        __syncthreads();
                }
                const attn_body::AttnTensors AT{(const attn_body::bf16*)R0, (const attn_body::bf16*)R1, (const attn_body::bf16*)R2, (attn_body::bf16*)(dry ? (bf16*)(ws + WS_END) : R0), CS};
                const attn_body::StaticOrder S(G, bx);
#ifndef NO_ATTN
                attn_body::attn_phase<attn_body::StaticOrder>((char*)lds, AT, S, tid);
#endif
                }
                if (s == 6 && !dry) {
                PHASE_ENV();
                if (gw < NH) {
                    const int h = gw, q = lane & 15, dc = lane >> 4;
                    const bf16* qp = R0 + (size_t)(MMAIN + q) * DM + 64 * h + 16 * dc;
                    const v4u qa = ((const GAS v4u*)qp)[0], qb = ((const GAS v4u*)qp)[1];
                    float qv[16];
#pragma unroll
                    for (int e = 0; e < 4; ++e) { qv[2 * e] = bflo(qa[e]); qv[2 * e + 1] = bfhi(qa[e]); qv[8 + 2 * e] = bflo(qb[e]); qv[8 + 2 * e + 1] = bfhi(qb[e]); }
                    float sc[16], cbm[16]; { float run = 0.f;
#pragma unroll
                        for (int j = 0; j < 16; ++j) { run += *(const GAS float*)(LFM + h * 16 + j); cbm[j] = run * LOG2E; } }
#pragma unroll
                    for (int jb = 0; jb < 16; jb += 8) {
                        v4u ka[8], kb[8]; float cb[8];
#pragma unroll
                        for (int j = 0; j < 8; ++j) { const bf16* kp = R1 + (size_t)(48 + jb + j) * DM + 64 * h + 16 * dc; ka[j] = ((const GAS v4u*)kp)[0]; kb[j] = ((const GAS v4u*)kp)[1];
                            cb[j] = cbm[jb + j]; }
#pragma unroll
                        for (int j = 0; j < 8; ++j) { float d = 0.f;
#pragma unroll
                            for (int e = 0; e < 4; ++e) d += qv[2 * e] * bflo(ka[j][e]) + qv[2 * e + 1] * bfhi(ka[j][e]) + qv[8 + 2 * e] * bflo(kb[j][e]) + qv[8 + 2 * e + 1] * bfhi(kb[j][e]);
                            d += lane_get(d, lane ^ 16); d += lane_get(d, lane ^ 32);
                            sc[jb + j] = (jb + j <= q) ? d - cb[j] : -__builtin_inff(); }
                    }
                    float mrun = sc[0];
#pragma unroll
                    for (int j = 1; j < 16; ++j) mrun = fmaxf(mrun, sc[j]);
                    float l = 0.f, o[16];
#pragma unroll
                    for (int e = 0; e < 16; ++e) o[e] = 0.f;
#pragma unroll
                    for (int jb = 0; jb < 16; jb += 8) {
                        v4u va[8], vb[8];
#pragma unroll
                        for (int j = 0; j < 8; ++j) { const bf16* vp = R2 + (size_t)(48 + jb + j) * DM + 64 * h + 16 * dc; va[j] = ((const GAS v4u*)vp)[0]; vb[j] = ((const GAS v4u*)vp)[1]; }
#pragma unroll
                        for (int j = 0; j < 8; ++j) { const float p = __builtin_amdgcn_exp2f(sc[jb + j] - mrun); l += p;
#pragma unroll
                            for (int e = 0; e < 4; ++e) { o[2 * e] += p * bflo(va[j][e]); o[2 * e + 1] += p * bfhi(va[j][e]); o[8 + 2 * e] += p * bflo(vb[j][e]); o[8 + 2 * e + 1] += p * bfhi(vb[j][e]); } }
                    }
                    const float rl = 1.0f / l; v4u oa, ob;
#pragma unroll
                    for (int e = 0; e < 4; ++e) { oa[e] = pk2(o[2 * e] * rl, o[2 * e + 1] * rl); ob[e] = pk2(o[8 + 2 * e] * rl, o[8 + 2 * e + 1] * rl); }
                    GAS v4u* op = (GAS v4u*)(R0 + (size_t)(MMAIN + q) * DM + 64 * h + 16 * dc); op[0] = oa; op[1] = ob;
                }
            }
            { PHASE_ENV();
            xcd_barrier(bar, tid);
#ifdef PROBE_SEL
            if (tid == 0) { const unsigned long long tn = __builtin_amdgcn_s_memrealtime(); const int cat = (s == 1 || s == 9) ? 1 : (s == 2 || s == 10) ? 2 : (s == 4) ? 3 : (s == 5) ? 4 : (s == 6) ? 5 : 6;
              TS[cat] += tn - TS[9]; TS[9] = tn; }
#endif
            }
            }
        }
    }
#ifdef PROBE_SEL
    { PHASE_ENV(); if (bx == 0 && tid == 0) { const unsigned long long t0 = __builtin_amdgcn_s_memrealtime(), span = 4ull * TS[PROBE_SEL];
        while (__builtin_amdgcn_s_memrealtime() - t0 < span) __builtin_amdgcn_s_sleep(8); } }
#endif
}

extern "C" void kernel_launch(void* const* d_in, const int* in_sizes, int n_in, void* d_out, int out_size, void* d_ws, size_t ws_size, hipStream_t stream) {
    static int grid = 0;
    if (grid == 0) {
        if (n_in != 21 || out_size != MMAIN * DM || ws_size < WS_END + SZ_ROWBUF) { fprintf(stderr, "kernel_launch: unexpected shapes (n_in %d out %d ws %zu)\n", n_in, out_size, ws_size); grid = -1; return; }
        int dev = 0, cus = 0, per_cu = 0;
        hipGetDevice(&dev); hipDeviceGetAttribute(&cus, hipDeviceAttributeMultiprocessorCount, dev);
        if (hipFuncSetAttribute((const void*)fwd_megakernel, hipFuncAttributeMaxDynamicSharedMemorySize, LDS_BYTES) != hipSuccess) { fprintf(stderr, "kernel_launch: hipFuncSetAttribute failed\n"); grid = -1; return; }
        if (hipOccupancyMaxActiveBlocksPerMultiprocessor(&per_cu, (const void*)fwd_megakernel, NWAVES * 64, LDS_BYTES) != hipSuccess || per_cu < 1) { fprintf(stderr, "kernel_launch: occupancy query says %d\n", per_cu); per_cu = 1; }
        (void)hipGetLastError();
        grid = cus * 1;
        if (grid != 256) fprintf(stderr, "kernel_launch: grid %d (expected 256)\n", grid);
    }
    if (grid < 0) return;
    if (hipMemsetAsync((char*)d_ws + WS_CTL, 0, CTL_ZERO_BYTES, stream) != hipSuccess) { fprintf(stderr, "kernel_launch: hipMemsetAsync failed\n"); return; }
    Args a{};
    const float** f = (const float**)&a;
    for (int i = 0; i < 21; ++i) f[i] = (const float*)d_in[i];
    a.out = (float*)d_out; a.ws = (unsigned char*)d_ws;
    void* args[] = {&a};
    hipError_t e = hipLaunchCooperativeKernel((const void*)fwd_megakernel, dim3(grid), dim3(NWAVES * 64), args, LDS_BYTES, stream);
    if (e != hipSuccess) fprintf(stderr, "cooperative launch failed: %s (grid %d)\n", hipGetErrorString(e), grid);
}
```

```cpp
#include <hip/hip_runtime.h>
#include <hip/hip_cooperative_groups.h>
#include <cstdio>
#include <cstdint>
namespace pg8 {
#define PG8_LAS __attribute__((address_space(3)))
typedef unsigned short bf16_t;
typedef short bf16x8 __attribute__((ext_vector_type(8)));
typedef float f32x4 __attribute__((ext_vector_type(4)));
typedef unsigned u32x4 __attribute__((ext_vector_type(4)));
constexpr int BM = 256, BK = 64, HALF = 128, HTB = HALF * BK * 2  , STAGE_BYTES = 8 * HTB, NXCD = 8, WGM = 4;

__host__ __device__ __forceinline__ int lds_byte(int r, int c) { const int st = (r >> 4) * 2 + (c >> 5), rr = r & 15, cc = c & 31, ob = rr * 64 + cc * 2; return st * 1024 + (ob ^ (((ob >> 9) & 1) << 5)); }
__host__ __device__ __forceinline__ void stage_rc(int b, int& R, int& C) { const int st = b / 1024, sb = b % 1024, swz = sb ^ (((sb >> 9) & 1) << 5); R = (st >> 1) * 16 + swz / 64; C = (st & 1) * 32 + (swz % 64) / 2; }
__host__ __device__ __forceinline__ int perm32(int rho) { const int n = rho >> 4, i = rho & 15; return 8 * (i >> 2) + 4 * n + (i & 3); }

struct Unit { int pm, pn; };
struct Gemm { const bf16_t* A; const bf16_t* Bt; int M, N, K; };

struct StaticOrder {
    int nM, nN, nwg, G, c;
    __host__ __device__ void init(int M, int N, int G_, int c_) { nM = M / BM; nN = N / BM; nwg = nM * nN; G = G_; c = c_; }
    __host__ __device__ bool next(int i, Unit& u) const {
        const long L = (long)i * G + c; if (L >= nwg) return false;
        int wgid = (int)L; { const int q = nwg / NXCD, r = nwg % NXCD, xcd = wgid % NXCD, off = wgid / NXCD; wgid = (xcd < r ? xcd * (q + 1) : r * (q + 1) + (xcd - r) * q) + off; }
        const int nig = WGM * nN, gid = wgid / nig, fm = gid * WGM, gsz = (nM - fm) < WGM ? (nM - fm) : WGM;
        u.pm = fm + ((wgid % nig) % gsz); u.pn = (wgid % nig) / gsz; return true;
    }
    __device__ __forceinline__ void a_ready(const Unit&) const {}
    __device__ __forceinline__ void done(const Unit&) const {}
};

__device__ __forceinline__ unsigned cvt_pk_bf16(float lo, float hi) { unsigned r; asm volatile("v_cvt_pk_bf16_f32 %0, %1, %2" : "=v"(r) : "v"(lo), "v"(hi)); return r; }
typedef float f32x2 __attribute__((ext_vector_type(2)));
__device__ __forceinline__ float sigm(float x) { return __builtin_amdgcn_rcpf(1.0f + __builtin_amdgcn_exp2f(-1.4426950408889634f * x)); }
constexpr float QK_C2 = 0.125f * 1.4426950408889634f;
#define PG8_GAS __attribute__((address_space(1)))
struct EpiAll {
    static constexpr bool PERM = true, AFTER_DRAIN = false;
    int mode;
    int mtiles_main;
    bf16_t* O1; bf16_t* O2; bf16_t* O3; int ldo;
    float* hmain; float* hmeta; float scale;
    const float* qg; const float* kg;
    const PG8_LAS float* rsl;
    const float* ssq;
    float* ssq_out; bf16_t* hb; float* fout; PG8_LAS float* ldsp;
    __device__ __forceinline__ void operator()(const f32x4 (&acc)[2][2][4][2], const Unit& u, int wr, int wc, int fr, int fq, int ui) const {
        const int rloc_ = wr * 64 + fr;
#define EPI_LAUNDER() int rloc = rloc_; asm volatile("" : "+v"(rloc))
#define EPI_RS() float rsv[2][4]; { const PG8_LAS float* sp_ = rsl + ui * 256 + rloc;     \
    _Pragma("unroll") for (int ai = 0; ai < 2; ++ai) _Pragma("unroll") for (int m = 0; m < 4; ++m) rsv[ai][m] = sp_[ai * HALF + m * 16]; }
        if (mode <= 1 || (mode == 2 && u.pn < 8)) {
            EPI_LAUNDER(); EPI_RS();
            bf16_t* base = O1 + (size_t)(u.pm * BM + rloc) * ldo + u.pn * HALF + wc * 32 + 8 * fq;
#pragma unroll
            for (int ai = 0; ai < 2; ++ai)
#pragma unroll
                for (int m = 0; m < 4; ++m) {
                    const float rs_ = rsv[ai][m]; const f32x4 a0 = acc[ai][0][m][0] * rs_, a1 = acc[ai][0][m][1] * rs_, b0 = acc[ai][1][m][0] * rs_, b1 = acc[ai][1][m][1] * rs_;
                    f32x4 r0, r1;
                    if (mode == 0) {
#pragma unroll
                        for (int i = 0; i < 4; ++i) { r0[i] = a0[i] * sigm(a0[i]) * b0[i]; r1[i] = a1[i] * sigm(a1[i]) * b1[i]; }
                    } else if (mode == 1) {
#pragma unroll
                        for (int i = 0; i < 4; ++i) { r0[i] = a0[i] * sigm(b0[i]); r1[i] = a1[i] * sigm(b1[i]); }
                    } else { r0 = a0 * b0; r1 = a1 * b1; }
                    u32x4 w; w.x = cvt_pk_bf16(r0[0], r0[1]); w.y = cvt_pk_bf16(r0[2], r0[3]); w.z = cvt_pk_bf16(r1[0], r1[1]); w.w = cvt_pk_bf16(r1[2], r1[3]);
                    *(PG8_GAS u32x4*)(base + (size_t)(ai * HALF + m * 16) * ldo) = w;
                }
        } else if (mode == 2) {
            EPI_LAUNDER(); EPI_RS();
            bf16_t* base = O2 + (size_t)(u.pm * BM + rloc) * 1024 + (u.pn - 8) * BM + wc * 32 + 8 * fq;
#pragma unroll
            for (int ai = 0; ai < 2; ++ai)
#pragma unroll
                for (int m = 0; m < 4; ++m)
#pragma unroll
                    for (int bj = 0; bj < 2; ++bj) {
                        const f32x4 v0 = acc[ai][bj][m][0] * rsv[ai][m], v1 = acc[ai][bj][m][1] * rsv[ai][m];
                        u32x4 w; w.x = cvt_pk_bf16(v0[0], v0[1]); w.y = cvt_pk_bf16(v0[2], v0[3]); w.z = cvt_pk_bf16(v1[0], v1[1]); w.w = cvt_pk_bf16(v1[2], v1[3]);
                        *(PG8_GAS u32x4*)(base + (size_t)(ai * HALF + m * 16) * 1024 + bj * HALF) = w;
                    }
        } else if (mode == 3) {
            EPI_LAUNDER(); EPI_RS();
            const int sec = u.pn >> 2;
            const bool meta = false;
            const long krow0 = meta ? 48 : (long)u.pm * BM + 128 * (1 + (u.pm >> 5));
            bf16_t* dst = (sec == 0) ? O1 + (size_t)(u.pm * BM) * 1024 : ((sec == 1) ? O2 : O3) + (size_t)krow0 * 1024;
            const bool dup = meta && sec != 0; const int rlim = dup ? 16 : 256;
            if (sec < 2) {
                const int head = 4 * (u.pn & 3) + wc;
                const int lxor16 = (fr + 16 * (fq ^ 1)) << 2, lxor32 = (fr + 16 * (fq ^ 2)) << 2;
                const float* g = (sec == 0) ? qg : kg; const float gs = (sec == 0) ? QK_C2 : 1.0f;
                f32x4 gv[2][2];
#pragma unroll
                for (int bj = 0; bj < 2; ++bj)
#pragma unroll
                    for (int n = 0; n < 2; ++n) gv[bj][n] = *(const PG8_GAS f32x4*)(g + 32 * bj + 8 * fq + 4 * n) * gs;
#pragma unroll
                for (int ai = 0; ai < 2; ++ai)
#pragma unroll
                    for (int m = 0; m < 4; ++m) {
                        float ss = 0.f;
#pragma unroll
                        for (int bj = 0; bj < 2; ++bj)
#pragma unroll
                            for (int n = 0; n < 2; ++n) { const f32x4 x = acc[ai][bj][m][n] * rsv[ai][m]; ss += (x[0] * x[0] + x[1] * x[1]) + (x[2] * x[2] + x[3] * x[3]); }
                        ss += __builtin_bit_cast(float, __builtin_amdgcn_ds_bpermute(lxor16, __builtin_bit_cast(int, ss))); ss += __builtin_bit_cast(float, __builtin_amdgcn_ds_bpermute(lxor32, __builtin_bit_cast(int, ss)));
                        const float rs = __builtin_amdgcn_rsqf(ss * (1.0f / 64.0f) + 1e-6f) * rsv[ai][m];
                        const int rl = rloc + ai * HALF + m * 16;
#pragma unroll
                        for (int bj = 0; bj < 2; ++bj) {
                            const f32x4 v0 = acc[ai][bj][m][0] * rs * gv[bj][0], v1 = acc[ai][bj][m][1] * rs * gv[bj][1];
                            u32x4 w; w.x = cvt_pk_bf16(v0[0], v0[1]); w.y = cvt_pk_bf16(v0[2], v0[3]); w.z = cvt_pk_bf16(v1[0], v1[1]); w.w = cvt_pk_bf16(v1[2], v1[3]);
                            const int col = 64 * head + 32 * bj + 8 * fq;
                            if (rl < rlim) { *(PG8_GAS u32x4*)(dst + (size_t)rl * 1024 + col) = w; if (dup) *(PG8_GAS u32x4*)(dst + (size_t)(8320 + rl) * 1024 + col) = w; }
                        }
                    }
            } else {
#pragma unroll
                for (int ai = 0; ai < 2; ++ai)
#pragma unroll
                    for (int m = 0; m < 4; ++m) {
                        const int rl = rloc + ai * HALF + m * 16;
#pragma unroll
                        for (int bj = 0; bj < 2; ++bj) {
                            const f32x4 v0 = acc[ai][bj][m][0] * rsv[ai][m], v1 = acc[ai][bj][m][1] * rsv[ai][m];
                            u32x4 w; w.x = cvt_pk_bf16(v0[0], v0[1]); w.y = cvt_pk_bf16(v0[2], v0[3]); w.z = cvt_pk_bf16(v1[0], v1[1]); w.w = cvt_pk_bf16(v1[2], v1[3]);
                            const int col = (u.pn - 8) * BM + bj * HALF + wc * 32 + 8 * fq;
                            if (rl < rlim) { *(PG8_GAS u32x4*)(dst + (size_t)rl * 1024 + col) = w; if (dup) *(PG8_GAS u32x4*)(dst + (size_t)(8320 + rl) * 1024 + col) = w; }
                        }
                    }
            }
        } else {
            EPI_LAUNDER();
            bf16_t* hbase = hb + (size_t)(u.pm * BM + rloc) * 1024 + u.pn * BM + wc * 32 + 8 * fq;
            float* fbase = fout ? fout + (size_t)(u.pm * BM + rloc) * 1024 + u.pn * BM + wc * 32 + 8 * fq : nullptr;
            const float sc = scale; const int lx16 = (fr + 16 * (fq ^ 1)) << 2, lx32 = (fr + 16 * (fq ^ 2)) << 2;
#pragma unroll
            for (int ai = 0; ai < 2; ++ai) {
                u32x4 hx[4][2];
#pragma unroll
                for (int m = 0; m < 4; ++m)
#pragma unroll
                    for (int bj = 0; bj < 2; ++bj) hx[m][bj] = *(const PG8_GAS u32x4*)(hbase + (size_t)(ai * HALF + m * 16) * 1024 + bj * HALF);
                asm volatile("" ::: "memory");
#pragma unroll
                for (int m = 0; m < 4; ++m) {
                    float ps = 0.f;
#pragma unroll
                    for (int bj = 0; bj < 2; ++bj) {
                        const u32x4 hw = hx[m][bj];
                        f32x4 x0 = {__builtin_bit_cast(float, hw.x << 16), __builtin_bit_cast(float, hw.x & 0xffff0000u), __builtin_bit_cast(float, hw.y << 16), __builtin_bit_cast(float, hw.y & 0xffff0000u)};
                        f32x4 x1 = {__builtin_bit_cast(float, hw.z << 16), __builtin_bit_cast(float, hw.z & 0xffff0000u), __builtin_bit_cast(float, hw.w << 16), __builtin_bit_cast(float, hw.w & 0xffff0000u)};
                        x0 += acc[ai][bj][m][0] * sc; x1 += acc[ai][bj][m][1] * sc;
                        if (fbase) { float* p = fbase + (size_t)(ai * HALF + m * 16) * 1024 + bj * HALF; *(PG8_GAS f32x4*)p = x0; *(PG8_GAS f32x4*)(p + 4) = x1; }
                        ps += ((x0[0] * x0[0] + x0[1] * x0[1]) + (x0[2] * x0[2] + x0[3] * x0[3])) + ((x1[0] * x1[0] + x1[1] * x1[1]) + (x1[2] * x1[2] + x1[3] * x1[3]));
                        u32x4 w; w.x = cvt_pk_bf16(x0[0], x0[1]); w.y = cvt_pk_bf16(x0[2], x0[3]); w.z = cvt_pk_bf16(x1[0], x1[1]); w.w = cvt_pk_bf16(x1[2], x1[3]);
                        if (!fbase) *(PG8_GAS u32x4*)(hbase + (size_t)(ai * HALF + m * 16) * 1024 + bj * HALF) = w;
                    }
                    ps += __builtin_bit_cast(float, __builtin_amdgcn_ds_bpermute(lx16, __builtin_bit_cast(int, ps))); ps += __builtin_bit_cast(float, __builtin_amdgcn_ds_bpermute(lx32, __builtin_bit_cast(int, ps)));
                    if (fq == 0) ldsp[(rloc + ai * HALF + m * 16) * 4 + wc] = ps;
                }
            }
            asm volatile("s_waitcnt lgkmcnt(0)" ::: "memory");
        }
    }
};
template <class Epi, class Sched, bool ALIGN_EPI = false, bool SP2 = false>
__device__ __forceinline__ void gemm_phase(PG8_LAS unsigned char* lds, const Gemm g, const Sched& S, const Epi& E, const int tid_in) {
    const int tid = tid_in, wid = __builtin_amdgcn_readfirstlane(tid >> 6), lane = tid & 63, wr = wid >> 2, wc = wid & 3, fr = lane & 15, fq = lane >> 4;
    const int K = g.K, nt = K / BK;
    unsigned voffA[2], voffB[2];
#pragma unroll
    for (int i = 0; i < 2; ++i) { int R, C; stage_rc(tid * 16 + i * 8192, R, C); const int Rb = Epi::PERM ? ((R & ~31) + perm32(R & 31)) : R;
        voffA[i] = (unsigned)(R * K + C) * 2u; voffB[i] = (unsigned)(Rb * K + C) * 2u; }
    const size_t kstep = (size_t)(BK * 2);
    const size_t hstep = (size_t)HALF * K * 2;
    const size_t tstep = 2 * hstep;
    const unsigned ldsw = (unsigned)wid * 1024u;
    const int aoff = lds_byte(wr * 64 + fr, fq * 8), boff = lds_byte(wc * 32 + fr, fq * 8);
#define PG8_SA(b, h) (((b) * 2 + (h)) * HTB)
#define PG8_SB(b, h) ((4 + (b) * 2 + (h)) * HTB)
#define PG8_STAGE(bufoff, gbase, voff) do { _Pragma("unroll") for (int _i = 0; _i < 2; ++_i) \
        __builtin_amdgcn_global_load_lds((const unsigned*)((const char*)(gbase) + (voff)[_i]), (PG8_LAS unsigned*)(lds + (bufoff) + ldsw + _i * 8192), 16, 0, 0); } while (0)
#define PG8_LDA(dst, b, h) do { _Pragma("unroll") for (int m = 0; m < 4; ++m) _Pragma("unroll") for (int k = 0; k < 2; ++k) dst[m][k] = *(const PG8_LAS bf16x8*)(lds + PG8_SA(b, h) + aoff + m * 2048 + k * 1024); } while (0)
#define PG8_LDB(dst, b, h) do { _Pragma("unroll") for (int n = 0; n < 2; ++n) _Pragma("unroll") for (int k = 0; k < 2; ++k) dst[n][k] = *(const PG8_LAS bf16x8*)(lds + PG8_SB(b, h) + boff + n * 2048 + k * 1024); } while (0)
#define PG8_MMA(ai, bj, At, Bt) do { __builtin_amdgcn_s_setprio(1); _Pragma("unroll") for (int m = 0; m < 4; ++m) _Pragma("unroll") for (int n = 0; n < 2; ++n) _Pragma("unroll") for (int k = 0; k < 2; ++k) \
        acc[ai][bj][m][n] = __builtin_amdgcn_mfma_f32_16x16x32_bf16(Bt[n][k], At[m][k], acc[ai][bj][m][n], 0, 0, 0); __builtin_amdgcn_s_setprio(0); } while (0)
#define PG8_WAIT_V(n) asm volatile("s_waitcnt vmcnt(" #n ")" ::: "memory")
#define PG8_WAIT_L(n) asm volatile("s_waitcnt lgkmcnt(" #n ")" ::: "memory")
#define PG8_BAR __builtin_amdgcn_s_barrier()
#define PG8_SCHED __builtin_amdgcn_sched_barrier(0)
    Unit cur, nxt; int ui = 0;
    if (!S.next(0, cur)) return;
    f32x4 acc[2][2][4][2];
#pragma unroll
    for (int a = 0; a < 2; ++a)
#pragma unroll
        for (int b = 0; b < 2; ++b)
#pragma unroll
            for (int m = 0; m < 4; ++m)
#pragma unroll
                for (int n = 0; n < 2; ++n) acc[a][b][m][n] = (f32x4){0.f, 0.f, 0.f, 0.f};
    bf16x8 At[4][2], B0[2][2], B1[2][2];
    const char* cA = (const char*)g.A + (size_t)cur.pm * tstep; const char* cB = (const char*)g.Bt + (size_t)cur.pn * tstep;
    S.a_ready(cur);
    if constexpr (SP2) {
        PG8_STAGE(PG8_SB(0, 0), cB, voffB); PG8_STAGE(PG8_SB(0, 1), cB + hstep, voffB); PG8_STAGE(PG8_SA(0, 0), cA, voffA); PG8_STAGE(PG8_SA(0, 1), cA + hstep, voffA);
        if (wr == 1) PG8_BAR;
        PG8_WAIT_V(2); PG8_BAR;
        PG8_STAGE(PG8_SB(1, 0), cB + kstep, voffB); PG8_STAGE(PG8_SA(1, 0), cA + kstep, voffA); PG8_STAGE(PG8_SB(1, 1), cB + hstep + kstep, voffB);
        PG8_WAIT_V(6); PG8_BAR;
    } else {
        PG8_STAGE(PG8_SB(0, 0), cB, voffB); PG8_STAGE(PG8_SA(0, 0), cA, voffA); PG8_STAGE(PG8_SB(0, 1), cB + hstep, voffB); PG8_STAGE(PG8_SA(0, 1), cA + hstep, voffA);
        if (wr == 1) PG8_BAR;
        PG8_WAIT_V(4); PG8_BAR;
        PG8_STAGE(PG8_SB(1, 0), cB + kstep, voffB); PG8_STAGE(PG8_SA(1, 0), cA + kstep, voffA); PG8_STAGE(PG8_SB(1, 1), cB + hstep + kstep, voffB);
        PG8_WAIT_V(6); PG8_BAR;
    }
    for (;;) {
        const bool has_next = S.next(ui + 1, nxt);
        const char* nA = has_next ? (const char*)g.A + (size_t)nxt.pm * tstep : cA; const char* nB = has_next ? (const char*)g.Bt + (size_t)nxt.pn * tstep : cB;
        for (int t = 0; t < nt; t += 2) {
            const bool last = (t == nt - 2);
            const char* a1 = cA + (size_t)(t + 1) * kstep;
            const char* a2 = last ? nA : cA + (size_t)(t + 2) * kstep; const char* b2 = last ? nB : cB + (size_t)(t + 2) * kstep;
            const char* a3 = a2 + kstep; const char* b3 = b2 + kstep;
            if (last && has_next) S.a_ready(nxt);
            if constexpr (SP2) {
            PG8_LDB(B0, 0, 0); PG8_LDB(B1, 0, 1); PG8_SCHED; PG8_LDA(At, 0, 0); PG8_STAGE(PG8_SA(1, 1), a1 + hstep, voffA);
            PG8_WAIT_V(8); PG8_WAIT_L(0); PG8_BAR; PG8_MMA(0, 0, At, B0); PG8_MMA(0, 1, At, B1); PG8_BAR; PG8_SCHED;
            PG8_LDA(At, 0, 1); PG8_STAGE(PG8_SB(0, 0), b2, voffB); PG8_STAGE(PG8_SB(0, 1), b2 + hstep, voffB); PG8_STAGE(PG8_SA(0, 0), a2, voffA);
            PG8_WAIT_V(8); PG8_WAIT_L(0); PG8_BAR; PG8_MMA(1, 0, At, B0); PG8_MMA(1, 1, At, B1); PG8_BAR; PG8_SCHED;
            PG8_LDB(B0, 1, 0); PG8_LDB(B1, 1, 1); PG8_SCHED; PG8_LDA(At, 1, 0); PG8_STAGE(PG8_SA(0, 1), a2 + hstep, voffA);
            PG8_WAIT_V(8); PG8_WAIT_L(0); PG8_BAR; PG8_MMA(0, 0, At, B0); PG8_MMA(0, 1, At, B1); PG8_BAR; PG8_SCHED;
            PG8_LDA(At, 1, 1); PG8_STAGE(PG8_SB(1, 0), b3, voffB); PG8_STAGE(PG8_SB(1, 1), b3 + hstep, voffB); PG8_STAGE(PG8_SA(1, 0), a3, voffA);
            PG8_WAIT_V(8); PG8_WAIT_L(0); PG8_BAR; PG8_MMA(1, 0, At, B0); PG8_MMA(1, 1, At, B1); PG8_BAR; PG8_SCHED;
            } else {
            PG8_LDB(B0, 0, 0); PG8_SCHED; PG8_LDA(At, 0, 0); PG8_STAGE(PG8_SA(1, 1), a1 + hstep, voffA);
            PG8_WAIT_L(8); PG8_BAR; PG8_WAIT_L(0); PG8_MMA(0, 0, At, B0); PG8_BAR; PG8_SCHED;
            PG8_LDB(B1, 0, 1); PG8_STAGE(PG8_SB(0, 0), b2, voffB);
            PG8_BAR; PG8_WAIT_L(0); PG8_MMA(0, 1, At, B1); PG8_BAR;
            PG8_LDA(At, 0, 1); PG8_STAGE(PG8_SA(0, 0), a2, voffA);
            PG8_BAR; PG8_WAIT_L(0); PG8_MMA(1, 0, At, B0); PG8_BAR; PG8_SCHED;
            PG8_STAGE(PG8_SB(0, 1), b2 + hstep, voffB);
            PG8_WAIT_V(6); PG8_BAR; PG8_MMA(1, 1, At, B1); PG8_BAR;
            PG8_LDB(B0, 1, 0); PG8_SCHED; PG8_LDA(At, 1, 0); PG8_STAGE(PG8_SA(0, 1), a2 + hstep, voffA);
            PG8_WAIT_L(8); PG8_BAR; PG8_WAIT_L(0); PG8_MMA(0, 0, At, B0); PG8_BAR; PG8_SCHED;
            PG8_LDB(B1, 1, 1); PG8_STAGE(PG8_SB(1, 0), b3, voffB);
            PG8_BAR; PG8_WAIT_L(0); PG8_MMA(0, 1, At, B1); PG8_BAR;
            PG8_LDA(At, 1, 1); PG8_STAGE(PG8_SA(1, 0), a3, voffA);
            PG8_BAR; PG8_WAIT_L(0); PG8_MMA(1, 0, At, B0); PG8_BAR; PG8_SCHED;
            PG8_STAGE(PG8_SB(1, 1), b3 + hstep, voffB);
            PG8_WAIT_V(6); PG8_BAR; PG8_MMA(1, 1, At, B1); PG8_BAR;
            }
        }
        if constexpr (ALIGN_EPI) { if (wr == 0) PG8_BAR; }
        if constexpr (!Epi::AFTER_DRAIN) { E(acc, cur, wr, wc, fr, fq, ui); S.done(cur); }
        if (!has_next) break;
#pragma unroll
        for (int a = 0; a < 2; ++a)
#pragma unroll
            for (int b = 0; b < 2; ++b)
#pragma unroll
                for (int m = 0; m < 4; ++m)
#pragma unroll
                    for (int n = 0; n < 2; ++n) acc[a][b][m][n] = (f32x4){0.f, 0.f, 0.f, 0.f};
        cur = nxt; cA = nA; cB = nB; ++ui;
        if constexpr (ALIGN_EPI) { if (wr == 1) PG8_BAR; }
    }
    PG8_WAIT_V(0);
    if constexpr (!ALIGN_EPI) { if (wr == 0) PG8_BAR; }
    PG8_BAR;
    if constexpr (Epi::AFTER_DRAIN) { E.fused(acc, cur, wr, wc, fr, fq, lds, wid, lane); S.done(cur); }
#undef PG8_SA
#undef PG8_SB
#undef PG8_STAGE
#undef PG8_LDA
#undef PG8_LDB
#undef PG8_MMA
#undef PG8_WAIT_V
#undef PG8_WAIT_L
#undef PG8_BAR
#undef PG8_SCHED
}
}

#ifndef PG8_SP2
#define PG8_SP2 true
#endif
#ifndef PG8_ALIGN
#define PG8_ALIGN true
#endif
#include <hip/hip_bf16.h>
#include <cmath>
namespace attn_body {
using bf16=__hip_bfloat16;
using bf16x8=__attribute__((ext_vector_type(8)))short;
using s16x4=__attribute__((ext_vector_type(4)))short;
using f32x16=__attribute__((ext_vector_type(16)))float;
using u32x4=__attribute__((ext_vector_type(4)))unsigned;
constexpr int BATCH=2,NHEAD=16,SEQ=8192,D=64,DM=NHEAD*D;
constexpr int NW=8,QBLK=32,QB=QBLK*NW,KVBLK=64,NQB=SEQ/QB; constexpr int KVPAD=128,KVROWS=SEQ+KVPAD;
constexpr int ATTN_PITCH=DM, ATTN_UNIT_ROWS=QB;
__device__ __forceinline__ int crow(int r,int hi){return (r&3)+8*(r>>2)+4*hi;}
#define SBAR() __builtin_amdgcn_sched_barrier(0)
__device__ __forceinline__ void cmask(f32x16&p0,f32x16&p1,int jb,int qrel,int hi){
  const float NEG=-INFINITY; int kb=64*jb+4*hi;
  #pragma unroll
  for(int r=0;r<16;++r){int kv=kb+(r&3)+8*(r>>2); if(kv>qrel)p0[r]=NEG; if(kv+32>qrel)p1[r]=NEG;}
}

constexpr int NSLOT=3, SLOTB=8192;
constexpr int LDS_K=0, LDS_V=NSLOT*SLOTB, LDS_WS=2*NSLOT*SLOTB, LDS_OST=LDS_WS+NW*64*4, LDS_CS=LDS_OST+NW*4096, LDS_BYTES=LDS_CS+KVROWS*4;
constexpr float C2=0.125f*1.4426950408889634f;
__device__ __forceinline__ void glds16(const void*gsrc,unsigned lds_dst){unsigned keep;
  asm volatile("s_mov_b32 %0, m0\n\ts_mov_b32 m0, %2\n\ts_nop 0\n\tglobal_load_lds_dwordx4 %1, off\n\ts_mov_b32 m0, %0":"=&s"(keep):"v"(gsrc),"s"(lds_dst):"memory");}
__device__ __forceinline__ float max3f(float a,float b,float c){float r;asm("v_max3_f32 %0, %1, %2, %3":"=v"(r):"v"(a),"v"(b),"v"(c));return r;}
__device__ __forceinline__ float max2f(float a,float b){float r;asm("v_max_f32_e32 %0, %1, %2":"=v"(r):"v"(a),"v"(b));return r;}
__device__ __forceinline__ float fadd_s(float a,float b){float r;asm("v_add_f32_e32 %0, %1, %2":"=v"(r):"v"(a),"v"(b));return r;}
__device__ __forceinline__ float fsub_s(float a,float b){float r;asm("v_sub_f32_e32 %0, %1, %2":"=v"(r):"v"(a),"v"(b));return r;}
typedef float f32x2_t __attribute__((ext_vector_type(2))); typedef __bf16 bf16x2_t __attribute__((ext_vector_type(2)));
__device__ __forceinline__ unsigned cvtpk_s(float lo,float hi){f32x2_t v={lo,hi};bf16x2_t b=__builtin_convertvector(v,bf16x2_t);return __builtin_bit_cast(unsigned,b);}
#define WAIT_BAR(N) asm volatile("s_waitcnt vmcnt(" #N ") lgkmcnt(0)\n\ts_barrier":::"memory")

__device__ __forceinline__ void qkt(f32x16&p0,f32x16&p1,const char*Kslot,const bf16x8*qr,int r32,int hi){
  const char*kb=Kslot+hi*1024+r32*16;
  #pragma unroll
  for(int d0=0;d0<4;++d0){
    const bf16x8 b0=*reinterpret_cast<const bf16x8*>(kb+d0*2048);
    const bf16x8 b1=*reinterpret_cast<const bf16x8*>(kb+d0*2048+512);
    p0=__builtin_amdgcn_mfma_f32_32x32x16_bf16(b0,qr[d0],p0,0,0,0);p1=__builtin_amdgcn_mfma_f32_32x32x16_bf16(b1,qr[d0],p1,0,0,0);}
}
typedef __attribute__((address_space(3))) const char* lds_cptr;
typedef short v4i16_t __attribute__((ext_vector_type(4))); typedef float f32x4_t __attribute__((ext_vector_type(4)));
__device__ __forceinline__ void kload8(bf16x8*kf,lds_cptr kp){
  kf[0]=*(const __attribute__((address_space(3))) bf16x8*)(kp);      kf[1]=*(const __attribute__((address_space(3))) bf16x8*)(kp+512);
  kf[2]=*(const __attribute__((address_space(3))) bf16x8*)(kp+2048); kf[3]=*(const __attribute__((address_space(3))) bf16x8*)(kp+2560);
  kf[4]=*(const __attribute__((address_space(3))) bf16x8*)(kp+4096); kf[5]=*(const __attribute__((address_space(3))) bf16x8*)(kp+4608);
  kf[6]=*(const __attribute__((address_space(3))) bf16x8*)(kp+6144); kf[7]=*(const __attribute__((address_space(3))) bf16x8*)(kp+6656);
}
__device__ __forceinline__ void kload2(bf16x8*kf,lds_cptr kp,int j){ kf[2*j]=*(const __attribute__((address_space(3))) bf16x8*)(kp+j*2048); kf[2*j+1]=*(const __attribute__((address_space(3))) bf16x8*)(kp+j*2048+512); }
__device__ __forceinline__ s16x4 vtr(lds_cptr p){ return __builtin_bit_cast(s16x4,__builtin_amdgcn_ds_read_tr16_b64_v4i16((__attribute__((address_space(3))) v4i16_t*)p)); }
__device__ __forceinline__ float rowmax(const f32x16&p0,const f32x16&p1){
  float a=max3f(p0[0],p0[1],p1[0]),b=max3f(p0[2],p0[3],p1[1]);a=max3f(a,p1[2],p1[3]);
  #pragma unroll
  for(int r=4;r<16;r+=4){a=max3f(a,p0[r],p0[r+1]);b=max3f(b,p0[r+2],p0[r+3]);a=max3f(a,p1[r],p1[r+1]);b=max3f(b,p1[r+2],p1[r+3]);}
  const float m=max2f(a,b);
  auto rr=__builtin_amdgcn_permlane32_swap(__float_as_uint(m),__float_as_uint(m),false,false);
  return max2f(__uint_as_float(rr[0]),__uint_as_float(rr[1]));
}
__device__ __forceinline__ void pv(f32x16*o,int vb,bf16x8 pa0,bf16x8 pa1,bf16x8 pa2,bf16x8 pa3){
  #pragma unroll
  for(int d0=0;d0<2;++d0){s16x4 lo[4],hi[4];
    #pragma unroll
    for(int ks=0;ks<4;++ks){
      asm volatile("ds_read_b64_tr_b16 %0,%1 offset:%c2":"=&v"(lo[ks]):"v"(vb),"i"(d0*4096+ks*1024):"memory");
      asm volatile("ds_read_b64_tr_b16 %0,%1 offset:%c2":"=&v"(hi[ks]):"v"(vb),"i"(d0*4096+ks*1024+512):"memory");}
    asm volatile("s_waitcnt lgkmcnt(0)":::"memory");SBAR();
    #define PK(k) (bf16x8){lo[k][0],lo[k][1],lo[k][2],lo[k][3],hi[k][0],hi[k][1],hi[k][2],hi[k][3]}
    o[d0]=__builtin_amdgcn_mfma_f32_32x32x16_bf16(pa0,PK(0),o[d0],0,0,0);
    o[d0]=__builtin_amdgcn_mfma_f32_32x32x16_bf16(pa1,PK(1),o[d0],0,0,0);
    o[d0]=__builtin_amdgcn_mfma_f32_32x32x16_bf16(pa2,PK(2),o[d0],0,0,0);
    o[d0]=__builtin_amdgcn_mfma_f32_32x32x16_bf16(pa3,PK(3),o[d0],0,0,0);
    #undef PK
  }
}

#ifndef ATTN_STORE16
#define ATTN_STORE16(p,v) (*(__attribute__((address_space(1))) u32x4*)(p)=(v))
#endif
template<int THRL> __device__ __forceinline__ void attn_unit(int b,int h,int qb,const bf16*Q,const bf16*__restrict__ K,const bf16*__restrict__ V,bf16*O,const float*__restrict__ CS,char*shm,const int tid_in){
  const int tid=tid_in,lane=tid&63,r32=lane&31,hi=lane>>5; const int wid=__builtin_amdgcn_readfirstlane(tid>>6);
  const long rowbase=(long)b*SEQ, kvbase=(long)b*KVROWS; const int q0=qb*QB;
  const bf16*Qw=Q+(rowbase+q0+wid*QBLK)*DM+h*D;
  const bf16*Kh=K+kvbase*DM+h*D,*Vh=V+kvbase*DM+h*D;
  const unsigned lds0=(unsigned)(uintptr_t)shm;
  float*wsf=(float*)(shm+LDS_WS)+wid*64;
  const bf16*ksrc=Kh+(long)lane*DM+wid*8;
  const bf16*vsrc=Vh+(long)(16*(wid&3)+(lane>>2))*DM+(wid>>2)*32+(lane&3)*8;
  const unsigned kdst=lds0+LDS_K+wid*1024, vdst=lds0+LDS_V+wid*1024;
  #define DMA_K(t,slot) glds16(ksrc+(long)(t)*KVBLK*DM,(unsigned)__builtin_amdgcn_readfirstlane(kdst+(slot)))
  #define DMA_V(t,slot) glds16(vsrc+(long)(t)*KVBLK*DM,(unsigned)__builtin_amdgcn_readfirstlane(vdst+(slot)))
  const int vb0=(int)(lds0+LDS_V)+((lane>>4)&1)*32+(lane&3)*8+(4*hi+((lane&15)>>2))*64;
  const char*Kbase=shm+LDS_K; bf16x8 kf[8];
  const lds_cptr shm3=(lds_cptr)shm; const lds_cptr kp0=shm3+LDS_K+hi*1024+r32*16; const lds_cptr vp0=shm3+LDS_V+((lane>>4)&1)*32+(lane&3)*8+(4*hi+((lane&15)>>2))*64;
  const int NT=(q0+QB+KVPAD)/KVBLK;
  DMA_K(0,0);DMA_V(0,0);DMA_K(1,SLOTB);
  bf16x8 qr[4];
  #pragma unroll
  for(int d0=0;d0<4;++d0)qr[d0]=*(const __attribute__((address_space(1))) bf16x8*)(&Qw[(long)r32*DM+d0*16+hi*8]);
  float mhat=0.f,l_reg=0.f;f32x16 o[2];o[0]=f32x16{};o[1]=f32x16{};
  const __attribute__((address_space(3))) float*csl=(const __attribute__((address_space(3))) float*)((lds_cptr)shm+LDS_CS)+4*hi;
  #define BIASINIT(C0,C1,t) do{ const __attribute__((address_space(3))) float*bp_=csl+64*(t); const float nm_=-mhat; \
    _Pragma("unroll") for(int g_=0;g_<4;++g_){ const f32x4_t a_=*(const __attribute__((address_space(3))) f32x4_t*)(bp_+8*g_), b_=*(const __attribute__((address_space(3))) f32x4_t*)(bp_+32+8*g_); \
      C0[4*g_]=nm_-a_[0];C0[4*g_+1]=nm_-a_[1];C0[4*g_+2]=nm_-a_[2];C0[4*g_+3]=nm_-a_[3]; C1[4*g_]=nm_-b_[0];C1[4*g_+1]=nm_-b_[1];C1[4*g_+2]=nm_-b_[2];C1[4*g_+3]=nm_-b_[3]; } }while(0)
  #define BIASLOAD(C0,C1,t) do{ const __attribute__((address_space(3))) float*bp_=csl+64*(t); \
    _Pragma("unroll") for(int g_=0;g_<4;++g_){ const f32x4_t a_=*(const __attribute__((address_space(3))) f32x4_t*)(bp_+8*g_), b_=*(const __attribute__((address_space(3))) f32x4_t*)(bp_+32+8*g_); \
      C0[4*g_]=a_[0];C0[4*g_+1]=a_[1];C0[4*g_+2]=a_[2];C0[4*g_+3]=a_[3]; C1[4*g_]=b_[0];C1[4*g_+1]=b_[1];C1[4*g_+2]=b_[2];C1[4*g_+3]=b_[3]; } }while(0)
  const int qrel=wid*QBLK+r32;
  #define CMASK(P0,P1,t) do{int jb_=(t)-(NT-4); if(jb_>=0)cmask(P0,P1,jb_,qrel,hi);}while(0)
  bool resc=false;
  #define START(P0,P1) do{ const float rm=rowmax(P0,P1); resc=false; \
    { const float dl=rm; mhat=fadd_s(mhat,dl); \
      _Pragma("unroll") for(int r=0;r<16;++r){P0[r]=fsub_s(P0[r],dl);P1[r]=fsub_s(P1[r],dl);} \
      } \
    _Pragma("unroll") for(int r=0;r<16;++r)P0[r]=__builtin_amdgcn_exp2f(P0[r]); }while(0)
  #define RESC() do{ if(resc){ asm volatile("s_waitcnt lgkmcnt(0)":::"memory"); \
      _Pragma("unroll") for(int d_=0;d_<2;++d_) _Pragma("unroll") for(int r=0;r<16;++r)o[d_][r]*=wsf[crow(r,hi)]; } }while(0)
  f32x16 pA0,pA1,pB0,pB1;
  int sl_prev=0,sl_cur=0,sl_next=SLOTB;
  #define ROT() do{sl_prev=sl_cur;sl_cur=sl_next;sl_next=(sl_next==(NSLOT-1)*SLOTB)?0:sl_next+SLOTB;}while(0)
  DMA_K(2,2*SLOTB);
  WAIT_BAR(3);
  BIASINIT(pA0,pA1,0); qkt(pA0,pA1,Kbase,qr,r32,hi);asm volatile("s_nop 15\n\ts_nop 7":"+v"(pA0),"+v"(pA1));
  START(pA0,pA1);
  _Pragma("unroll") for(int r=0;r<16;++r)pA1[r]=__builtin_amdgcn_exp2f(pA1[r]);
  WAIT_BAR(0);
  DMA_K(3,0);DMA_V(1,SLOTB);
  ROT();
  kload8(kf,kp0+sl_cur);
  WAIT_BAR(2);
  s16x4 vlo[8],vhi[8]; u32x4 pw0,pw1,pw2,pw3;
  #define PKW(P,B) cvtpk_s(P[B],P[B+1])
  #define PAF(k) __builtin_bit_cast(bf16x8,pw##k)
  #define VFR(i) (bf16x8){vlo[i][0],vlo[i][1],vlo[i][2],vlo[i][3],vhi[i][0],vhi[i][1],vhi[i][2],vhi[i][3]}
  #define PIN(x) asm volatile("":"+v"(x))
  #define MX3(a,b,c) __builtin_fmaxf(__builtin_fmaxf((a),(b)),(c))
  #define GAPA(MF,A0,A1,A2,A3,W0,W1,PW) do{ MF; sacc+=A0; sacc+=A1; sacc+=A2; sacc+=A3; PIN(sacc); W0; W1; PIN(PW); SBAR(); }while(0)
  #define EX(v) __builtin_amdgcn_exp2f(v)
  #define GAPB(MF,X,B,NX) do{ MF; X[B]=EX(X[B]); X[B+1]=EX(X[B+1]); X[B+2]=EX(X[B+2]); X[B+3]=EX(X[B+3]); NX[B]=fsub_s(nm_,NX[B]); NX[B+1]=fsub_s(nm_,NX[B+1]); NX[B+2]=fsub_s(nm_,NX[B+2]); NX[B+3]=fsub_s(nm_,NX[B+3]); PIN(X); PIN(NX); SBAR(); }while(0)
  #define VRD(i) do{ vlo[i]=vtr(vp_+(((i)>>2)*4096+((i)&3)*1024)); vhi[i]=vtr(vp_+(((i)>>2)*4096+((i)&3)*1024+512)); }while(0)
  #define KRD(G,j) do{ if(G){ kload2(kf,kp0+sl_next,j); SBAR(); } }while(0)
  #define STEP(C0,C1,P0,P1,t,GK,GV,GL) do{ SBAR(); \
    const lds_cptr vp_=vp0+sl_prev; \
    VRD(0); SBAR(); float sacc=(P0[0]+P0[1]); \
    GAPA(C0=__builtin_amdgcn_mfma_f32_32x32x16_bf16(kf[0],qr[0],C0,0,0,0), P0[2],P0[3],P0[4],P0[5],     pw0[0]=PKW(P0,0), pw0[1]=PKW(P0,2), pw0); \
    VRD(4); SBAR(); GAPA(C1=__builtin_amdgcn_mfma_f32_32x32x16_bf16(kf[1],qr[0],C1,0,0,0), P0[6],P0[7],P0[8],P0[9],     pw0[2]=PKW(P0,4), pw0[3]=PKW(P0,6), pw0); \
    VRD(1); SBAR(); GAPA(C0=__builtin_amdgcn_mfma_f32_32x32x16_bf16(kf[2],qr[1],C0,0,0,0),   P0[10],P0[11],P0[12],P0[13], pw1[0]=PKW(P0,8), pw1[1]=PKW(P0,10), pw1); \
    VRD(5); SBAR(); GAPA(C1=__builtin_amdgcn_mfma_f32_32x32x16_bf16(kf[3],qr[1],C1,0,0,0),   P0[14],P0[15],P1[0],P1[1],   pw1[2]=PKW(P0,12),pw1[3]=PKW(P0,14), pw1); \
    VRD(2); SBAR(); GAPA(C0=__builtin_amdgcn_mfma_f32_32x32x16_bf16(kf[4],qr[2],C0,0,0,0),   P1[2],P1[3],P1[4],P1[5],     pw2[0]=PKW(P1,0), pw2[1]=PKW(P1,2), pw2); \
    VRD(6); SBAR(); GAPA(C1=__builtin_amdgcn_mfma_f32_32x32x16_bf16(kf[5],qr[2],C1,0,0,0),   P1[6],P1[7],P1[8],P1[9],     pw2[2]=PKW(P1,4), pw2[3]=PKW(P1,6), pw2); \
    VRD(3); SBAR(); GAPA(C0=__builtin_amdgcn_mfma_f32_32x32x16_bf16(kf[6],qr[3],C0,0,0,0),   P1[10],P1[11],P1[12],P1[13], pw3[0]=PKW(P1,8), pw3[1]=PKW(P1,10), pw3); \
    VRD(7); SBAR(); GAPA(C1=__builtin_amdgcn_mfma_f32_32x32x16_bf16(kf[7],qr[3],C1,0,0,0),   P1[14],P1[15],0.f,0.f,       pw3[2]=PKW(P1,12),pw3[3]=PKW(P1,14), pw3); \
    l_reg+=sacc; \
    BIASLOAD(P0,P1,(t)+1); \
    if(GK){DMA_K((t)+3,sl_cur);} if(GV){DMA_V((t)+1,sl_next);} \
    CMASK(C0,C1,t); \
    { float a=MX3(C0[0],C0[1],C1[0]),b=MX3(C0[2],C0[3],C1[1]); a=MX3(a,C1[2],C1[3]); \
      _Pragma("unroll") for(int r=4;r<16;r+=4){a=MX3(a,C0[r],C0[r+1]);b=MX3(b,C0[r+2],C0[r+3]);a=MX3(a,C1[r],C1[r+1]);b=MX3(b,C1[r+2],C1[r+3]);} \
      float rm=__builtin_fmaxf(a,b); { auto rr=__builtin_amdgcn_permlane32_swap(__float_as_uint(rm),__float_as_uint(rm),false,false); rm=__builtin_fmaxf(__uint_as_float(rr[0]),__uint_as_float(rr[1])); } \
      resc=false; \
      if(__builtin_expect(__any(rm>(float)THRL),0)){ const float dl=__builtin_fmaxf(rm,0.f); mhat+=dl; \
        _Pragma("unroll") for(int r=0;r<16;++r){C0[r]-=dl;C1[r]-=dl;} \
        const float f=__builtin_amdgcn_exp2f(-dl); l_reg*=f; if(hi==0)wsf[r32]=f; resc=true; } } \
    SBAR(); const float nm_=-mhat; \
    GAPB(o[0]=__builtin_amdgcn_mfma_f32_32x32x16_bf16(PAF(0),VFR(0),o[0],0,0,0), C0,0,P0); \
    GAPB(o[1]=__builtin_amdgcn_mfma_f32_32x32x16_bf16(PAF(0),VFR(4),o[1],0,0,0), C0,4,P0); \
    KRD(GL,0); GAPB(o[0]=__builtin_amdgcn_mfma_f32_32x32x16_bf16(PAF(1),VFR(1),o[0],0,0,0), C0,8,P0); \
    KRD(GL,1); GAPB(o[1]=__builtin_amdgcn_mfma_f32_32x32x16_bf16(PAF(1),VFR(5),o[1],0,0,0), C0,12,P0); \
    KRD(GL,2); GAPB(o[0]=__builtin_amdgcn_mfma_f32_32x32x16_bf16(PAF(2),VFR(2),o[0],0,0,0), C1,0,P1); \
    KRD(GL,3); GAPB(o[1]=__builtin_amdgcn_mfma_f32_32x32x16_bf16(PAF(2),VFR(6),o[1],0,0,0), C1,4,P1); \
    GAPB(o[0]=__builtin_amdgcn_mfma_f32_32x32x16_bf16(PAF(3),VFR(3),o[0],0,0,0), C1,8,P1); \
    GAPB(o[1]=__builtin_amdgcn_mfma_f32_32x32x16_bf16(PAF(3),VFR(7),o[1],0,0,0), C1,12,P1); \
    }while(0)
  BIASINIT(pB0,pB1,1);
  int t=1;
  #undef CMASK
  #define CMASK(P0,P1,t) do{}while(0)
  for(;t+5<NT;t+=2){
    STEP(pB0,pB1,pA0,pA1,t,true,true,true);     WAIT_BAR(2); RESC(); ROT();
    STEP(pA0,pA1,pB0,pB1,t+1,true,true,true);   WAIT_BAR(2); RESC(); ROT();
  }
  #undef CMASK
  #define CMASK(P0,P1,t) do{int jb_=(t)-(NT-4); if(jb_>=0)cmask(P0,P1,jb_,qrel,hi);}while(0)
  #define ENDW(tt) do{ if((tt)+3<NT){WAIT_BAR(2);} else if((tt)+2<NT){WAIT_BAR(1);} else {WAIT_BAR(0);} }while(0)
  for(;t+1<NT;t+=2){
    STEP(pB0,pB1,pA0,pA1,t,(t+3<NT),(t+1<NT),(t+1<NT));       ENDW(t);   RESC(); ROT();
    STEP(pA0,pA1,pB0,pB1,t+1,(t+4<NT),(t+2<NT),(t+2<NT));     ENDW(t+1); RESC(); ROT();
  }
  STEP(pB0,pB1,pA0,pA1,NT-1,false,false,false); RESC();
  { float sacc=pB0[0]+pB0[1]; _Pragma("unroll") for(int r=2;r<16;++r)sacc+=pB0[r]; _Pragma("unroll") for(int r=0;r<16;++r)sacc+=pB1[r]; l_reg+=sacc;
    pw0=(u32x4){PKW(pB0,0),PKW(pB0,2),PKW(pB0,4),PKW(pB0,6)};pw1=(u32x4){PKW(pB0,8),PKW(pB0,10),PKW(pB0,12),PKW(pB0,14)};pw2=(u32x4){PKW(pB1,0),PKW(pB1,2),PKW(pB1,4),PKW(pB1,6)};pw3=(u32x4){PKW(pB1,8),PKW(pB1,10),PKW(pB1,12),PKW(pB1,14)};
    SBAR(); pv(o,vb0+sl_cur,PAF(0),PAF(1),PAF(2),PAF(3)); }
  #undef PKW
  #undef PAF
  #undef VFR
  #undef PIN
  #undef MX3
  #undef GAPA
  #undef GAPB
  #undef EX
  #undef VRD
  #undef KRD
  #undef STEP
  #undef ENDW
  {auto rr=__builtin_amdgcn_permlane32_swap(__float_as_uint(l_reg),__float_as_uint(l_reg),false,false);l_reg=__uint_as_float(rr[0])+__uint_as_float(rr[1]);}
  if(hi==0)wsf[32+r32]=l_reg;asm volatile("s_waitcnt lgkmcnt(0)":::"memory");
  float rli[16];
  #pragma unroll
  for(int r=0;r<16;++r)rli[r]=__builtin_amdgcn_rcpf(wsf[32+crow(r,hi)]);
  bf16*Ow=O+(rowbase+q0+wid*QBLK)*DM+h*D;
  { bf16*stg=(bf16*)(shm+LDS_OST)+wid*2048;
    #pragma unroll
    for(int r=0;r<16;++r){const int orow=crow(r,hi);
      #pragma unroll
      for(int d0=0;d0<2;++d0)stg[orow*64+d0*32+r32]=__float2bfloat16(o[d0][r]*rli[r]);}
    asm volatile("s_waitcnt lgkmcnt(0)":::"memory");
    #pragma unroll
    for(int i=0;i<4;++i){const int row=i*8+(lane>>3),ch=lane&7; const u32x4 v=*(const u32x4*)(stg+row*64+ch*8); ATTN_STORE16(Ow+(long)row*DM+ch*8,v);} }
  asm volatile("s_waitcnt lgkmcnt(0)\n\ts_barrier":::"memory");
  #undef DMA_K
  #undef DMA_V
  #undef CMASK
  #undef START
  #undef RESC
  #undef ROT
  #undef BIASINIT
  #undef BIASLOAD
}
constexpr int ATTN_LDS_BYTES=LDS_BYTES;
struct AttnTensors { const bf16* Q; const bf16* K; const bf16* V; bf16* O; const float* CS; };
struct AttnUnit { int bh; int qb; };
struct StaticOrder {
  int vcu;
  __device__ __forceinline__ explicit StaticOrder(int grid,int block):vcu((block%8)*(grid/8)+block/8){}
  __device__ __forceinline__ bool next(int i,AttnUnit&u)const{ if(i>=4)return false; const int s=vcu&7; u.bh=vcu>>3; u.qb=(i==0)?s:(i==1)?15-s:(i==2)?16+s:31-s; return true; }
  __device__ __forceinline__ void a_ready(const AttnUnit&)const{}
  __device__ __forceinline__ void done(const AttnUnit&)const{}
};
template<class Sched,int THRL=96> __device__ __forceinline__ void attn_phase(char*lds,const AttnTensors&T,const Sched&S,const int tid_in){
  AttnUnit u;
  for(int i=0;S.next(i,u);++i){ S.a_ready(u); attn_unit<THRL>(u.bh/NHEAD,u.bh%NHEAD,u.qb,T.Q,T.K,T.V,T.O,T.CS,lds,tid_in); S.done(u); }
}
#undef SBAR
#undef WAIT_BAR
}
#define LAS __attribute__((address_space(3)))
#define XB_TMO      128
#define XB_XCNT(j)  (256  + 64 * (j))
#define XB_XSUB(j)  (1280 + 64 * (j))
#define XB_XGEN(j)  (2304 + 64 * (j))
#define XB_TOP      3328
#define XB_TOPGEN   3392
#define XCD_BAR_WORDS 3456
#define XB_SPIN_CAP (1u << 18)

__device__ __forceinline__ unsigned xb_ld(unsigned* p)              { return __hip_atomic_load(p, __ATOMIC_RELAXED, __HIP_MEMORY_SCOPE_AGENT); }
__device__ __forceinline__ unsigned xb_add(unsigned* p, unsigned v) { return __hip_atomic_fetch_add(p, v, __ATOMIC_RELAXED, __HIP_MEMORY_SCOPE_AGENT); }
__device__ __forceinline__ unsigned xb_xcc_id() { return (unsigned)__builtin_amdgcn_s_getreg((3 << 11) | 20) & 0xFu; }
#define XB_SPIN(cond, bar) do { unsigned _sp = 0; while (cond) { __builtin_amdgcn_s_sleep(1); \
    if ((++_sp & 255u) == 0u) { if (xb_ld(&(bar)[XB_TMO])) break; if (_sp > XB_SPIN_CAP) { atomicAdd(&(bar)[XB_TMO], 1u); break; } } } } while (0)

struct XcdBarrier {
    unsigned* bar; unsigned x;
    volatile LAS unsigned* st;
};

__device__ __forceinline__ XcdBarrier xcd_barrier_post(unsigned* bar, volatile LAS unsigned* st, const int tid) {
    XcdBarrier b; b.bar = bar; b.x = xb_xcc_id(); b.st = st;
    if (tid == 0) (void)xb_add(&bar[XB_XCNT(b.x)], 1u);
    return b;
}
__device__ __forceinline__ void xcd_barrier_complete(unsigned* bar, unsigned x, unsigned& nloc, unsigned& nx) {
    const unsigned G = gridDim.x * gridDim.y * gridDim.z;
    unsigned sum, cnt, mine, sp = 0u;
    for (;;) {
        sum = 0u; cnt = 0u; mine = 0u;
#pragma unroll
        for (unsigned j = 0; j < 16; ++j) { const unsigned c = xb_ld(&bar[XB_XCNT(j)]); sum += c; cnt += (c > 0u) ? 1u : 0u; mine = (j == x) ? c : mine; }
        if (sum == G) break;
        __builtin_amdgcn_s_sleep(1);
        if ((++sp & 255u) == 0u) { if (xb_ld(&bar[XB_TMO])) break; if (sp > XB_SPIN_CAP) { atomicAdd(&bar[XB_TMO], 1u); break; } }
    }
    nloc = mine > 0u ? mine : 1u; nx = cnt > 0u ? cnt : 1u;
}

__device__ __forceinline__ void xcd_barrier(const XcdBarrier& b, const int tid) {
    asm volatile("s_waitcnt vmcnt(0)" ::: "memory");
    __syncthreads();
    if (tid == 0) {
        unsigned* bar = b.bar; asm volatile("" : "+s"(bar)); unsigned bx_ = (unsigned)__builtin_amdgcn_readfirstlane((int)b.x); asm volatile("" : "+s"(bx_));
        __builtin_amdgcn_s_waitcnt(0);
        unsigned nloc = b.st[0], nx = b.st[1];
        if (nloc == 0u) { xcd_barrier_complete(bar, bx_, nloc, nx); b.st[0] = nloc; b.st[1] = nx; }
        const unsigned old = xb_add(&bar[XB_XSUB(bx_)], 1u);
        const unsigned gen = old / nloc;
        if (old + 1u == (gen + 1u) * nloc) {
            __builtin_amdgcn_fence(__ATOMIC_RELEASE, "agent");
            asm volatile("s_waitcnt vmcnt(0)" ::: "memory");
            const unsigned og = xb_add(&bar[XB_TOP], 1u);
            const unsigned tg = og / nx;
            if (og + 1u == (tg + 1u) * nx) xb_add(&bar[XB_TOPGEN], 1u);
            else XB_SPIN(xb_ld(&bar[XB_TOPGEN]) == tg, bar);
            __builtin_amdgcn_fence(__ATOMIC_ACQUIRE, "agent");
            xb_add(&bar[XB_XGEN(bx_)], 1u);
            asm volatile("s_waitcnt vmcnt(0)" ::: "memory");
        } else {
            XB_SPIN(xb_ld(&bar[XB_XGEN(bx_)]) == gen, bar);
            __builtin_amdgcn_fence(__ATOMIC_ACQUIRE, "agent");
            asm volatile("s_waitcnt vmcnt(0)" ::: "memory");
        }
    }
    __syncthreads();
}
namespace cg = cooperative_groups;
constexpr int NWAVES = 8;
constexpr int DM = 1024, FF = 2816, NH = 16, SEQ = 8192, NMETA = 16, DEPTH = 4;
constexpr int MMAIN = 2 * SEQ;
constexpr int MROWS = MMAIN + NMETA;
constexpr int MPAD = 65 * 256;
constexpr int KVROWS = attn_body::KVROWS;
constexpr float EPS = 1e-6f, LOG2E = 1.4426950408889634f;

constexpr size_t MiB = 1u << 20;
constexpr size_t SZ_GU = (size_t)5632 * 1024 * 2, SZ_DN = (size_t)1024 * 2816 * 2;
constexpr size_t WS_CTL = 0, CTL_ZERO_BYTES = 65536;
constexpr size_t WS_WGU = 1 * MiB, WS_WDN = WS_WGU + 8 * SZ_GU;
constexpr size_t WS_WAI = WS_WDN + 8 * SZ_DN, WS_WAO = WS_WAI + 2 * 6 * MiB, WS_WBI = WS_WAO + 2 * 2 * MiB, WS_WBO = WS_WBI + 4 * MiB;
constexpr size_t WS_WCI = WS_WBO + 2 * MiB, WS_WCO = WS_WCI + 6 * MiB, WS_WF = WS_WCO + 2 * MiB;
constexpr size_t WS_XN = WS_WF + 1 * MiB;
constexpr size_t SZ_ROWBUF = (size_t)MPAD * 1024 * 2;
constexpr size_t WS_ACT = WS_XN + 33 * MiB;
constexpr size_t WS_HMETA = WS_ACT + 98 * MiB, WS_LF = WS_HMETA + 1 * MiB, WS_LFM = WS_LF + 1 * MiB, WS_CS = WS_LFM + 1 * MiB, WS_SSQ = WS_CS + 2 * MiB, WS_SSQM = WS_SSQ + 1 * MiB, WS_END = WS_SSQM + 1 * MiB;
static_assert(SZ_ROWBUF <= 33 * MiB && 3 * SZ_ROWBUF <= 98 * MiB && (size_t)MPAD * FF * 2 <= 98 * MiB, "ws map");

constexpr int RING_BYTES = 131072, LDS_BYTES = 147456;
static_assert(attn_body::ATTN_LDS_BYTES <= RING_BYTES, "attention LDS");
constexpr int MISC_OFF = RING_BYTES + 320;

#define GAS __attribute__((address_space(1)))
typedef unsigned short bf16;
typedef unsigned v4u __attribute__((ext_vector_type(4)));
typedef unsigned v2u __attribute__((ext_vector_type(2)));
typedef float f32x4 __attribute__((ext_vector_type(4)));
typedef float f32x2 __attribute__((ext_vector_type(2)));
typedef short bf16x8 __attribute__((ext_vector_type(8)));
#define LDS_WAIT() asm volatile("s_waitcnt lgkmcnt(0)" ::: "memory")
__device__ __forceinline__ unsigned f2bf(float f) { unsigned u = __builtin_bit_cast(unsigned, f); return (u + 0x7fffu + ((u >> 16) & 1u)) >> 16; }
__device__ __forceinline__ unsigned pk2(float lo, float hi) { return f2bf(lo) | (f2bf(hi) << 16); }
__device__ __forceinline__ float bflo(unsigned w) { return __builtin_bit_cast(float, w << 16); }
__device__ __forceinline__ float bfhi(unsigned w) { return __builtin_bit_cast(float, w & 0xffff0000u); }
__device__ __forceinline__ float lane_get(float v, int src_lane) { return __builtin_bit_cast(float, __builtin_amdgcn_ds_bpermute(src_lane << 2, __builtin_bit_cast(int, v))); }
__device__ __forceinline__ float wave_sum(float v, int lane) {
#pragma unroll
    for (int o = 1; o < 64; o <<= 1) v += lane_get(v, lane ^ o);
    return v;
}

struct Args {
    const float* x; const float* meta; const float* ffn_norm; const float* ffn_w_gate; const float* ffn_w_up; const float* ffn_w_down; const float* mix_norm;
    const float* a_w_in; const float* a_conv; const float* a_w_out;
    const float* b_w_in; const float* b_conv; const float* b_conv_bias; const float* b_ln_g; const float* b_ln_b; const float* b_w_out;
    const float* c_w_in; const float* c_b_f; const float* c_q_norm; const float* c_k_norm; const float* c_w_out;
    float* out; unsigned char* ws;
};

__device__ __forceinline__ void transpose_item(const float* src, int Nsrc, bf16* dst, int K, int kb, LAS float* scr, int lane, const float* gain = nullptr) {
    const int k0 = 64 * kb;
    const GAS float* sp = (const GAS float*)src + (size_t)(k0 + (lane >> 5)) * Nsrc + (lane & 31);
    float v[32];
#pragma unroll
    for (int i = 0; i < 32; ++i) v[i] = sp[(size_t)(2 * i) * Nsrc];
    const int c = lane & 7;
    f32x4 g0 = {1.f, 1.f, 1.f, 1.f}, g1 = g0;
    if (gain) { g0 = *(const GAS f32x4*)(gain + k0 + 8 * c); g1 = *(const GAS f32x4*)(gain + k0 + 8 * c + 4); }
#pragma unroll
    for (int i = 0; i < 32; ++i) scr[(2 * i + (lane >> 5)) * 33 + (lane & 31)] = v[i];
    LDS_WAIT(); asm volatile("" ::: "memory");
#pragma unroll
    for (int j = 0; j < 4; ++j) { const int n = (lane >> 3) + 8 * j; const LAS float* s = scr + (8 * c) * 33 + n;
        v4u o; o.x = pk2(s[0 * 33] * g0.x, s[1 * 33] * g0.y); o.y = pk2(s[2 * 33] * g0.z, s[3 * 33] * g0.w); o.z = pk2(s[4 * 33] * g1.x, s[5 * 33] * g1.y); o.w = pk2(s[6 * 33] * g1.z, s[7 * 33] * g1.w);
        *(GAS v4u*)(dst + (size_t)n * K + k0 + 8 * c) = o; }
    LDS_WAIT(); asm volatile("" ::: "memory");
}

__device__ __forceinline__ float hb_row(const float* xrow, bf16* orow, int lane) {
    const GAS f32x4* xr = (const GAS f32x4*)xrow + lane;
    f32x4 v[4]; float s = 0.f;
#pragma unroll
    for (int j = 0; j < 4; ++j) { v[j] = xr[64 * j]; s += (v[j].x * v[j].x + v[j].y * v[j].y) + (v[j].z * v[j].z + v[j].w * v[j].w); }
    GAS unsigned long long* o8 = (GAS unsigned long long*)orow + lane;
#pragma unroll
    for (int j = 0; j < 4; ++j) o8[64 * j] = (unsigned long long)pk2(v[j].x, v[j].y) | ((unsigned long long)pk2(v[j].z, v[j].w) << 32);
    return wave_sum(s, lane);
}

constexpr int I_GU = 176 * 16, I_DN = 32 * 44, I_AI = 96 * 16, I_SQ = 32 * 16, I_BI = 64 * 16, I_CI = 96 * 16;
constexpr int I_FFN = 2 * I_GU + 2 * I_DN, I_MIXBASE = 8 * I_GU + 8 * I_DN;
static_assert(I_CI == I_AI, "conv_nv");
__device__ __forceinline__ int conv_nv(int L) { return I_FFN + ((L == 1) ? I_BI + I_SQ : I_AI + I_SQ); }
__device__ __forceinline__ int conv_item(int L, int v) {
    if (v < 2 * I_GU) return 2 * L * I_GU + v;
    if (v < I_FFN) return 8 * I_GU + 2 * L * I_DN + (v - 2 * I_GU);
    const int w = v - I_FFN;
    if (L == 0) return (w < I_AI) ? I_MIXBASE + w : I_MIXBASE + 2 * I_AI + (w - I_AI);
    if (L == 3) return (w < I_AI) ? I_MIXBASE + I_AI + w : I_MIXBASE + 2 * I_AI + I_SQ + (w - I_AI);
    if (L == 1) return I_MIXBASE + 2 * I_AI + 2 * I_SQ + w;
    return I_MIXBASE + 2 * I_AI + 2 * I_SQ + I_BI + I_SQ + w;
}
#define CONVERT_BODY \
            int r = it; \
            if (r < 8 * I_GU) { const int mat = r / I_GU; r %= I_GU; const int kb = r / 176, nb = r % 176, pn = nb >> 3, q = nb & 7; \
                const float* src = ((q < 4) ? a.ffn_w_gate : a.ffn_w_up) + (size_t)mat * 1024 * FF + 128 * pn + 32 * (q & 3); \
                transpose_item(src, FF, WGU + (size_t)mat * 5632 * 1024 + (size_t)nb * 32 * 1024, 1024, kb, scr, lane, a.ffn_norm + (size_t)mat * DM); continue; } \
            r -= 8 * I_GU; \
            if (r < 8 * I_DN) { const int mat = r / I_DN; r %= I_DN; const int kb = r / 32, nb = r % 32; \
                transpose_item(a.ffn_w_down + (size_t)mat * FF * 1024 + 32 * nb, 1024, WDN + (size_t)mat * 1024 * FF + (size_t)nb * 32 * FF, FF, kb, scr, lane); continue; } \
            r -= 8 * I_DN; \
            if (r < 2 * I_AI) { const int mat = r / I_AI; r %= I_AI; const int kb = r / 96, nb = r % 96, pn = nb >> 3, q = nb & 7; \
                const int scol = (pn < 8) ? ((q < 4) ? 1024 + 128 * pn + 32 * q : 2048 + 128 * pn + 32 * (q - 4)) : (nb - 64) * 32; \
                transpose_item(a.a_w_in + (size_t)mat * 1024 * 3072 + scol, 3072, WAI + (size_t)mat * 3072 * 1024 + (size_t)nb * 32 * 1024, 1024, kb, scr, lane, a.mix_norm + (size_t)(3 * mat) * DM); continue; } \
            r -= 2 * I_AI; \
            if (r < 2 * I_SQ) { const int mat = r / I_SQ; r %= I_SQ; const int kb = r / 32, nb = r % 32; \
                transpose_item(a.a_w_out + (size_t)mat * 1024 * 1024 + 32 * nb, 1024, WAO + (size_t)mat * 1024 * 1024 + (size_t)nb * 32 * 1024, 1024, kb, scr, lane); continue; } \
            r -= 2 * I_SQ; \
            if (r < I_BI) { const int kb = r / 64, nb = r % 64, pn = nb >> 3, q = nb & 7; \
                const int scol = (q < 4) ? 128 * pn + 32 * q : 1024 + 128 * pn + 32 * (q - 4); \
                transpose_item(a.b_w_in + scol, 2048, WBI + (size_t)nb * 32 * 1024, 1024, kb, scr, lane, a.mix_norm + (size_t)1 * DM); continue; } \
            r -= I_BI; \
            if (r < I_SQ) { const int kb = r / 32, nb = r % 32; \
                transpose_item(a.b_w_out + 32 * nb, 1024, WBO + (size_t)nb * 32 * 1024, 1024, kb, scr, lane); continue; } \
            r -= I_SQ; \
            if (r < I_CI) { const int kb = r / 96, nb = r % 96, pn = nb >> 3, q = nb & 7; \
                const int scol = (pn < 8) ? (pn >> 2) * 1024 + 64 * (4 * (pn & 3) + (q & 3)) + 32 * (q >> 2) : 2048 + (nb - 64) * 32; \
                transpose_item(a.c_w_in + scol, 3088, WCI + (size_t)nb * 32 * 1024, 1024, kb, scr, lane, a.mix_norm + (size_t)2 * DM); continue; } \
            r -= I_CI; \
            { const int kb = r / 32, nb = r % 32; \
                transpose_item(a.c_w_out + 32 * nb, 1024, WCO + (size_t)nb * 32 * 1024, 1024, kb, scr, lane); }

__device__ __forceinline__ void thin_gemm(LAS unsigned char* ldsl, const int tid, const int task, const bf16* A, const bf16* Bt, const int K, const int mode,
                                          bf16* R0, bf16* R1, bf16* R2, float* hmeta, const float scale, const float* qg, const float* kg, float* SSQM, bf16* HB) {
    const int ntasks = (mode == 0) ? 176 : (mode == 2) ? 128 : (mode == 3) ? 48 : 64;
    if (task < 0 || task >= ntasks) return;
    v2u ho_pre = {0u, 0u}; if (mode == 4) ho_pre = *(const GAS v2u*)(HB + (size_t)(MMAIN + (tid & 15)) * 1024 + 16 * task + 4 * ((tid & 63) >> 4));
    float rsm_t = 0.f;
    if (mode != 4) {
#pragma unroll
        for (int i = 0; i < 16; ++i) { const f32x4 q4 = *(const GAS f32x4*)(SSQM + (tid & 15) * 64 + 4 * i); rsm_t += (q4.x + q4.y) + (q4.z + q4.w); } }
    const int lane = tid & 63, wave = __builtin_amdgcn_readfirstlane(tid >> 6), fr = lane & 15, fq = lane >> 4;
    int nt = 1, b0 = 0, b1 = 0, b2 = 0, b3 = 0;
    if (mode <= 1 || (mode == 2 && task < 64)) { const int f0 = 16 * task; b0 = 256 * (f0 >> 7) + (f0 & 127); b1 = b0 + 128; nt = 2; }
    else if (mode == 2) { b0 = 2048 + 16 * (task - 64); }
    else if (mode == 3) { const int sec = task >> 4, hd = task & 15; nt = 4;
        if (sec < 2) { b0 = 256 * (sec * 4 + (hd >> 2)) + 32 * (hd & 3); b1 = b0 + 16; b2 = b0 + 128; b3 = b0 + 144; }
        else { b0 = 2048 + 64 * hd; b1 = b0 + 16; b2 = b0 + 32; b3 = b0 + 48; } }
    else { b0 = 16 * task; }
    const int kw = K >> 3, ksteps = kw >> 5;
    const GAS bf16x8* ap = (const GAS bf16x8*)(A + (size_t)(MMAIN + fr) * K + wave * kw + 8 * fq);
    const GAS bf16x8* p0 = (const GAS bf16x8*)(Bt + (size_t)(b0 + fr) * K + wave * kw + 8 * fq);
    const GAS bf16x8* p1 = (const GAS bf16x8*)(Bt + (size_t)(b1 + fr) * K + wave * kw + 8 * fq);
    const GAS bf16x8* p2 = (const GAS bf16x8*)(Bt + (size_t)(b2 + fr) * K + wave * kw + 8 * fq);
    const GAS bf16x8* p3 = (const GAS bf16x8*)(Bt + (size_t)(b3 + fr) * K + wave * kw + 8 * fq);
    f32x4 c0 = {0.f, 0.f, 0.f, 0.f}, c1 = c0, c2 = c0, c3 = c0;
    if (ksteps > 4) {
        bf16x8 xa[11], wb[11];
#pragma unroll
        for (int ks = 0; ks < 11; ++ks) { xa[ks] = ap[4 * ks]; wb[ks] = p0[4 * ks]; }
#pragma unroll
        for (int ks = 0; ks < 11; ++ks) c0 = __builtin_amdgcn_mfma_f32_16x16x32_bf16(wb[ks], xa[ks], c0, 0, 0, 0);
    } else {
#pragma unroll 4
    for (int ks = 0; ks < ksteps; ++ks) {
        const bf16x8 xa = ap[4 * ks];
        c0 = __builtin_amdgcn_mfma_f32_16x16x32_bf16(p0[4 * ks], xa, c0, 0, 0, 0);
        if (nt >= 2) c1 = __builtin_amdgcn_mfma_f32_16x16x32_bf16(p1[4 * ks], xa, c1, 0, 0, 0);
        if (nt >= 4) { c2 = __builtin_amdgcn_mfma_f32_16x16x32_bf16(p2[4 * ks], xa, c2, 0, 0, 0); c3 = __builtin_amdgcn_mfma_f32_16x16x32_bf16(p3[4 * ks], xa, c3, 0, 0, 0); }
    }
    }
    LAS f32x4* P = (LAS f32x4*)ldsl;
    P[(wave * 4 + 0) * 64 + lane] = c0; P[(wave * 4 + 1) * 64 + lane] = c1; P[(wave * 4 + 2) * 64 + lane] = c2; P[(wave * 4 + 3) * 64 + lane] = c3;
    __syncthreads();
    if (wave == 0) {
#pragma unroll
        for (int w = 1; w < 8; ++w) { c0 += P[(w * 4 + 0) * 64 + lane]; c1 += P[(w * 4 + 1) * 64 + lane]; c2 += P[(w * 4 + 2) * 64 + lane]; c3 += P[(w * 4 + 3) * 64 + lane]; }
        const size_t mrow = (size_t)(MMAIN + fr);
        if (mode != 4) { const float rsm = __builtin_amdgcn_rsqf(rsm_t * (1.f / DM) + EPS); c0 *= rsm; c1 *= rsm; c2 *= rsm; c3 *= rsm; }
        if (mode <= 1 || (mode == 2 && task < 64)) {
            f32x4 r;
            if (mode == 0) {
#pragma unroll
                for (int i = 0; i < 4; ++i) r[i] = c0[i] * pg8::sigm(c0[i]) * c1[i];
            } else if (mode == 1) {
#pragma unroll
                for (int i = 0; i < 4; ++i) r[i] = c0[i] * pg8::sigm(c1[i]);
            } else r = c0 * c1;
            *(GAS v2u*)(R0 + mrow * (mode == 0 ? FF : 1024) + 16 * task + 4 * fq) = (v2u){pk2(r[0], r[1]), pk2(r[2], r[3])};
        } else if (mode == 2) {
            *(GAS v2u*)(R1 + mrow * 1024 + 16 * (task - 64) + 4 * fq) = (v2u){pk2(c0[0], c0[1]), pk2(c0[2], c0[3])};
        } else if (mode == 3) {
            const int sec = task >> 4, hd = task & 15;
            f32x4 v0 = c0, v1 = c1, v2 = c2, v3 = c3;
            if (sec < 2) {
                float ss = (c0[0] * c0[0] + c0[1] * c0[1]) + (c0[2] * c0[2] + c0[3] * c0[3]) + (c1[0] * c1[0] + c1[1] * c1[1]) + (c1[2] * c1[2] + c1[3] * c1[3])
                         + (c2[0] * c2[0] + c2[1] * c2[1]) + (c2[2] * c2[2] + c2[3] * c2[3]) + (c3[0] * c3[0] + c3[1] * c3[1]) + (c3[2] * c3[2] + c3[3] * c3[3]);
                ss += lane_get(ss, lane ^ 16); ss += lane_get(ss, lane ^ 32);
                const float rs = __builtin_amdgcn_rsqf(ss * (1.0f / 64.0f) + EPS) * ((sec == 0) ? pg8::QK_C2 : 1.0f);
                const float* g = (sec == 0) ? qg : kg;
                v0 = c0 * rs * *(const GAS f32x4*)(g + 4 * fq); v1 = c1 * rs * *(const GAS f32x4*)(g + 16 + 4 * fq); v2 = c2 * rs * *(const GAS f32x4*)(g + 32 + 4 * fq); v3 = c3 * rs * *(const GAS f32x4*)(g + 48 + 4 * fq);
            }
            const v2u w0 = {pk2(v0[0], v0[1]), pk2(v0[2], v0[3])}, w1 = {pk2(v1[0], v1[1]), pk2(v1[2], v1[3])}, w2 = {pk2(v2[0], v2[1]), pk2(v2[2], v2[3])}, w3 = {pk2(v3[0], v3[1]), pk2(v3[2], v3[3])};
            const int col = 64 * hd + 4 * fq;
            if (sec == 0) { bf16* q = R0 + mrow * 1024 + col; *(GAS v2u*)q = w0; *(GAS v2u*)(q + 16) = w1; *(GAS v2u*)(q + 32) = w2; *(GAS v2u*)(q + 48) = w3; }
            else { bf16* T = (sec == 1) ? R1 : R2;
#pragma unroll
                for (int b = 0; b < 2; ++b) { bf16* q = T + (size_t)(b * KVROWS + 48 + fr) * 1024 + col; *(GAS v2u*)q = w0; *(GAS v2u*)(q + 16) = w1; *(GAS v2u*)(q + 32) = w2; *(GAS v2u*)(q + 48) = w3; } }
        } else {
            const v2u ho = ho_pre;
            const f32x4 hn = (f32x4){bflo(ho.x), bfhi(ho.x), bflo(ho.y), bfhi(ho.y)} + c0 * scale;
            *(GAS v2u*)(HB + mrow * 1024 + 16 * task + 4 * fq) = (v2u){pk2(hn[0], hn[1]), pk2(hn[2], hn[3])};
            float ps = (hn[0] * hn[0] + hn[1] * hn[1]) + (hn[2] * hn[2] + hn[3] * hn[3]); ps += lane_get(ps, lane ^ 16); ps += lane_get(ps, lane ^ 32);
            if (fq == 0) SSQM[fr * 64 + task] = ps;
        }
    }
    __syncthreads();
}

__global__ void __launch_bounds__(NWAVES * 64, 2) fwd_megakernel(Args a_unused) {
    extern __shared__ __attribute__((aligned(16))) unsigned char lds[];
    cg::grid_group grid = cg::this_grid();
    const int G = gridDim.x, bx = blockIdx.x;
    const int vcu0 = (G % 8 == 0) ? (bx % 8) * (G / 8) + bx / 8 : bx;
    const int NGW = G * NWAVES;
    if (threadIdx.x < 64) ((LAS unsigned*)((LAS unsigned char*)lds + RING_BYTES))[threadIdx.x * 2] = 0u, ((LAS unsigned*)((LAS unsigned char*)lds + RING_BYTES))[threadIdx.x * 2 + 1] = 0u;
    __syncthreads();
    const int wave_s = __builtin_amdgcn_readfirstlane((int)threadIdx.x >> 6);
#define PHASE_ENV() \
    const __attribute__((address_space(4))) Args* kap_ = (const __attribute__((address_space(4))) Args*)__builtin_amdgcn_kernarg_segment_ptr(); asm volatile("" : "+s"(kap_)); \
    const __attribute__((address_space(4))) Args& a = *kap_;     \
    unsigned zero_ = 0u; asm volatile("" : "+s"(zero_)); int vcu = vcu0; asm volatile("" : "+s"(vcu)); \
    int tid = (wave_s << 6) | (int)__builtin_amdgcn_mbcnt_hi(~0u, __builtin_amdgcn_mbcnt_lo(~0u, zero_)); \
    const int lane = tid & 63, wave = __builtin_amdgcn_readfirstlane(tid >> 6), gw = vcu * NWAVES + wave; \
    unsigned char* ws0_ = a.ws; asm volatile("" : "+s"(ws0_)); unsigned char* const ws = (unsigned char*)(GAS unsigned char*)ws0_;     \
    float* hm0_ = a.out; asm volatile("" : "+s"(hm0_)); float* const hmain = (float*)(GAS float*)hm0_; \
    bf16* const WGU = (bf16*)(ws + WS_WGU); bf16* const WDN = (bf16*)(ws + WS_WDN); \
    bf16* const WAI = (bf16*)(ws + WS_WAI); bf16* const WAO = (bf16*)(ws + WS_WAO); bf16* const WBI = (bf16*)(ws + WS_WBI); bf16* const WBO = (bf16*)(ws + WS_WBO); \
    bf16* const WCI = (bf16*)(ws + WS_WCI); bf16* const WCO = (bf16*)(ws + WS_WCO); bf16* const WFt = (bf16*)(ws + WS_WF); \
    bf16* const XN = (bf16*)(ws + WS_XN); \
    bf16* const R0 = (bf16*)(ws + WS_ACT); bf16* const R1 = (bf16*)(ws + WS_ACT + SZ_ROWBUF); bf16* const R2 = (bf16*)(ws + WS_ACT + 2 * SZ_ROWBUF); \
    float* const hmeta = (float*)(ws + WS_HMETA); \
    float* const LF = (float*)(ws + WS_LF); float* const LFM = (float*)(ws + WS_LFM); float* const CS = (float*)(ws + WS_CS); \
    float* const SSQ = (float*)(ws + WS_SSQ); float* const SSQM = (float*)(ws + WS_SSQM); (void)SSQ; (void)SSQM; \
    LAS unsigned char* const ldsl = (LAS unsigned char*)lds; \
    (void)WGU; (void)WDN; (void)WAI; (void)WAO; (void)WBI; (void)WBO; (void)WCI; (void)WCO; (void)WFt; (void)XN; (void)R0; (void)R1; (void)R2; (void)hmeta; (void)LF; (void)LFM; (void)CS; (void)ldsl; (void)lane; (void)gw; (void)hmain;

#ifdef PROBE_SEL
    LAS unsigned long long* const TS = (LAS unsigned long long*)((LAS unsigned char*)lds + RING_BYTES + 12288);
    if (threadIdx.x == 0) { for (int c = 0; c < 8; ++c) TS[c] = 0; TS[8] = __builtin_amdgcn_s_memrealtime(); }
#endif
    XcdBarrier bar;
    { PHASE_ENV(); bar = xcd_barrier_post((unsigned*)(ws + WS_CTL), (volatile LAS unsigned*)(ldsl + MISC_OFF) + 8, tid); }
    {
        PHASE_ENV();
        LAS float* scr = (LAS float*)(ldsl + wave * 16384);
        for (int v = gw; v < conv_nv(0); v += NGW) { const int it = conv_item(0, v);
            CONVERT_BODY
        }
        for (int i = gw * 64 + lane; i < 16 * 1024; i += NGW * 64) { const int h = i >> 10, k = i & 1023; WFt[i] = (bf16)f2bf(a.c_w_in[(size_t)k * 3088 + 3072 + h] * a.mix_norm[2 * DM + k]); }
        for (int m0 = gw; m0 < MROWS; m0 += 2 * NGW) {
            const int m1 = m0 + NGW; const bool has1 = (m1 < MROWS);
            const float* s0 = (m0 < MMAIN) ? a.x + (size_t)m0 * DM : a.meta + (size_t)(m0 - MMAIN) * DM;
            const float* s1 = !has1 ? s0 : (m1 < MMAIN) ? a.x + (size_t)m1 * DM : a.meta + (size_t)(m1 - MMAIN) * DM;
            f32x4 va[4], vb[4];
#pragma unroll
            for (int j = 0; j < 4; ++j) { va[j] = ((const GAS f32x4*)s0 + lane)[64 * j]; vb[j] = ((const GAS f32x4*)s1 + lane)[64 * j]; }
#pragma unroll
            for (int half = 0; half < 2; ++half) {
                if (half == 1 && !has1) break;
                const int m = half ? m1 : m0; float ssl = 0.f;
                GAS unsigned long long* o8 = (GAS unsigned long long*)(XN + (size_t)m * DM) + lane;
#pragma unroll
                for (int j = 0; j < 4; ++j) { const f32x4 v = half ? vb[j] : va[j]; ssl += (v.x * v.x + v.y * v.y) + (v.z * v.z + v.w * v.w);
                    o8[64 * j] = (unsigned long long)pk2(v.x, v.y) | ((unsigned long long)pk2(v.z, v.w) << 32); }
                const float ss = wave_sum(ssl, lane);
                if (m < MMAIN) { if (lane < 4) SSQ[(size_t)m * 4 + lane] = (lane == 0) ? ss : 0.f; } else SSQM[(m - MMAIN) * 64 + lane] = (lane == 0) ? ss : 0.f;
            }
        }
    }
    { PHASE_ENV(); if (ws == nullptr) grid.sync();
      xcd_barrier(bar, tid); }
#ifdef PROBE_SEL
    { PHASE_ENV(); if (tid == 0) { TS[9] = __builtin_amdgcn_s_memrealtime(); TS[0] = TS[9] - TS[8]; } }
#endif
    for (int L = 0; L < DEPTH; ++L) {
        const int mx = L % 3, mj = L / 3;
        for (int s = 0; s <= 10; ++s) {
            if ((s == 6 && mx != 2) || (s == 5 && mx == 2) || s == 0 || s == 3 || s == 8) continue;
#ifdef PROBE_REP
            const int pcat = (s == 1 || s == 9) ? 1 : (s == 2 || s == 10 || s == 7) ? 2 : (s == 4) ? 4 : (s == 5) ? 8 : 16; const int nrep = (PROBE_REP & pcat) ? 2 : 1;
#else
            const int nrep = 1;
#endif
            for (int rp = 0; rp < nrep; ++rp) {
            const bool dry = (rp + 1 < nrep); (void)dry;
            PHASE_ENV();
            if (s == 0 || s == 3 || s == 8) {
                continue;
            } else if (s == 1 || s == 2 || s == 4 || s == 7 || s == 9 || s == 10) {
                pg8::Gemm g; pg8::EpiAll E;
                E.mtiles_main = 64; E.O1 = R0; E.O2 = R1; E.O3 = R2; E.ldo = 1024; E.hmain = hmain; E.hmeta = hmeta; E.scale = 1.f; E.qg = a.c_q_norm; E.kg = a.c_k_norm; E.mode = 0;
                E.ssq = SSQ; E.ssq_out = SSQ; E.hb = XN; E.fout = (L == DEPTH - 1 && s == 10 && !dry) ? hmain : nullptr; E.ldsp = (LAS float*)(ldsl + RING_BYTES + 1024); E.rsl = (const LAS float*)(ldsl + RING_BYTES + 5120);
                g.M = MMAIN;
                if (s == 1 || s == 9) { g.A = XN; g.Bt = WGU + (size_t)(L * 2 + (s == 9)) * 5632 * 1024; g.N = 5632; g.K = 1024; E.mode = 0; E.ldo = FF; }
                else if (s == 2 || s == 10) { g.A = R0; g.Bt = WDN + (size_t)(L * 2 + (s == 10)) * 1024 * FF; g.N = 1024; g.K = FF; E.mode = 4; E.scale = dry ? 0.f : 0.5f; }
                else if (s == 4) {
                    g.A = XN; g.K = 1024;
                    if (mx == 0) { g.Bt = WAI + (size_t)mj * 3072 * 1024; g.N = 3072; E.mode = 2; }
                    else if (mx == 1) { g.Bt = WBI; g.N = 2048; E.mode = 1; }
                    else { g.Bt = WCI; g.N = 3072; E.mode = 3;
                    for (int i = gw; i < 2 * 2 * 112; i += NGW) { const int tsel = i / 224, rr = i % 224, b = rr / 112, j = rr % 112; const int row = b * KVROWS + (j < 48 ? j : j + 16);
                        bf16* p = (tsel ? R2 : R1) + (size_t)row * 1024; ((GAS v4u*)p)[lane * 2] = (v4u){zero_, zero_, zero_, zero_}; ((GAS v4u*)p)[lane * 2 + 1] = (v4u){zero_, zero_, zero_, zero_}; }
                        const int fr = lane & 15, fq = lane >> 4;
                        for (int grp = gw; grp < MROWS / 16; grp += NGW) {
                            const bf16* xp = XN + (size_t)(16 * grp + fr) * DM + 8 * fq; const bf16* wp = WFt + (size_t)fr * DM + 8 * fq;
                            f32x4 acc = {0.f, 0.f, 0.f, 0.f};
#pragma unroll 16
                            for (int k = 0; k < 32; ++k) { const bf16x8 xa = *(const GAS bf16x8*)(xp + 32 * k), wb = *(const GAS bf16x8*)(wp + 32 * k);
                                acc = __builtin_amdgcn_mfma_f32_16x16x32_bf16(xa, wb, acc, 0, 0, 0); }
                            const float bf = a.c_b_f[fr]; f32x4 o; float rsr[4];
                            if (grp < MMAIN / 16) {
#pragma unroll
                                for (int r = 0; r < 4; ++r) { const f32x4 q4 = *(const GAS f32x4*)(SSQ + (size_t)(16 * grp + 4 * fq + r) * 4); rsr[r] = __builtin_amdgcn_rsqf(((q4.x + q4.y) + (q4.z + q4.w)) * (1.f / DM) + EPS); }
                            } else {
#pragma unroll
                                for (int r = 0; r < 4; ++r) { float t = 0.f; for (int i = 0; i < 16; ++i) { const f32x4 q4 = *(const GAS f32x4*)(SSQM + (4 * fq + r) * 64 + 4 * i); t += (q4.x + q4.y) + (q4.z + q4.w); } rsr[r] = __builtin_amdgcn_rsqf(t * (1.f / DM) + EPS); }
                            }
#pragma unroll
                            for (int r = 0; r < 4; ++r) { const float xv = acc[r] * rsr[r] + bf; o[r] = fminf(xv, 0.f) - log1pf(expf(-fabsf(xv))); }
                            if (grp < MMAIN / 16) { const int r0 = 16 * grp, b = r0 >> 13, t0 = r0 & 8191; *(GAS f32x4*)(LF + ((size_t)(b * NH + fr) * SEQ + t0 + 4 * fq)) = o; }
                            else *(GAS f32x4*)(LFM + fr * 16 + 4 * fq) = o;
                        }
                        asm volatile("s_waitcnt vmcnt(0) lgkmcnt(0)" ::: "memory"); __syncthreads();
                    }
                }
                else { g.K = 1024; g.N = 1024; E.mode = 4; E.scale = dry ? 0.f : 1.f;
                    if (mx == 0) { g.A = R2; g.Bt = WAO + (size_t)mj * 1024 * 1024; } else if (mx == 1) { g.A = R1; g.Bt = WBO; } else { g.A = R0; g.Bt = WCO; } }
                pg8::StaticOrder S; S.init(g.M, g.N, G, bx);
                f32x4 rs_q[3] = {{0.f, 0.f, 0.f, 0.f}, {0.f, 0.f, 0.f, 0.f}, {0.f, 0.f, 0.f, 0.f}}; bool rs_has[3] = {false, false, false};
                if (E.mode != 4) { pg8::Unit uu{0, 0};
#pragma unroll
                    for (int j = 0; j < 3; ++j) { const int i = (tid >> 8) + 2 * j; rs_has[j] = S.next(i, uu); if (rs_has[j]) rs_q[j] = *(const GAS f32x4*)(SSQ + (size_t)(uu.pm * 256 + (tid & 255)) * 4); } }
                for (int rep2 = 0; rep2 < 2; ++rep2) { const int task = (E.mode == 0) ? ((bx >= 128) ? bx - 128 + 128 * rep2 : -1) : (rep2 == 0 ? vcu : -1);
                    thin_gemm(ldsl, tid, task, g.A, g.Bt, g.K, E.mode, R0, R1, R2, hmeta, E.scale, a.c_q_norm, a.c_k_norm, SSQM, XN); }
                if (E.mode != 4) {
                    LAS float* rsl = (LAS float*)(ldsl + RING_BYTES + 5120);
#pragma unroll
                    for (int j = 0; j < 3; ++j) { const int i = (tid >> 8) + 2 * j; if (rs_has[j]) rsl[i * 256 + (tid & 255)] = __builtin_amdgcn_rsqf(((rs_q[j].x + rs_q[j].y) + (rs_q[j].z + rs_q[j].w)) * (1.f / DM) + EPS); }
                }
#ifndef NO_GEMM
                pg8::gemm_phase<pg8::EpiAll, pg8::StaticOrder, PG8_ALIGN, PG8_SP2>(ldsl, g, S, E, tid);
#endif
                if ((s == 1 || s == 9) && L + 1 < DEPTH && bx >= 128 && !dry) {
                    LAS float* scr = (LAS float*)(ldsl + wave * 16384);
                    const int nv = conv_nv(L + 1), lo = (s == 1) ? 0 : nv / 2, hi = (s == 1) ? nv / 2 : nv;
                    for (int v = lo + (bx - 128) * NWAVES + wave; v < hi; v += 128 * NWAVES) { const int it = conv_item(L + 1, v);
                        CONVERT_BODY
                    }
                }
                if (E.mode == 4) {
                    const int wg0_ = (bx & 7) * 32 + (bx >> 3), nig0_ = pg8::WGM * 4, pm0 = (wg0_ / nig0_) * pg8::WGM + (wg0_ % nig0_) % pg8::WGM, pn0 = (wg0_ % nig0_) / pg8::WGM;
                    if (G == 256 && tid < 256) { const f32x4 p4 = *(const LAS f32x4*)(E.ldsp + tid * 4); SSQ[(size_t)(pm0 * 256 + tid) * 4 + pn0] = (p4.x + p4.y) + (p4.z + p4.w); }
                }
            } else if (s == 5) {
                if (mx == 0) {
                    const float* cw = a.a_conv + (size_t)mj * 3 * DM + 16 * lane;
                    f32x4 w0[4], w1[4], w2[4];
#pragma unroll
                    for (int j = 0; j < 4; ++j) { w0[j] = *(const f32x4*)(cw + 4 * j); w1[j] = *(const f32x4*)(cw + DM + 4 * j); w2[j] = *(const f32x4*)(cw + 2 * DM + 4 * j); }
                    for (int blk = gw; blk < MROWS / 4; blk += NGW) {
                        const bool mainb = (blk < MMAIN / 4); const int r0 = mainb ? 4 * blk : MMAIN + 4 * (blk - MMAIN / 4);
                        int rm1, rm2;
                        if (mainb) { const int t0 = r0 & 8191; rm1 = (t0 >= 1) ? r0 - 1 : MMAIN + 15; rm2 = (t0 >= 2) ? r0 - 2 : MMAIN + 14; }
                        else { const int p0 = r0 - MMAIN; rm1 = (p0 >= 1) ? r0 - 1 : -1; rm2 = (p0 >= 2) ? r0 - 2 : -1; }
                        const v4u z4 = {0u, 0u, 0u, 0u};
                        v4u xw[6][2], bb[4][2];
#pragma unroll
                        for (int hh = 0; hh < 2; ++hh) {
                            xw[0][hh] = (rm2 >= 0) ? ((const GAS v4u*)(R0 + (size_t)rm2 * DM) + 2 * lane)[hh] : z4; xw[1][hh] = (rm1 >= 0) ? ((const GAS v4u*)(R0 + (size_t)rm1 * DM) + 2 * lane)[hh] : z4;
#pragma unroll
                            for (int i = 0; i < 4; ++i) { xw[2 + i][hh] = ((const GAS v4u*)(R0 + (size_t)(r0 + i) * DM) + 2 * lane)[hh]; bb[i][hh] = ((const GAS v4u*)(R1 + (size_t)(r0 + i) * DM) + 2 * lane)[hh]; } }
#pragma unroll
                        for (int i = 0; i < 4; ++i) { GAS v4u* yp = (GAS v4u*)(R2 + (size_t)(r0 + i) * DM) + 2 * lane;
#pragma unroll
                            for (int hh = 0; hh < 2; ++hh) { v4u o;
#pragma unroll
                                for (int e = 0; e < 4; ++e) { const int j = 2 * hh + (e >> 1), c = 2 * (e & 1);
                                    const float lo = bflo(bb[i][hh][e]) * (w2[j][c] * bflo(xw[2 + i][hh][e]) + w1[j][c] * bflo(xw[1 + i][hh][e]) + w0[j][c] * bflo(xw[i][hh][e]));
                                    const float hi = bfhi(bb[i][hh][e]) * (w2[j][c + 1] * bfhi(xw[2 + i][hh][e]) + w1[j][c + 1] * bfhi(xw[1 + i][hh][e]) + w0[j][c + 1] * bfhi(xw[i][hh][e]));
                                    o[e] = pk2(lo, hi); }
                                yp[hh] = o; } }
                    }
                } else if (mx == 1) {
#ifndef NO_CONF
                    const int c = 2 * tid;
                    f32x2 w[31];
#pragma unroll
                    for (int k = 0; k < 31; ++k) w[k] = *(const GAS f32x2*)(a.b_conv + (size_t)k * DM + c);
                    const f32x2 cb = *(const f32x2*)(a.b_conv_bias + c), lg = *(const f32x2*)(a.b_ln_g + c), lb = *(const f32x2*)(a.b_ln_b + c);
                    LAS float* red = (LAS float*)ldsl;
                    LAS float* red2 = red + 256;
                    for (int un = vcu; un < MROWS / 16; un += G) {
                        const int r0 = 16 * un; const bool meta = (r0 >= MMAIN);
                        const int p0 = meta ? 0 : 16 + (r0 & 8191); const int rowb = meta ? 0 : (r0 >> 13) * SEQ;
                        unsigned xin[46];
#pragma unroll
                        for (int j = 0; j < 46; ++j) { const int pj = p0 - 30 + j;
                            xin[j] = (pj >= 0) ? *(const GAS unsigned*)(R0 + (size_t)((pj < 16) ? MMAIN + pj : rowb + pj - 16) * DM + c) : 0u; }
                        f32x2 acc[16];
#pragma unroll
                        for (int i = 0; i < 16; ++i) acc[i] = cb;
#pragma unroll
                        for (int j = 0; j < 46; ++j) { const f32x2 xv = {bflo(xin[j]), bfhi(xin[j])};
#pragma unroll
                            for (int i = 0; i < 16; ++i) { const int k = j - i; if (k >= 0 && k <= 30) acc[i] += w[k] * xv; } }
                        float st[32];
#pragma unroll
                        for (int i = 0; i < 16; ++i) { st[2 * i] = acc[i].x + acc[i].y; st[2 * i + 1] = acc[i].x * acc[i].x + acc[i].y * acc[i].y; }
#pragma unroll
                        for (int i = 0; i < 32; ++i) st[i] = wave_sum(st[i], lane);
                        if (lane == 0) {
#pragma unroll
                            for (int i = 0; i < 8; ++i) *(LAS f32x4*)(red + wave * 32 + 4 * i) = (f32x4){st[4 * i], st[4 * i + 1], st[4 * i + 2], st[4 * i + 3]}; }
                        __syncthreads();
                        if (tid < 32) { float t = 0.f;
#pragma unroll
                            for (int wv = 0; wv < 8; ++wv) t += red[wv * 32 + tid];
                            red2[tid] = t; }
                        __syncthreads();
#pragma unroll
                        for (int i = 0; i < 16; ++i) { const f32x2 sv = *(const LAS f32x2*)(red2 + 2 * i);
                            const float mu = sv.x * (1.f / DM), var = fmaxf(sv.y * (1.f / DM) - mu * mu, 0.f), rs = 1.0f / sqrtf(var + EPS);
                            const float y0 = (acc[i].x - mu) * rs * lg.x + lb.x, y1 = (acc[i].y - mu) * rs * lg.y + lb.y;
                            *(GAS unsigned*)(R1 + (size_t)(r0 + i) * DM + c) = pk2(y0 * pg8::sigm(y0), y1 * pg8::sigm(y1)); }
                    }
#endif
                } else {
                }
            } else if (s == 6) {
                {
                        const int bh = vcu >> 3, h = bh & 15; LAS float* wt = (LAS float*)ldsl;
                        LAS float* csrow = (LAS float*)(ldsl + attn_body::LDS_CS);
                        float cm = 0.f, cmp = 0.f;
#pragma unroll
                        for (int j = 0; j < 16; ++j) { cm += LFM[h * 16 + j]; if (j == tid) cmp = cm; }
                        const float* lp = LF + (size_t)bh * SEQ + 16 * tid; float v[16];
#pragma unroll
                        for (int j = 0; j < 4; ++j) { const f32x4 q = *(const GAS f32x4*)(lp + 4 * j); v[4 * j] = q.x; v[4 * j + 1] = q.y; v[4 * j + 2] = q.z; v[4 * j + 3] = q.w; }
#pragma unroll
                        for (int j = 1; j < 16; ++j) v[j] += v[j - 1];
                        float inc = v[15];
#pragma unroll
                        for (int o = 1; o < 64; o <<= 1) { const float t = lane_get(inc, (lane - o) & 63); if (lane >= o) inc += t; }
                        if (lane == 63) wt[wave] = inc;
                        __syncthreads();
                        float off = cm + inc - v[15];
                        for (int wv = 0; wv < wave; ++wv) off += wt[wv];
#pragma unroll
                        for (int j = 0; j < 4; ++j) *(LAS f32x4*)(csrow + 128 + 16 * tid + 4 * j) = (f32x4){(off + v[4 * j]) * LOG2E, (off + v[4 * j + 1]) * LOG2E, (off + v[4 * j + 2]) * LOG2E, (off + v[4 * j + 3]) * LOG2E};
                        const float cmsh = lane_get(cmp, (lane + 16) & 63);
                        if (tid < 128) csrow[tid] = (tid >= 48 && tid < 64) ? cmsh * LOG2E : __builtin_inff();
                        __syncthreads();
                }
                const attn_body::AttnTensors AT{(const attn_body::bf16*)R0, (const attn_body::bf16*)R1, (const attn_body::bf16*)R2, (attn_body::bf16*)(dry ? (bf16*)(ws + WS_END) : R0), CS};
                const attn_body::StaticOrder S(G, bx);
#ifndef NO_ATTN
                attn_body::attn_phase<attn_body::StaticOrder>((char*)lds, AT, S, tid);
#endif
                }
                if (s == 6 && !dry) {
                PHASE_ENV();
                if (gw < NH) {
                    const int h = gw, q = lane & 15, dc = lane >> 4;
                    const bf16* qp = R0 + (size_t)(MMAIN + q) * DM + 64 * h + 16 * dc;
                    const v4u qa = ((const GAS v4u*)qp)[0], qb = ((const GAS v4u*)qp)[1];
                    float qv[16];
#pragma unroll
                    for (int e = 0; e < 4; ++e) { qv[2 * e] = bflo(qa[e]); qv[2 * e + 1] = bfhi(qa[e]); qv[8 + 2 * e] = bflo(qb[e]); qv[8 + 2 * e + 1] = bfhi(qb[e]); }
                    float sc[16], cbm[16]; { float run = 0.f;
#pragma unroll
                        for (int j = 0; j < 16; ++j) { run += *(const GAS float*)(LFM + h * 16 + j); cbm[j] = run * LOG2E; } }
#pragma unroll
                    for (int jb = 0; jb < 16; jb += 8) {
                        v4u ka[8], kb[8]; float cb[8];
#pragma unroll
                        for (int j = 0; j < 8; ++j) { const bf16* kp = R1 + (size_t)(48 + jb + j) * DM + 64 * h + 16 * dc; ka[j] = ((const GAS v4u*)kp)[0]; kb[j] = ((const GAS v4u*)kp)[1];
                            cb[j] = cbm[jb + j]; }
#pragma unroll
                        for (int j = 0; j < 8; ++j) { float d = 0.f;
#pragma unroll
                            for (int e = 0; e < 4; ++e) d += qv[2 * e] * bflo(ka[j][e]) + qv[2 * e + 1] * bfhi(ka[j][e]) + qv[8 + 2 * e] * bflo(kb[j][e]) + qv[8 + 2 * e + 1] * bfhi(kb[j][e]);
                            d += lane_get(d, lane ^ 16); d += lane_get(d, lane ^ 32);
                            sc[jb + j] = (jb + j <= q) ? d - cb[j] : -__builtin_inff(); }
                    }
                    float mrun = sc[0];
#pragma unroll
                    for (int j = 1; j < 16; ++j) mrun = fmaxf(mrun, sc[j]);
                    float l = 0.f, o[16];
#pragma unroll
                    for (int e = 0; e < 16; ++e) o[e] = 0.f;
#pragma unroll
                    for (int jb = 0; jb < 16; jb += 8) {
                        v4u va[8], vb[8];
#pragma unroll
                        for (int j = 0; j < 8; ++j) { const bf16* vp = R2 + (size_t)(48 + jb + j) * DM + 64 * h + 16 * dc; va[j] = ((const GAS v4u*)vp)[0]; vb[j] = ((const GAS v4u*)vp)[1]; }
#pragma unroll
                        for (int j = 0; j < 8; ++j) { const float p = __builtin_amdgcn_exp2f(sc[jb + j] - mrun); l += p;
#pragma unroll
                            for (int e = 0; e < 4; ++e) { o[2 * e] += p * bflo(va[j][e]); o[2 * e + 1] += p * bfhi(va[j][e]); o[8 + 2 * e] += p * bflo(vb[j][e]); o[8 + 2 * e + 1] += p * bfhi(vb[j][e]); } }
                    }
                    const float rl = 1.0f / l; v4u oa, ob;
#pragma unroll
                    for (int e = 0; e < 4; ++e) { oa[e] = pk2(o[2 * e] * rl, o[2 * e + 1] * rl); ob[e] = pk2(o[8 + 2 * e] * rl, o[8 + 2 * e + 1] * rl); }
                    GAS v4u* op = (GAS v4u*)(R0 + (size_t)(MMAIN + q) * DM + 64 * h + 16 * dc); op[0] = oa; op[1] = ob;
                }
            }
            { PHASE_ENV();
            xcd_barrier(bar, tid);
#ifdef PROBE_SEL
            if (tid == 0) { const unsigned long long tn = __builtin_amdgcn_s_memrealtime(); const int cat = (s == 1 || s == 9) ? 1 : (s == 2 || s == 10) ? 2 : (s == 4) ? 3 : (s == 5) ? 4 : (s == 6) ? 5 : 6;
              TS[cat] += tn - TS[9]; TS[9] = tn; }
#endif
            }
            }
        }
    }
#ifdef PROBE_SEL
    { PHASE_ENV(); if (bx == 0 && tid == 0) { const unsigned long long t0 = __builtin_amdgcn_s_memrealtime(), span = 4ull * TS[PROBE_SEL];
        while (__builtin_amdgcn_s_memrealtime() - t0 < span) __builtin_amdgcn_s_sleep(8); } }
#endif
}

extern "C" void kernel_launch(void* const* d_in, const int* in_sizes, int n_in, void* d_out, int out_size, void* d_ws, size_t ws_size, hipStream_t stream) {
    static int grid = 0;
    if (grid == 0) {
        if (n_in != 21 || out_size != MMAIN * DM || ws_size < WS_END + SZ_ROWBUF) { fprintf(stderr, "kernel_launch: unexpected shapes (n_in %d out %d ws %zu)\n", n_in, out_size, ws_size); grid = -1; return; }
        int dev = 0, cus = 0, per_cu = 0;
        hipGetDevice(&dev); hipDeviceGetAttribute(&cus, hipDeviceAttributeMultiprocessorCount, dev);
        if (hipFuncSetAttribute((const void*)fwd_megakernel, hipFuncAttributeMaxDynamicSharedMemorySize, LDS_BYTES) != hipSuccess) { fprintf(stderr, "kernel_launch: hipFuncSetAttribute failed\n"); grid = -1; return; }
        if (hipOccupancyMaxActiveBlocksPerMultiprocessor(&per_cu, (const void*)fwd_megakernel, NWAVES * 64, LDS_BYTES) != hipSuccess || per_cu < 1) { fprintf(stderr, "kernel_launch: occupancy query says %d\n", per_cu); per_cu = 1; }
        (void)hipGetLastError();
        grid = cus * 1;
        if (grid != 256) fprintf(stderr, "kernel_launch: grid %d (expected 256)\n", grid);
    }
    if (grid < 0) return;
    if (hipMemsetAsync((char*)d_ws + WS_CTL, 0, CTL_ZERO_BYTES, stream) != hipSuccess) { fprintf(stderr, "kernel_launch: hipMemsetAsync failed\n"); return; }
    Args a{};
    const float** f = (const float**)&a;
    for (int i = 0; i < 21; ++i) f[i] = (const float*)d_in[i];
    a.out = (float*)d_out; a.ws = (unsigned char*)d_ws;
    void* args[] = {&a};
    hipError_t e = hipLaunchCooperativeKernel((const void*)fwd_megakernel, dim3(grid), dim3(NWAVES * 64), args, LDS_BYTES, stream);
    if (e != hipSuccess) fprintf(stderr, "cooperative launch failed: %s (grid %d)\n", hipGetErrorString(e), grid);
}
```

```cpp
#include <hip/hip_runtime.h>
#include <hip/hip_cooperative_groups.h>
#include <cstdio>
#include <cstdint>
namespace pg8 {
#define PG8_LAS __attribute__((address_space(3)))
typedef unsigned short bf16_t;
typedef short bf16x8 __attribute__((ext_vector_type(8)));
typedef float f32x4 __attribute__((ext_vector_type(4)));
typedef unsigned u32x4 __attribute__((ext_vector_type(4)));
constexpr int BM = 256, BK = 64, HALF = 128, HTB = HALF * BK * 2  , STAGE_BYTES = 8 * HTB, NXCD = 8, WGM = 8;

__host__ __device__ __forceinline__ int lds_byte(int r, int c) { const int st = (r >> 4) * 2 + (c >> 5), rr = r & 15, cc = c & 31, ob = rr * 64 + cc * 2; return st * 1024 + (ob ^ (((ob >> 9) & 1) << 5)); }
__host__ __device__ __forceinline__ void stage_rc(int b, int& R, int& C) { const int st = b / 1024, sb = b % 1024, swz = sb ^ (((sb >> 9) & 1) << 5); R = (st >> 1) * 16 + swz / 64; C = (st & 1) * 32 + (swz % 64) / 2; }
__host__ __device__ __forceinline__ int perm32(int rho) { const int n = rho >> 4, i = rho & 15; return 8 * (i >> 2) + 4 * n + (i & 3); }

struct Unit { int pm, pn; };
struct Gemm { const bf16_t* A; const bf16_t* Bt; int M, N, K; };

struct StaticOrder {
    int nM, nN, nwg, G, c;
    __host__ __device__ void init(int M, int N, int G_, int c_) { nM = M / BM; nN = N / BM; nwg = nM * nN; G = G_; c = c_; }
    __host__ __device__ bool next(int i, Unit& u) const {
        const long L = (long)i * G + c; if (L >= nwg) return false;
        int wgid = (int)L; { const int q = nwg / NXCD, r = nwg % NXCD, xcd = wgid % NXCD, off = wgid / NXCD; wgid = (xcd < r ? xcd * (q + 1) : r * (q + 1) + (xcd - r) * q) + off; }
        const int nig = WGM * nN, gid = wgid / nig, fm = gid * WGM, gsz = (nM - fm) < WGM ? (nM - fm) : WGM;
        u.pm = fm + ((wgid % nig) % gsz); u.pn = (wgid % nig) / gsz; return true;
    }
    __device__ __forceinline__ void a_ready(const Unit&) const {}
    __device__ __forceinline__ void done(const Unit&) const {}
};

__device__ __forceinline__ unsigned cvt_pk_bf16(float lo, float hi) { unsigned r; asm volatile("v_cvt_pk_bf16_f32 %0, %1, %2" : "=v"(r) : "v"(lo), "v"(hi)); return r; }
typedef float f32x2 __attribute__((ext_vector_type(2)));
__device__ __forceinline__ float sigm(float x) { return __builtin_amdgcn_rcpf(1.0f + __builtin_amdgcn_exp2f(-1.4426950408889634f * x)); }
constexpr float QK_C2 = 0.125f * 1.4426950408889634f;
#define PG8_GAS __attribute__((address_space(1)))
struct EpiAll {
    static constexpr bool PERM = true, AFTER_DRAIN = false;
    int mode;
    int mtiles_main;
    bf16_t* O1; bf16_t* O2; bf16_t* O3; int ldo;
    float* hmain; float* hmeta; float scale;
    const float* qg; const float* kg;
    const PG8_LAS float* rsl;
    const float* ssq;
    float* ssq_out; bf16_t* hb; float* fout; PG8_LAS float* ldsp;
    __device__ __forceinline__ void operator()(const f32x4 (&acc)[2][2][4][2], const Unit& u, int wr, int wc, int fr, int fq, int ui) const {
        const int rloc_ = wr * 64 + fr;
#define EPI_LAUNDER() int rloc = rloc_; asm volatile("" : "+v"(rloc))
#define EPI_RS() float rsv[2][4]; { const PG8_LAS float* sp_ = rsl + ui * 256 + rloc;     \
    _Pragma("unroll") for (int ai = 0; ai < 2; ++ai) _Pragma("unroll") for (int m = 0; m < 4; ++m) rsv[ai][m] = sp_[ai * HALF + m * 16]; }
        if (mode <= 1 || (mode == 2 && u.pn < 8)) {
            EPI_LAUNDER(); EPI_RS();
            bf16_t* base = O1 + (size_t)(u.pm * BM + rloc) * ldo + u.pn * HALF + wc * 32 + 8 * fq;
#pragma unroll
            for (int ai = 0; ai < 2; ++ai)
#pragma unroll
                for (int m = 0; m < 4; ++m) {
                    const float rs_ = rsv[ai][m]; const f32x4 a0 = acc[ai][0][m][0] * rs_, a1 = acc[ai][0][m][1] * rs_, b0 = acc[ai][1][m][0] * rs_, b1 = acc[ai][1][m][1] * rs_;
                    f32x4 r0, r1;
                    if (mode == 0) {
                        const float ke_ = -1.4426950408889634f * rs_, rs2_ = rs_ * rs_;
                        const f32x4 ga0 = acc[ai][0][m][0], ga1 = acc[ai][0][m][1], gb0 = acc[ai][1][m][0], gb1 = acc[ai][1][m][1];
#pragma unroll
                        for (int i = 0; i < 4; ++i) {
                            r0[i] = (ga0[i] * gb0[i]) * (rs2_ * __builtin_amdgcn_rcpf(1.0f + __builtin_amdgcn_exp2f(ke_ * ga0[i])));
                            r1[i] = (ga1[i] * gb1[i]) * (rs2_ * __builtin_amdgcn_rcpf(1.0f + __builtin_amdgcn_exp2f(ke_ * ga1[i]))); }
                    } else if (mode == 1) {
#pragma unroll
                        for (int i = 0; i < 4; ++i) { r0[i] = a0[i] * sigm(b0[i]); r1[i] = a1[i] * sigm(b1[i]); }
                    } else { r0 = a0 * b0; r1 = a1 * b1; }
                    u32x4 w; w.x = cvt_pk_bf16(r0[0], r0[1]); w.y = cvt_pk_bf16(r0[2], r0[3]); w.z = cvt_pk_bf16(r1[0], r1[1]); w.w = cvt_pk_bf16(r1[2], r1[3]);
                    *(PG8_GAS u32x4*)(base + (size_t)(ai * HALF + m * 16) * ldo) = w;
                }
        } else if (mode == 2) {
            EPI_LAUNDER(); EPI_RS();
            bf16_t* base = O2 + (size_t)(u.pm * BM + rloc) * 1024 + (u.pn - 8) * BM + wc * 32 + 8 * fq;
#pragma unroll
            for (int ai = 0; ai < 2; ++ai)
#pragma unroll
                for (int m = 0; m < 4; ++m)
#pragma unroll
                    for (int bj = 0; bj < 2; ++bj) {
                        const f32x4 v0 = acc[ai][bj][m][0] * rsv[ai][m], v1 = acc[ai][bj][m][1] * rsv[ai][m];
                        u32x4 w; w.x = cvt_pk_bf16(v0[0], v0[1]); w.y = cvt_pk_bf16(v0[2], v0[3]); w.z = cvt_pk_bf16(v1[0], v1[1]); w.w = cvt_pk_bf16(v1[2], v1[3]);
                        *(PG8_GAS u32x4*)(base + (size_t)(ai * HALF + m * 16) * 1024 + bj * HALF) = w;
                    }
        } else if (mode == 3) {
            EPI_LAUNDER(); EPI_RS();
            const int sec = u.pn >> 2;
            const bool meta = false;
            const long krow0 = meta ? 48 : (long)u.pm * BM + 128 * (1 + (u.pm >> 5));
            bf16_t* dst = (sec == 0) ? O1 + (size_t)(u.pm * BM) * 1024 : ((sec == 1) ? O2 : O3) + (size_t)krow0 * 1024;
            const bool dup = meta && sec != 0; const int rlim = dup ? 16 : 256;
            if (sec < 2) {
                const int head = 4 * (u.pn & 3) + wc;
                const int lxor16 = (fr + 16 * (fq ^ 1)) << 2, lxor32 = (fr + 16 * (fq ^ 2)) << 2;
                const float* g = (sec == 0) ? qg : kg; const float gs = (sec == 0) ? QK_C2 : 1.0f;
                f32x4 gv[2][2];
#pragma unroll
                for (int bj = 0; bj < 2; ++bj)
#pragma unroll
                    for (int n = 0; n < 2; ++n) gv[bj][n] = *(const PG8_GAS f32x4*)(g + 32 * bj + 8 * fq + 4 * n) * gs;
#pragma unroll
                for (int ai = 0; ai < 2; ++ai)
#pragma unroll
                    for (int m = 0; m < 4; ++m) {
                        float ss = 0.f;
#pragma unroll
                        for (int bj = 0; bj < 2; ++bj)
#pragma unroll
                            for (int n = 0; n < 2; ++n) { const f32x4 x = acc[ai][bj][m][n] * rsv[ai][m]; ss += (x[0] * x[0] + x[1] * x[1]) + (x[2] * x[2] + x[3] * x[3]); }
                        ss += __builtin_bit_cast(float, __builtin_amdgcn_ds_bpermute(lxor16, __builtin_bit_cast(int, ss))); ss += __builtin_bit_cast(float, __builtin_amdgcn_ds_bpermute(lxor32, __builtin_bit_cast(int, ss)));
                        const float rs = __builtin_amdgcn_rsqf(ss * (1.0f / 64.0f) + 1e-6f) * rsv[ai][m];
                        const int rl = rloc + ai * HALF + m * 16;
#pragma unroll
                        for (int bj = 0; bj < 2; ++bj) {
                            const f32x4 v0 = acc[ai][bj][m][0] * rs * gv[bj][0], v1 = acc[ai][bj][m][1] * rs * gv[bj][1];
                            u32x4 w; w.x = cvt_pk_bf16(v0[0], v0[1]); w.y = cvt_pk_bf16(v0[2], v0[3]); w.z = cvt_pk_bf16(v1[0], v1[1]); w.w = cvt_pk_bf16(v1[2], v1[3]);
                            const int col = 64 * head + 32 * bj + 8 * fq;
                            if (rl < rlim) { *(PG8_GAS u32x4*)(dst + (size_t)rl * 1024 + col) = w; if (dup) *(PG8_GAS u32x4*)(dst + (size_t)(8320 + rl) * 1024 + col) = w; }
                        }
                    }
            } else {
#pragma unroll
                for (int ai = 0; ai < 2; ++ai)
#pragma unroll
                    for (int m = 0; m < 4; ++m) {
                        const int rl = rloc + ai * HALF + m * 16;
#pragma unroll
                        for (int bj = 0; bj < 2; ++bj) {
                            const f32x4 v0 = acc[ai][bj][m][0] * rsv[ai][m], v1 = acc[ai][bj][m][1] * rsv[ai][m];
                            u32x4 w; w.x = cvt_pk_bf16(v0[0], v0[1]); w.y = cvt_pk_bf16(v0[2], v0[3]); w.z = cvt_pk_bf16(v1[0], v1[1]); w.w = cvt_pk_bf16(v1[2], v1[3]);
                            const int col = (u.pn - 8) * BM + bj * HALF + wc * 32 + 8 * fq;
                            if (rl < rlim) { *(PG8_GAS u32x4*)(dst + (size_t)rl * 1024 + col) = w; if (dup) *(PG8_GAS u32x4*)(dst + (size_t)(8320 + rl) * 1024 + col) = w; }
                        }
                    }
            }
        } else {
            EPI_LAUNDER();
            bf16_t* hbase = hb + (size_t)(u.pm * BM + rloc) * 1024 + u.pn * BM + wc * 32 + 8 * fq;
            float* fbase = fout ? fout + (size_t)(u.pm * BM + rloc) * 1024 + u.pn * BM + wc * 32 + 8 * fq : nullptr;
            const float sc = scale; const int lx16 = (fr + 16 * (fq ^ 1)) << 2, lx32 = (fr + 16 * (fq ^ 2)) << 2;
#pragma unroll
            for (int ai = 0; ai < 2; ++ai) {
                u32x4 hx[4][2];
#pragma unroll
                for (int m = 0; m < 4; ++m)
#pragma unroll
                    for (int bj = 0; bj < 2; ++bj) hx[m][bj] = *(const PG8_GAS u32x4*)(hbase + (size_t)(ai * HALF + m * 16) * 1024 + bj * HALF);
                asm volatile("" ::: "memory");
#pragma unroll
                for (int m = 0; m < 4; ++m) {
                    float ps = 0.f;
#pragma unroll
                    for (int bj = 0; bj < 2; ++bj) {
                        const u32x4 hw = hx[m][bj];
                        f32x4 x0 = {__builtin_bit_cast(float, hw.x << 16), __builtin_bit_cast(float, hw.x & 0xffff0000u), __builtin_bit_cast(float, hw.y << 16), __builtin_bit_cast(float, hw.y & 0xffff0000u)};
                        f32x4 x1 = {__builtin_bit_cast(float, hw.z << 16), __builtin_bit_cast(float, hw.z & 0xffff0000u), __builtin_bit_cast(float, hw.w << 16), __builtin_bit_cast(float, hw.w & 0xffff0000u)};
                        x0 += acc[ai][bj][m][0] * sc; x1 += acc[ai][bj][m][1] * sc;
                        if (fbase) { float* p = fbase + (size_t)(ai * HALF + m * 16) * 1024 + bj * HALF; *(PG8_GAS f32x4*)p = x0; *(PG8_GAS f32x4*)(p + 4) = x1; }
                        ps += ((x0[0] * x0[0] + x0[1] * x0[1]) + (x0[2] * x0[2] + x0[3] * x0[3])) + ((x1[0] * x1[0] + x1[1] * x1[1]) + (x1[2] * x1[2] + x1[3] * x1[3]));
                        u32x4 w; w.x = cvt_pk_bf16(x0[0], x0[1]); w.y = cvt_pk_bf16(x0[2], x0[3]); w.z = cvt_pk_bf16(x1[0], x1[1]); w.w = cvt_pk_bf16(x1[2], x1[3]);
                        if (!fbase) *(PG8_GAS u32x4*)(hbase + (size_t)(ai * HALF + m * 16) * 1024 + bj * HALF) = w;
                    }
                    ps += __builtin_bit_cast(float, __builtin_amdgcn_ds_bpermute(lx16, __builtin_bit_cast(int, ps))); ps += __builtin_bit_cast(float, __builtin_amdgcn_ds_bpermute(lx32, __builtin_bit_cast(int, ps)));
                    if (fq == 0) ldsp[(rloc + ai * HALF + m * 16) * 4 + wc] = ps;
                }
            }
            asm volatile("s_waitcnt lgkmcnt(0)" ::: "memory");
        }
    }
};
template <class Epi, class Sched, bool ALIGN_EPI = false, bool SP2 = false>
__device__ __forceinline__ void gemm_phase(PG8_LAS unsigned char* lds, const Gemm g, const Sched& S, const Epi& E, const int tid_in) {
    const int tid = tid_in, wid = __builtin_amdgcn_readfirstlane(tid >> 6), lane = tid & 63, wr = wid >> 2, wc = wid & 3, fr = lane & 15, fq = lane >> 4;
    const int K = g.K, nt = K / BK;
    unsigned voffA[2], voffB[2];
#pragma unroll
    for (int i = 0; i < 2; ++i) { int R, C; stage_rc(tid * 16 + i * 8192, R, C); const int Rb = Epi::PERM ? ((R & ~31) + perm32(R & 31)) : R;
        voffA[i] = (unsigned)(R * K + C) * 2u; voffB[i] = (unsigned)(Rb * K + C) * 2u; }
    const size_t kstep = (size_t)(BK * 2);
    const size_t hstep = (size_t)HALF * K * 2;
    const size_t tstep = 2 * hstep;
    const unsigned ldsw = (unsigned)wid * 1024u;
    const int aoff = lds_byte(wr * 64 + fr, fq * 8), boff = lds_byte(wc * 32 + fr, fq * 8);
#define PG8_SA(b, h) (((b) * 2 + (h)) * HTB)
#define PG8_SB(b, h) ((4 + (b) * 2 + (h)) * HTB)
#define PG8_STAGE(bufoff, gbase, voff) do { _Pragma("unroll") for (int _i = 0; _i < 2; ++_i) \
        __builtin_amdgcn_global_load_lds((const unsigned*)((const char*)(gbase) + (voff)[_i]), (PG8_LAS unsigned*)(lds + (bufoff) + ldsw + _i * 8192), 16, 0, 0); } while (0)
#define PG8_LDA(dst, b, h) do { _Pragma("unroll") for (int m = 0; m < 4; ++m) _Pragma("unroll") for (int k = 0; k < 2; ++k) dst[m][k] = *(const PG8_LAS bf16x8*)(lds + PG8_SA(b, h) + aoff + m * 2048 + k * 1024); } while (0)
#define PG8_LDB(dst, b, h) do { _Pragma("unroll") for (int n = 0; n < 2; ++n) _Pragma("unroll") for (int k = 0; k < 2; ++k) dst[n][k] = *(const PG8_LAS bf16x8*)(lds + PG8_SB(b, h) + boff + n * 2048 + k * 1024); } while (0)
#define PG8_MMA(ai, bj, At, Bt) do { __builtin_amdgcn_s_setprio(1); _Pragma("unroll") for (int m = 0; m < 4; ++m) _Pragma("unroll") for (int n = 0; n < 2; ++n) _Pragma("unroll") for (int k = 0; k < 2; ++k) \
        acc[ai][bj][m][n] = __builtin_amdgcn_mfma_f32_16x16x32_bf16(Bt[n][k], At[m][k], acc[ai][bj][m][n], 0, 0, 0); __builtin_amdgcn_s_setprio(0); } while (0)
#define PG8_WAIT_V(n) asm volatile("s_waitcnt vmcnt(" #n ")" ::: "memory")
#define PG8_WAIT_L(n) asm volatile("s_waitcnt lgkmcnt(" #n ")" ::: "memory")
#define PG8_BAR __builtin_amdgcn_s_barrier()
#define PG8_SCHED __builtin_amdgcn_sched_barrier(0)
    Unit cur, nxt; int ui = 0;
    if (!S.next(0, cur)) return;
    f32x4 acc[2][2][4][2];
#pragma unroll
    for (int a = 0; a < 2; ++a)
#pragma unroll
        for (int b = 0; b < 2; ++b)
#pragma unroll
            for (int m = 0; m < 4; ++m)
#pragma unroll
                for (int n = 0; n < 2; ++n) acc[a][b][m][n] = (f32x4){0.f, 0.f, 0.f, 0.f};
    bf16x8 At[4][2], B0[2][2], B1[2][2];
    const char* cA = (const char*)g.A + (size_t)cur.pm * tstep; const char* cB = (const char*)g.Bt + (size_t)cur.pn * tstep;
    S.a_ready(cur);
    if constexpr (SP2) {
        PG8_STAGE(PG8_SB(0, 0), cB, voffB); PG8_STAGE(PG8_SB(0, 1), cB + hstep, voffB); PG8_STAGE(PG8_SA(0, 0), cA, voffA); PG8_STAGE(PG8_SA(0, 1), cA + hstep, voffA);
        if (wr == 1) PG8_BAR;
        PG8_WAIT_V(2); PG8_BAR;
        PG8_STAGE(PG8_SB(1, 0), cB + kstep, voffB); PG8_STAGE(PG8_SA(1, 0), cA + kstep, voffA); PG8_STAGE(PG8_SB(1, 1), cB + hstep + kstep, voffB);
        PG8_WAIT_V(6); PG8_BAR;
    } else {
        PG8_STAGE(PG8_SB(0, 0), cB, voffB); PG8_STAGE(PG8_SA(0, 0), cA, voffA); PG8_STAGE(PG8_SB(0, 1), cB + hstep, voffB); PG8_STAGE(PG8_SA(0, 1), cA + hstep, voffA);
        if (wr == 1) PG8_BAR;
        PG8_WAIT_V(4); PG8_BAR;
        PG8_STAGE(PG8_SB(1, 0), cB + kstep, voffB); PG8_STAGE(PG8_SA(1, 0), cA + kstep, voffA); PG8_STAGE(PG8_SB(1, 1), cB + hstep + kstep, voffB);
        PG8_WAIT_V(6); PG8_BAR;
    }
    for (;;) {
        const bool has_next = S.next(ui + 1, nxt);
        const char* nA = has_next ? (const char*)g.A + (size_t)nxt.pm * tstep : cA; const char* nB = has_next ? (const char*)g.Bt + (size_t)nxt.pn * tstep : cB;
        for (int t = 0; t < nt; t += 2) {
            const bool last = (t == nt - 2);
            const char* a1 = cA + (size_t)(t + 1) * kstep;
            const char* a2 = last ? nA : cA + (size_t)(t + 2) * kstep; const char* b2 = last ? nB : cB + (size_t)(t + 2) * kstep;
            const char* a3 = a2 + kstep; const char* b3 = b2 + kstep;
            if (last && has_next) S.a_ready(nxt);
            if constexpr (SP2) {
            PG8_LDB(B0, 0, 0); PG8_LDB(B1, 0, 1); PG8_SCHED; PG8_LDA(At, 0, 0); PG8_STAGE(PG8_SA(1, 1), a1 + hstep, voffA);
            PG8_WAIT_V(8); PG8_WAIT_L(0); PG8_BAR; PG8_MMA(0, 0, At, B0); PG8_MMA(0, 1, At, B1); PG8_BAR; PG8_SCHED;
            PG8_LDA(At, 0, 1); PG8_STAGE(PG8_SB(0, 0), b2, voffB); PG8_STAGE(PG8_SB(0, 1), b2 + hstep, voffB); PG8_STAGE(PG8_SA(0, 0), a2, voffA);
            PG8_WAIT_V(8); PG8_WAIT_L(0); PG8_BAR; PG8_MMA(1, 0, At, B0); PG8_MMA(1, 1, At, B1); PG8_BAR; PG8_SCHED;
            PG8_LDB(B0, 1, 0); PG8_LDB(B1, 1, 1); PG8_SCHED; PG8_LDA(At, 1, 0); PG8_STAGE(PG8_SA(0, 1), a2 + hstep, voffA);
            PG8_WAIT_V(8); PG8_WAIT_L(0); PG8_BAR; PG8_MMA(0, 0, At, B0); PG8_MMA(0, 1, At, B1); PG8_BAR; PG8_SCHED;
            PG8_LDA(At, 1, 1); PG8_STAGE(PG8_SB(1, 0), b3, voffB); PG8_STAGE(PG8_SB(1, 1), b3 + hstep, voffB); PG8_STAGE(PG8_SA(1, 0), a3, voffA);
            PG8_WAIT_V(8); PG8_WAIT_L(0); PG8_BAR; PG8_MMA(1, 0, At, B0); PG8_MMA(1, 1, At, B1); PG8_BAR; PG8_SCHED;
            } else {
            PG8_LDB(B0, 0, 0); PG8_SCHED; PG8_LDA(At, 0, 0); PG8_STAGE(PG8_SA(1, 1), a1 + hstep, voffA);
            PG8_WAIT_L(8); PG8_BAR; PG8_WAIT_L(0); PG8_MMA(0, 0, At, B0); PG8_BAR; PG8_SCHED;
            PG8_LDB(B1, 0, 1); PG8_STAGE(PG8_SB(0, 0), b2, voffB);
            PG8_BAR; PG8_WAIT_L(0); PG8_MMA(0, 1, At, B1); PG8_BAR;
            PG8_LDA(At, 0, 1); PG8_STAGE(PG8_SA(0, 0), a2, voffA);
            PG8_BAR; PG8_WAIT_L(0); PG8_MMA(1, 0, At, B0); PG8_BAR; PG8_SCHED;
            PG8_STAGE(PG8_SB(0, 1), b2 + hstep, voffB);
            PG8_WAIT_V(6); PG8_BAR; PG8_MMA(1, 1, At, B1); PG8_BAR;
            PG8_LDB(B0, 1, 0); PG8_SCHED; PG8_LDA(At, 1, 0); PG8_STAGE(PG8_SA(0, 1), a2 + hstep, voffA);
            PG8_WAIT_L(8); PG8_BAR; PG8_WAIT_L(0); PG8_MMA(0, 0, At, B0); PG8_BAR; PG8_SCHED;
            PG8_LDB(B1, 1, 1); PG8_STAGE(PG8_SB(1, 0), b3, voffB);
            PG8_BAR; PG8_WAIT_L(0); PG8_MMA(0, 1, At, B1); PG8_BAR;
            PG8_LDA(At, 1, 1); PG8_STAGE(PG8_SA(1, 0), a3, voffA);
            PG8_BAR; PG8_WAIT_L(0); PG8_MMA(1, 0, At, B0); PG8_BAR; PG8_SCHED;
            PG8_STAGE(PG8_SB(1, 1), b3 + hstep, voffB);
            PG8_WAIT_V(6); PG8_BAR; PG8_MMA(1, 1, At, B1); PG8_BAR;
            }
        }
        if constexpr (ALIGN_EPI) { if (wr == 0) PG8_BAR; }
        if constexpr (!Epi::AFTER_DRAIN) { E(acc, cur, wr, wc, fr, fq, ui); S.done(cur); }
        if (!has_next) break;
#pragma unroll
        for (int a = 0; a < 2; ++a)
#pragma unroll
            for (int b = 0; b < 2; ++b)
#pragma unroll
                for (int m = 0; m < 4; ++m)
#pragma unroll
                    for (int n = 0; n < 2; ++n) acc[a][b][m][n] = (f32x4){0.f, 0.f, 0.f, 0.f};
        cur = nxt; cA = nA; cB = nB; ++ui;
        if constexpr (ALIGN_EPI) { if (wr == 1) PG8_BAR; }
    }
    PG8_WAIT_V(0);
    if constexpr (!ALIGN_EPI) { if (wr == 0) PG8_BAR; }
    PG8_BAR;
    if constexpr (Epi::AFTER_DRAIN) { E.fused(acc, cur, wr, wc, fr, fq, lds, wid, lane); S.done(cur); }
#undef PG8_SA
#undef PG8_SB
#undef PG8_STAGE
#undef PG8_LDA
#undef PG8_LDB
#undef PG8_MMA
#undef PG8_WAIT_V
#undef PG8_WAIT_L
#undef PG8_BAR
#undef PG8_SCHED
}
}

#ifndef PG8_SP2
#define PG8_SP2 true
#endif
#ifndef PG8_ALIGN
#define PG8_ALIGN true
#endif
#include <hip/hip_bf16.h>
#include <cmath>
namespace attn_body {
using bf16=__hip_bfloat16;
using bf16x8=__attribute__((ext_vector_type(8)))short;
using s16x4=__attribute__((ext_vector_type(4)))short;
using f32x16=__attribute__((ext_vector_type(16)))float;
using u32x4=__attribute__((ext_vector_type(4)))unsigned;
constexpr int BATCH=2,NHEAD=16,SEQ=8192,D=64,DM=NHEAD*D;
constexpr int NW=8,QBLK=32,QB=QBLK*NW,KVBLK=64,NQB=SEQ/QB; constexpr int KVPAD=128,KVROWS=SEQ+KVPAD;
constexpr int ATTN_PITCH=DM, ATTN_UNIT_ROWS=QB;
__device__ __forceinline__ int crow(int r,int hi){return (r&3)+8*(r>>2)+4*hi;}
#define SBAR() __builtin_amdgcn_sched_barrier(0)
__device__ __forceinline__ void cmask(f32x16&p0,f32x16&p1,int jb,int qrel,int hi){
  const float NEG=-INFINITY; int kb=64*jb+4*hi;
  #pragma unroll
  for(int r=0;r<16;++r){int kv=kb+(r&3)+8*(r>>2); if(kv>qrel)p0[r]=NEG; if(kv+32>qrel)p1[r]=NEG;}
}

constexpr int NSLOT=3, SLOTB=8192;
constexpr int LDS_K=0, LDS_V=NSLOT*SLOTB, LDS_WS=2*NSLOT*SLOTB, LDS_OST=LDS_WS+NW*64*4, LDS_CS=LDS_OST+NW*4096, LDS_BYTES=LDS_CS+KVROWS*4;
constexpr float C2=0.125f*1.4426950408889634f;
__device__ __forceinline__ void glds16(const void*gsrc,unsigned lds_dst){unsigned keep;
  asm volatile("s_mov_b32 %0, m0\n\ts_mov_b32 m0, %2\n\ts_nop 0\n\tglobal_load_lds_dwordx4 %1, off\n\ts_mov_b32 m0, %0":"=&s"(keep):"v"(gsrc),"s"(lds_dst):"memory");}
__device__ __forceinline__ float max3f(float a,float b,float c){float r;asm("v_max3_f32 %0, %1, %2, %3":"=v"(r):"v"(a),"v"(b),"v"(c));return r;}
__device__ __forceinline__ float max2f(float a,float b){float r;asm("v_max_f32_e32 %0, %1, %2":"=v"(r):"v"(a),"v"(b));return r;}
__device__ __forceinline__ float fadd_s(float a,float b){float r;asm("v_add_f32_e32 %0, %1, %2":"=v"(r):"v"(a),"v"(b));return r;}
__device__ __forceinline__ float fsub_s(float a,float b){float r;asm("v_sub_f32_e32 %0, %1, %2":"=v"(r):"v"(a),"v"(b));return r;}
typedef float f32x2_t __attribute__((ext_vector_type(2))); typedef __bf16 bf16x2_t __attribute__((ext_vector_type(2)));
__device__ __forceinline__ unsigned cvtpk_s(float lo,float hi){f32x2_t v={lo,hi};bf16x2_t b=__builtin_convertvector(v,bf16x2_t);return __builtin_bit_cast(unsigned,b);}
#define WAIT_BAR(N) asm volatile("s_waitcnt vmcnt(" #N ") lgkmcnt(0)\n\ts_barrier":::"memory")

__device__ __forceinline__ void qkt(f32x16&p0,f32x16&p1,const char*Kslot,const bf16x8*qr,int r32,int hi){
  const char*kb=Kslot+hi*1024+r32*16;
  #pragma unroll
  for(int d0=0;d0<4;++d0){
    const bf16x8 b0=*reinterpret_cast<const bf16x8*>(kb+d0*2048);
    const bf16x8 b1=*reinterpret_cast<const bf16x8*>(kb+d0*2048+512);
    p0=__builtin_amdgcn_mfma_f32_32x32x16_bf16(b0,qr[d0],p0,0,0,0);p1=__builtin_amdgcn_mfma_f32_32x32x16_bf16(b1,qr[d0],p1,0,0,0);}
}
typedef __attribute__((address_space(3))) const char* lds_cptr;
typedef short v4i16_t __attribute__((ext_vector_type(4))); typedef float f32x4_t __attribute__((ext_vector_type(4)));
__device__ __forceinline__ void kload8(bf16x8*kf,lds_cptr kp){
  kf[0]=*(const __attribute__((address_space(3))) bf16x8*)(kp);      kf[1]=*(const __attribute__((address_space(3))) bf16x8*)(kp+512);
  kf[2]=*(const __attribute__((address_space(3))) bf16x8*)(kp+2048); kf[3]=*(const __attribute__((address_space(3))) bf16x8*)(kp+2560);
  kf[4]=*(const __attribute__((address_space(3))) bf16x8*)(kp+4096); kf[5]=*(const __attribute__((address_space(3))) bf16x8*)(kp+4608);
  kf[6]=*(const __attribute__((address_space(3))) bf16x8*)(kp+6144); kf[7]=*(const __attribute__((address_space(3))) bf16x8*)(kp+6656);
}
__device__ __forceinline__ void kload2(bf16x8*kf,lds_cptr kp,int j){ kf[2*j]=*(const __attribute__((address_space(3))) bf16x8*)(kp+j*2048); kf[2*j+1]=*(const __attribute__((address_space(3))) bf16x8*)(kp+j*2048+512); }
__device__ __forceinline__ s16x4 vtr(lds_cptr p){ return __builtin_bit_cast(s16x4,__builtin_amdgcn_ds_read_tr16_b64_v4i16((__attribute__((address_space(3))) v4i16_t*)p)); }
__device__ __forceinline__ float rowmax(const f32x16&p0,const f32x16&p1){
  float a=max3f(p0[0],p0[1],p1[0]),b=max3f(p0[2],p0[3],p1[1]);a=max3f(a,p1[2],p1[3]);
  #pragma unroll
  for(int r=4;r<16;r+=4){a=max3f(a,p0[r],p0[r+1]);b=max3f(b,p0[r+2],p0[r+3]);a=max3f(a,p1[r],p1[r+1]);b=max3f(b,p1[r+2],p1[r+3]);}
  const float m=max2f(a,b);
  auto rr=__builtin_amdgcn_permlane32_swap(__float_as_uint(m),__float_as_uint(m),false,false);
  return max2f(__uint_as_float(rr[0]),__uint_as_float(rr[1]));
}
__device__ __forceinline__ void pv(f32x16*o,int vb,bf16x8 pa0,bf16x8 pa1,bf16x8 pa2,bf16x8 pa3){
  #pragma unroll
  for(int d0=0;d0<2;++d0){s16x4 lo[4],hi[4];
    #pragma unroll
    for(int ks=0;ks<4;++ks){
      asm volatile("ds_read_b64_tr_b16 %0,%1 offset:%c2":"=&v"(lo[ks]):"v"(vb),"i"(d0*4096+ks*1024):"memory");
      asm volatile("ds_read_b64_tr_b16 %0,%1 offset:%c2":"=&v"(hi[ks]):"v"(vb),"i"(d0*4096+ks*1024+512):"memory");}
    asm volatile("s_waitcnt lgkmcnt(0)":::"memory");SBAR();
    #define PK(k) (bf16x8){lo[k][0],lo[k][1],lo[k][2],lo[k][3],hi[k][0],hi[k][1],hi[k][2],hi[k][3]}
    o[d0]=__builtin_amdgcn_mfma_f32_32x32x16_bf16(pa0,PK(0),o[d0],0,0,0);
    o[d0]=__builtin_amdgcn_mfma_f32_32x32x16_bf16(pa1,PK(1),o[d0],0,0,0);
    o[d0]=__builtin_amdgcn_mfma_f32_32x32x16_bf16(pa2,PK(2),o[d0],0,0,0);
    o[d0]=__builtin_amdgcn_mfma_f32_32x32x16_bf16(pa3,PK(3),o[d0],0,0,0);
    #undef PK
  }
}

#ifndef ATTN_STORE16
#define ATTN_STORE16(p,v) (*(__attribute__((address_space(1))) u32x4*)(p)=(v))
#endif
template<int THRL> __device__ __forceinline__ void attn_unit(int b,int h,int qb,const bf16*Q,const bf16*__restrict__ K,const bf16*__restrict__ V,bf16*O,const float*__restrict__ CS,char*shm,const int tid_in){
  const int tid=tid_in,lane=tid&63,r32=lane&31,hi=lane>>5; const int wid=__builtin_amdgcn_readfirstlane(tid>>6);
  const long rowbase=(long)b*SEQ, kvbase=(long)b*KVROWS; const int q0=qb*QB;
  const bf16*Qw=Q+(rowbase+q0+wid*QBLK)*DM+h*D;
  const bf16*Kh=K+kvbase*DM+h*D,*Vh=V+kvbase*DM+h*D;
  const unsigned lds0=(unsigned)(uintptr_t)shm;
  float*wsf=(float*)(shm+LDS_WS)+wid*64;
  const bf16*ksrc=Kh+(long)lane*DM+wid*8;
  const bf16*vsrc=Vh+(long)(16*(wid&3)+(lane>>2))*DM+(wid>>2)*32+(lane&3)*8;
  const unsigned kdst=lds0+LDS_K+wid*1024, vdst=lds0+LDS_V+wid*1024;
  #define DMA_K(t,slot) glds16(ksrc+(long)(t)*KVBLK*DM,(unsigned)__builtin_amdgcn_readfirstlane(kdst+(slot)))
  #define DMA_V(t,slot) glds16(vsrc+(long)(t)*KVBLK*DM,(unsigned)__builtin_amdgcn_readfirstlane(vdst+(slot)))
  const int vb0=(int)(lds0+LDS_V)+((lane>>4)&1)*32+(lane&3)*8+(4*hi+((lane&15)>>2))*64;
  const char*Kbase=shm+LDS_K; bf16x8 kf[8];
  const lds_cptr shm3=(lds_cptr)shm; const lds_cptr kp0=shm3+LDS_K+hi*1024+r32*16; const lds_cptr vp0=shm3+LDS_V+((lane>>4)&1)*32+(lane&3)*8+(4*hi+((lane&15)>>2))*64;
  const int NT=(q0+QB+KVPAD)/KVBLK;
  DMA_K(0,0);DMA_V(0,0);DMA_K(1,SLOTB);
  bf16x8 qr[4];
  #pragma unroll
  for(int d0=0;d0<4;++d0)qr[d0]=*(const __attribute__((address_space(1))) bf16x8*)(&Qw[(long)r32*DM+d0*16+hi*8]);
  float mhat=0.f,l_reg=0.f;f32x16 o[2];o[0]=f32x16{};o[1]=f32x16{};
  const __attribute__((address_space(3))) float*csl=(const __attribute__((address_space(3))) float*)((lds_cptr)shm+LDS_CS)+4*hi;
  #define BIASINIT(C0,C1,t) do{ const __attribute__((address_space(3))) float*bp_=csl+64*(t); const float nm_=-mhat; \
    _Pragma("unroll") for(int g_=0;g_<4;++g_){ const f32x4_t a_=*(const __attribute__((address_space(3))) f32x4_t*)(bp_+8*g_), b_=*(const __attribute__((address_space(3))) f32x4_t*)(bp_+32+8*g_); \
      C0[4*g_]=nm_-a_[0];C0[4*g_+1]=nm_-a_[1];C0[4*g_+2]=nm_-a_[2];C0[4*g_+3]=nm_-a_[3]; C1[4*g_]=nm_-b_[0];C1[4*g_+1]=nm_-b_[1];C1[4*g_+2]=nm_-b_[2];C1[4*g_+3]=nm_-b_[3]; } }while(0)
  #define BIASLOAD(C0,C1,t) do{ const __attribute__((address_space(3))) float*bp_=csl+64*(t); \
    _Pragma("unroll") for(int g_=0;g_<4;++g_){ const f32x4_t a_=*(const __attribute__((address_space(3))) f32x4_t*)(bp_+8*g_), b_=*(const __attribute__((address_space(3))) f32x4_t*)(bp_+32+8*g_); \
      C0[4*g_]=a_[0];C0[4*g_+1]=a_[1];C0[4*g_+2]=a_[2];C0[4*g_+3]=a_[3]; C1[4*g_]=b_[0];C1[4*g_+1]=b_[1];C1[4*g_+2]=b_[2];C1[4*g_+3]=b_[3]; } }while(0)
  const int qrel=wid*QBLK+r32;
  #define CMASK(P0,P1,t) do{int jb_=(t)-(NT-4); if(jb_>=0)cmask(P0,P1,jb_,qrel,hi);}while(0)
  bool resc=false;
  #define START(P0,P1) do{ const float rm=rowmax(P0,P1); resc=false; \
    { const float dl=rm; mhat=fadd_s(mhat,dl); \
      _Pragma("unroll") for(int r=0;r<16;++r){P0[r]=fsub_s(P0[r],dl);P1[r]=fsub_s(P1[r],dl);} \
      } \
    _Pragma("unroll") for(int r=0;r<16;++r)P0[r]=__builtin_amdgcn_exp2f(P0[r]); }while(0)
  #define RESC() do{ if(resc){ asm volatile("s_waitcnt lgkmcnt(0)":::"memory"); \
      _Pragma("unroll") for(int d_=0;d_<2;++d_) _Pragma("unroll") for(int r=0;r<16;++r)o[d_][r]*=wsf[crow(r,hi)]; } }while(0)
  f32x16 pA0,pA1,pB0,pB1;
  int sl_prev=0,sl_cur=0,sl_next=SLOTB;
  #define ROT() do{sl_prev=sl_cur;sl_cur=sl_next;sl_next=(sl_next==(NSLOT-1)*SLOTB)?0:sl_next+SLOTB;}while(0)
  DMA_K(2,2*SLOTB);
  WAIT_BAR(3);
  BIASINIT(pA0,pA1,0); qkt(pA0,pA1,Kbase,qr,r32,hi);asm volatile("s_nop 15\n\ts_nop 7":"+v"(pA0),"+v"(pA1));
  START(pA0,pA1);
  _Pragma("unroll") for(int r=0;r<16;++r)pA1[r]=__builtin_amdgcn_exp2f(pA1[r]);
  WAIT_BAR(0);
  DMA_K(3,0);DMA_V(1,SLOTB);
  ROT();
  kload8(kf,kp0+sl_cur);
  WAIT_BAR(2);
  s16x4 vlo[8],vhi[8]; u32x4 pw0,pw1,pw2,pw3;
  #define PKW(P,B) cvtpk_s(P[B],P[B+1])
  #define PAF(k) __builtin_bit_cast(bf16x8,pw##k)
  #define VFR(i) (bf16x8){vlo[i][0],vlo[i][1],vlo[i][2],vlo[i][3],vhi[i][0],vhi[i][1],vhi[i][2],vhi[i][3]}
  #define PIN(x) asm volatile("":"+v"(x))
  #define MX3(a,b,c) __builtin_fmaxf(__builtin_fmaxf((a),(b)),(c))
  #define GAPA(MF,A0,A1,A2,A3,W0,W1,PW) do{ MF; sacc+=A0; sacc+=A1; sacc+=A2; sacc+=A3; PIN(sacc); W0; W1; PIN(PW); SBAR(); }while(0)
  #define EX(v) __builtin_amdgcn_exp2f(v)
  #define GAPB(MF,X,B,NX) do{ MF; X[B]=EX(X[B]); X[B+1]=EX(X[B+1]); X[B+2]=EX(X[B+2]); X[B+3]=EX(X[B+3]); NX[B]=fsub_s(nm_,NX[B]); NX[B+1]=fsub_s(nm_,NX[B+1]); NX[B+2]=fsub_s(nm_,NX[B+2]); NX[B+3]=fsub_s(nm_,NX[B+3]); PIN(X); PIN(NX); SBAR(); }while(0)
  #define VRD(i) do{ vlo[i]=vtr(vp_+(((i)>>2)*4096+((i)&3)*1024)); vhi[i]=vtr(vp_+(((i)>>2)*4096+((i)&3)*1024+512)); }while(0)
  #define KRD(G,j) do{ if(G){ kload2(kf,kp0+sl_next,j); SBAR(); } }while(0)
  #define STEP(C0,C1,P0,P1,t,GK,GV,GL) do{ SBAR(); \
    const lds_cptr vp_=vp0+sl_prev; \
    VRD(0); SBAR(); float sacc=(P0[0]+P0[1]); \
    GAPA(C0=__builtin_amdgcn_mfma_f32_32x32x16_bf16(kf[0],qr[0],C0,0,0,0), P0[2],P0[3],P0[4],P0[5],     pw0[0]=PKW(P0,0), pw0[1]=PKW(P0,2), pw0); \
    VRD(4); SBAR(); GAPA(C1=__builtin_amdgcn_mfma_f32_32x32x16_bf16(kf[1],qr[0],C1,0,0,0), P0[6],P0[7],P0[8],P0[9],     pw0[2]=PKW(P0,4), pw0[3]=PKW(P0,6), pw0); \
    VRD(1); SBAR(); GAPA(C0=__builtin_amdgcn_mfma_f32_32x32x16_bf16(kf[2],qr[1],C0,0,0,0),   P0[10],P0[11],P0[12],P0[13], pw1[0]=PKW(P0,8), pw1[1]=PKW(P0,10), pw1); \
    VRD(5); SBAR(); GAPA(C1=__builtin_amdgcn_mfma_f32_32x32x16_bf16(kf[3],qr[1],C1,0,0,0),   P0[14],P0[15],P1[0],P1[1],   pw1[2]=PKW(P0,12),pw1[3]=PKW(P0,14), pw1); \
    VRD(2); SBAR(); GAPA(C0=__builtin_amdgcn_mfma_f32_32x32x16_bf16(kf[4],qr[2],C0,0,0,0),   P1[2],P1[3],P1[4],P1[5],     pw2[0]=PKW(P1,0), pw2[1]=PKW(P1,2), pw2); \
    VRD(6); SBAR(); GAPA(C1=__builtin_amdgcn_mfma_f32_32x32x16_bf16(kf[5],qr[2],C1,0,0,0),   P1[6],P1[7],P1[8],P1[9],     pw2[2]=PKW(P1,4), pw2[3]=PKW(P1,6), pw2); \
    VRD(3); SBAR(); GAPA(C0=__builtin_amdgcn_mfma_f32_32x32x16_bf16(kf[6],qr[3],C0,0,0,0),   P1[10],P1[11],P1[12],P1[13], pw3[0]=PKW(P1,8), pw3[1]=PKW(P1,10), pw3); \
    VRD(7); SBAR(); GAPA(C1=__builtin_amdgcn_mfma_f32_32x32x16_bf16(kf[7],qr[3],C1,0,0,0),   P1[14],P1[15],0.f,0.f,       pw3[2]=PKW(P1,12),pw3[3]=PKW(P1,14), pw3); \
    l_reg+=sacc; \
    BIASLOAD(P0,P1,(t)+1); \
    if(GK){DMA_K((t)+3,sl_cur);} if(GV){DMA_V((t)+1,sl_next);} \
    CMASK(C0,C1,t); \
    { float a=MX3(C0[0],C0[1],C1[0]),b=MX3(C0[2],C0[3],C1[1]); a=MX3(a,C1[2],C1[3]); \
      _Pragma("unroll") for(int r=4;r<16;r+=4){a=MX3(a,C0[r],C0[r+1]);b=MX3(b,C0[r+2],C0[r+3]);a=MX3(a,C1[r],C1[r+1]);b=MX3(b,C1[r+2],C1[r+3]);} \
      float rm=__builtin_fmaxf(a,b); { auto rr=__builtin_amdgcn_permlane32_swap(__float_as_uint(rm),__float_as_uint(rm),false,false); rm=__builtin_fmaxf(__uint_as_float(rr[0]),__uint_as_float(rr[1])); } \
      resc=false; \
      if(__builtin_expect(__any(rm>(float)THRL),0)){ const float dl=__builtin_fmaxf(rm,0.f); mhat+=dl; \
        _Pragma("unroll") for(int r=0;r<16;++r){C0[r]-=dl;C1[r]-=dl;} \
        const float f=__builtin_amdgcn_exp2f(-dl); l_reg*=f; if(hi==0)wsf[r32]=f; resc=true; } } \
    SBAR(); const float nm_=-mhat; \
    GAPB(o[0]=__builtin_amdgcn_mfma_f32_32x32x16_bf16(PAF(0),VFR(0),o[0],0,0,0), C0,0,P0); \
    GAPB(o[1]=__builtin_amdgcn_mfma_f32_32x32x16_bf16(PAF(0),VFR(4),o[1],0,0,0), C0,4,P0); \
    KRD(GL,0); GAPB(o[0]=__builtin_amdgcn_mfma_f32_32x32x16_bf16(PAF(1),VFR(1),o[0],0,0,0), C0,8,P0); \
    KRD(GL,1); GAPB(o[1]=__builtin_amdgcn_mfma_f32_32x32x16_bf16(PAF(1),VFR(5),o[1],0,0,0), C0,12,P0); \
    KRD(GL,2); GAPB(o[0]=__builtin_amdgcn_mfma_f32_32x32x16_bf16(PAF(2),VFR(2),o[0],0,0,0), C1,0,P1); \
    KRD(GL,3); GAPB(o[1]=__builtin_amdgcn_mfma_f32_32x32x16_bf16(PAF(2),VFR(6),o[1],0,0,0), C1,4,P1); \
    GAPB(o[0]=__builtin_amdgcn_mfma_f32_32x32x16_bf16(PAF(3),VFR(3),o[0],0,0,0), C1,8,P1); \
    GAPB(o[1]=__builtin_amdgcn_mfma_f32_32x32x16_bf16(PAF(3),VFR(7),o[1],0,0,0), C1,12,P1); \
    }while(0)
  BIASINIT(pB0,pB1,1);
  int t=1;
  #undef CMASK
  #define CMASK(P0,P1,t) do{}while(0)
  for(;t+5<NT;t+=2){
    STEP(pB0,pB1,pA0,pA1,t,true,true,true);     WAIT_BAR(2); RESC(); ROT();
    STEP(pA0,pA1,pB0,pB1,t+1,true,true,true);   WAIT_BAR(2); RESC(); ROT();
  }
  #undef CMASK
  #define CMASK(P0,P1,t) do{int jb_=(t)-(NT-4); if(jb_>=0)cmask(P0,P1,jb_,qrel,hi);}while(0)
  #define ENDW(tt) do{ if((tt)+3<NT){WAIT_BAR(2);} else if((tt)+2<NT){WAIT_BAR(1);} else {WAIT_BAR(0);} }while(0)
  for(;t+1<NT;t+=2){
    STEP(pB0,pB1,pA0,pA1,t,(t+3<NT),(t+1<NT),(t+1<NT));       ENDW(t);   RESC(); ROT();
    STEP(pA0,pA1,pB0,pB1,t+1,(t+4<NT),(t+2<NT),(t+2<NT));     ENDW(t+1); RESC(); ROT();
  }
  STEP(pB0,pB1,pA0,pA1,NT-1,false,false,false); RESC();
  { float sacc=pB0[0]+pB0[1]; _Pragma("unroll") for(int r=2;r<16;++r)sacc+=pB0[r]; _Pragma("unroll") for(int r=0;r<16;++r)sacc+=pB1[r]; l_reg+=sacc;
    pw0=(u32x4){PKW(pB0,0),PKW(pB0,2),PKW(pB0,4),PKW(pB0,6)};pw1=(u32x4){PKW(pB0,8),PKW(pB0,10),PKW(pB0,12),PKW(pB0,14)};pw2=(u32x4){PKW(pB1,0),PKW(pB1,2),PKW(pB1,4),PKW(pB1,6)};pw3=(u32x4){PKW(pB1,8),PKW(pB1,10),PKW(pB1,12),PKW(pB1,14)};
    SBAR(); pv(o,vb0+sl_cur,PAF(0),PAF(1),PAF(2),PAF(3)); }
  #undef PKW
  #undef PAF
  #undef VFR
  #undef PIN
  #undef MX3
  #undef GAPA
  #undef GAPB
  #undef EX
  #undef VRD
  #undef KRD
  #undef STEP
  #undef ENDW
  {auto rr=__builtin_amdgcn_permlane32_swap(__float_as_uint(l_reg),__float_as_uint(l_reg),false,false);l_reg=__uint_as_float(rr[0])+__uint_as_float(rr[1]);}
  if(hi==0)wsf[32+r32]=l_reg;asm volatile("s_waitcnt lgkmcnt(0)":::"memory");
  float rli[16];
  #pragma unroll
  for(int r=0;r<16;++r)rli[r]=__builtin_amdgcn_rcpf(wsf[32+crow(r,hi)]);
  bf16*Ow=O+(rowbase+q0+wid*QBLK)*DM+h*D;
  { bf16*stg=(bf16*)(shm+LDS_OST)+wid*2048;
    #pragma unroll
    for(int r=0;r<16;++r){const int orow=crow(r,hi);
      #pragma unroll
      for(int d0=0;d0<2;++d0)stg[orow*64+d0*32+r32]=__float2bfloat16(o[d0][r]*rli[r]);}
    asm volatile("s_waitcnt lgkmcnt(0)":::"memory");
    #pragma unroll
    for(int i=0;i<4;++i){const int row=i*8+(lane>>3),ch=lane&7; const u32x4 v=*(const u32x4*)(stg+row*64+ch*8); ATTN_STORE16(Ow+(long)row*DM+ch*8,v);} }
  asm volatile("s_waitcnt lgkmcnt(0)\n\ts_barrier":::"memory");
  #undef DMA_K
  #undef DMA_V
  #undef CMASK
  #undef START
  #undef RESC
  #undef ROT
  #undef BIASINIT
  #undef BIASLOAD
}
constexpr int ATTN_LDS_BYTES=LDS_BYTES;
struct AttnTensors { const bf16* Q; const bf16* K; const bf16* V; bf16* O; const float* CS; };
struct AttnUnit { int bh; int qb; };
struct StaticOrder {
  int vcu;
  __device__ __forceinline__ explicit StaticOrder(int grid,int block):vcu((block%8)*(grid/8)+block/8){}
  __device__ __forceinline__ bool next(int i,AttnUnit&u)const{ if(i>=4)return false; const int s=vcu&7; u.bh=vcu>>3; u.qb=(i==0)?s:(i==1)?15-s:(i==2)?16+s:31-s; return true; }
  __device__ __forceinline__ void a_ready(const AttnUnit&)const{}
  __device__ __forceinline__ void done(const AttnUnit&)const{}
};
template<class Sched,int THRL=96> __device__ __forceinline__ void attn_phase(char*lds,const AttnTensors&T,const Sched&S,const int tid_in){
  AttnUnit u;
  for(int i=0;S.next(i,u);++i){ S.a_ready(u); attn_unit<THRL>(u.bh/NHEAD,u.bh%NHEAD,u.qb,T.Q,T.K,T.V,T.O,T.CS,lds,tid_in); S.done(u); }
}
#undef SBAR
#undef WAIT_BAR
}
#define LAS __attribute__((address_space(3)))
#define XB_TMO      128
#define XB_XCNT(j)  (256  + 64 * (j))
#define XB_XSUB(j)  (1280 + 64 * (j))
#define XB_XGEN(j)  (2304 + 64 * (j))
#define XB_TOP      3328
#define XB_TOPGEN   3392
#define XCD_BAR_WORDS 3456
#define XB_SPIN_CAP (1u << 18)

__device__ __forceinline__ unsigned xb_ld(unsigned* p)              { return __hip_atomic_load(p, __ATOMIC_RELAXED, __HIP_MEMORY_SCOPE_AGENT); }
__device__ __forceinline__ unsigned xb_add(unsigned* p, unsigned v) { return __hip_atomic_fetch_add(p, v, __ATOMIC_RELAXED, __HIP_MEMORY_SCOPE_AGENT); }
__device__ __forceinline__ unsigned xb_xcc_id() { return (unsigned)__builtin_amdgcn_s_getreg((3 << 11) | 20) & 0xFu; }
#define XB_SPIN(cond, bar) do { unsigned _sp = 0; while (cond) { __builtin_amdgcn_s_sleep(1); \
    if ((++_sp & 255u) == 0u) { if (xb_ld(&(bar)[XB_TMO])) break; if (_sp > XB_SPIN_CAP) { atomicAdd(&(bar)[XB_TMO], 1u); break; } } } } while (0)

struct XcdBarrier {
    unsigned* bar; unsigned x;
    volatile LAS unsigned* st;
};

__device__ __forceinline__ XcdBarrier xcd_barrier_post(unsigned* bar, volatile LAS unsigned* st, const int tid) {
    XcdBarrier b; b.bar = bar; b.x = xb_xcc_id(); b.st = st;
    if (tid == 0) (void)xb_add(&bar[XB_XCNT(b.x)], 1u);
    return b;
}
__device__ __forceinline__ void xcd_barrier_complete(unsigned* bar, unsigned x, unsigned& nloc, unsigned& nx) {
    const unsigned G = gridDim.x * gridDim.y * gridDim.z;
    unsigned sum, cnt, mine, sp = 0u;
    for (;;) {
        sum = 0u; cnt = 0u; mine = 0u;
#pragma unroll
        for (unsigned j = 0; j < 16; ++j) { const unsigned c = xb_ld(&bar[XB_XCNT(j)]); sum += c; cnt += (c > 0u) ? 1u : 0u; mine = (j == x) ? c : mine; }
        if (sum == G) break;
        __builtin_amdgcn_s_sleep(1);
        if ((++sp & 255u) == 0u) { if (xb_ld(&bar[XB_TMO])) break; if (sp > XB_SPIN_CAP) { atomicAdd(&bar[XB_TMO], 1u); break; } }
    }
    nloc = mine > 0u ? mine : 1u; nx = cnt > 0u ? cnt : 1u;
}

__device__ __forceinline__ void xcd_barrier(const XcdBarrier& b, const int tid) {
    asm volatile("s_waitcnt vmcnt(0)" ::: "memory");
    __syncthreads();
    if (tid == 0) {
        unsigned* bar = b.bar; asm volatile("" : "+s"(bar)); unsigned bx_ = (unsigned)__builtin_amdgcn_readfirstlane((int)b.x); asm volatile("" : "+s"(bx_));
        __builtin_amdgcn_s_waitcnt(0);
        unsigned nloc = b.st[0], nx = b.st[1];
        if (nloc == 0u) { xcd_barrier_complete(bar, bx_, nloc, nx); b.st[0] = nloc; b.st[1] = nx; }
        const unsigned old = xb_add(&bar[XB_XSUB(bx_)], 1u);
        const unsigned gen = old / nloc;
        if (old + 1u == (gen + 1u) * nloc) {
            __builtin_amdgcn_fence(__ATOMIC_RELEASE, "agent");
            asm volatile("s_waitcnt vmcnt(0)" ::: "memory");
            const unsigned og = xb_add(&bar[XB_TOP], 1u);
            const unsigned tg = og / nx;
            if (og + 1u == (tg + 1u) * nx) xb_add(&bar[XB_TOPGEN], 1u);
            else XB_SPIN(xb_ld(&bar[XB_TOPGEN]) == tg, bar);
            __builtin_amdgcn_fence(__ATOMIC_ACQUIRE, "agent");
            xb_add(&bar[XB_XGEN(bx_)], 1u);
            asm volatile("s_waitcnt vmcnt(0)" ::: "memory");
        } else {
            XB_SPIN(xb_ld(&bar[XB_XGEN(bx_)]) == gen, bar);
            __builtin_amdgcn_fence(__ATOMIC_ACQUIRE, "agent");
            asm volatile("s_waitcnt vmcnt(0)" ::: "memory");
        }
    }
    __syncthreads();
}
namespace cg = cooperative_groups;
constexpr int NWAVES = 8;
constexpr int DM = 1024, FF = 2816, NH = 16, SEQ = 8192, NMETA = 16, DEPTH = 4;
constexpr int MMAIN = 2 * SEQ;
constexpr int MROWS = MMAIN + NMETA;
constexpr int MPAD = 65 * 256;
constexpr int KVROWS = attn_body::KVROWS;
constexpr float EPS = 1e-6f, LOG2E = 1.4426950408889634f;

constexpr size_t MiB = 1u << 20;
constexpr size_t SZ_GU = (size_t)5632 * 1024 * 2, SZ_DN = (size_t)1024 * 2816 * 2;
constexpr size_t WS_CTL = 0, CTL_ZERO_BYTES = 16384;
constexpr size_t WS_WGU = 1 * MiB, WS_WDN = WS_WGU + 8 * SZ_GU;
constexpr size_t WS_WAI = WS_WDN + 8 * SZ_DN, WS_WAO = WS_WAI + 2 * 6 * MiB, WS_WBI = WS_WAO + 2 * 2 * MiB, WS_WBO = WS_WBI + 4 * MiB;
constexpr size_t WS_WCI = WS_WBO + 2 * MiB, WS_WCO = WS_WCI + 6 * MiB, WS_WF = WS_WCO + 2 * MiB;
constexpr size_t WS_XN = WS_WF + 1 * MiB;
constexpr size_t SZ_ROWBUF = (size_t)MPAD * 1024 * 2;
constexpr size_t WS_ACT = WS_XN + 33 * MiB;
constexpr size_t WS_HMETA = WS_ACT + 98 * MiB, WS_LF = WS_HMETA + 1 * MiB, WS_LFM = WS_LF + 1 * MiB, WS_CS = WS_LFM + 1 * MiB, WS_SSQ = WS_CS + 2 * MiB, WS_SSQM = WS_SSQ + 1 * MiB, WS_END = WS_SSQM + 1 * MiB;
static_assert(SZ_ROWBUF <= 33 * MiB && 3 * SZ_ROWBUF <= 98 * MiB && (size_t)MPAD * FF * 2 <= 98 * MiB, "ws map");

constexpr int RING_BYTES = 131072, LDS_BYTES = 147456;
static_assert(attn_body::ATTN_LDS_BYTES <= RING_BYTES, "attention LDS");
constexpr int MISC_OFF = RING_BYTES + 320;

#define GAS __attribute__((address_space(1)))
typedef unsigned short bf16;
typedef unsigned v4u __attribute__((ext_vector_type(4)));
typedef unsigned v2u __attribute__((ext_vector_type(2)));
typedef float f32x4 __attribute__((ext_vector_type(4)));
typedef float f32x2 __attribute__((ext_vector_type(2)));
typedef short bf16x8 __attribute__((ext_vector_type(8)));
#define LDS_WAIT() asm volatile("s_waitcnt lgkmcnt(0)" ::: "memory")
__device__ __forceinline__ unsigned f2bf(float f) { unsigned u = __builtin_bit_cast(unsigned, f); return (u + 0x7fffu + ((u >> 16) & 1u)) >> 16; }
__device__ __forceinline__ unsigned pk2(float lo, float hi) { return f2bf(lo) | (f2bf(hi) << 16); }
__device__ __forceinline__ float bflo(unsigned w) { return __builtin_bit_cast(float, w << 16); }
__device__ __forceinline__ float bfhi(unsigned w) { return __builtin_bit_cast(float, w & 0xffff0000u); }
__device__ __forceinline__ float lane_get(float v, int src_lane) { return __builtin_bit_cast(float, __builtin_amdgcn_ds_bpermute(src_lane << 2, __builtin_bit_cast(int, v))); }
__device__ __forceinline__ float wave_sum(float v, int lane) {
#pragma unroll
    for (int o = 1; o < 64; o <<= 1) v += lane_get(v, lane ^ o);
    return v;
}

struct Args {
    const float* x; const float* meta; const float* ffn_norm; const float* ffn_w_gate; const float* ffn_w_up; const float* ffn_w_down; const float* mix_norm;
    const float* a_w_in; const float* a_conv; const float* a_w_out;
    const float* b_w_in; const float* b_conv; const float* b_conv_bias; const float* b_ln_g; const float* b_ln_b; const float* b_w_out;
    const float* c_w_in; const float* c_b_f; const float* c_q_norm; const float* c_k_norm; const float* c_w_out;
    float* out; unsigned char* ws;
};

__device__ __forceinline__ void transpose_item(const float* src, int Nsrc, bf16* dst, int K, int kb, LAS float* scr, int lane, const float* gain = nullptr) {
    const int k0 = 64 * kb;
    const GAS float* sp = (const GAS float*)src + (size_t)(k0 + (lane >> 5)) * Nsrc + (lane & 31);
    float v[32];
#pragma unroll
    for (int i = 0; i < 32; ++i) v[i] = sp[(size_t)(2 * i) * Nsrc];
    const int c = lane & 7;
    f32x4 g0 = {1.f, 1.f, 1.f, 1.f}, g1 = g0;
    if (gain) { g0 = *(const GAS f32x4*)(gain + k0 + 8 * c); g1 = *(const GAS f32x4*)(gain + k0 + 8 * c + 4); }
#pragma unroll
    for (int i = 0; i < 32; ++i) scr[(2 * i + (lane >> 5)) * 33 + (lane & 31)] = v[i];
    LDS_WAIT(); asm volatile("" ::: "memory");
#pragma unroll
    for (int j = 0; j < 4; ++j) { const int n = (lane >> 3) + 8 * j; const LAS float* s = scr + (8 * c) * 33 + n;
        v4u o; o.x = pk2(s[0 * 33] * g0.x, s[1 * 33] * g0.y); o.y = pk2(s[2 * 33] * g0.z, s[3 * 33] * g0.w); o.z = pk2(s[4 * 33] * g1.x, s[5 * 33] * g1.y); o.w = pk2(s[6 * 33] * g1.z, s[7 * 33] * g1.w);
        *(GAS v4u*)(dst + (size_t)n * K + k0 + 8 * c) = o; }
    LDS_WAIT(); asm volatile("" ::: "memory");
}

__device__ __forceinline__ float hb_row(const float* xrow, bf16* orow, int lane) {
    const GAS f32x4* xr = (const GAS f32x4*)xrow + lane;
    f32x4 v[4]; float s = 0.f;
#pragma unroll
    for (int j = 0; j < 4; ++j) { v[j] = xr[64 * j]; s += (v[j].x * v[j].x + v[j].y * v[j].y) + (v[j].z * v[j].z + v[j].w * v[j].w); }
    GAS unsigned long long* o8 = (GAS unsigned long long*)orow + lane;
#pragma unroll
    for (int j = 0; j < 4; ++j) o8[64 * j] = (unsigned long long)pk2(v[j].x, v[j].y) | ((unsigned long long)pk2(v[j].z, v[j].w) << 32);
    return wave_sum(s, lane);
}

constexpr int I_GU = 176 * 16, I_DN = 32 * 44, I_AI = 96 * 16, I_SQ = 32 * 16, I_BI = 64 * 16, I_CI = 96 * 16;
constexpr int I_FFN = 2 * I_GU + 2 * I_DN, I_MIXBASE = 8 * I_GU + 8 * I_DN;
static_assert(I_CI == I_AI, "conv_nv");
__device__ __forceinline__ int conv_nv(int L) { return I_FFN + ((L == 1) ? I_BI + I_SQ : I_AI + I_SQ); }
__device__ __forceinline__ int conv_item(int L, int v) {
    if (v < 2 * I_GU) return 2 * L * I_GU + v;
    if (v < I_FFN) return 8 * I_GU + 2 * L * I_DN + (v - 2 * I_GU);
    const int w = v - I_FFN;
    if (L == 0) return (w < I_AI) ? I_MIXBASE + w : I_MIXBASE + 2 * I_AI + (w - I_AI);
    if (L == 3) return (w < I_AI) ? I_MIXBASE + I_AI + w : I_MIXBASE + 2 * I_AI + I_SQ + (w - I_AI);
    if (L == 1) return I_MIXBASE + 2 * I_AI + 2 * I_SQ + w;
    return I_MIXBASE + 2 * I_AI + 2 * I_SQ + I_BI + I_SQ + w;
}
#define CONVERT_BODY \
            int r = it; \
            if (r < 8 * I_GU) { const int mat = r / I_GU; r %= I_GU; const int kb = r / 176, nb = r % 176, pn = nb >> 3, q = nb & 7; \
                const float* src = ((q < 4) ? a.ffn_w_gate : a.ffn_w_up) + (size_t)mat * 1024 * FF + 128 * pn + 32 * (q & 3); \
                transpose_item(src, FF, WGU + (size_t)mat * 5632 * 1024 + (size_t)nb * 32 * 1024, 1024, kb, scr, lane, a.ffn_norm + (size_t)mat * DM); continue; } \
            r -= 8 * I_GU; \
            if (r < 8 * I_DN) { const int mat = r / I_DN; r %= I_DN; const int kb = r / 32, nb = r % 32; \
                transpose_item(a.ffn_w_down + (size_t)mat * FF * 1024 + 32 * nb, 1024, WDN + (size_t)mat * 1024 * FF + (size_t)nb * 32 * FF, FF, kb, scr, lane); continue; } \
            r -= 8 * I_DN; \
            if (r < 2 * I_AI) { const int mat = r / I_AI; r %= I_AI; const int kb = r / 96, nb = r % 96, pn = nb >> 3, q = nb & 7; \
                const int scol = (pn < 8) ? ((q < 4) ? 1024 + 128 * pn + 32 * q : 2048 + 128 * pn + 32 * (q - 4)) : (nb - 64) * 32; \
                transpose_item(a.a_w_in + (size_t)mat * 1024 * 3072 + scol, 3072, WAI + (size_t)mat * 3072 * 1024 + (size_t)nb * 32 * 1024, 1024, kb, scr, lane, a.mix_norm + (size_t)(3 * mat) * DM); continue; } \
            r -= 2 * I_AI; \
            if (r < 2 * I_SQ) { const int mat = r / I_SQ; r %= I_SQ; const int kb = r / 32, nb = r % 32; \
                transpose_item(a.a_w_out + (size_t)mat * 1024 * 1024 + 32 * nb, 1024, WAO + (size_t)mat * 1024 * 1024 + (size_t)nb * 32 * 1024, 1024, kb, scr, lane); continue; } \
            r -= 2 * I_SQ; \
            if (r < I_BI) { const int kb = r / 64, nb = r % 64, pn = nb >> 3, q = nb & 7; \
                const int scol = (q < 4) ? 128 * pn + 32 * q : 1024 + 128 * pn + 32 * (q - 4); \
                transpose_item(a.b_w_in + scol, 2048, WBI + (size_t)nb * 32 * 1024, 1024, kb, scr, lane, a.mix_norm + (size_t)1 * DM); continue; } \
            r -= I_BI; \
            if (r < I_SQ) { const int kb = r / 32, nb = r % 32; \
                transpose_item(a.b_w_out + 32 * nb, 1024, WBO + (size_t)nb * 32 * 1024, 1024, kb, scr, lane); continue; } \
            r -= I_SQ; \
            if (r < I_CI) { const int kb = r / 96, nb = r % 96, pn = nb >> 3, q = nb & 7; \
                const int scol = (pn < 8) ? (pn >> 2) * 1024 + 64 * (4 * (pn & 3) + (q & 3)) + 32 * (q >> 2) : 2048 + (nb - 64) * 32; \
                transpose_item(a.c_w_in + scol, 3088, WCI + (size_t)nb * 32 * 1024, 1024, kb, scr, lane, a.mix_norm + (size_t)2 * DM); continue; } \
            r -= I_CI; \
            { const int kb = r / 32, nb = r % 32; \
                transpose_item(a.c_w_out + 32 * nb, 1024, WCO + (size_t)nb * 32 * 1024, 1024, kb, scr, lane); }

__device__ __forceinline__ void thin_gemm(LAS unsigned char* ldsl, const int tid, const int task, const bf16* A, const bf16* Bt, const int K, const int mode,
                                          bf16* R0, bf16* R1, bf16* R2, float* hmeta, const float scale, const float* qg, const float* kg, float* SSQM, bf16* HB) {
    const int ntasks = (mode == 0) ? 176 : (mode == 2) ? 128 : (mode == 3) ? 48 : 64;
    if (task < 0 || task >= ntasks) return;
    v2u ho_pre = {0u, 0u}; if (mode == 4) ho_pre = *(const GAS v2u*)(HB + (size_t)(MMAIN + (tid & 15)) * 1024 + 16 * task + 4 * ((tid & 63) >> 4));
    float rsm_t = 0.f;
    if (mode != 4) {
#pragma unroll
        for (int i = 0; i < 16; ++i) { const f32x4 q4 = *(const GAS f32x4*)(SSQM + (tid & 15) * 64 + 4 * i); rsm_t += (q4.x + q4.y) + (q4.z + q4.w); } }
    const int lane = tid & 63, wave = __builtin_amdgcn_readfirstlane(tid >> 6), fr = lane & 15, fq = lane >> 4;
    int nt = 1, b0 = 0, b1 = 0, b2 = 0, b3 = 0;
    if (mode <= 1 || (mode == 2 && task < 64)) { const int f0 = 16 * task; b0 = 256 * (f0 >> 7) + (f0 & 127); b1 = b0 + 128; nt = 2; }
    else if (mode == 2) { b0 = 2048 + 16 * (task - 64); }
    else if (mode == 3) { const int sec = task >> 4, hd = task & 15; nt = 4;
        if (sec < 2) { b0 = 256 * (sec * 4 + (hd >> 2)) + 32 * (hd & 3); b1 = b0 + 16; b2 = b0 + 128; b3 = b0 + 144; }
        else { b0 = 2048 + 64 * hd; b1 = b0 + 16; b2 = b0 + 32; b3 = b0 + 48; } }
    else { b0 = 16 * task; }
    const int kw = K >> 3, ksteps = kw >> 5;
    const GAS bf16x8* ap = (const GAS bf16x8*)(A + (size_t)(MMAIN + fr) * K + wave * kw + 8 * fq);
    const GAS bf16x8* p0 = (const GAS bf16x8*)(Bt + (size_t)(b0 + fr) * K + wave * kw + 8 * fq);
    const GAS bf16x8* p1 = (const GAS bf16x8*)(Bt + (size_t)(b1 + fr) * K + wave * kw + 8 * fq);
    const GAS bf16x8* p2 = (const GAS bf16x8*)(Bt + (size_t)(b2 + fr) * K + wave * kw + 8 * fq);
    const GAS bf16x8* p3 = (const GAS bf16x8*)(Bt + (size_t)(b3 + fr) * K + wave * kw + 8 * fq);
    f32x4 c0 = {0.f, 0.f, 0.f, 0.f}, c1 = c0, c2 = c0, c3 = c0;
    if (ksteps > 4) {
        bf16x8 xa[11], wb[11];
#pragma unroll
        for (int ks = 0; ks < 11; ++ks) { xa[ks] = ap[4 * ks]; wb[ks] = p0[4 * ks]; }
#pragma unroll
        for (int ks = 0; ks < 11; ++ks) c0 = __builtin_amdgcn_mfma_f32_16x16x32_bf16(wb[ks], xa[ks], c0, 0, 0, 0);
    } else {
#pragma unroll 4
    for (int ks = 0; ks < ksteps; ++ks) {
        const bf16x8 xa = ap[4 * ks];
        c0 = __builtin_amdgcn_mfma_f32_16x16x32_bf16(p0[4 * ks], xa, c0, 0, 0, 0);
        if (nt >= 2) c1 = __builtin_amdgcn_mfma_f32_16x16x32_bf16(p1[4 * ks], xa, c1, 0, 0, 0);
        if (nt >= 4) { c2 = __builtin_amdgcn_mfma_f32_16x16x32_bf16(p2[4 * ks], xa, c2, 0, 0, 0); c3 = __builtin_amdgcn_mfma_f32_16x16x32_bf16(p3[4 * ks], xa, c3, 0, 0, 0); }
    }
    }
    LAS f32x4* P = (LAS f32x4*)ldsl;
    P[(wave * 4 + 0) * 64 + lane] = c0; P[(wave * 4 + 1) * 64 + lane] = c1; P[(wave * 4 + 2) * 64 + lane] = c2; P[(wave * 4 + 3) * 64 + lane] = c3;
    __syncthreads();
    if (wave == 0) {
#pragma unroll
        for (int w = 1; w < 8; ++w) { c0 += P[(w * 4 + 0) * 64 + lane]; c1 += P[(w * 4 + 1) * 64 + lane]; c2 += P[(w * 4 + 2) * 64 + lane]; c3 += P[(w * 4 + 3) * 64 + lane]; }
        const size_t mrow = (size_t)(MMAIN + fr);
        if (mode != 4) { const float rsm = __builtin_amdgcn_rsqf(rsm_t * (1.f / DM) + EPS); c0 *= rsm; c1 *= rsm; c2 *= rsm; c3 *= rsm; }
        if (mode <= 1 || (mode == 2 && task < 64)) {
            f32x4 r;
            if (mode == 0) {
#pragma unroll
                for (int i = 0; i < 4; ++i) r[i] = c0[i] * pg8::sigm(c0[i]) * c1[i];
            } else if (mode == 1) {
#pragma unroll
                for (int i = 0; i < 4; ++i) r[i] = c0[i] * pg8::sigm(c1[i]);
            } else r = c0 * c1;
            *(GAS v2u*)(R0 + mrow * (mode == 0 ? FF : 1024) + 16 * task + 4 * fq) = (v2u){pk2(r[0], r[1]), pk2(r[2], r[3])};
        } else if (mode == 2) {
            *(GAS v2u*)(R1 + mrow * 1024 + 16 * (task - 64) + 4 * fq) = (v2u){pk2(c0[0], c0[1]), pk2(c0[2], c0[3])};
        } else if (mode == 3) {
            const int sec = task >> 4, hd = task & 15;
            f32x4 v0 = c0, v1 = c1, v2 = c2, v3 = c3;
            if (sec < 2) {
                float ss = (c0[0] * c0[0] + c0[1] * c0[1]) + (c0[2] * c0[2] + c0[3] * c0[3]) + (c1[0] * c1[0] + c1[1] * c1[1]) + (c1[2] * c1[2] + c1[3] * c1[3])
                         + (c2[0] * c2[0] + c2[1] * c2[1]) + (c2[2] * c2[2] + c2[3] * c2[3]) + (c3[0] * c3[0] + c3[1] * c3[1]) + (c3[2] * c3[2] + c3[3] * c3[3]);
                ss += lane_get(ss, lane ^ 16); ss += lane_get(ss, lane ^ 32);
                const float rs = __builtin_amdgcn_rsqf(ss * (1.0f / 64.0f) + EPS) * ((sec == 0) ? pg8::QK_C2 : 1.0f);
                const float* g = (sec == 0) ? qg : kg;
                v0 = c0 * rs * *(const GAS f32x4*)(g + 4 * fq); v1 = c1 * rs * *(const GAS f32x4*)(g + 16 + 4 * fq); v2 = c2 * rs * *(const GAS f32x4*)(g + 32 + 4 * fq); v3 = c3 * rs * *(const GAS f32x4*)(g + 48 + 4 * fq);
            }
            const v2u w0 = {pk2(v0[0], v0[1]), pk2(v0[2], v0[3])}, w1 = {pk2(v1[0], v1[1]), pk2(v1[2], v1[3])}, w2 = {pk2(v2[0], v2[1]), pk2(v2[2], v2[3])}, w3 = {pk2(v3[0], v3[1]), pk2(v3[2], v3[3])};
            const int col = 64 * hd + 4 * fq;
            if (sec == 0) { bf16* q = R0 + mrow * 1024 + col; *(GAS v2u*)q = w0; *(GAS v2u*)(q + 16) = w1; *(GAS v2u*)(q + 32) = w2; *(GAS v2u*)(q + 48) = w3; }
            else { bf16* T = (sec == 1) ? R1 : R2;
#pragma unroll
                for (int b = 0; b < 2; ++b) { bf16* q = T + (size_t)(b * KVROWS + 48 + fr) * 1024 + col; *(GAS v2u*)q = w0; *(GAS v2u*)(q + 16) = w1; *(GAS v2u*)(q + 32) = w2; *(GAS v2u*)(q + 48) = w3; } }
        } else {
            const v2u ho = ho_pre;
            const f32x4 hn = (f32x4){bflo(ho.x), bfhi(ho.x), bflo(ho.y), bfhi(ho.y)} + c0 * scale;
            *(GAS v2u*)(HB + mrow * 1024 + 16 * task + 4 * fq) = (v2u){pk2(hn[0], hn[1]), pk2(hn[2], hn[3])};
            float ps = (hn[0] * hn[0] + hn[1] * hn[1]) + (hn[2] * hn[2] + hn[3] * hn[3]); ps += lane_get(ps, lane ^ 16); ps += lane_get(ps, lane ^ 32);
            if (fq == 0) SSQM[fr * 64 + task] = ps;
        }
    }
    __syncthreads();
}

__global__ void __launch_bounds__(NWAVES * 64, 2) fwd_megakernel(Args a_unused) {
    extern __shared__ __attribute__((aligned(16))) unsigned char lds[];
    cg::grid_group grid = cg::this_grid();
    const int G = gridDim.x, bx = blockIdx.x;
    const int vcu0 = (G % 8 == 0) ? (bx % 8) * (G / 8) + bx / 8 : bx;
    const int NGW = G * NWAVES;
    if (threadIdx.x < 64) ((LAS unsigned*)((LAS unsigned char*)lds + RING_BYTES))[threadIdx.x * 2] = 0u, ((LAS unsigned*)((LAS unsigned char*)lds + RING_BYTES))[threadIdx.x * 2 + 1] = 0u;
    __syncthreads();
    const int wave_s = __builtin_amdgcn_readfirstlane((int)threadIdx.x >> 6);
#define PHASE_ENV() \
    const __attribute__((address_space(4))) Args* kap_ = (const __attribute__((address_space(4))) Args*)__builtin_amdgcn_kernarg_segment_ptr(); asm volatile("" : "+s"(kap_)); \
    const __attribute__((address_space(4))) Args& a = *kap_;     \
    unsigned zero_ = 0u; asm volatile("" : "+s"(zero_)); int vcu = vcu0; asm volatile("" : "+s"(vcu)); \
    int tid = (wave_s << 6) | (int)__builtin_amdgcn_mbcnt_hi(~0u, __builtin_amdgcn_mbcnt_lo(~0u, zero_)); \
    const int lane = tid & 63, wave = __builtin_amdgcn_readfirstlane(tid >> 6), gw = vcu * NWAVES + wave; \
    unsigned char* ws0_ = a.ws; asm volatile("" : "+s"(ws0_)); unsigned char* const ws = (unsigned char*)(GAS unsigned char*)ws0_;     \
    float* hm0_ = a.out; asm volatile("" : "+s"(hm0_)); float* const hmain = (float*)(GAS float*)hm0_; \
    bf16* const WGU = (bf16*)(ws + WS_WGU); bf16* const WDN = (bf16*)(ws + WS_WDN); \
    bf16* const WAI = (bf16*)(ws + WS_WAI); bf16* const WAO = (bf16*)(ws + WS_WAO); bf16* const WBI = (bf16*)(ws + WS_WBI); bf16* const WBO = (bf16*)(ws + WS_WBO); \
    bf16* const WCI = (bf16*)(ws + WS_WCI); bf16* const WCO = (bf16*)(ws + WS_WCO); bf16* const WFt = (bf16*)(ws + WS_WF); \
    bf16* const XN = (bf16*)(ws + WS_XN); \
    bf16* const R0 = (bf16*)(ws + WS_ACT); bf16* const R1 = (bf16*)(ws + WS_ACT + SZ_ROWBUF); bf16* const R2 = (bf16*)(ws + WS_ACT + 2 * SZ_ROWBUF); \
    float* const hmeta = (float*)(ws + WS_HMETA); \
    float* const LF = (float*)(ws + WS_LF); float* const LFM = (float*)(ws + WS_LFM); float* const CS = (float*)(ws + WS_CS); \
    float* const SSQ = (float*)(ws + WS_SSQ); float* const SSQM = (float*)(ws + WS_SSQM); (void)SSQ; (void)SSQM; \
    LAS unsigned char* const ldsl = (LAS unsigned char*)lds; \
    (void)WGU; (void)WDN; (void)WAI; (void)WAO; (void)WBI; (void)WBO; (void)WCI; (void)WCO; (void)WFt; (void)XN; (void)R0; (void)R1; (void)R2; (void)hmeta; (void)LF; (void)LFM; (void)CS; (void)ldsl; (void)lane; (void)gw; (void)hmain;

#ifdef PROBE_SEL
    LAS unsigned long long* const TS = (LAS unsigned long long*)((LAS unsigned char*)lds + RING_BYTES + 12288);
    if (threadIdx.x == 0) { for (int c = 0; c < 8; ++c) TS[c] = 0; TS[8] = __builtin_amdgcn_s_memrealtime(); }
#endif
    XcdBarrier bar;
    { PHASE_ENV(); bar = xcd_barrier_post((unsigned*)(ws + WS_CTL), (volatile LAS unsigned*)(ldsl + MISC_OFF) + 8, tid); }
    {
        PHASE_ENV();
        LAS float* scr = (LAS float*)(ldsl + wave * 16384);
        for (int v = gw; v < conv_nv(0); v += NGW) { const int it = conv_item(0, v);
            CONVERT_BODY
        }
        for (int i = gw * 64 + lane; i < 16 * 1024; i += NGW * 64) { const int h = i >> 10, k = i & 1023; WFt[i] = (bf16)f2bf(a.c_w_in[(size_t)k * 3088 + 3072 + h] * a.mix_norm[2 * DM + k]); }
        for (int m0 = gw; m0 < MROWS; m0 += 2 * NGW) {
            const int m1 = m0 + NGW; const bool has1 = (m1 < MROWS);
            const float* s0 = (m0 < MMAIN) ? a.x + (size_t)m0 * DM : a.meta + (size_t)(m0 - MMAIN) * DM;
            const float* s1 = !has1 ? s0 : (m1 < MMAIN) ? a.x + (size_t)m1 * DM : a.meta + (size_t)(m1 - MMAIN) * DM;
            f32x4 va[4], vb[4];
#pragma unroll
            for (int j = 0; j < 4; ++j) { va[j] = ((const GAS f32x4*)s0 + lane)[64 * j]; vb[j] = ((const GAS f32x4*)s1 + lane)[64 * j]; }
#pragma unroll
            for (int half = 0; half < 2; ++half) {
                if (half == 1 && !has1) break;
                const int m = half ? m1 : m0; float ssl = 0.f;
                GAS unsigned long long* o8 = (GAS unsigned long long*)(XN + (size_t)m * DM) + lane;
#pragma unroll
                for (int j = 0; j < 4; ++j) { const f32x4 v = half ? vb[j] : va[j]; ssl += (v.x * v.x + v.y * v.y) + (v.z * v.z + v.w * v.w);
                    o8[64 * j] = (unsigned long long)pk2(v.x, v.y) | ((unsigned long long)pk2(v.z, v.w) << 32); }
                const float ss = wave_sum(ssl, lane);
                if (m < MMAIN) { if (lane < 4) SSQ[(size_t)m * 4 + lane] = (lane == 0) ? ss : 0.f; } else SSQM[(m - MMAIN) * 64 + lane] = (lane == 0) ? ss : 0.f;
            }
        }
    }
    { PHASE_ENV(); if (ws == nullptr) grid.sync();
      xcd_barrier(bar, tid); }
#ifdef PROBE_SEL
    { PHASE_ENV(); if (tid == 0) { TS[9] = __builtin_amdgcn_s_memrealtime(); TS[0] = TS[9] - TS[8]; } }
#endif
    for (int L = 0; L < DEPTH; ++L) {
        const int mx = L % 3, mj = L / 3;
        for (int s = 0; s <= 10; ++s) {
            if ((s == 6 && mx != 2) || (s == 5 && mx == 2) || s == 0 || s == 3 || s == 8) continue;
#ifdef PROBE_REP
            const int pcat = (s == 1 || s == 9) ? 1 : (s == 2 || s == 10 || s == 7) ? 2 : (s == 4) ? 4 : (s == 5) ? 8 : 16; const int nrep = (PROBE_REP & pcat) ? 2 : 1;
#else
            const int nrep = 1;
#endif
            for (int rp = 0; rp < nrep; ++rp) {
            const bool dry = (rp + 1 < nrep); (void)dry;
            PHASE_ENV();
            if (s == 0 || s == 3 || s == 8) {
                continue;
            } else if (s == 1 || s == 2 || s == 4 || s == 7 || s == 9 || s == 10) {
                pg8::Gemm g; pg8::EpiAll E;
                E.mtiles_main = 64; E.O1 = R0; E.O2 = R1; E.O3 = R2; E.ldo = 1024; E.hmain = hmain; E.hmeta = hmeta; E.scale = 1.f; E.qg = a.c_q_norm; E.kg = a.c_k_norm; E.mode = 0;
                E.ssq = SSQ; E.ssq_out = SSQ; E.hb = XN; E.fout = (L == DEPTH - 1 && s == 10 && !dry) ? hmain : nullptr; E.ldsp = (LAS float*)(ldsl + RING_BYTES + 1024); E.rsl = (const LAS float*)(ldsl + RING_BYTES + 5120);
                g.M = MMAIN;
                if (s == 1 || s == 9) { g.A = XN; g.Bt = WGU + (size_t)(L * 2 + (s == 9)) * 5632 * 1024; g.N = 5632; g.K = 1024; E.mode = 0; E.ldo = FF; }
                else if (s == 2 || s == 10) { g.A = R0; g.Bt = WDN + (size_t)(L * 2 + (s == 10)) * 1024 * FF; g.N = 1024; g.K = FF; E.mode = 4; E.scale = dry ? 0.f : 0.5f; }
                else if (s == 4) {
                    g.A = XN; g.K = 1024;
                    if (mx == 0) { g.Bt = WAI + (size_t)mj * 3072 * 1024; g.N = 3072; E.mode = 2; }
                    else if (mx == 1) { g.Bt = WBI; g.N = 2048; E.mode = 1; }
                    else { g.Bt = WCI; g.N = 3072; E.mode = 3;
                    for (int i = gw; i < 2 * 2 * 112; i += NGW) { const int tsel = i / 224, rr = i % 224, b = rr / 112, j = rr % 112; const int row = b * KVROWS + (j < 48 ? j : j + 16);
                        bf16* p = (tsel ? R2 : R1) + (size_t)row * 1024; ((GAS v4u*)p)[lane * 2] = (v4u){zero_, zero_, zero_, zero_}; ((GAS v4u*)p)[lane * 2 + 1] = (v4u){zero_, zero_, zero_, zero_}; }
                        const int fr = lane & 15, fq = lane >> 4;
                        for (int grp = gw; grp < MROWS / 16; grp += NGW) {
                            const bf16* xp = XN + (size_t)(16 * grp + fr) * DM + 8 * fq; const bf16* wp = WFt + (size_t)fr * DM + 8 * fq;
                            f32x4 acc = {0.f, 0.f, 0.f, 0.f};
#pragma unroll 16
                            for (int k = 0; k < 32; ++k) { const bf16x8 xa = *(const GAS bf16x8*)(xp + 32 * k), wb = *(const GAS bf16x8*)(wp + 32 * k);
                                acc = __builtin_amdgcn_mfma_f32_16x16x32_bf16(xa, wb, acc, 0, 0, 0); }
                            const float bf = a.c_b_f[fr]; f32x4 o; float rsr[4];
                            if (grp < MMAIN / 16) {
#pragma unroll
                                for (int r = 0; r < 4; ++r) { const f32x4 q4 = *(const GAS f32x4*)(SSQ + (size_t)(16 * grp + 4 * fq + r) * 4); rsr[r] = __builtin_amdgcn_rsqf(((q4.x + q4.y) + (q4.z + q4.w)) * (1.f / DM) + EPS); }
                            } else {
#pragma unroll
                                for (int r = 0; r < 4; ++r) { float t = 0.f; for (int i = 0; i < 16; ++i) { const f32x4 q4 = *(const GAS f32x4*)(SSQM + (4 * fq + r) * 64 + 4 * i); t += (q4.x + q4.y) + (q4.z + q4.w); } rsr[r] = __builtin_amdgcn_rsqf(t * (1.f / DM) + EPS); }
                            }
#pragma unroll
                            for (int r = 0; r < 4; ++r) { const float xv = acc[r] * rsr[r] + bf; o[r] = fminf(xv, 0.f) - log1pf(expf(-fabsf(xv))); }
                            if (grp < MMAIN / 16) { const int r0 = 16 * grp, b = r0 >> 13, t0 = r0 & 8191; *(GAS f32x4*)(LF + ((size_t)(b * NH + fr) * SEQ + t0 + 4 * fq)) = o; }
                            else *(GAS f32x4*)(LFM + fr * 16 + 4 * fq) = o;
                        }
                        asm volatile("s_waitcnt vmcnt(0) lgkmcnt(0)" ::: "memory"); __syncthreads();
                    }
                }
                else { g.K = 1024; g.N = 1024; E.mode = 4; E.scale = dry ? 0.f : 1.f;
                    if (mx == 0) { g.A = R2; g.Bt = WAO + (size_t)mj * 1024 * 1024; } else if (mx == 1) { g.A = R1; g.Bt = WBO; } else { g.A = R0; g.Bt = WCO; } }
                pg8::StaticOrder S; S.init(g.M, g.N, G, bx);
                f32x4 rs_q[3] = {{0.f, 0.f, 0.f, 0.f}, {0.f, 0.f, 0.f, 0.f}, {0.f, 0.f, 0.f, 0.f}}; bool rs_has[3] = {false, false, false};
                if (E.mode != 4) { pg8::Unit uu{0, 0};
#pragma unroll
                    for (int j = 0; j < 3; ++j) { const int i = (tid >> 8) + 2 * j; rs_has[j] = S.next(i, uu); if (rs_has[j]) rs_q[j] = *(const GAS f32x4*)(SSQ + (size_t)(uu.pm * 256 + (tid & 255)) * 4); } }
                for (int rep2 = 0; rep2 < 2; ++rep2) { const int task = (E.mode == 0) ? ((bx >= 128) ? bx - 128 + 128 * rep2 : -1) : (rep2 == 0 ? vcu : -1);
                    thin_gemm(ldsl, tid, task, g.A, g.Bt, g.K, E.mode, R0, R1, R2, hmeta, E.scale, a.c_q_norm, a.c_k_norm, SSQM, XN); }
                if (E.mode != 4) {
                    LAS float* rsl = (LAS float*)(ldsl + RING_BYTES + 5120);
#pragma unroll
                    for (int j = 0; j < 3; ++j) { const int i = (tid >> 8) + 2 * j; if (rs_has[j]) rsl[i * 256 + (tid & 255)] = __builtin_amdgcn_rsqf(((rs_q[j].x + rs_q[j].y) + (rs_q[j].z + rs_q[j].w)) * (1.f / DM) + EPS); }
                }
#ifndef NO_GEMM
                pg8::gemm_phase<pg8::EpiAll, pg8::StaticOrder, PG8_ALIGN, PG8_SP2>(ldsl, g, S, E, tid);
#endif
                if ((s == 1 || s == 9) && L + 1 < DEPTH && bx >= 128 && !dry) {
                    LAS float* scr = (LAS float*)(ldsl + wave * 16384);
                    const int nv = conv_nv(L + 1), lo = (s == 1) ? 0 : nv / 2, hi = (s == 1) ? nv / 2 : nv;
                    for (int v = lo + (bx - 128) * NWAVES + wave; v < hi; v += 128 * NWAVES) { const int it = conv_item(L + 1, v);
                        CONVERT_BODY
                    }
                }
                if (E.mode == 4) {
                    const int pm0 = 8 * (bx & 7) + ((bx >> 3) & 7), pn0 = bx >> 6;
                    if (G == 256 && tid < 256) { const f32x4 p4 = *(const LAS f32x4*)(E.ldsp + tid * 4); SSQ[(size_t)(pm0 * 256 + tid) * 4 + pn0] = (p4.x + p4.y) + (p4.z + p4.w); }
                }
            } else if (s == 5) {
                if (mx == 0) {
                    const float* cw = a.a_conv + (size_t)mj * 3 * DM + 16 * lane;
                    f32x4 w0[4], w1[4], w2[4];
#pragma unroll
                    for (int j = 0; j < 4; ++j) { w0[j] = *(const f32x4*)(cw + 4 * j); w1[j] = *(const f32x4*)(cw + DM + 4 * j); w2[j] = *(const f32x4*)(cw + 2 * DM + 4 * j); }
                    for (int blk = gw; blk < MROWS / 4; blk += NGW) {
                        const bool mainb = (blk < MMAIN / 4); const int r0 = mainb ? 4 * blk : MMAIN + 4 * (blk - MMAIN / 4);
                        int rm1, rm2;
                        if (mainb) { const int t0 = r0 & 8191; rm1 = (t0 >= 1) ? r0 - 1 : MMAIN + 15; rm2 = (t0 >= 2) ? r0 - 2 : MMAIN + 14; }
                        else { const int p0 = r0 - MMAIN; rm1 = (p0 >= 1) ? r0 - 1 : -1; rm2 = (p0 >= 2) ? r0 - 2 : -1; }
                        const v4u z4 = {0u, 0u, 0u, 0u};
                        v4u xw[6][2], bb[4][2];
#pragma unroll
                        for (int hh = 0; hh < 2; ++hh) {
                            xw[0][hh] = (rm2 >= 0) ? ((const GAS v4u*)(R0 + (size_t)rm2 * DM) + 2 * lane)[hh] : z4; xw[1][hh] = (rm1 >= 0) ? ((const GAS v4u*)(R0 + (size_t)rm1 * DM) + 2 * lane)[hh] : z4;
#pragma unroll
                            for (int i = 0; i < 4; ++i) { xw[2 + i][hh] = ((const GAS v4u*)(R0 + (size_t)(r0 + i) * DM) + 2 * lane)[hh]; bb[i][hh] = ((const GAS v4u*)(R1 + (size_t)(r0 + i) * DM) + 2 * lane)[hh]; } }
#pragma unroll
                        for (int i = 0; i < 4; ++i) { GAS v4u* yp = (GAS v4u*)(R2 + (size_t)(r0 + i) * DM) + 2 * lane;
#pragma unroll
                            for (int hh = 0; hh < 2; ++hh) { v4u o;
#pragma unroll
                                for (int e = 0; e < 4; ++e) { const int j = 2 * hh + (e >> 1), c = 2 * (e & 1);
                                    const float lo = bflo(bb[i][hh][e]) * (w2[j][c] * bflo(xw[2 + i][hh][e]) + w1[j][c] * bflo(xw[1 + i][hh][e]) + w0[j][c] * bflo(xw[i][hh][e]));
                                    const float hi = bfhi(bb[i][hh][e]) * (w2[j][c + 1] * bfhi(xw[2 + i][hh][e]) + w1[j][c + 1] * bfhi(xw[1 + i][hh][e]) + w0[j][c + 1] * bfhi(xw[i][hh][e]));
                                    o[e] = pk2(lo, hi); }
                                yp[hh] = o; } }
                    }
                } else if (mx == 1) {
#ifndef NO_CONF
                    const int c = 2 * tid;
                    f32x2 w[31];
#pragma unroll
                    for (int k = 0; k < 31; ++k) w[k] = *(const GAS f32x2*)(a.b_conv + (size_t)k * DM + c);
                    const f32x2 cb = *(const f32x2*)(a.b_conv_bias + c), lg = *(const f32x2*)(a.b_ln_g + c), lb = *(const f32x2*)(a.b_ln_b + c);
                    LAS float* red = (LAS float*)ldsl;
                    LAS float* red2 = red + 256;
                    for (int un = vcu; un < MROWS / 16; un += G) {
                        const int r0 = 16 * un; const bool meta = (r0 >= MMAIN);
                        const int p0 = meta ? 0 : 16 + (r0 & 8191); const int rowb = meta ? 0 : (r0 >> 13) * SEQ;
                        unsigned xin[46];
#pragma unroll
                        for (int j = 0; j < 46; ++j) { const int pj = p0 - 30 + j;
                            xin[j] = (pj >= 0) ? *(const GAS unsigned*)(R0 + (size_t)((pj < 16) ? MMAIN + pj : rowb + pj - 16) * DM + c) : 0u; }
                        f32x2 acc[16];
#pragma unroll
                        for (int i = 0; i < 16; ++i) acc[i] = cb;
#pragma unroll
                        for (int j = 0; j < 46; ++j) { const f32x2 xv = {bflo(xin[j]), bfhi(xin[j])};
#pragma unroll
                            for (int i = 0; i < 16; ++i) { const int k = j - i; if (k >= 0 && k <= 30) acc[i] += w[k] * xv; } }
                        float st[32];
#pragma unroll
                        for (int i = 0; i < 16; ++i) { st[2 * i] = acc[i].x + acc[i].y; st[2 * i + 1] = acc[i].x * acc[i].x + acc[i].y * acc[i].y; }
#pragma unroll
                        for (int i = 0; i < 32; ++i) st[i] = wave_sum(st[i], lane);
                        if (lane == 0) {
#pragma unroll
                            for (int i = 0; i < 8; ++i) *(LAS f32x4*)(red + wave * 32 + 4 * i) = (f32x4){st[4 * i], st[4 * i + 1], st[4 * i + 2], st[4 * i + 3]}; }
                        __syncthreads();
                        if (tid < 32) { float t = 0.f;
#pragma unroll
                            for (int wv = 0; wv < 8; ++wv) t += red[wv * 32 + tid];
                            red2[tid] = t; }
                        __syncthreads();
#pragma unroll
                        for (int i = 0; i < 16; ++i) { const f32x2 sv = *(const LAS f32x2*)(red2 + 2 * i);
                            const float mu = sv.x * (1.f / DM), var = fmaxf(sv.y * (1.f / DM) - mu * mu, 0.f), rs = 1.0f / sqrtf(var + EPS);
                            const float y0 = (acc[i].x - mu) * rs * lg.x + lb.x, y1 = (acc[i].y - mu) * rs * lg.y + lb.y;
                            *(GAS unsigned*)(R1 + (size_t)(r0 + i) * DM + c) = pk2(y0 * pg8::sigm(y0), y1 * pg8::sigm(y1)); }
                    }
#endif
                } else {
                }
            } else if (s == 6) {
                {
                        const int bh = vcu >> 3, h = bh & 15; LAS float* wt = (LAS float*)ldsl;
                        LAS float* csrow = (LAS float*)(ldsl + attn_body::LDS_CS);
                        float cm = 0.f, cmp = 0.f;
#pragma unroll
                        for (int j = 0; j < 16; ++j) { cm += LFM[h * 16 + j]; if (j == tid) cmp = cm; }
                        const float* lp = LF + (size_t)bh * SEQ + 16 * tid; float v[16];
#pragma unroll
                        for (int j = 0; j < 4; ++j) { const f32x4 q = *(const GAS f32x4*)(lp + 4 * j); v[4 * j] = q.x; v[4 * j + 1] = q.y; v[4 * j + 2] = q.z; v[4 * j + 3] = q.w; }
#pragma unroll
                        for (int j = 1; j < 16; ++j) v[j] += v[j - 1];
                        float inc = v[15];
#pragma unroll
                        for (int o = 1; o < 64; o <<= 1) { const float t = lane_get(inc, (lane - o) & 63); if (lane >= o) inc += t; }
                        if (lane == 63) wt[wave] = inc;
                        __syncthreads();
                        float off = cm + inc - v[15];
                        for (int wv = 0; wv < wave; ++wv) off += wt[wv];
#pragma unroll
                        for (int j = 0; j < 4; ++j) *(LAS f32x4*)(csrow + 128 + 16 * tid + 4 * j) = (f32x4){(off + v[4 * j]) * LOG2E, (off + v[4 * j + 1]) * LOG2E, (off + v[4 * j + 2]) * LOG2E, (off + v[4 * j + 3]) * LOG2E};
                        const float cmsh = lane_get(cmp, (lane + 16) & 63);
                        if (tid < 128) csrow[tid] = (tid >= 48 && tid < 64) ? cmsh * LOG2E : __builtin_inff();
                        __syncthreads();
                }
                const attn_body::AttnTensors AT{(const attn_body::bf16*)R0, (const attn_body::bf16*)R1, (const attn_body::bf16*)R2, (attn_body::bf16*)(dry ? (bf16*)(ws + WS_END) : R0), CS};
                const attn_body::StaticOrder S(G, bx);
#ifndef NO_ATTN
                attn_body::attn_phase<attn_body::StaticOrder>((char*)lds, AT, S, tid);
#endif
                }
                if (s == 6 && !dry) {
                PHASE_ENV();
                if (gw < NH) {
                    const int h = gw, q = lane & 15, dc = lane >> 4;
                    const bf16* qp = R0 + (size_t)(MMAIN + q) * DM + 64 * h + 16 * dc;
                    const v4u qa = ((const GAS v4u*)qp)[0], qb = ((const GAS v4u*)qp)[1];
                    float qv[16];
#pragma unroll
                    for (int e = 0; e < 4; ++e) { qv[2 * e] = bflo(qa[e]); qv[2 * e + 1] = bfhi(qa[e]); qv[8 + 2 * e] = bflo(qb[e]); qv[8 + 2 * e + 1] = bfhi(qb[e]); }
                    float sc[16], cbm[16]; { float run = 0.f;
#pragma unroll
                        for (int j = 0; j < 16; ++j) { run += *(const GAS float*)(LFM + h * 16 + j); cbm[j] = run * LOG2E; } }
#pragma unroll
                    for (int jb = 0; jb < 16; jb += 8) {
                        v4u ka[8], kb[8]; float cb[8];
#pragma unroll
                        for (int j = 0; j < 8; ++j) { const bf16* kp = R1 + (size_t)(48 + jb + j) * DM + 64 * h + 16 * dc; ka[j] = ((const GAS v4u*)kp)[0]; kb[j] = ((const GAS v4u*)kp)[1];
                            cb[j] = cbm[jb + j]; }
#pragma unroll
                        for (int j = 0; j < 8; ++j) { float d = 0.f;
#pragma unroll
                            for (int e = 0; e < 4; ++e) d += qv[2 * e] * bflo(ka[j][e]) + qv[2 * e + 1] * bfhi(ka[j][e]) + qv[8 + 2 * e] * bflo(kb[j][e]) + qv[8 + 2 * e + 1] * bfhi(kb[j][e]);
                            d += lane_get(d, lane ^ 16); d += lane_get(d, lane ^ 32);
                            sc[jb + j] = (jb + j <= q) ? d - cb[j] : -__builtin_inff(); }
                    }
                    float mrun = sc[0];
#pragma unroll
                    for (int j = 1; j < 16; ++j) mrun = fmaxf(mrun, sc[j]);
                    float l = 0.f, o[16];
#pragma unroll
                    for (int e = 0; e < 16; ++e) o[e] = 0.f;
#pragma unroll
                    for (int jb = 0; jb < 16; jb += 8) {
                        v4u va[8], vb[8];
#pragma unroll
                        for (int j = 0; j < 8; ++j) { const bf16* vp = R2 + (size_t)(48 + jb + j) * DM + 64 * h + 16 * dc; va[j] = ((const GAS v4u*)vp)[0]; vb[j] = ((const GAS v4u*)vp)[1]; }
#pragma unroll
                        for (int j = 0; j < 8; ++j) { const float p = __builtin_amdgcn_exp2f(sc[jb + j] - mrun); l += p;
#pragma unroll
                            for (int e = 0; e < 4; ++e) { o[2 * e] += p * bflo(va[j][e]); o[2 * e + 1] += p * bfhi(va[j][e]); o[8 + 2 * e] += p * bflo(vb[j][e]); o[8 + 2 * e + 1] += p * bfhi(vb[j][e]); } }
                    }
                    const float rl = 1.0f / l; v4u oa, ob;
#pragma unroll
                    for (int e = 0; e < 4; ++e) { oa[e] = pk2(o[2 * e] * rl, o[2 * e + 1] * rl); ob[e] = pk2(o[8 + 2 * e] * rl, o[8 + 2 * e + 1] * rl); }
                    GAS v4u* op = (GAS v4u*)(R0 + (size_t)(MMAIN + q) * DM + 64 * h + 16 * dc); op[0] = oa; op[1] = ob;
                }
            }
            { PHASE_ENV();
            xcd_barrier(bar, tid);
#ifdef PROBE_SEL
            if (tid == 0) { const unsigned long long tn = __builtin_amdgcn_s_memrealtime(); const int cat = (s == 1 || s == 9) ? 1 : (s == 2 || s == 10) ? 2 : (s == 4) ? 3 : (s == 5) ? 4 : (s == 6) ? 5 : 6;
              TS[cat] += tn - TS[9]; TS[9] = tn; }
#endif
            }
            }
        }
    }
#ifdef PROBE_SEL
    { PHASE_ENV(); if (bx == 0 && tid == 0) { const unsigned long long t0 = __builtin_amdgcn_s_memrealtime(), span = 4ull * TS[PROBE_SEL];
        while (__builtin_amdgcn_s_memrealtime() - t0 < span) __builtin_amdgcn_s_sleep(8); } }
#endif
}

extern "C" void kernel_launch(void* const* d_in, const int* in_sizes, int n_in, void* d_out, int out_size, void* d_ws, size_t ws_size, hipStream_t stream) {
    static int grid = 0;
    if (grid == 0) {
        if (n_in != 21 || out_size != MMAIN * DM || ws_size < WS_END + SZ_ROWBUF) { fprintf(stderr, "kernel_launch: unexpected shapes (n_in %d out %d ws %zu)\n", n_in, out_size, ws_size); grid = -1; return; }
        int dev = 0, cus = 0, per_cu = 0;
        hipGetDevice(&dev); hipDeviceGetAttribute(&cus, hipDeviceAttributeMultiprocessorCount, dev);
        if (hipFuncSetAttribute((const void*)fwd_megakernel, hipFuncAttributeMaxDynamicSharedMemorySize, LDS_BYTES) != hipSuccess) { fprintf(stderr, "kernel_launch: hipFuncSetAttribute failed\n"); grid = -1; return; }
        if (hipOccupancyMaxActiveBlocksPerMultiprocessor(&per_cu, (const void*)fwd_megakernel, NWAVES * 64, LDS_BYTES) != hipSuccess || per_cu < 1) { fprintf(stderr, "kernel_launch: occupancy query says %d\n", per_cu); per_cu = 1; }
        (void)hipGetLastError();
        grid = cus * 1;
        if (grid != 256) fprintf(stderr, "kernel_launch: grid %d (expected 256)\n", grid);
    }
    if (grid < 0) return;
    if (hipMemsetAsync((char*)d_ws + WS_CTL, 0, CTL_ZERO_BYTES, stream) != hipSuccess) { fprintf(stderr, "kernel_launch: hipMemsetAsync failed\n"); return; }
    Args a{};
    const float** f = (const float**)&a;
    for (int i = 0; i < 21; ++i) f[i] = (const float*)d_in[i];
    a.out = (float*)d_out; a.ws = (unsigned char*)d_ws;
    void* args[] = {&a};
    hipError_t e = hipLaunchCooperativeKernel((const void*)fwd_megakernel, dim3(grid), dim3(NWAVES * 64), args, LDS_BYTES, stream);
    if (e != hipSuccess) fprintf(stderr, "cooperative launch failed: %s (grid %d)\n", hipGetErrorString(e), grid);
}
```

```cpp
#include <hip/hip_runtime.h>
#include <hip/hip_cooperative_groups.h>
#include <cstdio>
#include <cstdint>
namespace pg8 {
#define PG8_LAS __attribute__((address_space(3)))
typedef unsigned short bf16_t;
typedef short bf16x8 __attribute__((ext_vector_type(8)));
typedef float f32x4 __attribute__((ext_vector_type(4)));
typedef unsigned u32x4 __attribute__((ext_vector_type(4)));
constexpr int BM = 256, BK = 64, HALF = 128, HTB = HALF * BK * 2  , STAGE_BYTES = 8 * HTB, NXCD = 8, WGM = 8;

__host__ __device__ __forceinline__ int lds_byte(int r, int c) { const int st = (r >> 4) * 2 + (c >> 5), rr = r & 15, cc = c & 31, ob = rr * 64 + cc * 2; return st * 1024 + (ob ^ (((ob >> 9) & 1) << 5)); }
__host__ __device__ __forceinline__ void stage_rc(int b, int& R, int& C) { const int st = b / 1024, sb = b % 1024, swz = sb ^ (((sb >> 9) & 1) << 5); R = (st >> 1) * 16 + swz / 64; C = (st & 1) * 32 + (swz % 64) / 2; }
__host__ __device__ __forceinline__ int perm32(int rho) { const int n = rho >> 4, i = rho & 15; return 8 * (i >> 2) + 4 * n + (i & 3); }

struct Unit { int pm, pn; };
struct Gemm { const bf16_t* A; const bf16_t* Bt; int M, N, K; };

struct StaticOrder {
    int nM, nN, nwg, G, c;
    __host__ __device__ void init(int M, int N, int G_, int c_) { nM = M / BM; nN = N / BM; nwg = nM * nN; G = G_; c = c_; }
    __host__ __device__ bool next(int i, Unit& u) const {
        const long L = (long)i * G + c; if (L >= nwg) return false;
        int wgid = (int)L; { const int q = nwg / NXCD, r = nwg % NXCD, xcd = wgid % NXCD, off = wgid / NXCD; wgid = (xcd < r ? xcd * (q + 1) : r * (q + 1) + (xcd - r) * q) + off; }
        const int nig = WGM * nN, gid = wgid / nig, fm = gid * WGM, gsz = (nM - fm) < WGM ? (nM - fm) : WGM;
        u.pm = fm + ((wgid % nig) % gsz); u.pn = (wgid % nig) / gsz; return true;
    }
    __device__ __forceinline__ void a_ready(const Unit&) const {}
    __device__ __forceinline__ void done(const Unit&) const {}
};

__device__ __forceinline__ unsigned cvt_pk_bf16(float lo, float hi) { unsigned r; asm volatile("v_cvt_pk_bf16_f32 %0, %1, %2" : "=v"(r) : "v"(lo), "v"(hi)); return r; }
typedef float f32x2 __attribute__((ext_vector_type(2)));
__device__ __forceinline__ float sigm(float x) { return __builtin_amdgcn_rcpf(1.0f + __builtin_amdgcn_exp2f(-1.4426950408889634f * x)); }
constexpr float QK_C2 = 0.125f * 1.4426950408889634f;
#define PG8_GAS __attribute__((address_space(1)))
struct EpiAll {
    static constexpr bool PERM = true, AFTER_DRAIN = false;
    int mode;
    int mtiles_main;
    bf16_t* O1; bf16_t* O2; bf16_t* O3; int ldo;
    float* hmain; float* hmeta; float scale;
    const float* qg; const float* kg;
    const PG8_LAS float* rsl;
    const float* ssq;
    float* ssq_out; bf16_t* hb; float* fout; PG8_LAS float* ldsp;
    __device__ __forceinline__ void operator()(const f32x4 (&acc)[2][2][4][2], const Unit& u, int wr, int wc, int fr, int fq, int ui) const {
        const int rloc_ = wr * 64 + fr;
#define EPI_LAUNDER() int rloc = rloc_; asm volatile("" : "+v"(rloc))
#define EPI_RS() float rsv[2][4]; { const PG8_LAS float* sp_ = rsl + ui * 256 + rloc;     \
    _Pragma("unroll") for (int ai = 0; ai < 2; ++ai) _Pragma("unroll") for (int m = 0; m < 4; ++m) rsv[ai][m] = sp_[ai * HALF + m * 16]; }
        if (mode <= 1 || (mode == 2 && u.pn < 8)) {
            EPI_LAUNDER(); EPI_RS();
            bf16_t* base = O1 + (size_t)(u.pm * BM + rloc) * ldo + u.pn * HALF + wc * 32 + 8 * fq;
#pragma unroll
            for (int ai = 0; ai < 2; ++ai)
#pragma unroll
                for (int m = 0; m < 4; ++m) {
                    const float rs_ = rsv[ai][m]; const f32x4 a0 = acc[ai][0][m][0] * rs_, a1 = acc[ai][0][m][1] * rs_, b0 = acc[ai][1][m][0] * rs_, b1 = acc[ai][1][m][1] * rs_;
                    f32x4 r0, r1;
                    if (mode == 0) {
                        const float ke_ = -1.4426950408889634f * rs_, rs2_ = rs_ * rs_;
                        const f32x4 ga0 = acc[ai][0][m][0], ga1 = acc[ai][0][m][1], gb0 = acc[ai][1][m][0], gb1 = acc[ai][1][m][1];
#pragma unroll
                        for (int i = 0; i < 4; ++i) {
                            r0[i] = (ga0[i] * gb0[i]) * (rs2_ * __builtin_amdgcn_rcpf(1.0f + __builtin_amdgcn_exp2f(ke_ * ga0[i])));
                            r1[i] = (ga1[i] * gb1[i]) * (rs2_ * __builtin_amdgcn_rcpf(1.0f + __builtin_amdgcn_exp2f(ke_ * ga1[i]))); }
                    } else if (mode == 1) {
#pragma unroll
                        for (int i = 0; i < 4; ++i) { r0[i] = a0[i] * sigm(b0[i]); r1[i] = a1[i] * sigm(b1[i]); }
                    } else { r0 = a0 * b0; r1 = a1 * b1; }
                    u32x4 w; w.x = cvt_pk_bf16(r0[0], r0[1]); w.y = cvt_pk_bf16(r0[2], r0[3]); w.z = cvt_pk_bf16(r1[0], r1[1]); w.w = cvt_pk_bf16(r1[2], r1[3]);
                    *(PG8_GAS u32x4*)(base + (size_t)(ai * HALF + m * 16) * ldo) = w;
                }
        } else if (mode == 2) {
            EPI_LAUNDER(); EPI_RS();
            bf16_t* base = O2 + (size_t)(u.pm * BM + rloc) * 1024 + (u.pn - 8) * BM + wc * 32 + 8 * fq;
#pragma unroll
            for (int ai = 0; ai < 2; ++ai)
#pragma unroll
                for (int m = 0; m < 4; ++m)
#pragma unroll
                    for (int bj = 0; bj < 2; ++bj) {
                        const f32x4 v0 = acc[ai][bj][m][0] * rsv[ai][m], v1 = acc[ai][bj][m][1] * rsv[ai][m];
                        u32x4 w; w.x = cvt_pk_bf16(v0[0], v0[1]); w.y = cvt_pk_bf16(v0[2], v0[3]); w.z = cvt_pk_bf16(v1[0], v1[1]); w.w = cvt_pk_bf16(v1[2], v1[3]);
                        *(PG8_GAS u32x4*)(base + (size_t)(ai * HALF + m * 16) * 1024 + bj * HALF) = w;
                    }
        } else if (mode == 3) {
            EPI_LAUNDER(); EPI_RS();
            const int sec = u.pn >> 2;
            const bool meta = false;
            const long krow0 = meta ? 48 : (long)u.pm * BM + 128 * (1 + (u.pm >> 5));
            bf16_t* dst = (sec == 0) ? O1 + (size_t)(u.pm * BM) * 1024 : ((sec == 1) ? O2 : O3) + (size_t)krow0 * 1024;
            const bool dup = meta && sec != 0; const int rlim = dup ? 16 : 256;
            if (sec < 2) {
                const int head = 4 * (u.pn & 3) + wc;
                const int lxor16 = (fr + 16 * (fq ^ 1)) << 2, lxor32 = (fr + 16 * (fq ^ 2)) << 2;
                const float* g = (sec == 0) ? qg : kg; const float gs = (sec == 0) ? QK_C2 : 1.0f;
                f32x4 gv[2][2];
#pragma unroll
                for (int bj = 0; bj < 2; ++bj)
#pragma unroll
                    for (int n = 0; n < 2; ++n) gv[bj][n] = *(const PG8_GAS f32x4*)(g + 32 * bj + 8 * fq + 4 * n) * gs;
#pragma unroll
                for (int ai = 0; ai < 2; ++ai)
#pragma unroll
                    for (int m = 0; m < 4; ++m) {
                        float ss = 0.f;
#pragma unroll
                        for (int bj = 0; bj < 2; ++bj)
#pragma unroll
                            for (int n = 0; n < 2; ++n) { const f32x4 x = acc[ai][bj][m][n] * rsv[ai][m]; ss += (x[0] * x[0] + x[1] * x[1]) + (x[2] * x[2] + x[3] * x[3]); }
                        ss += __builtin_bit_cast(float, __builtin_amdgcn_ds_bpermute(lxor16, __builtin_bit_cast(int, ss))); ss += __builtin_bit_cast(float, __builtin_amdgcn_ds_bpermute(lxor32, __builtin_bit_cast(int, ss)));
                        const float rs = __builtin_amdgcn_rsqf(ss * (1.0f / 64.0f) + 1e-6f) * rsv[ai][m];
                        const int rl = rloc + ai * HALF + m * 16;
#pragma unroll
                        for (int bj = 0; bj < 2; ++bj) {
                            const f32x4 v0 = acc[ai][bj][m][0] * rs * gv[bj][0], v1 = acc[ai][bj][m][1] * rs * gv[bj][1];
                            u32x4 w; w.x = cvt_pk_bf16(v0[0], v0[1]); w.y = cvt_pk_bf16(v0[2], v0[3]); w.z = cvt_pk_bf16(v1[0], v1[1]); w.w = cvt_pk_bf16(v1[2], v1[3]);
                            const int col = 64 * head + 32 * bj + 8 * fq;
                            if (sec == 0) *(PG8_GAS u32x4*)(dst + (size_t)rl * 1024 + col) = w;
                            else *(PG8_GAS u32x4*)(O2 + ((size_t)((u.pm >> 5) * 16 + head) * 130 + (2 + (u.pm & 31) * 4 + (rl >> 6))) * 4096 + (4 * bj + fq) * 512 + (rl & 63) * 8) = w;
                        }
                    }
            } else {
#pragma unroll
                for (int ai = 0; ai < 2; ++ai)
#pragma unroll
                    for (int m = 0; m < 4; ++m) {
                        const int rl = rloc + ai * HALF + m * 16;
#pragma unroll
                        for (int bj = 0; bj < 2; ++bj) {
                            const f32x4 v0 = acc[ai][bj][m][0] * rsv[ai][m], v1 = acc[ai][bj][m][1] * rsv[ai][m];
                            u32x4 w; w.x = cvt_pk_bf16(v0[0], v0[1]); w.y = cvt_pk_bf16(v0[2], v0[3]); w.z = cvt_pk_bf16(v1[0], v1[1]); w.w = cvt_pk_bf16(v1[2], v1[3]);
                            const int col = (u.pn - 8) * BM + bj * HALF + wc * 32 + 8 * fq;
                            (void)col; const int vhead = 4 * (u.pn - 8) + 2 * bj + (wc >> 1);
                            *(PG8_GAS u32x4*)(O3 + ((size_t)((u.pm >> 5) * 16 + vhead) * 130 + (2 + (u.pm & 31) * 4 + (rl >> 6))) * 4096 + (wc & 1) * 2048 + (rl & 63) * 32 + 8 * fq) = w;
                        }
                    }
            }
        } else {
            EPI_LAUNDER();
            bf16_t* hbase = hb + (size_t)(u.pm * BM + rloc) * 1024 + u.pn * BM + wc * 32 + 8 * fq;
            float* fbase = fout ? fout + (size_t)(u.pm * BM + rloc) * 1024 + u.pn * BM + wc * 32 + 8 * fq : nullptr;
            const float sc = scale; const int lx16 = (fr + 16 * (fq ^ 1)) << 2, lx32 = (fr + 16 * (fq ^ 2)) << 2;
#pragma unroll
            for (int ai = 0; ai < 2; ++ai) {
                u32x4 hx[4][2];
#pragma unroll
                for (int m = 0; m < 4; ++m)
#pragma unroll
                    for (int bj = 0; bj < 2; ++bj) hx[m][bj] = *(const PG8_GAS u32x4*)(hbase + (size_t)(ai * HALF + m * 16) * 1024 + bj * HALF);
                asm volatile("" ::: "memory");
#pragma unroll
                for (int m = 0; m < 4; ++m) {
                    float ps = 0.f;
#pragma unroll
                    for (int bj = 0; bj < 2; ++bj) {
                        const u32x4 hw = hx[m][bj];
                        f32x4 x0 = {__builtin_bit_cast(float, hw.x << 16), __builtin_bit_cast(float, hw.x & 0xffff0000u), __builtin_bit_cast(float, hw.y << 16), __builtin_bit_cast(float, hw.y & 0xffff0000u)};
                        f32x4 x1 = {__builtin_bit_cast(float, hw.z << 16), __builtin_bit_cast(float, hw.z & 0xffff0000u), __builtin_bit_cast(float, hw.w << 16), __builtin_bit_cast(float, hw.w & 0xffff0000u)};
                        x0 += acc[ai][bj][m][0] * sc; x1 += acc[ai][bj][m][1] * sc;
                        if (fbase) { float* p = fbase + (size_t)(ai * HALF + m * 16) * 1024 + bj * HALF; *(PG8_GAS f32x4*)p = x0; *(PG8_GAS f32x4*)(p + 4) = x1; }
                        ps += ((x0[0] * x0[0] + x0[1] * x0[1]) + (x0[2] * x0[2] + x0[3] * x0[3])) + ((x1[0] * x1[0] + x1[1] * x1[1]) + (x1[2] * x1[2] + x1[3] * x1[3]));
                        u32x4 w; w.x = cvt_pk_bf16(x0[0], x0[1]); w.y = cvt_pk_bf16(x0[2], x0[3]); w.z = cvt_pk_bf16(x1[0], x1[1]); w.w = cvt_pk_bf16(x1[2], x1[3]);
                        if (!fbase) *(PG8_GAS u32x4*)(hbase + (size_t)(ai * HALF + m * 16) * 1024 + bj * HALF) = w;
                    }
                    ps += __builtin_bit_cast(float, __builtin_amdgcn_ds_bpermute(lx16, __builtin_bit_cast(int, ps))); ps += __builtin_bit_cast(float, __builtin_amdgcn_ds_bpermute(lx32, __builtin_bit_cast(int, ps)));
                    if (fq == 0) ldsp[(rloc + ai * HALF + m * 16) * 4 + wc] = ps;
                }
            }
            asm volatile("s_waitcnt lgkmcnt(0)" ::: "memory");
        }
    }
};
template <class Epi, class Sched, bool ALIGN_EPI = false, bool SP2 = false>
__device__ __forceinline__ void gemm_phase(PG8_LAS unsigned char* lds, const Gemm g, const Sched& S, const Epi& E, const int tid_in) {
    const int tid = tid_in, wid = __builtin_amdgcn_readfirstlane(tid >> 6), lane = tid & 63, wr = wid >> 2, wc = wid & 3, fr = lane & 15, fq = lane >> 4;
    const int K = g.K, nt = K / BK;
    unsigned voffA[2], voffB[2];
#pragma unroll
    for (int i = 0; i < 2; ++i) { int R, C; stage_rc(tid * 16 + i * 8192, R, C); const int Rb = Epi::PERM ? ((R & ~31) + perm32(R & 31)) : R;
        voffA[i] = (unsigned)(R * K + C) * 2u; voffB[i] = (unsigned)(Rb * K + C) * 2u; }
    const size_t kstep = (size_t)(BK * 2);
    const size_t hstep = (size_t)HALF * K * 2;
    const size_t tstep = 2 * hstep;
    const unsigned ldsw = (unsigned)wid * 1024u;
    const int aoff = lds_byte(wr * 64 + fr, fq * 8), boff = lds_byte(wc * 32 + fr, fq * 8);
#define PG8_SA(b, h) (((b) * 2 + (h)) * HTB)
#define PG8_SB(b, h) ((4 + (b) * 2 + (h)) * HTB)
#define PG8_STAGE(bufoff, gbase, voff) do { _Pragma("unroll") for (int _i = 0; _i < 2; ++_i) \
        __builtin_amdgcn_global_load_lds((const unsigned*)((const char*)(gbase) + (voff)[_i]), (PG8_LAS unsigned*)(lds + (bufoff) + ldsw + _i * 8192), 16, 0, 0); } while (0)
#define PG8_LDA(dst, b, h) do { _Pragma("unroll") for (int m = 0; m < 4; ++m) _Pragma("unroll") for (int k = 0; k < 2; ++k) dst[m][k] = *(const PG8_LAS bf16x8*)(lds + PG8_SA(b, h) + aoff + m * 2048 + k * 1024); } while (0)
#define PG8_LDB(dst, b, h) do { _Pragma("unroll") for (int n = 0; n < 2; ++n) _Pragma("unroll") for (int k = 0; k < 2; ++k) dst[n][k] = *(const PG8_LAS bf16x8*)(lds + PG8_SB(b, h) + boff + n * 2048 + k * 1024); } while (0)
#define PG8_MMA(ai, bj, At, Bt) do { __builtin_amdgcn_s_setprio(1); _Pragma("unroll") for (int m = 0; m < 4; ++m) _Pragma("unroll") for (int n = 0; n < 2; ++n) _Pragma("unroll") for (int k = 0; k < 2; ++k) \
        acc[ai][bj][m][n] = __builtin_amdgcn_mfma_f32_16x16x32_bf16(Bt[n][k], At[m][k], acc[ai][bj][m][n], 0, 0, 0); __builtin_amdgcn_s_setprio(0); } while (0)
#define PG8_WAIT_V(n) asm volatile("s_waitcnt vmcnt(" #n ")" ::: "memory")
#define PG8_WAIT_L(n) asm volatile("s_waitcnt lgkmcnt(" #n ")" ::: "memory")
#define PG8_BAR __builtin_amdgcn_s_barrier()
#define PG8_SCHED __builtin_amdgcn_sched_barrier(0)
    Unit cur, nxt; int ui = 0;
    if (!S.next(0, cur)) return;
    f32x4 acc[2][2][4][2];
#pragma unroll
    for (int a = 0; a < 2; ++a)
#pragma unroll
        for (int b = 0; b < 2; ++b)
#pragma unroll
            for (int m = 0; m < 4; ++m)
#pragma unroll
                for (int n = 0; n < 2; ++n) acc[a][b][m][n] = (f32x4){0.f, 0.f, 0.f, 0.f};
    bf16x8 At[4][2], B0[2][2], B1[2][2];
    const char* cA = (const char*)g.A + (size_t)cur.pm * tstep; const char* cB = (const char*)g.Bt + (size_t)cur.pn * tstep;
    S.a_ready(cur);
    if constexpr (SP2) {
        PG8_STAGE(PG8_SB(0, 0), cB, voffB); PG8_STAGE(PG8_SB(0, 1), cB + hstep, voffB); PG8_STAGE(PG8_SA(0, 0), cA, voffA); PG8_STAGE(PG8_SA(0, 1), cA + hstep, voffA);
        if (wr == 1) PG8_BAR;
        PG8_WAIT_V(2); PG8_BAR;
        PG8_STAGE(PG8_SB(1, 0), cB + kstep, voffB); PG8_STAGE(PG8_SA(1, 0), cA + kstep, voffA); PG8_STAGE(PG8_SB(1, 1), cB + hstep + kstep, voffB);
        PG8_WAIT_V(6); PG8_BAR;
    } else {
        PG8_STAGE(PG8_SB(0, 0), cB, voffB); PG8_STAGE(PG8_SA(0, 0), cA, voffA); PG8_STAGE(PG8_SB(0, 1), cB + hstep, voffB); PG8_STAGE(PG8_SA(0, 1), cA + hstep, voffA);
        if (wr == 1) PG8_BAR;
        PG8_WAIT_V(4); PG8_BAR;
        PG8_STAGE(PG8_SB(1, 0), cB + kstep, voffB); PG8_STAGE(PG8_SA(1, 0), cA + kstep, voffA); PG8_STAGE(PG8_SB(1, 1), cB + hstep + kstep, voffB);
        PG8_WAIT_V(6); PG8_BAR;
    }
    for (;;) {
        const bool has_next = S.next(ui + 1, nxt);
        const char* nA = has_next ? (const char*)g.A + (size_t)nxt.pm * tstep : cA; const char* nB = has_next ? (const char*)g.Bt + (size_t)nxt.pn * tstep : cB;
        for (int t = 0; t < nt; t += 2) {
            const bool last = (t == nt - 2);
            const char* a1 = cA + (size_t)(t + 1) * kstep;
            const char* a2 = last ? nA : cA + (size_t)(t + 2) * kstep; const char* b2 = last ? nB : cB + (size_t)(t + 2) * kstep;
            const char* a3 = a2 + kstep; const char* b3 = b2 + kstep;
            if (last && has_next) S.a_ready(nxt);
            if constexpr (SP2) {
            PG8_LDB(B0, 0, 0); PG8_LDB(B1, 0, 1); PG8_SCHED; PG8_LDA(At, 0, 0); PG8_STAGE(PG8_SA(1, 1), a1 + hstep, voffA);
            PG8_WAIT_V(8); PG8_WAIT_L(0); PG8_BAR; PG8_MMA(0, 0, At, B0); PG8_MMA(0, 1, At, B1); PG8_BAR; PG8_SCHED;
            PG8_LDA(At, 0, 1); PG8_STAGE(PG8_SB(0, 0), b2, voffB); PG8_STAGE(PG8_SB(0, 1), b2 + hstep, voffB); PG8_STAGE(PG8_SA(0, 0), a2, voffA);
            PG8_WAIT_V(8); PG8_WAIT_L(0); PG8_BAR; PG8_MMA(1, 0, At, B0); PG8_MMA(1, 1, At, B1); PG8_BAR; PG8_SCHED;
            PG8_LDB(B0, 1, 0); PG8_LDB(B1, 1, 1); PG8_SCHED; PG8_LDA(At, 1, 0); PG8_STAGE(PG8_SA(0, 1), a2 + hstep, voffA);
            PG8_WAIT_V(8); PG8_WAIT_L(0); PG8_BAR; PG8_MMA(0, 0, At, B0); PG8_MMA(0, 1, At, B1); PG8_BAR; PG8_SCHED;
            PG8_LDA(At, 1, 1); PG8_STAGE(PG8_SB(1, 0), b3, voffB); PG8_STAGE(PG8_SB(1, 1), b3 + hstep, voffB); PG8_STAGE(PG8_SA(1, 0), a3, voffA);
            PG8_WAIT_V(8); PG8_WAIT_L(0); PG8_BAR; PG8_MMA(1, 0, At, B0); PG8_MMA(1, 1, At, B1); PG8_BAR; PG8_SCHED;
            } else {
            PG8_LDB(B0, 0, 0); PG8_SCHED; PG8_LDA(At, 0, 0); PG8_STAGE(PG8_SA(1, 1), a1 + hstep, voffA);
            PG8_WAIT_L(8); PG8_BAR; PG8_WAIT_L(0); PG8_MMA(0, 0, At, B0); PG8_BAR; PG8_SCHED;
            PG8_LDB(B1, 0, 1); PG8_STAGE(PG8_SB(0, 0), b2, voffB);
            PG8_BAR; PG8_WAIT_L(0); PG8_MMA(0, 1, At, B1); PG8_BAR;
            PG8_LDA(At, 0, 1); PG8_STAGE(PG8_SA(0, 0), a2, voffA);
            PG8_BAR; PG8_WAIT_L(0); PG8_MMA(1, 0, At, B0); PG8_BAR; PG8_SCHED;
            PG8_STAGE(PG8_SB(0, 1), b2 + hstep, voffB);
            PG8_WAIT_V(6); PG8_BAR; PG8_MMA(1, 1, At, B1); PG8_BAR;
            PG8_LDB(B0, 1, 0); PG8_SCHED; PG8_LDA(At, 1, 0); PG8_STAGE(PG8_SA(0, 1), a2 + hstep, voffA);
            PG8_WAIT_L(8); PG8_BAR; PG8_WAIT_L(0); PG8_MMA(0, 0, At, B0); PG8_BAR; PG8_SCHED;
            PG8_LDB(B1, 1, 1); PG8_STAGE(PG8_SB(1, 0), b3, voffB);
            PG8_BAR; PG8_WAIT_L(0); PG8_MMA(0, 1, At, B1); PG8_BAR;
            PG8_LDA(At, 1, 1); PG8_STAGE(PG8_SA(1, 0), a3, voffA);
            PG8_BAR; PG8_WAIT_L(0); PG8_MMA(1, 0, At, B0); PG8_BAR; PG8_SCHED;
            PG8_STAGE(PG8_SB(1, 1), b3 + hstep, voffB);
            PG8_WAIT_V(6); PG8_BAR; PG8_MMA(1, 1, At, B1); PG8_BAR;
            }
        }
        if constexpr (ALIGN_EPI) { if (wr == 0) PG8_BAR; }
        if constexpr (!Epi::AFTER_DRAIN) { E(acc, cur, wr, wc, fr, fq, ui); S.done(cur); }
        if (!has_next) break;
#pragma unroll
        for (int a = 0; a < 2; ++a)
#pragma unroll
            for (int b = 0; b < 2; ++b)
#pragma unroll
                for (int m = 0; m < 4; ++m)
#pragma unroll
                    for (int n = 0; n < 2; ++n) acc[a][b][m][n] = (f32x4){0.f, 0.f, 0.f, 0.f};
        cur = nxt; cA = nA; cB = nB; ++ui;
        if constexpr (ALIGN_EPI) { if (wr == 1) PG8_BAR; }
    }
    PG8_WAIT_V(0);
    if constexpr (!ALIGN_EPI) { if (wr == 0) PG8_BAR; }
    PG8_BAR;
    if constexpr (Epi::AFTER_DRAIN) { E.fused(acc, cur, wr, wc, fr, fq, lds, wid, lane); S.done(cur); }
#undef PG8_SA
#undef PG8_SB
#undef PG8_STAGE
#undef PG8_LDA
#undef PG8_LDB
#undef PG8_MMA
#undef PG8_WAIT_V
#undef PG8_WAIT_L
#undef PG8_BAR
#undef PG8_SCHED
}
}

#ifndef PG8_SP2
#define PG8_SP2 true
#endif
#ifndef PG8_ALIGN
#define PG8_ALIGN true
#endif
#include <hip/hip_bf16.h>
#include <cmath>
namespace attn_body {
using bf16=__hip_bfloat16;
using bf16x8=__attribute__((ext_vector_type(8)))short;
using s16x4=__attribute__((ext_vector_type(4)))short;
using f32x16=__attribute__((ext_vector_type(16)))float;
using u32x4=__attribute__((ext_vector_type(4)))unsigned;
constexpr int BATCH=2,NHEAD=16,SEQ=8192,D=64,DM=NHEAD*D;
constexpr int NW=8,QBLK=32,QB=QBLK*NW,KVBLK=64,NQB=SEQ/QB; constexpr int KVPAD=128,KVROWS=SEQ+KVPAD;
constexpr int ATTN_PITCH=DM, ATTN_UNIT_ROWS=QB;
__device__ __forceinline__ int crow(int r,int hi){return (r&3)+8*(r>>2)+4*hi;}
#define SBAR() __builtin_amdgcn_sched_barrier(0)
__device__ __forceinline__ void cmask(f32x16&p0,f32x16&p1,int jb,int qrel,int hi){
  const float NEG=-INFINITY; int kb=64*jb+4*hi;
  #pragma unroll
  for(int r=0;r<16;++r){int kv=kb+(r&3)+8*(r>>2); if(kv>qrel)p0[r]=NEG; if(kv+32>qrel)p1[r]=NEG;}
}

constexpr int NSLOT=3, SLOTB=8192;
constexpr int LDS_K=0, LDS_V=NSLOT*SLOTB, LDS_WS=2*NSLOT*SLOTB, LDS_OST=LDS_WS+NW*64*4, LDS_CS=LDS_OST+NW*4096, LDS_BYTES=LDS_CS+KVROWS*4;
constexpr float C2=0.125f*1.4426950408889634f;
__device__ __forceinline__ void glds16(const void*gsrc,unsigned lds_dst){unsigned keep;
  asm volatile("s_mov_b32 %0, m0\n\ts_mov_b32 m0, %2\n\ts_nop 0\n\tglobal_load_lds_dwordx4 %1, off\n\ts_mov_b32 m0, %0":"=&s"(keep):"v"(gsrc),"s"(lds_dst):"memory");}
__device__ __forceinline__ float max3f(float a,float b,float c){float r;asm("v_max3_f32 %0, %1, %2, %3":"=v"(r):"v"(a),"v"(b),"v"(c));return r;}
__device__ __forceinline__ float max2f(float a,float b){float r;asm("v_max_f32_e32 %0, %1, %2":"=v"(r):"v"(a),"v"(b));return r;}
__device__ __forceinline__ float fadd_s(float a,float b){float r;asm("v_add_f32_e32 %0, %1, %2":"=v"(r):"v"(a),"v"(b));return r;}
__device__ __forceinline__ float fsub_s(float a,float b){float r;asm("v_sub_f32_e32 %0, %1, %2":"=v"(r):"v"(a),"v"(b));return r;}
typedef float f32x2_t __attribute__((ext_vector_type(2))); typedef __bf16 bf16x2_t __attribute__((ext_vector_type(2)));
__device__ __forceinline__ unsigned cvtpk_s(float lo,float hi){f32x2_t v={lo,hi};bf16x2_t b=__builtin_convertvector(v,bf16x2_t);return __builtin_bit_cast(unsigned,b);}
#define WAIT_BAR(N) asm volatile("s_waitcnt vmcnt(" #N ") lgkmcnt(0)\n\ts_barrier":::"memory")

__device__ __forceinline__ void qkt(f32x16&p0,f32x16&p1,const char*Kslot,const bf16x8*qr,int r32,int hi){
  const char*kb=Kslot+hi*1024+r32*16;
  #pragma unroll
  for(int d0=0;d0<4;++d0){
    const bf16x8 b0=*reinterpret_cast<const bf16x8*>(kb+d0*2048);
    const bf16x8 b1=*reinterpret_cast<const bf16x8*>(kb+d0*2048+512);
    p0=__builtin_amdgcn_mfma_f32_32x32x16_bf16(b0,qr[d0],p0,0,0,0);p1=__builtin_amdgcn_mfma_f32_32x32x16_bf16(b1,qr[d0],p1,0,0,0);}
}
typedef __attribute__((address_space(3))) const char* lds_cptr;
typedef short v4i16_t __attribute__((ext_vector_type(4))); typedef float f32x4_t __attribute__((ext_vector_type(4)));
__device__ __forceinline__ void kload8(bf16x8*kf,lds_cptr kp){
  kf[0]=*(const __attribute__((address_space(3))) bf16x8*)(kp);      kf[1]=*(const __attribute__((address_space(3))) bf16x8*)(kp+512);
  kf[2]=*(const __attribute__((address_space(3))) bf16x8*)(kp+2048); kf[3]=*(const __attribute__((address_space(3))) bf16x8*)(kp+2560);
  kf[4]=*(const __attribute__((address_space(3))) bf16x8*)(kp+4096); kf[5]=*(const __attribute__((address_space(3))) bf16x8*)(kp+4608);
  kf[6]=*(const __attribute__((address_space(3))) bf16x8*)(kp+6144); kf[7]=*(const __attribute__((address_space(3))) bf16x8*)(kp+6656);
}
__device__ __forceinline__ void kload2(bf16x8*kf,lds_cptr kp,int j){ kf[2*j]=*(const __attribute__((address_space(3))) bf16x8*)(kp+j*2048); kf[2*j+1]=*(const __attribute__((address_space(3))) bf16x8*)(kp+j*2048+512); }
__device__ __forceinline__ s16x4 vtr(lds_cptr p){ return __builtin_bit_cast(s16x4,__builtin_amdgcn_ds_read_tr16_b64_v4i16((__attribute__((address_space(3))) v4i16_t*)p)); }
__device__ __forceinline__ float rowmax(const f32x16&p0,const f32x16&p1){
  float a=max3f(p0[0],p0[1],p1[0]),b=max3f(p0[2],p0[3],p1[1]);a=max3f(a,p1[2],p1[3]);
  #pragma unroll
  for(int r=4;r<16;r+=4){a=max3f(a,p0[r],p0[r+1]);b=max3f(b,p0[r+2],p0[r+3]);a=max3f(a,p1[r],p1[r+1]);b=max3f(b,p1[r+2],p1[r+3]);}
  const float m=max2f(a,b);
  auto rr=__builtin_amdgcn_permlane32_swap(__float_as_uint(m),__float_as_uint(m),false,false);
  return max2f(__uint_as_float(rr[0]),__uint_as_float(rr[1]));
}
__device__ __forceinline__ void pv(f32x16*o,int vb,bf16x8 pa0,bf16x8 pa1,bf16x8 pa2,bf16x8 pa3){
  #pragma unroll
  for(int d0=0;d0<2;++d0){s16x4 lo[4],hi[4];
    #pragma unroll
    for(int ks=0;ks<4;++ks){
      asm volatile("ds_read_b64_tr_b16 %0,%1 offset:%c2":"=&v"(lo[ks]):"v"(vb),"i"(d0*4096+ks*1024):"memory");
      asm volatile("ds_read_b64_tr_b16 %0,%1 offset:%c2":"=&v"(hi[ks]):"v"(vb),"i"(d0*4096+ks*1024+512):"memory");}
    asm volatile("s_waitcnt lgkmcnt(0)":::"memory");SBAR();
    #define PK(k) (bf16x8){lo[k][0],lo[k][1],lo[k][2],lo[k][3],hi[k][0],hi[k][1],hi[k][2],hi[k][3]}
    o[d0]=__builtin_amdgcn_mfma_f32_32x32x16_bf16(pa0,PK(0),o[d0],0,0,0);
    o[d0]=__builtin_amdgcn_mfma_f32_32x32x16_bf16(pa1,PK(1),o[d0],0,0,0);
    o[d0]=__builtin_amdgcn_mfma_f32_32x32x16_bf16(pa2,PK(2),o[d0],0,0,0);
    o[d0]=__builtin_amdgcn_mfma_f32_32x32x16_bf16(pa3,PK(3),o[d0],0,0,0);
    #undef PK
  }
}

#ifndef ATTN_STORE16
#define ATTN_STORE16(p,v) (*(__attribute__((address_space(1))) u32x4*)(p)=(v))
#endif
template<int THRL> __device__ __forceinline__ void attn_unit(int b,int h,int qb,const bf16*Q,const bf16*__restrict__ K,const bf16*__restrict__ V,bf16*O,const float*__restrict__ CS,char*shm,const int tid_in){
  const int tid=tid_in,lane=tid&63,r32=lane&31,hi=lane>>5; const int wid=__builtin_amdgcn_readfirstlane(tid>>6);
  const long rowbase=(long)b*SEQ, kvbase=(long)b*KVROWS; const int q0=qb*QB;
  const bf16*Qw=Q+(rowbase+q0+wid*QBLK)*DM+h*D;
  (void)kvbase; const bf16*Kh=K+(long)(b*NHEAD+h)*(KVROWS/KVBLK)*4096,*Vh=V+(long)(b*NHEAD+h)*(KVROWS/KVBLK)*4096;
  const unsigned lds0=(unsigned)(uintptr_t)shm;
  float*wsf=(float*)(shm+LDS_WS)+wid*64;
  const bf16*ksrc=Kh+wid*512+lane*8;
  const bf16*vsrc=Vh+wid*512+lane*8;
  const unsigned kdst=lds0+LDS_K+wid*1024, vdst=lds0+LDS_V+wid*1024;
  #define DMA_K(t,slot) glds16(ksrc+(long)(t)*4096,(unsigned)__builtin_amdgcn_readfirstlane(kdst+(slot)))
  #define DMA_V(t,slot) glds16(vsrc+(long)(t)*4096,(unsigned)__builtin_amdgcn_readfirstlane(vdst+(slot)))
  const int vb0=(int)(lds0+LDS_V)+((lane>>4)&1)*32+(lane&3)*8+(4*hi+((lane&15)>>2))*64;
  const char*Kbase=shm+LDS_K; bf16x8 kf[8];
  const lds_cptr shm3=(lds_cptr)shm; const lds_cptr kp0=shm3+LDS_K+hi*1024+r32*16; const lds_cptr vp0=shm3+LDS_V+((lane>>4)&1)*32+(lane&3)*8+(4*hi+((lane&15)>>2))*64;
  const int NT=(q0+QB+KVPAD)/KVBLK;
  DMA_K(0,0);DMA_V(0,0);DMA_K(1,SLOTB);
  bf16x8 qr[4];
  #pragma unroll
  for(int d0=0;d0<4;++d0)qr[d0]=*(const __attribute__((address_space(1))) bf16x8*)(&Qw[(long)r32*DM+d0*16+hi*8]);
  float mhat=0.f,l_reg=0.f;f32x16 o[2];o[0]=f32x16{};o[1]=f32x16{};
  const __attribute__((address_space(3))) float*csl=(const __attribute__((address_space(3))) float*)((lds_cptr)shm+LDS_CS)+4*hi;
  #define BIASINIT(C0,C1,t) do{ const __attribute__((address_space(3))) float*bp_=csl+64*(t); const float nm_=-mhat; \
    _Pragma("unroll") for(int g_=0;g_<4;++g_){ const f32x4_t a_=*(const __attribute__((address_space(3))) f32x4_t*)(bp_+8*g_), b_=*(const __attribute__((address_space(3))) f32x4_t*)(bp_+32+8*g_); \
      C0[4*g_]=nm_-a_[0];C0[4*g_+1]=nm_-a_[1];C0[4*g_+2]=nm_-a_[2];C0[4*g_+3]=nm_-a_[3]; C1[4*g_]=nm_-b_[0];C1[4*g_+1]=nm_-b_[1];C1[4*g_+2]=nm_-b_[2];C1[4*g_+3]=nm_-b_[3]; } }while(0)
  #define BIASLOAD(C0,C1,t) do{ const __attribute__((address_space(3))) float*bp_=csl+64*(t); \
    _Pragma("unroll") for(int g_=0;g_<4;++g_){ const f32x4_t a_=*(const __attribute__((address_space(3))) f32x4_t*)(bp_+8*g_), b_=*(const __attribute__((address_space(3))) f32x4_t*)(bp_+32+8*g_); \
      C0[4*g_]=a_[0];C0[4*g_+1]=a_[1];C0[4*g_+2]=a_[2];C0[4*g_+3]=a_[3]; C1[4*g_]=b_[0];C1[4*g_+1]=b_[1];C1[4*g_+2]=b_[2];C1[4*g_+3]=b_[3]; } }while(0)
  const int qrel=wid*QBLK+r32;
  #define CMASK(P0,P1,t) do{int jb_=(t)-(NT-4); if(jb_>=0)cmask(P0,P1,jb_,qrel,hi);}while(0)
  bool resc=false;
  #define START(P0,P1) do{ const float rm=rowmax(P0,P1); resc=false; \
    { const float dl=rm; mhat=fadd_s(mhat,dl); \
      _Pragma("unroll") for(int r=0;r<16;++r){P0[r]=fsub_s(P0[r],dl);P1[r]=fsub_s(P1[r],dl);} \
      } \
    _Pragma("unroll") for(int r=0;r<16;++r)P0[r]=__builtin_amdgcn_exp2f(P0[r]); }while(0)
  #define RESC() do{ if(resc){ asm volatile("s_waitcnt lgkmcnt(0)":::"memory"); \
      _Pragma("unroll") for(int d_=0;d_<2;++d_) _Pragma("unroll") for(int r=0;r<16;++r)o[d_][r]*=wsf[crow(r,hi)]; } }while(0)
  f32x16 pA0,pA1,pB0,pB1;
  int sl_prev=0,sl_cur=0,sl_next=SLOTB;
  #define ROT() do{sl_prev=sl_cur;sl_cur=sl_next;sl_next=(sl_next==(NSLOT-1)*SLOTB)?0:sl_next+SLOTB;}while(0)
  DMA_K(2,2*SLOTB);
  WAIT_BAR(3);
  BIASINIT(pA0,pA1,0); qkt(pA0,pA1,Kbase,qr,r32,hi);asm volatile("s_nop 15\n\ts_nop 7":"+v"(pA0),"+v"(pA1));
  START(pA0,pA1);
  _Pragma("unroll") for(int r=0;r<16;++r)pA1[r]=__builtin_amdgcn_exp2f(pA1[r]);
  WAIT_BAR(0);
  DMA_K(3,0);DMA_V(1,SLOTB);
  ROT();
  kload8(kf,kp0+sl_cur);
  WAIT_BAR(2);
  s16x4 vlo[8],vhi[8]; u32x4 pw0,pw1,pw2,pw3;
  #define PKW(P,B) cvtpk_s(P[B],P[B+1])
  #define PAF(k) __builtin_bit_cast(bf16x8,pw##k)
  #define VFR(i) (bf16x8){vlo[i][0],vlo[i][1],vlo[i][2],vlo[i][3],vhi[i][0],vhi[i][1],vhi[i][2],vhi[i][3]}
  #define PIN(x) asm volatile("":"+v"(x))
  #define MX3(a,b,c) __builtin_fmaxf(__builtin_fmaxf((a),(b)),(c))
  #define GAPA(MF,A0,A1,A2,A3,W0,W1,PW) do{ MF; sacc+=A0; sacc+=A1; sacc+=A2; sacc+=A3; PIN(sacc); W0; W1; PIN(PW); SBAR(); }while(0)
  #define EX(v) __builtin_amdgcn_exp2f(v)
  #define GAPB(MF,X,B,NX) do{ MF; X[B]=EX(X[B]); X[B+1]=EX(X[B+1]); X[B+2]=EX(X[B+2]); X[B+3]=EX(X[B+3]); NX[B]=fsub_s(nm_,NX[B]); NX[B+1]=fsub_s(nm_,NX[B+1]); NX[B+2]=fsub_s(nm_,NX[B+2]); NX[B+3]=fsub_s(nm_,NX[B+3]); PIN(X); PIN(NX); SBAR(); }while(0)
  #define VRD(i) do{ vlo[i]=vtr(vp_+(((i)>>2)*4096+((i)&3)*1024)); vhi[i]=vtr(vp_+(((i)>>2)*4096+((i)&3)*1024+512)); }while(0)
  #define KRD(G,j) do{ if(G){ kload2(kf,kp0+sl_next,j); SBAR(); } }while(0)
  #define STEP(C0,C1,P0,P1,t,GK,GV,GL) do{ SBAR(); \
    const lds_cptr vp_=vp0+sl_prev; \
    VRD(0); SBAR(); float sacc=(P0[0]+P0[1]); \
    GAPA(C0=__builtin_amdgcn_mfma_f32_32x32x16_bf16(kf[0],qr[0],C0,0,0,0), P0[2],P0[3],P0[4],P0[5],     pw0[0]=PKW(P0,0), pw0[1]=PKW(P0,2), pw0); \
    VRD(4); SBAR(); GAPA(C1=__builtin_amdgcn_mfma_f32_32x32x16_bf16(kf[1],qr[0],C1,0,0,0), P0[6],P0[7],P0[8],P0[9],     pw0[2]=PKW(P0,4), pw0[3]=PKW(P0,6), pw0); \
    VRD(1); SBAR(); GAPA(C0=__builtin_amdgcn_mfma_f32_32x32x16_bf16(kf[2],qr[1],C0,0,0,0),   P0[10],P0[11],P0[12],P0[13], pw1[0]=PKW(P0,8), pw1[1]=PKW(P0,10), pw1); \
    VRD(5); SBAR(); GAPA(C1=__builtin_amdgcn_mfma_f32_32x32x16_bf16(kf[3],qr[1],C1,0,0,0),   P0[14],P0[15],P1[0],P1[1],   pw1[2]=PKW(P0,12),pw1[3]=PKW(P0,14), pw1); \
    VRD(2); SBAR(); GAPA(C0=__builtin_amdgcn_mfma_f32_32x32x16_bf16(kf[4],qr[2],C0,0,0,0),   P1[2],P1[3],P1[4],P1[5],     pw2[0]=PKW(P1,0), pw2[1]=PKW(P1,2), pw2); \
    VRD(6); SBAR(); GAPA(C1=__builtin_amdgcn_mfma_f32_32x32x16_bf16(kf[5],qr[2],C1,0,0,0),   P1[6],P1[7],P1[8],P1[9],     pw2[2]=PKW(P1,4), pw2[3]=PKW(P1,6), pw2); \
    VRD(3); SBAR(); GAPA(C0=__builtin_amdgcn_mfma_f32_32x32x16_bf16(kf[6],qr[3],C0,0,0,0),   P1[10],P1[11],P1[12],P1[13], pw3[0]=PKW(P1,8), pw3[1]=PKW(P1,10), pw3); \
    VRD(7); SBAR(); GAPA(C1=__builtin_amdgcn_mfma_f32_32x32x16_bf16(kf[7],qr[3],C1,0,0,0),   P1[14],P1[15],0.f,0.f,       pw3[2]=PKW(P1,12),pw3[3]=PKW(P1,14), pw3); \
    l_reg+=sacc; \
    BIASLOAD(P0,P1,(t)+1); \
    if(GK){DMA_K((t)+3,sl_cur);} if(GV){DMA_V((t)+1,sl_next);} \
    CMASK(C0,C1,t); \
    { float a=MX3(C0[0],C0[1],C1[0]),b=MX3(C0[2],C0[3],C1[1]); a=MX3(a,C1[2],C1[3]); \
      _Pragma("unroll") for(int r=4;r<16;r+=4){a=MX3(a,C0[r],C0[r+1]);b=MX3(b,C0[r+2],C0[r+3]);a=MX3(a,C1[r],C1[r+1]);b=MX3(b,C1[r+2],C1[r+3]);} \
      float rm=__builtin_fmaxf(a,b); { auto rr=__builtin_amdgcn_permlane32_swap(__float_as_uint(rm),__float_as_uint(rm),false,false); rm=__builtin_fmaxf(__uint_as_float(rr[0]),__uint_as_float(rr[1])); } \
      resc=false; \
      if(__builtin_expect(__any(rm>(float)THRL),0)){ const float dl=__builtin_fmaxf(rm,0.f); mhat+=dl; \
        _Pragma("unroll") for(int r=0;r<16;++r){C0[r]-=dl;C1[r]-=dl;} \
        const float f=__builtin_amdgcn_exp2f(-dl); l_reg*=f; if(hi==0)wsf[r32]=f; resc=true; } } \
    SBAR(); const float nm_=-mhat; \
    GAPB(o[0]=__builtin_amdgcn_mfma_f32_32x32x16_bf16(PAF(0),VFR(0),o[0],0,0,0), C0,0,P0); \
    GAPB(o[1]=__builtin_amdgcn_mfma_f32_32x32x16_bf16(PAF(0),VFR(4),o[1],0,0,0), C0,4,P0); \
    KRD(GL,0); GAPB(o[0]=__builtin_amdgcn_mfma_f32_32x32x16_bf16(PAF(1),VFR(1),o[0],0,0,0), C0,8,P0); \
    KRD(GL,1); GAPB(o[1]=__builtin_amdgcn_mfma_f32_32x32x16_bf16(PAF(1),VFR(5),o[1],0,0,0), C0,12,P0); \
    KRD(GL,2); GAPB(o[0]=__builtin_amdgcn_mfma_f32_32x32x16_bf16(PAF(2),VFR(2),o[0],0,0,0), C1,0,P1); \
    KRD(GL,3); GAPB(o[1]=__builtin_amdgcn_mfma_f32_32x32x16_bf16(PAF(2),VFR(6),o[1],0,0,0), C1,4,P1); \
    GAPB(o[0]=__builtin_amdgcn_mfma_f32_32x32x16_bf16(PAF(3),VFR(3),o[0],0,0,0), C1,8,P1); \
    GAPB(o[1]=__builtin_amdgcn_mfma_f32_32x32x16_bf16(PAF(3),VFR(7),o[1],0,0,0), C1,12,P1); \
    }while(0)
  BIASINIT(pB0,pB1,1);
  int t=1;
  #undef CMASK
  #define CMASK(P0,P1,t) do{}while(0)
  for(;t+5<NT;t+=2){
    STEP(pB0,pB1,pA0,pA1,t,true,true,true);     WAIT_BAR(2); RESC(); ROT();
    STEP(pA0,pA1,pB0,pB1,t+1,true,true,true);   WAIT_BAR(2); RESC(); ROT();
  }
  #undef CMASK
  #define CMASK(P0,P1,t) do{int jb_=(t)-(NT-4); if(jb_>=0)cmask(P0,P1,jb_,qrel,hi);}while(0)
  #define ENDW(tt) do{ if((tt)+3<NT){WAIT_BAR(2);} else if((tt)+2<NT){WAIT_BAR(1);} else {WAIT_BAR(0);} }while(0)
  for(;t+1<NT;t+=2){
    STEP(pB0,pB1,pA0,pA1,t,(t+3<NT),(t+1<NT),(t+1<NT));       ENDW(t);   RESC(); ROT();
    STEP(pA0,pA1,pB0,pB1,t+1,(t+4<NT),(t+2<NT),(t+2<NT));     ENDW(t+1); RESC(); ROT();
  }
  STEP(pB0,pB1,pA0,pA1,NT-1,false,false,false); RESC();
  { float sacc=pB0[0]+pB0[1]; _Pragma("unroll") for(int r=2;r<16;++r)sacc+=pB0[r]; _Pragma("unroll") for(int r=0;r<16;++r)sacc+=pB1[r]; l_reg+=sacc;
    pw0=(u32x4){PKW(pB0,0),PKW(pB0,2),PKW(pB0,4),PKW(pB0,6)};pw1=(u32x4){PKW(pB0,8),PKW(pB0,10),PKW(pB0,12),PKW(pB0,14)};pw2=(u32x4){PKW(pB1,0),PKW(pB1,2),PKW(pB1,4),PKW(pB1,6)};pw3=(u32x4){PKW(pB1,8),PKW(pB1,10),PKW(pB1,12),PKW(pB1,14)};
    SBAR(); pv(o,vb0+sl_cur,PAF(0),PAF(1),PAF(2),PAF(3)); }
  #undef PKW
  #undef PAF
  #undef VFR
  #undef PIN
  #undef MX3
  #undef GAPA
  #undef GAPB
  #undef EX
  #undef VRD
  #undef KRD
  #undef STEP
  #undef ENDW
  {auto rr=__builtin_amdgcn_permlane32_swap(__float_as_uint(l_reg),__float_as_uint(l_reg),false,false);l_reg=__uint_as_float(rr[0])+__uint_as_float(rr[1]);}
  if(hi==0)wsf[32+r32]=l_reg;asm volatile("s_waitcnt lgkmcnt(0)":::"memory");
  float rli[16];
  #pragma unroll
  for(int r=0;r<16;++r)rli[r]=__builtin_amdgcn_rcpf(wsf[32+crow(r,hi)]);
  bf16*Ow=O+(rowbase+q0+wid*QBLK)*DM+h*D;
  { bf16*stg=(bf16*)(shm+LDS_OST)+wid*2048;
    #pragma unroll
    for(int r=0;r<16;++r){const int orow=crow(r,hi);
      #pragma unroll
      for(int d0=0;d0<2;++d0)stg[orow*64+d0*32+r32]=__float2bfloat16(o[d0][r]*rli[r]);}
    asm volatile("s_waitcnt lgkmcnt(0)":::"memory");
    #pragma unroll
    for(int i=0;i<4;++i){const int row=i*8+(lane>>3),ch=lane&7; const u32x4 v=*(const u32x4*)(stg+row*64+ch*8); ATTN_STORE16(Ow+(long)row*DM+ch*8,v);} }
  asm volatile("s_waitcnt lgkmcnt(0)\n\ts_barrier":::"memory");
  #undef DMA_K
  #undef DMA_V
  #undef CMASK
  #undef START
  #undef RESC
  #undef ROT
  #undef BIASINIT
  #undef BIASLOAD
}
constexpr int ATTN_LDS_BYTES=LDS_BYTES;
struct AttnTensors { const bf16* Q; const bf16* K; const bf16* V; bf16* O; const float* CS; };
struct AttnUnit { int bh; int qb; };
struct StaticOrder {
  int vcu;
  __device__ __forceinline__ explicit StaticOrder(int grid,int block):vcu((block%8)*(grid/8)+block/8){}
  __device__ __forceinline__ bool next(int i,AttnUnit&u)const{ if(i>=4)return false; const int s=vcu&7; u.bh=vcu>>3; u.qb=(i==0)?s:(i==1)?15-s:(i==2)?16+s:31-s; return true; }
  __device__ __forceinline__ void a_ready(const AttnUnit&)const{}
  __device__ __forceinline__ void done(const AttnUnit&)const{}
};
template<class Sched,int THRL=96> __device__ __forceinline__ void attn_phase(char*lds,const AttnTensors&T,const Sched&S,const int tid_in){
  AttnUnit u;
  for(int i=0;S.next(i,u);++i){ S.a_ready(u); attn_unit<THRL>(u.bh/NHEAD,u.bh%NHEAD,u.qb,T.Q,T.K,T.V,T.O,T.CS,lds,tid_in); S.done(u); }
}
#undef SBAR
#undef WAIT_BAR
}
#define LAS __attribute__((address_space(3)))
#define XB_TMO      128
#define XB_XCNT(j)  (256  + 64 * (j))
#define XB_XSUB(j)  (1280 + 64 * (j))
#define XB_XGEN(j)  (2304 + 64 * (j))
#define XB_TOP      3328
#define XB_TOPGEN   3392
#define XCD_BAR_WORDS 3456
#define XB_SPIN_CAP (1u << 18)

__device__ __forceinline__ unsigned xb_ld(unsigned* p)              { return __hip_atomic_load(p, __ATOMIC_RELAXED, __HIP_MEMORY_SCOPE_AGENT); }
__device__ __forceinline__ unsigned xb_add(unsigned* p, unsigned v) { return __hip_atomic_fetch_add(p, v, __ATOMIC_RELAXED, __HIP_MEMORY_SCOPE_AGENT); }
__device__ __forceinline__ unsigned xb_xcc_id() { return (unsigned)__builtin_amdgcn_s_getreg((3 << 11) | 20) & 0xFu; }
#define XB_SPIN(cond, bar) do { unsigned _sp = 0; while (cond) { __builtin_amdgcn_s_sleep(1); \
    if ((++_sp & 255u) == 0u) { if (xb_ld(&(bar)[XB_TMO])) break; if (_sp > XB_SPIN_CAP) { atomicAdd(&(bar)[XB_TMO], 1u); break; } } } } while (0)

struct XcdBarrier {
    unsigned* bar; unsigned x;
    volatile LAS unsigned* st;
};

__device__ __forceinline__ XcdBarrier xcd_barrier_post(unsigned* bar, volatile LAS unsigned* st, const int tid) {
    XcdBarrier b; b.bar = bar; b.x = xb_xcc_id(); b.st = st;
    if (tid == 0) (void)xb_add(&bar[XB_XCNT(b.x)], 1u);
    return b;
}
__device__ __forceinline__ void xcd_barrier_complete(unsigned* bar, unsigned x, unsigned& nloc, unsigned& nx) {
    const unsigned G = gridDim.x * gridDim.y * gridDim.z;
    unsigned sum, cnt, mine, sp = 0u;
    for (;;) {
        sum = 0u; cnt = 0u; mine = 0u;
#pragma unroll
        for (unsigned j = 0; j < 16; ++j) { const unsigned c = xb_ld(&bar[XB_XCNT(j)]); sum += c; cnt += (c > 0u) ? 1u : 0u; mine = (j == x) ? c : mine; }
        if (sum == G) break;
        __builtin_amdgcn_s_sleep(1);
        if ((++sp & 255u) == 0u) { if (xb_ld(&bar[XB_TMO])) break; if (sp > XB_SPIN_CAP) { atomicAdd(&bar[XB_TMO], 1u); break; } }
    }
    nloc = mine > 0u ? mine : 1u; nx = cnt > 0u ? cnt : 1u;
}

__device__ __forceinline__ void xcd_barrier(const XcdBarrier& b, const int tid) {
    asm volatile("s_waitcnt vmcnt(0)" ::: "memory");
    __syncthreads();
    if (tid == 0) {
        unsigned* bar = b.bar; asm volatile("" : "+s"(bar)); unsigned bx_ = (unsigned)__builtin_amdgcn_readfirstlane((int)b.x); asm volatile("" : "+s"(bx_));
        __builtin_amdgcn_s_waitcnt(0);
        unsigned nloc = b.st[0], nx = b.st[1];
        if (nloc == 0u) { xcd_barrier_complete(bar, bx_, nloc, nx); b.st[0] = nloc; b.st[1] = nx; }
        const unsigned old = xb_add(&bar[XB_XSUB(bx_)], 1u);
        const unsigned gen = old / nloc;
        if (old + 1u == (gen + 1u) * nloc) {
            __builtin_amdgcn_fence(__ATOMIC_RELEASE, "agent");
            asm volatile("s_waitcnt vmcnt(0)" ::: "memory");
            const unsigned og = xb_add(&bar[XB_TOP], 1u);
            const unsigned tg = og / nx;
            if (og + 1u == (tg + 1u) * nx) xb_add(&bar[XB_TOPGEN], 1u);
            else XB_SPIN(xb_ld(&bar[XB_TOPGEN]) == tg, bar);
            __builtin_amdgcn_fence(__ATOMIC_ACQUIRE, "agent");
            xb_add(&bar[XB_XGEN(bx_)], 1u);
            asm volatile("s_waitcnt vmcnt(0)" ::: "memory");
        } else {
            XB_SPIN(xb_ld(&bar[XB_XGEN(bx_)]) == gen, bar);
            __builtin_amdgcn_fence(__ATOMIC_ACQUIRE, "agent");
            asm volatile("s_waitcnt vmcnt(0)" ::: "memory");
        }
    }
    __syncthreads();
}
namespace cg = cooperative_groups;
constexpr int NWAVES = 8;
constexpr int DM = 1024, FF = 2816, NH = 16, SEQ = 8192, NMETA = 16, DEPTH = 4;
constexpr int MMAIN = 2 * SEQ;
constexpr int MROWS = MMAIN + NMETA;
constexpr int MPAD = 65 * 256;
constexpr int KVROWS = attn_body::KVROWS;
constexpr float EPS = 1e-6f, LOG2E = 1.4426950408889634f;

constexpr size_t MiB = 1u << 20;
constexpr size_t SZ_GU = (size_t)5632 * 1024 * 2, SZ_DN = (size_t)1024 * 2816 * 2;
constexpr size_t WS_CTL = 0, CTL_ZERO_BYTES = 16384;
constexpr size_t WS_WGU = 1 * MiB, WS_WDN = WS_WGU + 8 * SZ_GU;
constexpr size_t WS_WAI = WS_WDN + 8 * SZ_DN, WS_WAO = WS_WAI + 2 * 6 * MiB, WS_WBI = WS_WAO + 2 * 2 * MiB, WS_WBO = WS_WBI + 4 * MiB;
constexpr size_t WS_WCI = WS_WBO + 2 * MiB, WS_WCO = WS_WCI + 6 * MiB, WS_WF = WS_WCO + 2 * MiB;
constexpr size_t WS_XN = WS_WF + 1 * MiB;
constexpr size_t SZ_ROWBUF = (size_t)MPAD * 1024 * 2;
constexpr size_t WS_ACT = WS_XN + 33 * MiB;
constexpr size_t WS_HMETA = WS_ACT + 98 * MiB, WS_LF = WS_HMETA + 1 * MiB, WS_LFM = WS_LF + 1 * MiB, WS_CS = WS_LFM + 1 * MiB, WS_SSQ = WS_CS + 2 * MiB, WS_SSQM = WS_SSQ + 1 * MiB, WS_END = WS_SSQM + 1 * MiB;
static_assert(SZ_ROWBUF <= 33 * MiB && 3 * SZ_ROWBUF <= 98 * MiB && (size_t)MPAD * FF * 2 <= 98 * MiB, "ws map");

constexpr int RING_BYTES = 131072, LDS_BYTES = 147456;
static_assert(attn_body::ATTN_LDS_BYTES <= RING_BYTES, "attention LDS");
constexpr int MISC_OFF = RING_BYTES + 320;

#define GAS __attribute__((address_space(1)))
typedef unsigned short bf16;
typedef unsigned v4u __attribute__((ext_vector_type(4)));
typedef unsigned v2u __attribute__((ext_vector_type(2)));
typedef float f32x4 __attribute__((ext_vector_type(4)));
typedef float f32x2 __attribute__((ext_vector_type(2)));
typedef short bf16x8 __attribute__((ext_vector_type(8)));
#define LDS_WAIT() asm volatile("s_waitcnt lgkmcnt(0)" ::: "memory")
__device__ __forceinline__ unsigned f2bf(float f) { unsigned u = __builtin_bit_cast(unsigned, f); return (u + 0x7fffu + ((u >> 16) & 1u)) >> 16; }
__device__ __forceinline__ unsigned pk2(float lo, float hi) { return f2bf(lo) | (f2bf(hi) << 16); }
__device__ __forceinline__ float bflo(unsigned w) { return __builtin_bit_cast(float, w << 16); }
__device__ __forceinline__ float bfhi(unsigned w) { return __builtin_bit_cast(float, w & 0xffff0000u); }
__device__ __forceinline__ float lane_get(float v, int src_lane) { return __builtin_bit_cast(float, __builtin_amdgcn_ds_bpermute(src_lane << 2, __builtin_bit_cast(int, v))); }
__device__ __forceinline__ float wave_sum(float v, int lane) {
#pragma unroll
    for (int o = 1; o < 64; o <<= 1) v += lane_get(v, lane ^ o);
    return v;
}

struct Args {
    const float* x; const float* meta; const float* ffn_norm; const float* ffn_w_gate; const float* ffn_w_up; const float* ffn_w_down; const float* mix_norm;
    const float* a_w_in; const float* a_conv; const float* a_w_out;
    const float* b_w_in; const float* b_conv; const float* b_conv_bias; const float* b_ln_g; const float* b_ln_b; const float* b_w_out;
    const float* c_w_in; const float* c_b_f; const float* c_q_norm; const float* c_k_norm; const float* c_w_out;
    float* out; unsigned char* ws;
};

__device__ __forceinline__ void transpose_item(const float* src, int Nsrc, bf16* dst, int K, int kb, LAS float* scr, int lane, const float* gain = nullptr) {
    const int k0 = 64 * kb;
    const GAS float* sp = (const GAS float*)src + (size_t)(k0 + (lane >> 5)) * Nsrc + (lane & 31);
    float v[32];
#pragma unroll
    for (int i = 0; i < 32; ++i) v[i] = sp[(size_t)(2 * i) * Nsrc];
    const int c = lane & 7;
    f32x4 g0 = {1.f, 1.f, 1.f, 1.f}, g1 = g0;
    if (gain) { g0 = *(const GAS f32x4*)(gain + k0 + 8 * c); g1 = *(const GAS f32x4*)(gain + k0 + 8 * c + 4); }
#pragma unroll
    for (int i = 0; i < 32; ++i) scr[(2 * i + (lane >> 5)) * 33 + (lane & 31)] = v[i];
    LDS_WAIT(); asm volatile("" ::: "memory");
#pragma unroll
    for (int j = 0; j < 4; ++j) { const int n = (lane >> 3) + 8 * j; const LAS float* s = scr + (8 * c) * 33 + n;
        v4u o; o.x = pk2(s[0 * 33] * g0.x, s[1 * 33] * g0.y); o.y = pk2(s[2 * 33] * g0.z, s[3 * 33] * g0.w); o.z = pk2(s[4 * 33] * g1.x, s[5 * 33] * g1.y); o.w = pk2(s[6 * 33] * g1.z, s[7 * 33] * g1.w);
        *(GAS v4u*)(dst + (size_t)n * K + k0 + 8 * c) = o; }
    LDS_WAIT(); asm volatile("" ::: "memory");
}

__device__ __forceinline__ float hb_row(const float* xrow, bf16* orow, int lane) {
    const GAS f32x4* xr = (const GAS f32x4*)xrow + lane;
    f32x4 v[4]; float s = 0.f;
#pragma unroll
    for (int j = 0; j < 4; ++j) { v[j] = xr[64 * j]; s += (v[j].x * v[j].x + v[j].y * v[j].y) + (v[j].z * v[j].z + v[j].w * v[j].w); }
    GAS unsigned long long* o8 = (GAS unsigned long long*)orow + lane;
#pragma unroll
    for (int j = 0; j < 4; ++j) o8[64 * j] = (unsigned long long)pk2(v[j].x, v[j].y) | ((unsigned long long)pk2(v[j].z, v[j].w) << 32);
    return wave_sum(s, lane);
}

constexpr int I_GU = 176 * 16, I_DN = 32 * 44, I_AI = 96 * 16, I_SQ = 32 * 16, I_BI = 64 * 16, I_CI = 96 * 16;
constexpr int I_FFN = 2 * I_GU + 2 * I_DN, I_MIXBASE = 8 * I_GU + 8 * I_DN;
static_assert(I_CI == I_AI, "conv_nv");
__device__ __forceinline__ int conv_nv(int L) { return I_FFN + ((L == 1) ? I_BI + I_SQ : I_AI + I_SQ); }
__device__ __forceinline__ int conv_item(int L, int v) {
    if (v < 2 * I_GU) return 2 * L * I_GU + v;
    if (v < I_FFN) return 8 * I_GU + 2 * L * I_DN + (v - 2 * I_GU);
    const int w = v - I_FFN;
    if (L == 0) return (w < I_AI) ? I_MIXBASE + w : I_MIXBASE + 2 * I_AI + (w - I_AI);
    if (L == 3) return (w < I_AI) ? I_MIXBASE + I_AI + w : I_MIXBASE + 2 * I_AI + I_SQ + (w - I_AI);
    if (L == 1) return I_MIXBASE + 2 * I_AI + 2 * I_SQ + w;
    return I_MIXBASE + 2 * I_AI + 2 * I_SQ + I_BI + I_SQ + w;
}
#define CONVERT_BODY \
            int r = it; \
            if (r < 8 * I_GU) { const int mat = r / I_GU; r %= I_GU; const int kb = r / 176, nb = r % 176, pn = nb >> 3, q = nb & 7; \
                const float* src = ((q < 4) ? a.ffn_w_gate : a.ffn_w_up) + (size_t)mat * 1024 * FF + 128 * pn + 32 * (q & 3); \
                transpose_item(src, FF, WGU + (size_t)mat * 5632 * 1024 + (size_t)nb * 32 * 1024, 1024, kb, scr, lane, a.ffn_norm + (size_t)mat * DM); continue; } \
            r -= 8 * I_GU; \
            if (r < 8 * I_DN) { const int mat = r / I_DN; r %= I_DN; const int kb = r / 32, nb = r % 32; \
                transpose_item(a.ffn_w_down + (size_t)mat * FF * 1024 + 32 * nb, 1024, WDN + (size_t)mat * 1024 * FF + (size_t)nb * 32 * FF, FF, kb, scr, lane); continue; } \
            r -= 8 * I_DN; \
            if (r < 2 * I_AI) { const int mat = r / I_AI; r %= I_AI; const int kb = r / 96, nb = r % 96, pn = nb >> 3, q = nb & 7; \
                const int scol = (pn < 8) ? ((q < 4) ? 1024 + 128 * pn + 32 * q : 2048 + 128 * pn + 32 * (q - 4)) : (nb - 64) * 32; \
                transpose_item(a.a_w_in + (size_t)mat * 1024 * 3072 + scol, 3072, WAI + (size_t)mat * 3072 * 1024 + (size_t)nb * 32 * 1024, 1024, kb, scr, lane, a.mix_norm + (size_t)(3 * mat) * DM); continue; } \
            r -= 2 * I_AI; \
            if (r < 2 * I_SQ) { const int mat = r / I_SQ; r %= I_SQ; const int kb = r / 32, nb = r % 32; \
                transpose_item(a.a_w_out + (size_t)mat * 1024 * 1024 + 32 * nb, 1024, WAO + (size_t)mat * 1024 * 1024 + (size_t)nb * 32 * 1024, 1024, kb, scr, lane); continue; } \
            r -= 2 * I_SQ; \
            if (r < I_BI) { const int kb = r / 64, nb = r % 64, pn = nb >> 3, q = nb & 7; \
                const int scol = (q < 4) ? 128 * pn + 32 * q : 1024 + 128 * pn + 32 * (q - 4); \
                transpose_item(a.b_w_in + scol, 2048, WBI + (size_t)nb * 32 * 1024, 1024, kb, scr, lane, a.mix_norm + (size_t)1 * DM); continue; } \
            r -= I_BI; \
            if (r < I_SQ) { const int kb = r / 32, nb = r % 32; \
                transpose_item(a.b_w_out + 32 * nb, 1024, WBO + (size_t)nb * 32 * 1024, 1024, kb, scr, lane); continue; } \
            r -= I_SQ; \
            if (r < I_CI) { const int kb = r / 96, nb = r % 96, pn = nb >> 3, q = nb & 7; \
                const int scol = (pn < 8) ? (pn >> 2) * 1024 + 64 * (4 * (pn & 3) + (q & 3)) + 32 * (q >> 2) : 2048 + (nb - 64) * 32; \
                transpose_item(a.c_w_in + scol, 3088, WCI + (size_t)nb * 32 * 1024, 1024, kb, scr, lane, a.mix_norm + (size_t)2 * DM); continue; } \
            r -= I_CI; \
            { const int kb = r / 32, nb = r % 32; \
                transpose_item(a.c_w_out + 32 * nb, 1024, WCO + (size_t)nb * 32 * 1024, 1024, kb, scr, lane); }

__device__ __forceinline__ void thin_gemm(LAS unsigned char* ldsl, const int tid, const int task, const bf16* A, const bf16* Bt, const int K, const int mode,
                                          bf16* R0, bf16* R1, bf16* R2, float* hmeta, const float scale, const float* qg, const float* kg, float* SSQM, bf16* HB) {
    const int ntasks = (mode == 0) ? 176 : (mode == 2) ? 128 : (mode == 3) ? 48 : 64;
    if (task < 0 || task >= ntasks) return;
    v2u ho_pre = {0u, 0u}; if (mode == 4) ho_pre = *(const GAS v2u*)(HB + (size_t)(MMAIN + (tid & 15)) * 1024 + 16 * task + 4 * ((tid & 63) >> 4));
    float rsm_t = 0.f;
    if (mode != 4) {
#pragma unroll
        for (int i = 0; i < 16; ++i) { const f32x4 q4 = *(const GAS f32x4*)(SSQM + (tid & 15) * 64 + 4 * i); rsm_t += (q4.x + q4.y) + (q4.z + q4.w); } }
    const int lane = tid & 63, wave = __builtin_amdgcn_readfirstlane(tid >> 6), fr = lane & 15, fq = lane >> 4;
    int nt = 1, b0 = 0, b1 = 0, b2 = 0, b3 = 0;
    if (mode <= 1 || (mode == 2 && task < 64)) { const int f0 = 16 * task; b0 = 256 * (f0 >> 7) + (f0 & 127); b1 = b0 + 128; nt = 2; }
    else if (mode == 2) { b0 = 2048 + 16 * (task - 64); }
    else if (mode == 3) { const int sec = task >> 4, hd = task & 15; nt = 4;
        if (sec < 2) { b0 = 256 * (sec * 4 + (hd >> 2)) + 32 * (hd & 3); b1 = b0 + 16; b2 = b0 + 128; b3 = b0 + 144; }
        else { b0 = 2048 + 64 * hd; b1 = b0 + 16; b2 = b0 + 32; b3 = b0 + 48; } }
    else { b0 = 16 * task; }
    const int kw = K >> 3, ksteps = kw >> 5;
    const GAS bf16x8* ap = (const GAS bf16x8*)(A + (size_t)(MMAIN + fr) * K + wave * kw + 8 * fq);
    const GAS bf16x8* p0 = (const GAS bf16x8*)(Bt + (size_t)(b0 + fr) * K + wave * kw + 8 * fq);
    const GAS bf16x8* p1 = (const GAS bf16x8*)(Bt + (size_t)(b1 + fr) * K + wave * kw + 8 * fq);
    const GAS bf16x8* p2 = (const GAS bf16x8*)(Bt + (size_t)(b2 + fr) * K + wave * kw + 8 * fq);
    const GAS bf16x8* p3 = (const GAS bf16x8*)(Bt + (size_t)(b3 + fr) * K + wave * kw + 8 * fq);
    f32x4 c0 = {0.f, 0.f, 0.f, 0.f}, c1 = c0, c2 = c0, c3 = c0;
    if (ksteps > 4) {
        bf16x8 xa[11], wb[11];
#pragma unroll
        for (int ks = 0; ks < 11; ++ks) { xa[ks] = ap[4 * ks]; wb[ks] = p0[4 * ks]; }
#pragma unroll
        for (int ks = 0; ks < 11; ++ks) c0 = __builtin_amdgcn_mfma_f32_16x16x32_bf16(wb[ks], xa[ks], c0, 0, 0, 0);
    } else {
#pragma unroll 4
    for (int ks = 0; ks < ksteps; ++ks) {
        const bf16x8 xa = ap[4 * ks];
        c0 = __builtin_amdgcn_mfma_f32_16x16x32_bf16(p0[4 * ks], xa, c0, 0, 0, 0);
        if (nt >= 2) c1 = __builtin_amdgcn_mfma_f32_16x16x32_bf16(p1[4 * ks], xa, c1, 0, 0, 0);
        if (nt >= 4) { c2 = __builtin_amdgcn_mfma_f32_16x16x32_bf16(p2[4 * ks], xa, c2, 0, 0, 0); c3 = __builtin_amdgcn_mfma_f32_16x16x32_bf16(p3[4 * ks], xa, c3, 0, 0, 0); }
    }
    }
    LAS f32x4* P = (LAS f32x4*)ldsl;
    P[(wave * 4 + 0) * 64 + lane] = c0; P[(wave * 4 + 1) * 64 + lane] = c1; P[(wave * 4 + 2) * 64 + lane] = c2; P[(wave * 4 + 3) * 64 + lane] = c3;
    __syncthreads();
    if (wave == 0) {
#pragma unroll
        for (int w = 1; w < 8; ++w) { c0 += P[(w * 4 + 0) * 64 + lane]; c1 += P[(w * 4 + 1) * 64 + lane]; c2 += P[(w * 4 + 2) * 64 + lane]; c3 += P[(w * 4 + 3) * 64 + lane]; }
        const size_t mrow = (size_t)(MMAIN + fr);
        if (mode != 4) { const float rsm = __builtin_amdgcn_rsqf(rsm_t * (1.f / DM) + EPS); c0 *= rsm; c1 *= rsm; c2 *= rsm; c3 *= rsm; }
        if (mode <= 1 || (mode == 2 && task < 64)) {
            f32x4 r;
            if (mode == 0) {
#pragma unroll
                for (int i = 0; i < 4; ++i) r[i] = c0[i] * pg8::sigm(c0[i]) * c1[i];
            } else if (mode == 1) {
#pragma unroll
                for (int i = 0; i < 4; ++i) r[i] = c0[i] * pg8::sigm(c1[i]);
            } else r = c0 * c1;
            *(GAS v2u*)(R0 + mrow * (mode == 0 ? FF : 1024) + 16 * task + 4 * fq) = (v2u){pk2(r[0], r[1]), pk2(r[2], r[3])};
        } else if (mode == 2) {
            *(GAS v2u*)(R1 + mrow * 1024 + 16 * (task - 64) + 4 * fq) = (v2u){pk2(c0[0], c0[1]), pk2(c0[2], c0[3])};
        } else if (mode == 3) {
            const int sec = task >> 4, hd = task & 15;
            f32x4 v0 = c0, v1 = c1, v2 = c2, v3 = c3;
            if (sec < 2) {
                float ss = (c0[0] * c0[0] + c0[1] * c0[1]) + (c0[2] * c0[2] + c0[3] * c0[3]) + (c1[0] * c1[0] + c1[1] * c1[1]) + (c1[2] * c1[2] + c1[3] * c1[3])
                         + (c2[0] * c2[0] + c2[1] * c2[1]) + (c2[2] * c2[2] + c2[3] * c2[3]) + (c3[0] * c3[0] + c3[1] * c3[1]) + (c3[2] * c3[2] + c3[3] * c3[3]);
                ss += lane_get(ss, lane ^ 16); ss += lane_get(ss, lane ^ 32);
                const float rs = __builtin_amdgcn_rsqf(ss * (1.0f / 64.0f) + EPS) * ((sec == 0) ? pg8::QK_C2 : 1.0f);
                const float* g = (sec == 0) ? qg : kg;
                v0 = c0 * rs * *(const GAS f32x4*)(g + 4 * fq); v1 = c1 * rs * *(const GAS f32x4*)(g + 16 + 4 * fq); v2 = c2 * rs * *(const GAS f32x4*)(g + 32 + 4 * fq); v3 = c3 * rs * *(const GAS f32x4*)(g + 48 + 4 * fq);
            }
            const v2u w0 = {pk2(v0[0], v0[1]), pk2(v0[2], v0[3])}, w1 = {pk2(v1[0], v1[1]), pk2(v1[2], v1[3])}, w2 = {pk2(v2[0], v2[1]), pk2(v2[2], v2[3])}, w3 = {pk2(v3[0], v3[1]), pk2(v3[2], v3[3])};
            const int col = 64 * hd + 4 * fq;
            if (sec == 0) { bf16* q = R0 + mrow * 1024 + col; *(GAS v2u*)q = w0; *(GAS v2u*)(q + 16) = w1; *(GAS v2u*)(q + 32) = w2; *(GAS v2u*)(q + 48) = w3; }
            else { bf16* T = (sec == 1) ? R1 : R2;
#pragma unroll
                for (int b = 0; b < 2; ++b) { bf16* tb = T + (size_t)((b * NH + hd) * 130) * 4096; (void)col;
                    if (sec == 1) { bf16* q = tb + (size_t)(fq >> 1) * 512 + (48 + fr) * 8 + 4 * (fq & 1); *(GAS v2u*)q = w0; *(GAS v2u*)(q + 1024) = w1; *(GAS v2u*)(q + 2048) = w2; *(GAS v2u*)(q + 3072) = w3; }
                    else { bf16* q = tb + (size_t)(48 + fr) * 32 + 4 * fq; *(GAS v2u*)q = w0; *(GAS v2u*)(q + 16) = w1; *(GAS v2u*)(q + 2048) = w2; *(GAS v2u*)(q + 2048 + 16) = w3; } } }
        } else {
            const v2u ho = ho_pre;
            const f32x4 hn = (f32x4){bflo(ho.x), bfhi(ho.x), bflo(ho.y), bfhi(ho.y)} + c0 * scale;
            *(GAS v2u*)(HB + mrow * 1024 + 16 * task + 4 * fq) = (v2u){pk2(hn[0], hn[1]), pk2(hn[2], hn[3])};
            float ps = (hn[0] * hn[0] + hn[1] * hn[1]) + (hn[2] * hn[2] + hn[3] * hn[3]); ps += lane_get(ps, lane ^ 16); ps += lane_get(ps, lane ^ 32);
            if (fq == 0) SSQM[fr * 64 + task] = ps;
        }
    }
    __syncthreads();
}

__global__ void __launch_bounds__(NWAVES * 64, 2) fwd_megakernel(Args a_unused) {
    extern __shared__ __attribute__((aligned(16))) unsigned char lds[];
    cg::grid_group grid = cg::this_grid();
    const int G = gridDim.x, bx = blockIdx.x;
    const int vcu0 = (G % 8 == 0) ? (bx % 8) * (G / 8) + bx / 8 : bx;
    const int NGW = G * NWAVES;
    if (threadIdx.x < 64) ((LAS unsigned*)((LAS unsigned char*)lds + RING_BYTES))[threadIdx.x * 2] = 0u, ((LAS unsigned*)((LAS unsigned char*)lds + RING_BYTES))[threadIdx.x * 2 + 1] = 0u;
    __syncthreads();
    const int wave_s = __builtin_amdgcn_readfirstlane((int)threadIdx.x >> 6);
#define PHASE_ENV() \
    const __attribute__((address_space(4))) Args* kap_ = (const __attribute__((address_space(4))) Args*)__builtin_amdgcn_kernarg_segment_ptr(); asm volatile("" : "+s"(kap_)); \
    const __attribute__((address_space(4))) Args& a = *kap_;     \
    unsigned zero_ = 0u; asm volatile("" : "+s"(zero_)); int vcu = vcu0; asm volatile("" : "+s"(vcu)); \
    int tid = (wave_s << 6) | (int)__builtin_amdgcn_mbcnt_hi(~0u, __builtin_amdgcn_mbcnt_lo(~0u, zero_)); \
    const int lane = tid & 63, wave = __builtin_amdgcn_readfirstlane(tid >> 6), gw = vcu * NWAVES + wave; \
    unsigned char* ws0_ = a.ws; asm volatile("" : "+s"(ws0_)); unsigned char* const ws = (unsigned char*)(GAS unsigned char*)ws0_;     \
    float* hm0_ = a.out; asm volatile("" : "+s"(hm0_)); float* const hmain = (float*)(GAS float*)hm0_; \
    bf16* const WGU = (bf16*)(ws + WS_WGU); bf16* const WDN = (bf16*)(ws + WS_WDN); \
    bf16* const WAI = (bf16*)(ws + WS_WAI); bf16* const WAO = (bf16*)(ws + WS_WAO); bf16* const WBI = (bf16*)(ws + WS_WBI); bf16* const WBO = (bf16*)(ws + WS_WBO); \
    bf16* const WCI = (bf16*)(ws + WS_WCI); bf16* const WCO = (bf16*)(ws + WS_WCO); bf16* const WFt = (bf16*)(ws + WS_WF); \
    bf16* const XN = (bf16*)(ws + WS_XN); \
    bf16* const R0 = (bf16*)(ws + WS_ACT); bf16* const R1 = (bf16*)(ws + WS_ACT + SZ_ROWBUF); bf16* const R2 = (bf16*)(ws + WS_ACT + 2 * SZ_ROWBUF); \
    float* const hmeta = (float*)(ws + WS_HMETA); \
    float* const LF = (float*)(ws + WS_LF); float* const LFM = (float*)(ws + WS_LFM); float* const CS = (float*)(ws + WS_CS); \
    float* const SSQ = (float*)(ws + WS_SSQ); float* const SSQM = (float*)(ws + WS_SSQM); (void)SSQ; (void)SSQM; \
    LAS unsigned char* const ldsl = (LAS unsigned char*)lds; \
    (void)WGU; (void)WDN; (void)WAI; (void)WAO; (void)WBI; (void)WBO; (void)WCI; (void)WCO; (void)WFt; (void)XN; (void)R0; (void)R1; (void)R2; (void)hmeta; (void)LF; (void)LFM; (void)CS; (void)ldsl; (void)lane; (void)gw; (void)hmain;

#ifdef PROBE_SEL
    LAS unsigned long long* const TS = (LAS unsigned long long*)((LAS unsigned char*)lds + RING_BYTES + 12288);
    if (threadIdx.x == 0) { for (int c = 0; c < 8; ++c) TS[c] = 0; TS[8] = __builtin_amdgcn_s_memrealtime(); }
#endif
    XcdBarrier bar;
    { PHASE_ENV(); bar = xcd_barrier_post((unsigned*)(ws + WS_CTL), (volatile LAS unsigned*)(ldsl + MISC_OFF) + 8, tid); }
    {
        PHASE_ENV();
        LAS float* scr = (LAS float*)(ldsl + wave * 16384);
        for (int v = gw; v < conv_nv(0); v += NGW) { const int it = conv_item(0, v);
            CONVERT_BODY
        }
        for (int i = gw * 64 + lane; i < 16 * 1024; i += NGW * 64) { const int h = i >> 10, k = i & 1023; WFt[i] = (bf16)f2bf(a.c_w_in[(size_t)k * 3088 + 3072 + h] * a.mix_norm[2 * DM + k]); }
        for (int m0 = gw; m0 < MROWS; m0 += 2 * NGW) {
            const int m1 = m0 + NGW; const bool has1 = (m1 < MROWS);
            const float* s0 = (m0 < MMAIN) ? a.x + (size_t)m0 * DM : a.meta + (size_t)(m0 - MMAIN) * DM;
            const float* s1 = !has1 ? s0 : (m1 < MMAIN) ? a.x + (size_t)m1 * DM : a.meta + (size_t)(m1 - MMAIN) * DM;
            f32x4 va[4], vb[4];
#pragma unroll
            for (int j = 0; j < 4; ++j) { va[j] = ((const GAS f32x4*)s0 + lane)[64 * j]; vb[j] = ((const GAS f32x4*)s1 + lane)[64 * j]; }
#pragma unroll
            for (int half = 0; half < 2; ++half) {
                if (half == 1 && !has1) break;
                const int m = half ? m1 : m0; float ssl = 0.f;
                GAS unsigned long long* o8 = (GAS unsigned long long*)(XN + (size_t)m * DM) + lane;
#pragma unroll
                for (int j = 0; j < 4; ++j) { const f32x4 v = half ? vb[j] : va[j]; ssl += (v.x * v.x + v.y * v.y) + (v.z * v.z + v.w * v.w);
                    o8[64 * j] = (unsigned long long)pk2(v.x, v.y) | ((unsigned long long)pk2(v.z, v.w) << 32); }
                const float ss = wave_sum(ssl, lane);
                if (m < MMAIN) { if (lane < 4) SSQ[(size_t)m * 4 + lane] = (lane == 0) ? ss : 0.f; } else SSQM[(m - MMAIN) * 64 + lane] = (lane == 0) ? ss : 0.f;
            }
        }
    }
    { PHASE_ENV(); if (ws == nullptr) grid.sync();
      xcd_barrier(bar, tid); }
#ifdef PROBE_SEL
    { PHASE_ENV(); if (tid == 0) { TS[9] = __builtin_amdgcn_s_memrealtime(); TS[0] = TS[9] - TS[8]; } }
#endif
    for (int L = 0; L < DEPTH; ++L) {
        const int mx = L % 3, mj = L / 3;
        for (int s = 0; s <= 10; ++s) {
            if ((s == 6 && mx != 2) || (s == 5 && mx == 2) || s == 0 || s == 3 || s == 8) continue;
#ifdef PROBE_REP
            const int pcat = (s == 1 || s == 9) ? 1 : (s == 2 || s == 10 || s == 7) ? 2 : (s == 4) ? 4 : (s == 5) ? 8 : 16; const int nrep = (PROBE_REP & pcat) ? 2 : 1;
#else
            const int nrep = 1;
#endif
            for (int rp = 0; rp < nrep; ++rp) {
            const bool dry = (rp + 1 < nrep); (void)dry;
            PHASE_ENV();
            if (s == 0 || s == 3 || s == 8) {
                continue;
            } else if (s == 1 || s == 2 || s == 4 || s == 7 || s == 9 || s == 10) {
                pg8::Gemm g; pg8::EpiAll E;
                E.mtiles_main = 64; E.O1 = R0; E.O2 = R1; E.O3 = R2; E.ldo = 1024; E.hmain = hmain; E.hmeta = hmeta; E.scale = 1.f; E.qg = a.c_q_norm; E.kg = a.c_k_norm; E.mode = 0;
                E.ssq = SSQ; E.ssq_out = SSQ; E.hb = XN; E.fout = (L == DEPTH - 1 && s == 10 && !dry) ? hmain : nullptr; E.ldsp = (LAS float*)(ldsl + RING_BYTES + 1024); E.rsl = (const LAS float*)(ldsl + RING_BYTES + 5120);
                g.M = MMAIN;
                if (s == 1 || s == 9) { g.A = XN; g.Bt = WGU + (size_t)(L * 2 + (s == 9)) * 5632 * 1024; g.N = 5632; g.K = 1024; E.mode = 0; E.ldo = FF; }
                else if (s == 2 || s == 10) { g.A = R0; g.Bt = WDN + (size_t)(L * 2 + (s == 10)) * 1024 * FF; g.N = 1024; g.K = FF; E.mode = 4; E.scale = dry ? 0.f : 0.5f; }
                else if (s == 4) {
                    g.A = XN; g.K = 1024;
                    if (mx == 0) { g.Bt = WAI + (size_t)mj * 3072 * 1024; g.N = 3072; E.mode = 2; }
                    else if (mx == 1) { g.Bt = WBI; g.N = 2048; E.mode = 1; }
                    else { g.Bt = WCI; g.N = 3072; E.mode = 3;
                    for (int i = gw; i < 64; i += NGW) { const int tsel = i >> 5, bhh = i & 31; bf16* tb = (tsel ? R2 : R1) + (size_t)(bhh * 130) * 4096; const v4u z4_ = {zero_, zero_, zero_, zero_};
#pragma unroll
                        for (int j = 0; j < 8; ++j) ((GAS v4u*)(tb + 4096 + lane * 64))[j] = z4_;
                        if (lane < 48) {
                            if (tsel == 0) {
#pragma unroll
                                for (int c = 0; c < 8; ++c) *(GAS v4u*)(tb + c * 512 + lane * 8) = z4_; }
                            else {
#pragma unroll
                                for (int c = 0; c < 8; ++c) *(GAS v4u*)(tb + (c >> 2) * 2048 + lane * 32 + (c & 3) * 8) = z4_; } } }
                        const int fr = lane & 15, fq = lane >> 4;
                        for (int grp = gw; grp < MROWS / 16; grp += NGW) {
                            const bf16* xp = XN + (size_t)(16 * grp + fr) * DM + 8 * fq; const bf16* wp = WFt + (size_t)fr * DM + 8 * fq;
                            f32x4 acc = {0.f, 0.f, 0.f, 0.f};
#pragma unroll 16
                            for (int k = 0; k < 32; ++k) { const bf16x8 xa = *(const GAS bf16x8*)(xp + 32 * k), wb = *(const GAS bf16x8*)(wp + 32 * k);
                                acc = __builtin_amdgcn_mfma_f32_16x16x32_bf16(xa, wb, acc, 0, 0, 0); }
                            const float bf = a.c_b_f[fr]; f32x4 o; float rsr[4];
                            if (grp < MMAIN / 16) {
#pragma unroll
                                for (int r = 0; r < 4; ++r) { const f32x4 q4 = *(const GAS f32x4*)(SSQ + (size_t)(16 * grp + 4 * fq + r) * 4); rsr[r] = __builtin_amdgcn_rsqf(((q4.x + q4.y) + (q4.z + q4.w)) * (1.f / DM) + EPS); }
                            } else {
#pragma unroll
                                for (int r = 0; r < 4; ++r) { float t = 0.f; for (int i = 0; i < 16; ++i) { const f32x4 q4 = *(const GAS f32x4*)(SSQM + (4 * fq + r) * 64 + 4 * i); t += (q4.x + q4.y) + (q4.z + q4.w); } rsr[r] = __builtin_amdgcn_rsqf(t * (1.f / DM) + EPS); }
                            }
#pragma unroll
                            for (int r = 0; r < 4; ++r) { const float xv = acc[r] * rsr[r] + bf; o[r] = fminf(xv, 0.f) - log1pf(expf(-fabsf(xv))); }
                            if (grp < MMAIN / 16) { const int r0 = 16 * grp, b = r0 >> 13, t0 = r0 & 8191; *(GAS f32x4*)(LF + ((size_t)(b * NH + fr) * SEQ + t0 + 4 * fq)) = o; }
                            else *(GAS f32x4*)(LFM + fr * 16 + 4 * fq) = o;
                        }
                        asm volatile("s_waitcnt vmcnt(0) lgkmcnt(0)" ::: "memory"); __syncthreads();
                    }
                }
                else { g.K = 1024; g.N = 1024; E.mode = 4; E.scale = dry ? 0.f : 1.f;
                    if (mx == 0) { g.A = R2; g.Bt = WAO + (size_t)mj * 1024 * 1024; } else if (mx == 1) { g.A = R1; g.Bt = WBO; } else { g.A = R0; g.Bt = WCO; } }
                pg8::StaticOrder S; S.init(g.M, g.N, G, bx);
                f32x4 rs_q[3] = {{0.f, 0.f, 0.f, 0.f}, {0.f, 0.f, 0.f, 0.f}, {0.f, 0.f, 0.f, 0.f}}; bool rs_has[3] = {false, false, false};
                if (E.mode != 4) { pg8::Unit uu{0, 0};
#pragma unroll
                    for (int j = 0; j < 3; ++j) { const int i = (tid >> 8) + 2 * j; rs_has[j] = S.next(i, uu); if (rs_has[j]) rs_q[j] = *(const GAS f32x4*)(SSQ + (size_t)(uu.pm * 256 + (tid & 255)) * 4); } }
                for (int rep2 = 0; rep2 < 2; ++rep2) { const int task = (E.mode == 0) ? ((bx >= 128) ? bx - 128 + 128 * rep2 : -1) : (rep2 == 0 ? vcu : -1);
                    thin_gemm(ldsl, tid, task, g.A, g.Bt, g.K, E.mode, R0, R1, R2, hmeta, E.scale, a.c_q_norm, a.c_k_norm, SSQM, XN); }
                if (E.mode != 4) {
                    LAS float* rsl = (LAS float*)(ldsl + RING_BYTES + 5120);
#pragma unroll
                    for (int j = 0; j < 3; ++j) { const int i = (tid >> 8) + 2 * j; if (rs_has[j]) rsl[i * 256 + (tid & 255)] = __builtin_amdgcn_rsqf(((rs_q[j].x + rs_q[j].y) + (rs_q[j].z + rs_q[j].w)) * (1.f / DM) + EPS); }
                }
#ifndef NO_GEMM
                pg8::gemm_phase<pg8::EpiAll, pg8::StaticOrder, PG8_ALIGN, PG8_SP2>(ldsl, g, S, E, tid);
#endif
                if ((s == 1 || s == 9) && L + 1 < DEPTH && bx >= 128 && !dry) {
                    LAS float* scr = (LAS float*)(ldsl + wave * 16384);
                    const int nv = conv_nv(L + 1), lo = (s == 1) ? 0 : nv / 2, hi = (s == 1) ? nv / 2 : nv;
                    for (int v = lo + (bx - 128) * NWAVES + wave; v < hi; v += 128 * NWAVES) { const int it = conv_item(L + 1, v);
                        CONVERT_BODY
                    }
                }
                if (E.mode == 4) {
                    const int pm0 = 8 * (bx & 7) + ((bx >> 3) & 7), pn0 = bx >> 6;
                    if (G == 256 && tid < 256) { const f32x4 p4 = *(const LAS f32x4*)(E.ldsp + tid * 4); SSQ[(size_t)(pm0 * 256 + tid) * 4 + pn0] = (p4.x + p4.y) + (p4.z + p4.w); }
                }
            } else if (s == 5) {
                if (mx == 0) {
                    const float* cw = a.a_conv + (size_t)mj * 3 * DM + 16 * lane;
                    f32x4 w0[4], w1[4], w2[4];
#pragma unroll
                    for (int j = 0; j < 4; ++j) { w0[j] = *(const f32x4*)(cw + 4 * j); w1[j] = *(const f32x4*)(cw + DM + 4 * j); w2[j] = *(const f32x4*)(cw + 2 * DM + 4 * j); }
                    for (int blk = gw; blk < MROWS / 4; blk += NGW) {
                        const bool mainb = (blk < MMAIN / 4); const int r0 = mainb ? 4 * blk : MMAIN + 4 * (blk - MMAIN / 4);
                        int rm1, rm2;
                        if (mainb) { const int t0 = r0 & 8191; rm1 = (t0 >= 1) ? r0 - 1 : MMAIN + 15; rm2 = (t0 >= 2) ? r0 - 2 : MMAIN + 14; }
                        else { const int p0 = r0 - MMAIN; rm1 = (p0 >= 1) ? r0 - 1 : -1; rm2 = (p0 >= 2) ? r0 - 2 : -1; }
                        const v4u z4 = {0u, 0u, 0u, 0u};
                        v4u xw[6][2], bb[4][2];
#pragma unroll
                        for (int hh = 0; hh < 2; ++hh) {
                            xw[0][hh] = (rm2 >= 0) ? ((const GAS v4u*)(R0 + (size_t)rm2 * DM) + 2 * lane)[hh] : z4; xw[1][hh] = (rm1 >= 0) ? ((const GAS v4u*)(R0 + (size_t)rm1 * DM) + 2 * lane)[hh] : z4;
#pragma unroll
                            for (int i = 0; i < 4; ++i) { xw[2 + i][hh] = ((const GAS v4u*)(R0 + (size_t)(r0 + i) * DM) + 2 * lane)[hh]; bb[i][hh] = ((const GAS v4u*)(R1 + (size_t)(r0 + i) * DM) + 2 * lane)[hh]; } }
#pragma unroll
                        for (int i = 0; i < 4; ++i) { GAS v4u* yp = (GAS v4u*)(R2 + (size_t)(r0 + i) * DM) + 2 * lane;
#pragma unroll
                            for (int hh = 0; hh < 2; ++hh) { v4u o;
#pragma unroll
                                for (int e = 0; e < 4; ++e) { const int j = 2 * hh + (e >> 1), c = 2 * (e & 1);
                                    const float lo = bflo(bb[i][hh][e]) * (w2[j][c] * bflo(xw[2 + i][hh][e]) + w1[j][c] * bflo(xw[1 + i][hh][e]) + w0[j][c] * bflo(xw[i][hh][e]));
                                    const float hi = bfhi(bb[i][hh][e]) * (w2[j][c + 1] * bfhi(xw[2 + i][hh][e]) + w1[j][c + 1] * bfhi(xw[1 + i][hh][e]) + w0[j][c + 1] * bfhi(xw[i][hh][e]));
                                    o[e] = pk2(lo, hi); }
                                yp[hh] = o; } }
                    }
                } else if (mx == 1) {
#ifndef NO_CONF
                    const int c = 2 * tid;
                    f32x2 w[31];
#pragma unroll
                    for (int k = 0; k < 31; ++k) w[k] = *(const GAS f32x2*)(a.b_conv + (size_t)k * DM + c);
                    const f32x2 cb = *(const f32x2*)(a.b_conv_bias + c), lg = *(const f32x2*)(a.b_ln_g + c), lb = *(const f32x2*)(a.b_ln_b + c);
                    LAS float* red = (LAS float*)ldsl;
                    LAS float* red2 = red + 256;
                    for (int un = vcu; un < MROWS / 16; un += G) {
                        const int r0 = 16 * un; const bool meta = (r0 >= MMAIN);
                        const int p0 = meta ? 0 : 16 + (r0 & 8191); const int rowb = meta ? 0 : (r0 >> 13) * SEQ;
                        unsigned xin[46];
#pragma unroll
                        for (int j = 0; j < 46; ++j) { const int pj = p0 - 30 + j;
                            xin[j] = (pj >= 0) ? *(const GAS unsigned*)(R0 + (size_t)((pj < 16) ? MMAIN + pj : rowb + pj - 16) * DM + c) : 0u; }
                        f32x2 acc[16];
#pragma unroll
                        for (int i = 0; i < 16; ++i) acc[i] = cb;
#pragma unroll
                        for (int j = 0; j < 46; ++j) { const f32x2 xv = {bflo(xin[j]), bfhi(xin[j])};
#pragma unroll
                            for (int i = 0; i < 16; ++i) { const int k = j - i; if (k >= 0 && k <= 30) acc[i] += w[k] * xv; } }
                        float st[32];
#pragma unroll
                        for (int i = 0; i < 16; ++i) { st[2 * i] = acc[i].x + acc[i].y; st[2 * i + 1] = acc[i].x * acc[i].x + acc[i].y * acc[i].y; }
#pragma unroll
                        for (int i = 0; i < 32; ++i) st[i] = wave_sum(st[i], lane);
                        if (lane == 0) {
#pragma unroll
                            for (int i = 0; i < 8; ++i) *(LAS f32x4*)(red + wave * 32 + 4 * i) = (f32x4){st[4 * i], st[4 * i + 1], st[4 * i + 2], st[4 * i + 3]}; }
                        __syncthreads();
                        if (tid < 32) { float t = 0.f;
#pragma unroll
                            for (int wv = 0; wv < 8; ++wv) t += red[wv * 32 + tid];
                            red2[tid] = t; }
                        __syncthreads();
#pragma unroll
                        for (int i = 0; i < 16; ++i) { const f32x2 sv = *(const LAS f32x2*)(red2 + 2 * i);
                            const float mu = sv.x * (1.f / DM), var = fmaxf(sv.y * (1.f / DM) - mu * mu, 0.f), rs = 1.0f / sqrtf(var + EPS);
                            const float y0 = (acc[i].x - mu) * rs * lg.x + lb.x, y1 = (acc[i].y - mu) * rs * lg.y + lb.y;
                            *(GAS unsigned*)(R1 + (size_t)(r0 + i) * DM + c) = pk2(y0 * pg8::sigm(y0), y1 * pg8::sigm(y1)); }
                    }
#endif
                } else {
                }
            } else if (s == 6) {
                {
                        const int bh = vcu >> 3, h = bh & 15; LAS float* wt = (LAS float*)ldsl;
                        LAS float* csrow = (LAS float*)(ldsl + attn_body::LDS_CS);
                        float cm = 0.f, cmp = 0.f;
#pragma unroll
                        for (int j = 0; j < 16; ++j) { cm += LFM[h * 16 + j]; if (j == tid) cmp = cm; }
                        const float* lp = LF + (size_t)bh * SEQ + 16 * tid; float v[16];
#pragma unroll
                        for (int j = 0; j < 4; ++j) { const f32x4 q = *(const GAS f32x4*)(lp + 4 * j); v[4 * j] = q.x; v[4 * j + 1] = q.y; v[4 * j + 2] = q.z; v[4 * j + 3] = q.w; }
#pragma unroll
                        for (int j = 1; j < 16; ++j) v[j] += v[j - 1];
                        float inc = v[15];
#pragma unroll
                        for (int o = 1; o < 64; o <<= 1) { const float t = lane_get(inc, (lane - o) & 63); if (lane >= o) inc += t; }
                        if (lane == 63) wt[wave] = inc;
                        __syncthreads();
                        float off = cm + inc - v[15];
                        for (int wv = 0; wv < wave; ++wv) off += wt[wv];
#pragma unroll
                        for (int j = 0; j < 4; ++j) *(LAS f32x4*)(csrow + 128 + 16 * tid + 4 * j) = (f32x4){(off + v[4 * j]) * LOG2E, (off + v[4 * j + 1]) * LOG2E, (off + v[4 * j + 2]) * LOG2E, (off + v[4 * j + 3]) * LOG2E};
                        const float cmsh = lane_get(cmp, (lane + 16) & 63);
                        if (tid < 128) csrow[tid] = (tid >= 48 && tid < 64) ? cmsh * LOG2E : __builtin_inff();
                        __syncthreads();
                }
                const attn_body::AttnTensors AT{(const attn_body::bf16*)R0, (const attn_body::bf16*)R1, (const attn_body::bf16*)R2, (attn_body::bf16*)(dry ? (bf16*)(ws + WS_END) : R0), CS};
                const attn_body::StaticOrder S(G, bx);
#ifndef NO_ATTN
                attn_body::attn_phase<attn_body::StaticOrder>((char*)lds, AT, S, tid);
#endif
                }
                if (s == 6 && !dry) {
                PHASE_ENV();
                if (gw < NH) {
                    const int h = gw, q = lane & 15, dc = lane >> 4;
                    const bf16* qp = R0 + (size_t)(MMAIN + q) * DM + 64 * h + 16 * dc;
                    const v4u qa = ((const GAS v4u*)qp)[0], qb = ((const GAS v4u*)qp)[1];
                    float qv[16];
#pragma unroll
                    for (int e = 0; e < 4; ++e) { qv[2 * e] = bflo(qa[e]); qv[2 * e + 1] = bfhi(qa[e]); qv[8 + 2 * e] = bflo(qb[e]); qv[8 + 2 * e + 1] = bfhi(qb[e]); }
                    float sc[16], cbm[16]; { float run = 0.f;
#pragma unroll
                        for (int j = 0; j < 16; ++j) { run += *(const GAS float*)(LFM + h * 16 + j); cbm[j] = run * LOG2E; } }
#pragma unroll
                    for (int jb = 0; jb < 16; jb += 8) {
                        v4u ka[8], kb[8]; float cb[8];
#pragma unroll
                        for (int j = 0; j < 8; ++j) { const bf16* kp = R1 + (size_t)(h * 130) * 4096 + (2 * dc) * 512 + (48 + jb + j) * 8; ka[j] = *(const GAS v4u*)kp; kb[j] = *(const GAS v4u*)(kp + 512);
                            cb[j] = cbm[jb + j]; }
#pragma unroll
                        for (int j = 0; j < 8; ++j) { float d = 0.f;
#pragma unroll
                            for (int e = 0; e < 4; ++e) d += qv[2 * e] * bflo(ka[j][e]) + qv[2 * e + 1] * bfhi(ka[j][e]) + qv[8 + 2 * e] * bflo(kb[j][e]) + qv[8 + 2 * e + 1] * bfhi(kb[j][e]);
                            d += lane_get(d, lane ^ 16); d += lane_get(d, lane ^ 32);
                            sc[jb + j] = (jb + j <= q) ? d - cb[j] : -__builtin_inff(); }
                    }
                    float mrun = sc[0];
#pragma unroll
                    for (int j = 1; j < 16; ++j) mrun = fmaxf(mrun, sc[j]);
                    float l = 0.f, o[16];
#pragma unroll
                    for (int e = 0; e < 16; ++e) o[e] = 0.f;
#pragma unroll
                    for (int jb = 0; jb < 16; jb += 8) {
                        v4u va[8], vb[8];
#pragma unroll
                        for (int j = 0; j < 8; ++j) { const bf16* vp = R2 + (size_t)(h * 130) * 4096 + (dc >> 1) * 2048 + (48 + jb + j) * 32 + 16 * (dc & 1); va[j] = ((const GAS v4u*)vp)[0]; vb[j] = ((const GAS v4u*)vp)[1]; }
#pragma unroll
                        for (int j = 0; j < 8; ++j) { const float p = __builtin_amdgcn_exp2f(sc[jb + j] - mrun); l += p;
#pragma unroll
                            for (int e = 0; e < 4; ++e) { o[2 * e] += p * bflo(va[j][e]); o[2 * e + 1] += p * bfhi(va[j][e]); o[8 + 2 * e] += p * bflo(vb[j][e]); o[8 + 2 * e + 1] += p * bfhi(vb[j][e]); } }
                    }
                    const float rl = 1.0f / l; v4u oa, ob;
#pragma unroll
                    for (int e = 0; e < 4; ++e) { oa[e] = pk2(o[2 * e] * rl, o[2 * e + 1] * rl); ob[e] = pk2(o[8 + 2 * e] * rl, o[8 + 2 * e + 1] * rl); }
                    GAS v4u* op = (GAS v4u*)(R0 + (size_t)(MMAIN + q) * DM + 64 * h + 16 * dc); op[0] = oa; op[1] = ob;
                }
            }
            { PHASE_ENV();
            xcd_barrier(bar, tid);
#ifdef PROBE_SEL
            if (tid == 0) { const unsigned long long tn = __builtin_amdgcn_s_memrealtime(); const int cat = (s == 1 || s == 9) ? 1 : (s == 2 || s == 10) ? 2 : (s == 4) ? 3 : (s == 5) ? 4 : (s == 6) ? 5 : 6;
              TS[cat] += tn - TS[9]; TS[9] = tn; }
#endif
            }
            }
        }
    }
#ifdef PROBE_SEL
    { PHASE_ENV(); if (bx == 0 && tid == 0) { const unsigned long long t0 = __builtin_amdgcn_s_memrealtime(), span = 4ull * TS[PROBE_SEL];
        while (__builtin_amdgcn_s_memrealtime() - t0 < span) __builtin_amdgcn_s_sleep(8); } }
#endif
}

extern "C" void kernel_launch(void* const* d_in, const int* in_sizes, int n_in, void* d_out, int out_size, void* d_ws, size_t ws_size, hipStream_t stream) {
    static int grid = 0;
    if (grid == 0) {
        if (n_in != 21 || out_size != MMAIN * DM || ws_size < WS_END + SZ_ROWBUF) { fprintf(stderr, "kernel_launch: unexpected shapes (n_in %d out %d ws %zu)\n", n_in, out_size, ws_size); grid = -1; return; }
        int dev = 0, cus = 0, per_cu = 0;
        hipGetDevice(&dev); hipDeviceGetAttribute(&cus, hipDeviceAttributeMultiprocessorCount, dev);
        if (hipFuncSetAttribute((const void*)fwd_megakernel, hipFuncAttributeMaxDynamicSharedMemorySize, LDS_BYTES) != hipSuccess) { fprintf(stderr, "kernel_launch: hipFuncSetAttribute failed\n"); grid = -1; return; }
        if (hipOccupancyMaxActiveBlocksPerMultiprocessor(&per_cu, (const void*)fwd_megakernel, NWAVES * 64, LDS_BYTES) != hipSuccess || per_cu < 1) { fprintf(stderr, "kernel_launch: occupancy query says %d\n", per_cu); per_cu = 1; }
        (void)hipGetLastError();
        grid = cus * 1;
        if (grid != 256) fprintf(stderr, "kernel_launch: grid %d (expected 256)\n", grid);
    }
    if (grid < 0) return;
    if (hipMemsetAsync((char*)d_ws + WS_CTL, 0, CTL_ZERO_BYTES, stream) != hipSuccess) { fprintf(stderr, "kernel_launch: hipMemsetAsync failed\n"); return; }
    Args a{};
    const float** f = (const float**)&a;
    for (int i = 0; i < 21; ++i) f[i] = (const float*)d_in[i];
    a.out = (float*)d_out; a.ws = (unsigned char*)d_ws;
    void* args[] = {&a};
    hipError_t e = hipLaunchCooperativeKernel((const void*)fwd_megakernel, dim3(grid), dim3(NWAVES * 64), args, LDS_BYTES, stream);
    if (e != hipSuccess) fprintf(stderr, "cooperative launch failed: %s (grid %d)\n", hipGetErrorString(e), grid);
}
```

```cpp
#include <hip/hip_runtime.h>
#include <hip/hip_cooperative_groups.h>
#include <cstdio>
#include <cstdint>
namespace pg8 {
#define PG8_LAS __attribute__((address_space(3)))
typedef unsigned short bf16_t;
typedef short bf16x8 __attribute__((ext_vector_type(8)));
typedef float f32x4 __attribute__((ext_vector_type(4)));
typedef unsigned u32x4 __attribute__((ext_vector_type(4)));
constexpr int BM = 256, BK = 64, HALF = 128, HTB = HALF * BK * 2  , STAGE_BYTES = 8 * HTB, NXCD = 8, WGM = 8;

__host__ __device__ __forceinline__ int lds_byte(int r, int c) { const int st = (r >> 4) * 2 + (c >> 5), rr = r & 15, cc = c & 31, ob = rr * 64 + cc * 2; return st * 1024 + (ob ^ (((ob >> 9) & 1) << 5)); }
__host__ __device__ __forceinline__ void stage_rc(int b, int& R, int& C) { const int st = b / 1024, sb = b % 1024, swz = sb ^ (((sb >> 9) & 1) << 5); R = (st >> 1) * 16 + swz / 64; C = (st & 1) * 32 + (swz % 64) / 2; }
__host__ __device__ __forceinline__ int perm32(int rho) { const int n = rho >> 4, i = rho & 15; return 8 * (i >> 2) + 4 * n + (i & 3); }

struct Unit { int pm, pn; };
struct Gemm { const bf16_t* A; const bf16_t* Bt; int M, N, K; };

struct StaticOrder {
    int nM, nN, nwg, G, c;
    __host__ __device__ void init(int M, int N, int G_, int c_) { nM = M / BM; nN = N / BM; nwg = nM * nN; G = G_; c = c_; }
    __host__ __device__ bool next(int i, Unit& u) const {
        const long L = (long)i * G + c; if (L >= nwg) return false;
        int wgid = (int)L; { const int q = nwg / NXCD, r = nwg % NXCD, xcd = wgid % NXCD, off = wgid / NXCD; wgid = (xcd < r ? xcd * (q + 1) : r * (q + 1) + (xcd - r) * q) + off; }
        const int nig = WGM * nN, gid = wgid / nig, fm = gid * WGM, gsz = (nM - fm) < WGM ? (nM - fm) : WGM;
        u.pm = fm + ((wgid % nig) % gsz); u.pn = (wgid % nig) / gsz; return true;
    }
    __device__ __forceinline__ void a_ready(const Unit&) const {}
    __device__ __forceinline__ void done(const Unit&) const {}
};

__device__ __forceinline__ unsigned cvt_pk_bf16(float lo, float hi) { unsigned r; asm volatile("v_cvt_pk_bf16_f32 %0, %1, %2" : "=v"(r) : "v"(lo), "v"(hi)); return r; }
typedef float f32x2 __attribute__((ext_vector_type(2)));
__device__ __forceinline__ float sigm(float x) { return __builtin_amdgcn_rcpf(1.0f + __builtin_amdgcn_exp2f(-1.4426950408889634f * x)); }
constexpr float QK_C2 = 0.125f * 1.4426950408889634f;
#define PG8_GAS __attribute__((address_space(1)))
struct EpiAll {
    static constexpr bool PERM = true, AFTER_DRAIN = false;
    int mode;
    int mtiles_main;
    bf16_t* O1; bf16_t* O2; bf16_t* O3; int ldo;
    float* hmain; float* hmeta; float scale;
    const float* qg; const float* kg;
    const PG8_LAS float* rsl;
    const float* ssq;
    float* ssq_out; bf16_t* hb; float* fout; PG8_LAS float* ldsp;
    __device__ __forceinline__ void operator()(const f32x4 (&acc)[2][2][4][2], const Unit& u, int wr, int wc, int fr, int fq, int ui) const {
        const int rloc_ = wr * 64 + fr;
#define EPI_LAUNDER() int rloc = rloc_; asm volatile("" : "+v"(rloc))
#define EPI_RS() float rsv[2][4]; { const PG8_LAS float* sp_ = rsl + ui * 256 + rloc;     \
    _Pragma("unroll") for (int ai = 0; ai < 2; ++ai) _Pragma("unroll") for (int m = 0; m < 4; ++m) rsv[ai][m] = sp_[ai * HALF + m * 16]; }
        if (mode <= 1 || (mode == 2 && u.pn < 8)) {
            EPI_LAUNDER(); EPI_RS();
            bf16_t* base = O1 + (size_t)(u.pm * BM + rloc) * ldo + u.pn * HALF + wc * 32 + 8 * fq;
#pragma unroll
            for (int ai = 0; ai < 2; ++ai)
#pragma unroll
                for (int m = 0; m < 4; ++m) {
                    const float rs_ = rsv[ai][m]; const f32x4 a0 = acc[ai][0][m][0] * rs_, a1 = acc[ai][0][m][1] * rs_, b0 = acc[ai][1][m][0] * rs_, b1 = acc[ai][1][m][1] * rs_;
                    f32x4 r0, r1;
                    if (mode == 0) {
                        const float ke_ = -1.4426950408889634f * rs_, rs2_ = rs_ * rs_;
                        const f32x4 ga0 = acc[ai][0][m][0], ga1 = acc[ai][0][m][1], gb0 = acc[ai][1][m][0], gb1 = acc[ai][1][m][1];
#pragma unroll
                        for (int i = 0; i < 4; ++i) {
                            r0[i] = (ga0[i] * gb0[i]) * (rs2_ * __builtin_amdgcn_rcpf(1.0f + __builtin_amdgcn_exp2f(ke_ * ga0[i])));
                            r1[i] = (ga1[i] * gb1[i]) * (rs2_ * __builtin_amdgcn_rcpf(1.0f + __builtin_amdgcn_exp2f(ke_ * ga1[i]))); }
                    } else if (mode == 1) {
#pragma unroll
                        for (int i = 0; i < 4; ++i) { r0[i] = a0[i] * sigm(b0[i]); r1[i] = a1[i] * sigm(b1[i]); }
                    } else { r0 = a0 * b0; r1 = a1 * b1; }
                    u32x4 w; w.x = cvt_pk_bf16(r0[0], r0[1]); w.y = cvt_pk_bf16(r0[2], r0[3]); w.z = cvt_pk_bf16(r1[0], r1[1]); w.w = cvt_pk_bf16(r1[2], r1[3]);
                    *(PG8_GAS u32x4*)(base + (size_t)(ai * HALF + m * 16) * ldo) = w;
                }
        } else if (mode == 2) {
            EPI_LAUNDER(); EPI_RS();
            bf16_t* base = O2 + (size_t)(u.pm * BM + rloc) * 1024 + (u.pn - 8) * BM + wc * 32 + 8 * fq;
#pragma unroll
            for (int ai = 0; ai < 2; ++ai)
#pragma unroll
                for (int m = 0; m < 4; ++m)
#pragma unroll
                    for (int bj = 0; bj < 2; ++bj) {
                        const f32x4 v0 = acc[ai][bj][m][0] * rsv[ai][m], v1 = acc[ai][bj][m][1] * rsv[ai][m];
                        u32x4 w; w.x = cvt_pk_bf16(v0[0], v0[1]); w.y = cvt_pk_bf16(v0[2], v0[3]); w.z = cvt_pk_bf16(v1[0], v1[1]); w.w = cvt_pk_bf16(v1[2], v1[3]);
                        *(PG8_GAS u32x4*)(base + (size_t)(ai * HALF + m * 16) * 1024 + bj * HALF) = w;
                    }
        } else if (mode == 3) {
            EPI_LAUNDER(); EPI_RS();
            const int sec = u.pn >> 2;
            const bool meta = false;
            const long krow0 = meta ? 48 : (long)u.pm * BM + 128 * (1 + (u.pm >> 5));
            bf16_t* dst = (sec == 0) ? O1 + (size_t)(u.pm * BM) * 1024 : ((sec == 1) ? O2 : O3) + (size_t)krow0 * 1024;
            const bool dup = meta && sec != 0; const int rlim = dup ? 16 : 256;
            if (sec < 2) {
                const int head = 4 * (u.pn & 3) + wc;
                const int lxor16 = (fr + 16 * (fq ^ 1)) << 2, lxor32 = (fr + 16 * (fq ^ 2)) << 2;
                const float* g = (sec == 0) ? qg : kg; const float gs = (sec == 0) ? QK_C2 : 1.0f;
                f32x4 gv[2][2];
#pragma unroll
                for (int bj = 0; bj < 2; ++bj)
#pragma unroll
                    for (int n = 0; n < 2; ++n) gv[bj][n] = *(const PG8_GAS f32x4*)(g + 32 * bj + 8 * fq + 4 * n) * gs;
#pragma unroll
                for (int ai = 0; ai < 2; ++ai)
#pragma unroll
                    for (int m = 0; m < 4; ++m) {
                        float ss = 0.f;
#pragma unroll
                        for (int bj = 0; bj < 2; ++bj)
#pragma unroll
                            for (int n = 0; n < 2; ++n) { const f32x4 x = acc[ai][bj][m][n] * rsv[ai][m]; ss += (x[0] * x[0] + x[1] * x[1]) + (x[2] * x[2] + x[3] * x[3]); }
                        ss += __builtin_bit_cast(float, __builtin_amdgcn_ds_bpermute(lxor16, __builtin_bit_cast(int, ss))); ss += __builtin_bit_cast(float, __builtin_amdgcn_ds_bpermute(lxor32, __builtin_bit_cast(int, ss)));
                        const float rs = __builtin_amdgcn_rsqf(ss * (1.0f / 64.0f) + 1e-6f) * rsv[ai][m];
                        const int rl = rloc + ai * HALF + m * 16;
#pragma unroll
                        for (int bj = 0; bj < 2; ++bj) {
                            const f32x4 v0 = acc[ai][bj][m][0] * rs * gv[bj][0], v1 = acc[ai][bj][m][1] * rs * gv[bj][1];
                            u32x4 w; w.x = cvt_pk_bf16(v0[0], v0[1]); w.y = cvt_pk_bf16(v0[2], v0[3]); w.z = cvt_pk_bf16(v1[0], v1[1]); w.w = cvt_pk_bf16(v1[2], v1[3]);
                            const int col = 64 * head + 32 * bj + 8 * fq;
                            if (sec == 0) *(PG8_GAS u32x4*)(dst + (size_t)rl * 1024 + col) = w;
                            else *(PG8_GAS u32x4*)(O2 + ((size_t)((u.pm >> 5) * 16 + head) * 130 + (2 + (u.pm & 31) * 4 + (rl >> 6))) * 4096 + (4 * bj + fq) * 512 + (rl & 63) * 8) = w;
                        }
                    }
            } else {
#pragma unroll
                for (int ai = 0; ai < 2; ++ai)
#pragma unroll
                    for (int m = 0; m < 4; ++m) {
                        const int rl = rloc + ai * HALF + m * 16;
#pragma unroll
                        for (int bj = 0; bj < 2; ++bj) {
                            const f32x4 v0 = acc[ai][bj][m][0] * rsv[ai][m], v1 = acc[ai][bj][m][1] * rsv[ai][m];
                            u32x4 w; w.x = cvt_pk_bf16(v0[0], v0[1]); w.y = cvt_pk_bf16(v0[2], v0[3]); w.z = cvt_pk_bf16(v1[0], v1[1]); w.w = cvt_pk_bf16(v1[2], v1[3]);
                            const int col = (u.pn - 8) * BM + bj * HALF + wc * 32 + 8 * fq;
                            (void)col; const int vhead = 4 * (u.pn - 8) + 2 * bj + (wc >> 1);
                            *(PG8_GAS u32x4*)(O3 + ((size_t)((u.pm >> 5) * 16 + vhead) * 130 + (2 + (u.pm & 31) * 4 + (rl >> 6))) * 4096 + (wc & 1) * 2048 + (rl & 63) * 32 + 8 * fq) = w;
                        }
                    }
            }
        } else {
            EPI_LAUNDER();
            bf16_t* hbase = hb + (size_t)(u.pm * BM + rloc) * 1024 + u.pn * BM + wc * 32 + 8 * fq;
            float* fbase = fout ? fout + (size_t)(u.pm * BM + rloc) * 1024 + u.pn * BM + wc * 32 + 8 * fq : nullptr;
            const float sc = scale; const int lx16 = (fr + 16 * (fq ^ 1)) << 2, lx32 = (fr + 16 * (fq ^ 2)) << 2;
#pragma unroll
            for (int ai = 0; ai < 2; ++ai) {
                u32x4 hx[4][2];
#pragma unroll
                for (int m = 0; m < 4; ++m)
#pragma unroll
                    for (int bj = 0; bj < 2; ++bj) hx[m][bj] = *(const PG8_GAS u32x4*)(hbase + (size_t)(ai * HALF + m * 16) * 1024 + bj * HALF);
                asm volatile("" ::: "memory");
#pragma unroll
                for (int m = 0; m < 4; ++m) {
                    float ps = 0.f;
#pragma unroll
                    for (int bj = 0; bj < 2; ++bj) {
                        const u32x4 hw = hx[m][bj];
                        f32x4 x0 = {__builtin_bit_cast(float, hw.x << 16), __builtin_bit_cast(float, hw.x & 0xffff0000u), __builtin_bit_cast(float, hw.y << 16), __builtin_bit_cast(float, hw.y & 0xffff0000u)};
                        f32x4 x1 = {__builtin_bit_cast(float, hw.z << 16), __builtin_bit_cast(float, hw.z & 0xffff0000u), __builtin_bit_cast(float, hw.w << 16), __builtin_bit_cast(float, hw.w & 0xffff0000u)};
                        x0 += acc[ai][bj][m][0] * sc; x1 += acc[ai][bj][m][1] * sc;
                        if (fbase) { float* p = fbase + (size_t)(ai * HALF + m * 16) * 1024 + bj * HALF; *(PG8_GAS f32x4*)p = x0; *(PG8_GAS f32x4*)(p + 4) = x1; }
                        ps += ((x0[0] * x0[0] + x0[1] * x0[1]) + (x0[2] * x0[2] + x0[3] * x0[3])) + ((x1[0] * x1[0] + x1[1] * x1[1]) + (x1[2] * x1[2] + x1[3] * x1[3]));
                        u32x4 w; w.x = cvt_pk_bf16(x0[0], x0[1]); w.y = cvt_pk_bf16(x0[2], x0[3]); w.z = cvt_pk_bf16(x1[0], x1[1]); w.w = cvt_pk_bf16(x1[2], x1[3]);
                        if (!fbase) *(PG8_GAS u32x4*)(hbase + (size_t)(ai * HALF + m * 16) * 1024 + bj * HALF) = w;
                    }
                    ps += __builtin_bit_cast(float, __builtin_amdgcn_ds_bpermute(lx16, __builtin_bit_cast(int, ps))); ps += __builtin_bit_cast(float, __builtin_amdgcn_ds_bpermute(lx32, __builtin_bit_cast(int, ps)));
                    if (fq == 0) ldsp[(rloc + ai * HALF + m * 16) * 4 + wc] = ps;
                }
            }
            asm volatile("s_waitcnt lgkmcnt(0)" ::: "memory");
        }
    }
};
template <class Epi, class Sched, bool ALIGN_EPI = false, bool SP2 = false>
__device__ __forceinline__ void gemm_phase(PG8_LAS unsigned char* lds, const Gemm g, const Sched& S, const Epi& E, const int tid_in) {
    const int tid = tid_in, wid = __builtin_amdgcn_readfirstlane(tid >> 6), lane = tid & 63, wr = wid >> 2, wc = wid & 3, fr = lane & 15, fq = lane >> 4;
    const int K = g.K, nt = K / BK;
    unsigned voffA[2], voffB[2];
#pragma unroll
    for (int i = 0; i < 2; ++i) { int R, C; stage_rc(tid * 16 + i * 8192, R, C); const int Rb = Epi::PERM ? ((R & ~31) + perm32(R & 31)) : R;
        voffA[i] = (unsigned)(R * K + C) * 2u; voffB[i] = (unsigned)(Rb * K + C) * 2u; }
    const size_t kstep = (size_t)(BK * 2);
    const size_t hstep = (size_t)HALF * K * 2;
    const size_t tstep = 2 * hstep;
    const unsigned ldsw = (unsigned)wid * 1024u;
    const int aoff = lds_byte(wr * 64 + fr, fq * 8), boff = lds_byte(wc * 32 + fr, fq * 8);
#define PG8_SA(b, h) (((b) * 2 + (h)) * HTB)
#define PG8_SB(b, h) ((4 + (b) * 2 + (h)) * HTB)
#define PG8_STAGE(bufoff, gbase, voff) do { _Pragma("unroll") for (int _i = 0; _i < 2; ++_i) \
        __builtin_amdgcn_global_load_lds((const unsigned*)((const char*)(gbase) + (voff)[_i]), (PG8_LAS unsigned*)(lds + (bufoff) + ldsw + _i * 8192), 16, 0, 0); } while (0)
#define PG8_LDA(dst, b, h) do { _Pragma("unroll") for (int m = 0; m < 4; ++m) _Pragma("unroll") for (int k = 0; k < 2; ++k) dst[m][k] = *(const PG8_LAS bf16x8*)(lds + PG8_SA(b, h) + aoff + m * 2048 + k * 1024); } while (0)
#define PG8_LDB(dst, b, h) do { _Pragma("unroll") for (int n = 0; n < 2; ++n) _Pragma("unroll") for (int k = 0; k < 2; ++k) dst[n][k] = *(const PG8_LAS bf16x8*)(lds + PG8_SB(b, h) + boff + n * 2048 + k * 1024); } while (0)
#define PG8_MMA(ai, bj, At, Bt) do { __builtin_amdgcn_s_setprio(1); _Pragma("unroll") for (int m = 0; m < 4; ++m) _Pragma("unroll") for (int n = 0; n < 2; ++n) _Pragma("unroll") for (int k = 0; k < 2; ++k) \
        acc[ai][bj][m][n] = __builtin_amdgcn_mfma_f32_16x16x32_bf16(Bt[n][k], At[m][k], acc[ai][bj][m][n], 0, 0, 0); __builtin_amdgcn_s_setprio(0); } while (0)
#define PG8_WAIT_V(n) asm volatile("s_waitcnt vmcnt(" #n ")" ::: "memory")
#define PG8_WAIT_L(n) asm volatile("s_waitcnt lgkmcnt(" #n ")" ::: "memory")
#define PG8_BAR __builtin_amdgcn_s_barrier()
#define PG8_SCHED __builtin_amdgcn_sched_barrier(0)
    Unit cur, nxt; int ui = 0;
    if (!S.next(0, cur)) return;
    f32x4 acc[2][2][4][2];
#pragma unroll
    for (int a = 0; a < 2; ++a)
#pragma unroll
        for (int b = 0; b < 2; ++b)
#pragma unroll
            for (int m = 0; m < 4; ++m)
#pragma unroll
                for (int n = 0; n < 2; ++n) acc[a][b][m][n] = (f32x4){0.f, 0.f, 0.f, 0.f};
    bf16x8 At[4][2], B0[2][2], B1[2][2];
    const char* cA = (const char*)g.A + (size_t)cur.pm * tstep; const char* cB = (const char*)g.Bt + (size_t)cur.pn * tstep;
    S.a_ready(cur);
    if constexpr (SP2) {
        PG8_STAGE(PG8_SB(0, 0), cB, voffB); PG8_STAGE(PG8_SB(0, 1), cB + hstep, voffB); PG8_STAGE(PG8_SA(0, 0), cA, voffA); PG8_STAGE(PG8_SA(0, 1), cA + hstep, voffA);
        if (wr == 1) PG8_BAR;
        PG8_WAIT_V(2); PG8_BAR;
        PG8_STAGE(PG8_SB(1, 0), cB + kstep, voffB); PG8_STAGE(PG8_SA(1, 0), cA + kstep, voffA); PG8_STAGE(PG8_SB(1, 1), cB + hstep + kstep, voffB);
        PG8_WAIT_V(6); PG8_BAR;
    } else {
        PG8_STAGE(PG8_SB(0, 0), cB, voffB); PG8_STAGE(PG8_SA(0, 0), cA, voffA); PG8_STAGE(PG8_SB(0, 1), cB + hstep, voffB); PG8_STAGE(PG8_SA(0, 1), cA + hstep, voffA);
        if (wr == 1) PG8_BAR;
        PG8_WAIT_V(4); PG8_BAR;
        PG8_STAGE(PG8_SB(1, 0), cB + kstep, voffB); PG8_STAGE(PG8_SA(1, 0), cA + kstep, voffA); PG8_STAGE(PG8_SB(1, 1), cB + hstep + kstep, voffB);
        PG8_WAIT_V(6); PG8_BAR;
    }
    for (;;) {
        const bool has_next = S.next(ui + 1, nxt);
        const char* nA = has_next ? (const char*)g.A + (size_t)nxt.pm * tstep : cA; const char* nB = has_next ? (const char*)g.Bt + (size_t)nxt.pn * tstep : cB;
        for (int t = 0; t < nt; t += 2) {
            const bool last = (t == nt - 2);
            const char* a1 = cA + (size_t)(t + 1) * kstep;
            const char* a2 = last ? nA : cA + (size_t)(t + 2) * kstep; const char* b2 = last ? nB : cB + (size_t)(t + 2) * kstep;
            const char* a3 = a2 + kstep; const char* b3 = b2 + kstep;
            if (last && has_next) S.a_ready(nxt);
            if constexpr (SP2) {
            PG8_LDB(B0, 0, 0); PG8_LDB(B1, 0, 1); PG8_SCHED; PG8_LDA(At, 0, 0); PG8_STAGE(PG8_SA(1, 1), a1 + hstep, voffA);
            PG8_WAIT_V(8); PG8_WAIT_L(0); PG8_BAR; PG8_MMA(0, 0, At, B0); PG8_MMA(0, 1, At, B1); PG8_BAR; PG8_SCHED;
            PG8_LDA(At, 0, 1); PG8_STAGE(PG8_SB(0, 0), b2, voffB); PG8_STAGE(PG8_SB(0, 1), b2 + hstep, voffB); PG8_STAGE(PG8_SA(0, 0), a2, voffA);
            PG8_WAIT_V(8); PG8_WAIT_L(0); PG8_BAR; PG8_MMA(1, 0, At, B0); PG8_MMA(1, 1, At, B1); PG8_BAR; PG8_SCHED;
            PG8_LDB(B0, 1, 0); PG8_LDB(B1, 1, 1); PG8_SCHED; PG8_LDA(At, 1, 0); PG8_STAGE(PG8_SA(0, 1), a2 + hstep, voffA);
            PG8_WAIT_V(8); PG8_WAIT_L(0); PG8_BAR; PG8_MMA(0, 0, At, B0); PG8_MMA(0, 1, At, B1); PG8_BAR; PG8_SCHED;
            PG8_LDA(At, 1, 1); PG8_STAGE(PG8_SB(1, 0), b3, voffB); PG8_STAGE(PG8_SB(1, 1), b3 + hstep, voffB); PG8_STAGE(PG8_SA(1, 0), a3, voffA);
            PG8_WAIT_V(8); PG8_WAIT_L(0); PG8_BAR; PG8_MMA(1, 0, At, B0); PG8_MMA(1, 1, At, B1); PG8_BAR; PG8_SCHED;
            } else {
            PG8_LDB(B0, 0, 0); PG8_SCHED; PG8_LDA(At, 0, 0); PG8_STAGE(PG8_SA(1, 1), a1 + hstep, voffA);
            PG8_WAIT_L(8); PG8_BAR; PG8_WAIT_L(0); PG8_MMA(0, 0, At, B0); PG8_BAR; PG8_SCHED;
            PG8_LDB(B1, 0, 1); PG8_STAGE(PG8_SB(0, 0), b2, voffB);
            PG8_BAR; PG8_WAIT_L(0); PG8_MMA(0, 1, At, B1); PG8_BAR;
            PG8_LDA(At, 0, 1); PG8_STAGE(PG8_SA(0, 0), a2, voffA);
            PG8_BAR; PG8_WAIT_L(0); PG8_MMA(1, 0, At, B0); PG8_BAR; PG8_SCHED;
            PG8_STAGE(PG8_SB(0, 1), b2 + hstep, voffB);
            PG8_WAIT_V(6); PG8_BAR; PG8_MMA(1, 1, At, B1); PG8_BAR;
            PG8_LDB(B0, 1, 0); PG8_SCHED; PG8_LDA(At, 1, 0); PG8_STAGE(PG8_SA(0, 1), a2 + hstep, voffA);
            PG8_WAIT_L(8); PG8_BAR; PG8_WAIT_L(0); PG8_MMA(0, 0, At, B0); PG8_BAR; PG8_SCHED;
            PG8_LDB(B1, 1, 1); PG8_STAGE(PG8_SB(1, 0), b3, voffB);
            PG8_BAR; PG8_WAIT_L(0); PG8_MMA(0, 1, At, B1); PG8_BAR;
            PG8_LDA(At, 1, 1); PG8_STAGE(PG8_SA(1, 0), a3, voffA);
            PG8_BAR; PG8_WAIT_L(0); PG8_MMA(1, 0, At, B0); PG8_BAR; PG8_SCHED;
            PG8_STAGE(PG8_SB(1, 1), b3 + hstep, voffB);
            PG8_WAIT_V(6); PG8_BAR; PG8_MMA(1, 1, At, B1); PG8_BAR;
            }
        }
        if constexpr (ALIGN_EPI) { if (wr == 0) PG8_BAR; }
        if constexpr (!Epi::AFTER_DRAIN) { E(acc, cur, wr, wc, fr, fq, ui); S.done(cur); }
        if (!has_next) break;
#pragma unroll
        for (int a = 0; a < 2; ++a)
#pragma unroll
            for (int b = 0; b < 2; ++b)
#pragma unroll
                for (int m = 0; m < 4; ++m)
#pragma unroll
                    for (int n = 0; n < 2; ++n) acc[a][b][m][n] = (f32x4){0.f, 0.f, 0.f, 0.f};
        cur = nxt; cA = nA; cB = nB; ++ui;
        if constexpr (ALIGN_EPI) { if (wr == 1) PG8_BAR; }
    }
    PG8_WAIT_V(0);
    if constexpr (!ALIGN_EPI) { if (wr == 0) PG8_BAR; }
    PG8_BAR;
    if constexpr (Epi::AFTER_DRAIN) { E.fused(acc, cur, wr, wc, fr, fq, lds, wid, lane); S.done(cur); }
#undef PG8_SA
#undef PG8_SB
#undef PG8_STAGE
#undef PG8_LDA
#undef PG8_LDB
#undef PG8_MMA
#undef PG8_WAIT_V
#undef PG8_WAIT_L
#undef PG8_BAR
#undef PG8_SCHED
}
}

#ifndef PG8_SP2
#define PG8_SP2 true
#endif
#ifndef PG8_ALIGN
#define PG8_ALIGN true
#endif
#include <hip/hip_bf16.h>
#include <cmath>
namespace attn_body {
using bf16=__hip_bfloat16;
using bf16x8=__attribute__((ext_vector_type(8)))short;
using s16x4=__attribute__((ext_vector_type(4)))short;
using f32x16=__attribute__((ext_vector_type(16)))float;
using u32x4=__attribute__((ext_vector_type(4)))unsigned;
constexpr int BATCH=2,NHEAD=16,SEQ=8192,D=64,DM=NHEAD*D;
constexpr int NW=8,QBLK=32,QB=QBLK*NW,KVBLK=64,NQB=SEQ/QB; constexpr int KVPAD=128,KVROWS=SEQ+KVPAD;
constexpr int ATTN_PITCH=DM, ATTN_UNIT_ROWS=QB;
__device__ __forceinline__ int crow(int r,int hi){return (r&3)+8*(r>>2)+4*hi;}
#define SBAR() __builtin_amdgcn_sched_barrier(0)
__device__ __forceinline__ void cmask(f32x16&p0,f32x16&p1,int jb,int qrel,int hi){
  const float NEG=-INFINITY; int kb=64*jb+4*hi;
  #pragma unroll
  for(int r=0;r<16;++r){int kv=kb+(r&3)+8*(r>>2); if(kv>qrel)p0[r]=NEG; if(kv+32>qrel)p1[r]=NEG;}
}

constexpr int NSLOT=3, SLOTB=8192;
constexpr int LDS_K=0, LDS_V=NSLOT*SLOTB, LDS_WS=2*NSLOT*SLOTB, LDS_OST=LDS_WS+NW*64*4, LDS_CS=LDS_OST+NW*4096, LDS_BYTES=LDS_CS+KVROWS*4;
constexpr float C2=0.125f*1.4426950408889634f;
__device__ __forceinline__ void glds16(const void*gsrc,unsigned lds_dst){unsigned keep;
  asm volatile("s_mov_b32 %0, m0\n\ts_mov_b32 m0, %2\n\ts_nop 0\n\tglobal_load_lds_dwordx4 %1, off\n\ts_mov_b32 m0, %0":"=&s"(keep):"v"(gsrc),"s"(lds_dst):"memory");}
__device__ __forceinline__ float max3f(float a,float b,float c){float r;asm("v_max3_f32 %0, %1, %2, %3":"=v"(r):"v"(a),"v"(b),"v"(c));return r;}
__device__ __forceinline__ float max2f(float a,float b){float r;asm("v_max_f32_e32 %0, %1, %2":"=v"(r):"v"(a),"v"(b));return r;}
__device__ __forceinline__ float fadd_s(float a,float b){float r;asm("v_add_f32_e32 %0, %1, %2":"=v"(r):"v"(a),"v"(b));return r;}
__device__ __forceinline__ float fsub_s(float a,float b){float r;asm("v_sub_f32_e32 %0, %1, %2":"=v"(r):"v"(a),"v"(b));return r;}
typedef float f32x2_t __attribute__((ext_vector_type(2))); typedef __bf16 bf16x2_t __attribute__((ext_vector_type(2)));
__device__ __forceinline__ unsigned cvtpk_s(float lo,float hi){f32x2_t v={lo,hi};bf16x2_t b=__builtin_convertvector(v,bf16x2_t);return __builtin_bit_cast(unsigned,b);}
#define WAIT_BAR(N) asm volatile("s_waitcnt vmcnt(" #N ") lgkmcnt(0)\n\ts_barrier":::"memory")

__device__ __forceinline__ void qkt(f32x16&p0,f32x16&p1,const char*Kslot,const bf16x8*qr,int r32,int hi){
  const char*kb=Kslot+hi*1024+r32*16;
  #pragma unroll
  for(int d0=0;d0<4;++d0){
    const bf16x8 b0=*reinterpret_cast<const bf16x8*>(kb+d0*2048);
    const bf16x8 b1=*reinterpret_cast<const bf16x8*>(kb+d0*2048+512);
    p0=__builtin_amdgcn_mfma_f32_32x32x16_bf16(b0,qr[d0],p0,0,0,0);p1=__builtin_amdgcn_mfma_f32_32x32x16_bf16(b1,qr[d0],p1,0,0,0);}
}
typedef __attribute__((address_space(3))) const char* lds_cptr;
typedef short v4i16_t __attribute__((ext_vector_type(4))); typedef float f32x4_t __attribute__((ext_vector_type(4)));
__device__ __forceinline__ void kload8(bf16x8*kf,lds_cptr kp){
  kf[0]=*(const __attribute__((address_space(3))) bf16x8*)(kp);      kf[1]=*(const __attribute__((address_space(3))) bf16x8*)(kp+512);
  kf[2]=*(const __attribute__((address_space(3))) bf16x8*)(kp+2048); kf[3]=*(const __attribute__((address_space(3))) bf16x8*)(kp+2560);
  kf[4]=*(const __attribute__((address_space(3))) bf16x8*)(kp+4096); kf[5]=*(const __attribute__((address_space(3))) bf16x8*)(kp+4608);
  kf[6]=*(const __attribute__((address_space(3))) bf16x8*)(kp+6144); kf[7]=*(const __attribute__((address_space(3))) bf16x8*)(kp+6656);
}
__device__ __forceinline__ void kload2(bf16x8*kf,lds_cptr kp,int j){ kf[2*j]=*(const __attribute__((address_space(3))) bf16x8*)(kp+j*2048); kf[2*j+1]=*(const __attribute__((address_space(3))) bf16x8*)(kp+j*2048+512); }
__device__ __forceinline__ s16x4 vtr(lds_cptr p){ return __builtin_bit_cast(s16x4,__builtin_amdgcn_ds_read_tr16_b64_v4i16((__attribute__((address_space(3))) v4i16_t*)p)); }
__device__ __forceinline__ float rowmax(const f32x16&p0,const f32x16&p1){
  float a=max3f(p0[0],p0[1],p1[0]),b=max3f(p0[2],p0[3],p1[1]);a=max3f(a,p1[2],p1[3]);
  #pragma unroll
  for(int r=4;r<16;r+=4){a=max3f(a,p0[r],p0[r+1]);b=max3f(b,p0[r+2],p0[r+3]);a=max3f(a,p1[r],p1[r+1]);b=max3f(b,p1[r+2],p1[r+3]);}
  const float m=max2f(a,b);
  auto rr=__builtin_amdgcn_permlane32_swap(__float_as_uint(m),__float_as_uint(m),false,false);
  return max2f(__uint_as_float(rr[0]),__uint_as_float(rr[1]));
}
__device__ __forceinline__ void pv(f32x16*o,int vb,bf16x8 pa0,bf16x8 pa1,bf16x8 pa2,bf16x8 pa3){
  #pragma unroll
  for(int d0=0;d0<2;++d0){s16x4 lo[4],hi[4];
    #pragma unroll
    for(int ks=0;ks<4;++ks){
      asm volatile("ds_read_b64_tr_b16 %0,%1 offset:%c2":"=&v"(lo[ks]):"v"(vb),"i"(d0*4096+ks*1024):"memory");
      asm volatile("ds_read_b64_tr_b16 %0,%1 offset:%c2":"=&v"(hi[ks]):"v"(vb),"i"(d0*4096+ks*1024+512):"memory");}
    asm volatile("s_waitcnt lgkmcnt(0)":::"memory");SBAR();
    #define PK(k) (bf16x8){lo[k][0],lo[k][1],lo[k][2],lo[k][3],hi[k][0],hi[k][1],hi[k][2],hi[k][3]}
    o[d0]=__builtin_amdgcn_mfma_f32_32x32x16_bf16(pa0,PK(0),o[d0],0,0,0);
    o[d0]=__builtin_amdgcn_mfma_f32_32x32x16_bf16(pa1,PK(1),o[d0],0,0,0);
    o[d0]=__builtin_amdgcn_mfma_f32_32x32x16_bf16(pa2,PK(2),o[d0],0,0,0);
    o[d0]=__builtin_amdgcn_mfma_f32_32x32x16_bf16(pa3,PK(3),o[d0],0,0,0);
    #undef PK
  }
}

#ifndef ATTN_STORE16
#define ATTN_STORE16(p,v) (*(__attribute__((address_space(1))) u32x4*)(p)=(v))
#endif
template<int THRL> __device__ __forceinline__ void attn_unit(int b,int h,int qb,const bf16*Q,const bf16*__restrict__ K,const bf16*__restrict__ V,bf16*O,const float*__restrict__ CS,char*shm,const int tid_in){
  const int tid=tid_in,lane=tid&63,r32=lane&31,hi=lane>>5; const int wid=__builtin_amdgcn_readfirstlane(tid>>6);
  const long rowbase=(long)b*SEQ, kvbase=(long)b*KVROWS; const int q0=qb*QB;
  const bf16*Qw=Q+(rowbase+q0+wid*QBLK)*DM+h*D;
  (void)kvbase; const bf16*Kh=K+(long)(b*NHEAD+h)*(KVROWS/KVBLK)*4096,*Vh=V+(long)(b*NHEAD+h)*(KVROWS/KVBLK)*4096;
  const unsigned lds0=(unsigned)(uintptr_t)shm;
  float*wsf=(float*)(shm+LDS_WS)+wid*64;
  const bf16*ksrc=Kh+wid*512+lane*8;
  const bf16*vsrc=Vh+wid*512+lane*8;
  const unsigned kdst=lds0+LDS_K+wid*1024, vdst=lds0+LDS_V+wid*1024;
  #define DMA_K(t,slot) glds16(ksrc+(long)(t)*4096,(unsigned)__builtin_amdgcn_readfirstlane(kdst+(slot)))
  #define DMA_V(t,slot) glds16(vsrc+(long)(t)*4096,(unsigned)__builtin_amdgcn_readfirstlane(vdst+(slot)))
  const int vb0=(int)(lds0+LDS_V)+((lane>>4)&1)*32+(lane&3)*8+(4*hi+((lane&15)>>2))*64;
  const char*Kbase=shm+LDS_K; bf16x8 kf[8];
  const lds_cptr shm3=(lds_cptr)shm; const lds_cptr kp0=shm3+LDS_K+hi*1024+r32*16; const lds_cptr vp0=shm3+LDS_V+((lane>>4)&1)*32+(lane&3)*8+(4*hi+((lane&15)>>2))*64;
  const int NT=(q0+QB+KVPAD)/KVBLK;
  DMA_K(0,0);DMA_V(0,0);DMA_K(1,SLOTB);
  bf16x8 qr[4];
  #pragma unroll
  for(int d0=0;d0<4;++d0)qr[d0]=*(const __attribute__((address_space(1))) bf16x8*)(&Qw[(long)r32*DM+d0*16+hi*8]);
  float mhat=0.f,l_reg=0.f;f32x16 o[2];o[0]=f32x16{};o[1]=f32x16{};
  const __attribute__((address_space(3))) float*csl=(const __attribute__((address_space(3))) float*)((lds_cptr)shm+LDS_CS)+4*hi;
  #define BIASINIT(C0,C1,t) do{ const __attribute__((address_space(3))) float*bp_=csl+64*(t); const float nm_=-mhat; \
    _Pragma("unroll") for(int g_=0;g_<4;++g_){ const f32x4_t a_=*(const __attribute__((address_space(3))) f32x4_t*)(bp_+8*g_), b_=*(const __attribute__((address_space(3))) f32x4_t*)(bp_+32+8*g_); \
      C0[4*g_]=nm_-a_[0];C0[4*g_+1]=nm_-a_[1];C0[4*g_+2]=nm_-a_[2];C0[4*g_+3]=nm_-a_[3]; C1[4*g_]=nm_-b_[0];C1[4*g_+1]=nm_-b_[1];C1[4*g_+2]=nm_-b_[2];C1[4*g_+3]=nm_-b_[3]; } }while(0)
  #define BIASLOAD(C0,C1,t) do{ const __attribute__((address_space(3))) float*bp_=csl+64*(t); \
    _Pragma("unroll") for(int g_=0;g_<4;++g_){ const f32x4_t a_=*(const __attribute__((address_space(3))) f32x4_t*)(bp_+8*g_), b_=*(const __attribute__((address_space(3))) f32x4_t*)(bp_+32+8*g_); \
      C0[4*g_]=a_[0];C0[4*g_+1]=a_[1];C0[4*g_+2]=a_[2];C0[4*g_+3]=a_[3]; C1[4*g_]=b_[0];C1[4*g_+1]=b_[1];C1[4*g_+2]=b_[2];C1[4*g_+3]=b_[3]; } }while(0)
  const int qrel=wid*QBLK+r32;
  #define CMASK(P0,P1,t) do{int jb_=(t)-(NT-4); if(jb_>=0)cmask(P0,P1,jb_,qrel,hi);}while(0)
  bool resc=false;
  #define START(P0,P1) do{ const float rm=rowmax(P0,P1); resc=false; \
    { const float dl=rm; mhat=fadd_s(mhat,dl); \
      _Pragma("unroll") for(int r=0;r<16;++r){P0[r]=fsub_s(P0[r],dl);P1[r]=fsub_s(P1[r],dl);} \
      } \
    _Pragma("unroll") for(int r=0;r<16;++r)P0[r]=__builtin_amdgcn_exp2f(P0[r]); }while(0)
  #define RESC() do{ if(resc){ asm volatile("s_waitcnt lgkmcnt(0)":::"memory"); \
      _Pragma("unroll") for(int d_=0;d_<2;++d_) _Pragma("unroll") for(int r=0;r<16;++r)o[d_][r]*=wsf[crow(r,hi)]; } }while(0)
  f32x16 pA0,pA1,pB0,pB1;
  int sl_prev=0,sl_cur=0,sl_next=SLOTB;
  #define ROT() do{sl_prev=sl_cur;sl_cur=sl_next;sl_next=(sl_next==(NSLOT-1)*SLOTB)?0:sl_next+SLOTB;}while(0)
  DMA_K(2,2*SLOTB);
  WAIT_BAR(3);
  BIASINIT(pA0,pA1,0); qkt(pA0,pA1,Kbase,qr,r32,hi);asm volatile("s_nop 15\n\ts_nop 7":"+v"(pA0),"+v"(pA1));
  START(pA0,pA1);
  _Pragma("unroll") for(int r=0;r<16;++r)pA1[r]=__builtin_amdgcn_exp2f(pA1[r]);
  WAIT_BAR(0);
  DMA_K(3,0);DMA_V(1,SLOTB);
  ROT();
  kload8(kf,kp0+sl_cur);
  WAIT_BAR(2);
  s16x4 vlo[8],vhi[8]; u32x4 pw0,pw1,pw2,pw3;
  #define PKW(P,B) cvtpk_s(P[B],P[B+1])
  #define PAF(k) __builtin_bit_cast(bf16x8,pw##k)
  #define VFR(i) (bf16x8){vlo[i][0],vlo[i][1],vlo[i][2],vlo[i][3],vhi[i][0],vhi[i][1],vhi[i][2],vhi[i][3]}
  #define PIN(x) asm volatile("":"+v"(x))
  #define MX3(a,b,c) __builtin_fmaxf(__builtin_fmaxf((a),(b)),(c))
  #define GAPA(MF,A0,A1,A2,A3,W0,W1,PW) do{ MF; sacc+=A0; sacc+=A1; sacc+=A2; sacc+=A3; PIN(sacc); W0; W1; PIN(PW); SBAR(); }while(0)
  #define EX(v) __builtin_amdgcn_exp2f(v)
  #define GAPB(MF,X,B,NX) do{ MF; X[B]=EX(X[B]); X[B+1]=EX(X[B+1]); X[B+2]=EX(X[B+2]); X[B+3]=EX(X[B+3]); NX[B]=fsub_s(nm_,NX[B]); NX[B+1]=fsub_s(nm_,NX[B+1]); NX[B+2]=fsub_s(nm_,NX[B+2]); NX[B+3]=fsub_s(nm_,NX[B+3]); PIN(X); PIN(NX); SBAR(); }while(0)
  #define VRD(i) do{ vlo[i]=vtr(vp_+(((i)>>2)*4096+((i)&3)*1024)); vhi[i]=vtr(vp_+(((i)>>2)*4096+((i)&3)*1024+512)); }while(0)
  #define KRD(G,j) do{ if(G){ kload2(kf,kp0+sl_next,j); SBAR(); } }while(0)
  #define STEP(C0,C1,P0,P1,t,GK,GV,GL) do{ SBAR(); \
    const lds_cptr vp_=vp0+sl_prev; \
    VRD(0); SBAR(); float sacc=(P0[0]+P0[1]); \
    GAPA(C0=__builtin_amdgcn_mfma_f32_32x32x16_bf16(kf[0],qr[0],C0,0,0,0), P0[2],P0[3],P0[4],P0[5],     pw0[0]=PKW(P0,0), pw0[1]=PKW(P0,2), pw0); \
    VRD(4); SBAR(); GAPA(C1=__builtin_amdgcn_mfma_f32_32x32x16_bf16(kf[1],qr[0],C1,0,0,0), P0[6],P0[7],P0[8],P0[9],     pw0[2]=PKW(P0,4), pw0[3]=PKW(P0,6), pw0); \
    VRD(1); SBAR(); GAPA(C0=__builtin_amdgcn_mfma_f32_32x32x16_bf16(kf[2],qr[1],C0,0,0,0),   P0[10],P0[11],P0[12],P0[13], pw1[0]=PKW(P0,8), pw1[1]=PKW(P0,10), pw1); \
    VRD(5); SBAR(); GAPA(C1=__builtin_amdgcn_mfma_f32_32x32x16_bf16(kf[3],qr[1],C1,0,0,0),   P0[14],P0[15],P1[0],P1[1],   pw1[2]=PKW(P0,12),pw1[3]=PKW(P0,14), pw1); \
    VRD(2); SBAR(); GAPA(C0=__builtin_amdgcn_mfma_f32_32x32x16_bf16(kf[4],qr[2],C0,0,0,0),   P1[2],P1[3],P1[4],P1[5],     pw2[0]=PKW(P1,0), pw2[1]=PKW(P1,2), pw2); \
    VRD(6); SBAR(); GAPA(C1=__builtin_amdgcn_mfma_f32_32x32x16_bf16(kf[5],qr[2],C1,0,0,0),   P1[6],P1[7],P1[8],P1[9],     pw2[2]=PKW(P1,4), pw2[3]=PKW(P1,6), pw2); \
    VRD(3); SBAR(); GAPA(C0=__builtin_amdgcn_mfma_f32_32x32x16_bf16(kf[6],qr[3],C0,0,0,0),   P1[10],P1[11],P1[12],P1[13], pw3[0]=PKW(P1,8), pw3[1]=PKW(P1,10), pw3); \
    VRD(7); SBAR(); GAPA(C1=__builtin_amdgcn_mfma_f32_32x32x16_bf16(kf[7],qr[3],C1,0,0,0),   P1[14],P1[15],0.f,0.f,       pw3[2]=PKW(P1,12),pw3[3]=PKW(P1,14), pw3); \
    l_reg+=sacc; \
    BIASLOAD(P0,P1,(t)+1); \
    if(GK){DMA_K((t)+3,sl_cur);} if(GV){DMA_V((t)+1,sl_next);} \
    CMASK(C0,C1,t); \
    { float a=MX3(C0[0],C0[1],C1[0]),b=MX3(C0[2],C0[3],C1[1]); a=MX3(a,C1[2],C1[3]); \
      _Pragma("unroll") for(int r=4;r<16;r+=4){a=MX3(a,C0[r],C0[r+1]);b=MX3(b,C0[r+2],C0[r+3]);a=MX3(a,C1[r],C1[r+1]);b=MX3(b,C1[r+2],C1[r+3]);} \
      float rm=__builtin_fmaxf(a,b); { auto rr=__builtin_amdgcn_permlane32_swap(__float_as_uint(rm),__float_as_uint(rm),false,false); rm=__builtin_fmaxf(__uint_as_float(rr[0]),__uint_as_float(rr[1])); } \
      resc=false; \
      if(__builtin_expect(__any(rm>(float)THRL),0)){ const float dl=__builtin_fmaxf(rm,0.f); mhat+=dl; \
        _Pragma("unroll") for(int r=0;r<16;++r){C0[r]-=dl;C1[r]-=dl;} \
        const float f=__builtin_amdgcn_exp2f(-dl); l_reg*=f; if(hi==0)wsf[r32]=f; resc=true; } } \
    SBAR(); const float nm_=-mhat; \
    GAPB(o[0]=__builtin_amdgcn_mfma_f32_32x32x16_bf16(PAF(0),VFR(0),o[0],0,0,0), C0,0,P0); \
    GAPB(o[1]=__builtin_amdgcn_mfma_f32_32x32x16_bf16(PAF(0),VFR(4),o[1],0,0,0), C0,4,P0); \
    KRD(GL,0); GAPB(o[0]=__builtin_amdgcn_mfma_f32_32x32x16_bf16(PAF(1),VFR(1),o[0],0,0,0), C0,8,P0); \
    KRD(GL,1); GAPB(o[1]=__builtin_amdgcn_mfma_f32_32x32x16_bf16(PAF(1),VFR(5),o[1],0,0,0), C0,12,P0); \
    KRD(GL,2); GAPB(o[0]=__builtin_amdgcn_mfma_f32_32x32x16_bf16(PAF(2),VFR(2),o[0],0,0,0), C1,0,P1); \
    KRD(GL,3); GAPB(o[1]=__builtin_amdgcn_mfma_f32_32x32x16_bf16(PAF(2),VFR(6),o[1],0,0,0), C1,4,P1); \
    GAPB(o[0]=__builtin_amdgcn_mfma_f32_32x32x16_bf16(PAF(3),VFR(3),o[0],0,0,0), C1,8,P1); \
    GAPB(o[1]=__builtin_amdgcn_mfma_f32_32x32x16_bf16(PAF(3),VFR(7),o[1],0,0,0), C1,12,P1); \
    }while(0)
  BIASINIT(pB0,pB1,1);
  int t=1;
  #undef CMASK
  #define CMASK(P0,P1,t) do{}while(0)
  for(;t+5<NT;t+=2){
    STEP(pB0,pB1,pA0,pA1,t,true,true,true);     WAIT_BAR(2); RESC(); ROT();
    STEP(pA0,pA1,pB0,pB1,t+1,true,true,true);   WAIT_BAR(2); RESC(); ROT();
  }
  #undef CMASK
  #define CMASK(P0,P1,t) do{int jb_=(t)-(NT-4); if(jb_>=0)cmask(P0,P1,jb_,qrel,hi);}while(0)
  #define ENDW(tt) do{ if((tt)+3<NT){WAIT_BAR(2);} else if((tt)+2<NT){WAIT_BAR(1);} else {WAIT_BAR(0);} }while(0)
  for(;t+1<NT;t+=2){
    STEP(pB0,pB1,pA0,pA1,t,(t+3<NT),(t+1<NT),(t+1<NT));       ENDW(t);   RESC(); ROT();
    STEP(pA0,pA1,pB0,pB1,t+1,(t+4<NT),(t+2<NT),(t+2<NT));     ENDW(t+1); RESC(); ROT();
  }
  STEP(pB0,pB1,pA0,pA1,NT-1,false,false,false); RESC();
  { float sacc=pB0[0]+pB0[1]; _Pragma("unroll") for(int r=2;r<16;++r)sacc+=pB0[r]; _Pragma("unroll") for(int r=0;r<16;++r)sacc+=pB1[r]; l_reg+=sacc;
    pw0=(u32x4){PKW(pB0,0),PKW(pB0,2),PKW(pB0,4),PKW(pB0,6)};pw1=(u32x4){PKW(pB0,8),PKW(pB0,10),PKW(pB0,12),PKW(pB0,14)};pw2=(u32x4){PKW(pB1,0),PKW(pB1,2),PKW(pB1,4),PKW(pB1,6)};pw3=(u32x4){PKW(pB1,8),PKW(pB1,10),PKW(pB1,12),PKW(pB1,14)};
    SBAR(); pv(o,vb0+sl_cur,PAF(0),PAF(1),PAF(2),PAF(3)); }
  #undef PKW
  #undef PAF
  #undef VFR
  #undef PIN
  #undef MX3
  #undef GAPA
  #undef GAPB
  #undef EX
  #undef VRD
  #undef KRD
  #undef STEP
  #undef ENDW
  {auto rr=__builtin_amdgcn_permlane32_swap(__float_as_uint(l_reg),__float_as_uint(l_reg),false,false);l_reg=__uint_as_float(rr[0])+__uint_as_float(rr[1]);}
  if(hi==0)wsf[32+r32]=l_reg;asm volatile("s_waitcnt lgkmcnt(0)":::"memory");
  float rli[16];
  #pragma unroll
  for(int r=0;r<16;++r)rli[r]=__builtin_amdgcn_rcpf(wsf[32+crow(r,hi)]);
  bf16*Ow=O+(rowbase+q0+wid*QBLK)*DM+h*D;
  { bf16*stg=(bf16*)(shm+LDS_OST)+wid*2048;
    #pragma unroll
    for(int r=0;r<16;++r){const int orow=crow(r,hi);
      #pragma unroll
      for(int d0=0;d0<2;++d0)stg[orow*64+d0*32+r32]=__float2bfloat16(o[d0][r]*rli[r]);}
    asm volatile("s_waitcnt lgkmcnt(0)":::"memory");
    #pragma unroll
    for(int i=0;i<4;++i){const int row=i*8+(lane>>3),ch=lane&7; const u32x4 v=*(const u32x4*)(stg+row*64+ch*8); ATTN_STORE16(Ow+(long)row*DM+ch*8,v);} }
  asm volatile("s_waitcnt lgkmcnt(0)\n\ts_barrier":::"memory");
  #undef DMA_K
  #undef DMA_V
  #undef CMASK
  #undef START
  #undef RESC
  #undef ROT
  #undef BIASINIT
  #undef BIASLOAD
}
constexpr int ATTN_LDS_BYTES=LDS_BYTES;
struct AttnTensors { const bf16* Q; const bf16* K; const bf16* V; bf16* O; const float* CS; };
struct AttnUnit { int bh; int qb; };
struct StaticOrder {
  int vcu;
  __device__ __forceinline__ explicit StaticOrder(int grid,int block):vcu((block%8)*(grid/8)+block/8){}
  __device__ __forceinline__ bool next(int i,AttnUnit&u)const{ if(i>=4)return false; const int s=vcu&7; u.bh=vcu>>3; u.qb=(i==0)?31-s:(i==1)?16+s:(i==2)?15-s:s; return true; }
  __device__ __forceinline__ void a_ready(const AttnUnit&)const{}
  __device__ __forceinline__ void done(const AttnUnit&)const{}
};
template<class Sched,int THRL=96> __device__ __forceinline__ void attn_phase(char*lds,const AttnTensors&T,const Sched&S,const int tid_in){
  AttnUnit u;
  for(int i=0;S.next(i,u);++i){ S.a_ready(u); attn_unit<THRL>(u.bh/NHEAD,u.bh%NHEAD,u.qb,T.Q,T.K,T.V,T.O,T.CS,lds,tid_in); S.done(u); }
}
#undef SBAR
#undef WAIT_BAR
}
#define LAS __attribute__((address_space(3)))
#define XB_TMO      128
#define XB_XCNT(j)  (256  + 64 * (j))
#define XB_XSUB(j)  (1280 + 64 * (j))
#define XB_XGEN(j)  (2304 + 64 * (j))
#define XB_TOP      3328
#define XB_TOPGEN   3392
#define XCD_BAR_WORDS 3456
#define XB_SPIN_CAP (1u << 18)

__device__ __forceinline__ unsigned xb_ld(unsigned* p)              { return __hip_atomic_load(p, __ATOMIC_RELAXED, __HIP_MEMORY_SCOPE_AGENT); }
__device__ __forceinline__ unsigned xb_add(unsigned* p, unsigned v) { return __hip_atomic_fetch_add(p, v, __ATOMIC_RELAXED, __HIP_MEMORY_SCOPE_AGENT); }
__device__ __forceinline__ unsigned xb_xcc_id() { return (unsigned)__builtin_amdgcn_s_getreg((3 << 11) | 20) & 0xFu; }
#define XB_SPIN(cond, bar) do { unsigned _sp = 0; while (cond) { __builtin_amdgcn_s_sleep(1); \
    if ((++_sp & 255u) == 0u) { if (xb_ld(&(bar)[XB_TMO])) break; if (_sp > XB_SPIN_CAP) { atomicAdd(&(bar)[XB_TMO], 1u); break; } } } } while (0)

struct XcdBarrier {
    unsigned* bar; unsigned x;
    volatile LAS unsigned* st;
};

__device__ __forceinline__ XcdBarrier xcd_barrier_post(unsigned* bar, volatile LAS unsigned* st, const int tid) {
    XcdBarrier b; b.bar = bar; b.x = xb_xcc_id(); b.st = st;
    if (tid == 0) (void)xb_add(&bar[XB_XCNT(b.x)], 1u);
    return b;
}
__device__ __forceinline__ void xcd_barrier_complete(unsigned* bar, unsigned x, unsigned& nloc, unsigned& nx) {
    const unsigned G = gridDim.x * gridDim.y * gridDim.z;
    unsigned sum, cnt, mine, sp = 0u;
    for (;;) {
        sum = 0u; cnt = 0u; mine = 0u;
#pragma unroll
        for (unsigned j = 0; j < 16; ++j) { const unsigned c = xb_ld(&bar[XB_XCNT(j)]); sum += c; cnt += (c > 0u) ? 1u : 0u; mine = (j == x) ? c : mine; }
        if (sum == G) break;
        __builtin_amdgcn_s_sleep(1);
        if ((++sp & 255u) == 0u) { if (xb_ld(&bar[XB_TMO])) break; if (sp > XB_SPIN_CAP) { atomicAdd(&bar[XB_TMO], 1u); break; } }
    }
    nloc = mine > 0u ? mine : 1u; nx = cnt > 0u ? cnt : 1u;
}

__device__ __forceinline__ void xcd_barrier(const XcdBarrier& b, const int tid) {
    asm volatile("s_waitcnt vmcnt(0)" ::: "memory");
    __syncthreads();
    if (tid == 0) {
        unsigned* bar = b.bar; asm volatile("" : "+s"(bar)); unsigned bx_ = (unsigned)__builtin_amdgcn_readfirstlane((int)b.x); asm volatile("" : "+s"(bx_));
        __builtin_amdgcn_s_waitcnt(0);
        unsigned nloc = b.st[0], nx = b.st[1];
        if (nloc == 0u) { xcd_barrier_complete(bar, bx_, nloc, nx); b.st[0] = nloc; b.st[1] = nx; }
        const unsigned old = xb_add(&bar[XB_XSUB(bx_)], 1u);
        const unsigned gen = old / nloc;
        if (old + 1u == (gen + 1u) * nloc) {
            __builtin_amdgcn_fence(__ATOMIC_RELEASE, "agent");
            asm volatile("s_waitcnt vmcnt(0)" ::: "memory");
            const unsigned og = xb_add(&bar[XB_TOP], 1u);
            const unsigned tg = og / nx;
            if (og + 1u == (tg + 1u) * nx) xb_add(&bar[XB_TOPGEN], 1u);
            else XB_SPIN(xb_ld(&bar[XB_TOPGEN]) == tg, bar);
            __builtin_amdgcn_fence(__ATOMIC_ACQUIRE, "agent");
            xb_add(&bar[XB_XGEN(bx_)], 1u);
            asm volatile("s_waitcnt vmcnt(0)" ::: "memory");
        } else {
            XB_SPIN(xb_ld(&bar[XB_XGEN(bx_)]) == gen, bar);
            __builtin_amdgcn_fence(__ATOMIC_ACQUIRE, "agent");
            asm volatile("s_waitcnt vmcnt(0)" ::: "memory");
        }
    }
    __syncthreads();
}
namespace cg = cooperative_groups;
constexpr int NWAVES = 8;
constexpr int DM = 1024, FF = 2816, NH = 16, SEQ = 8192, NMETA = 16, DEPTH = 4;
constexpr int MMAIN = 2 * SEQ;
constexpr int MROWS = MMAIN + NMETA;
constexpr int MPAD = 65 * 256;
constexpr int KVROWS = attn_body::KVROWS;
constexpr float EPS = 1e-6f, LOG2E = 1.4426950408889634f;

constexpr size_t MiB = 1u << 20;
constexpr size_t SZ_GU = (size_t)5632 * 1024 * 2, SZ_DN = (size_t)1024 * 2816 * 2;
constexpr size_t WS_CTL = 0, CTL_ZERO_BYTES = 16384;
constexpr size_t WS_WGU = 1 * MiB, WS_WDN = WS_WGU + 8 * SZ_GU;
constexpr size_t WS_WAI = WS_WDN + 8 * SZ_DN, WS_WAO = WS_WAI + 2 * 6 * MiB, WS_WBI = WS_WAO + 2 * 2 * MiB, WS_WBO = WS_WBI + 4 * MiB;
constexpr size_t WS_WCI = WS_WBO + 2 * MiB, WS_WCO = WS_WCI + 6 * MiB, WS_WF = WS_WCO + 2 * MiB;
constexpr size_t WS_XN = WS_WF + 1 * MiB;
constexpr size_t SZ_ROWBUF = (size_t)MPAD * 1024 * 2;
constexpr size_t WS_ACT = WS_XN + 33 * MiB;
constexpr size_t WS_HMETA = WS_ACT + 98 * MiB, WS_LF = WS_HMETA + 1 * MiB, WS_LFM = WS_LF + 1 * MiB, WS_CS = WS_LFM + 1 * MiB, WS_SSQ = WS_CS + 2 * MiB, WS_SSQM = WS_SSQ + 1 * MiB, WS_END = WS_SSQM + 1 * MiB;
static_assert(SZ_ROWBUF <= 33 * MiB && 3 * SZ_ROWBUF <= 98 * MiB && (size_t)MPAD * FF * 2 <= 98 * MiB, "ws map");

constexpr int RING_BYTES = 131072, LDS_BYTES = 147456;
static_assert(attn_body::ATTN_LDS_BYTES <= RING_BYTES, "attention LDS");
constexpr int MISC_OFF = RING_BYTES + 320;

#define GAS __attribute__((address_space(1)))
typedef unsigned short bf16;
typedef unsigned v4u __attribute__((ext_vector_type(4)));
typedef unsigned v2u __attribute__((ext_vector_type(2)));
typedef float f32x4 __attribute__((ext_vector_type(4)));
typedef float f32x2 __attribute__((ext_vector_type(2)));
typedef short bf16x8 __attribute__((ext_vector_type(8)));
#define LDS_WAIT() asm volatile("s_waitcnt lgkmcnt(0)" ::: "memory")
__device__ __forceinline__ unsigned f2bf(float f) { unsigned u = __builtin_bit_cast(unsigned, f); return (u + 0x7fffu + ((u >> 16) & 1u)) >> 16; }
__device__ __forceinline__ unsigned pk2(float lo, float hi) { return f2bf(lo) | (f2bf(hi) << 16); }
__device__ __forceinline__ float bflo(unsigned w) { return __builtin_bit_cast(float, w << 16); }
__device__ __forceinline__ float bfhi(unsigned w) { return __builtin_bit_cast(float, w & 0xffff0000u); }
__device__ __forceinline__ float lane_get(float v, int src_lane) { return __builtin_bit_cast(float, __builtin_amdgcn_ds_bpermute(src_lane << 2, __builtin_bit_cast(int, v))); }
__device__ __forceinline__ float wave_sum(float v, int lane) {
#pragma unroll
    for (int o = 1; o < 64; o <<= 1) v += lane_get(v, lane ^ o);
    return v;
}

struct Args {
    const float* x; const float* meta; const float* ffn_norm; const float* ffn_w_gate; const float* ffn_w_up; const float* ffn_w_down; const float* mix_norm;
    const float* a_w_in; const float* a_conv; const float* a_w_out;
    const float* b_w_in; const float* b_conv; const float* b_conv_bias; const float* b_ln_g; const float* b_ln_b; const float* b_w_out;
    const float* c_w_in; const float* c_b_f; const float* c_q_norm; const float* c_k_norm; const float* c_w_out;
    float* out; unsigned char* ws;
};

__device__ __forceinline__ void transpose_item(const float* src, int Nsrc, bf16* dst, int K, int kb, LAS float* scr, int lane, const float* gain = nullptr) {
    const int k0 = 64 * kb;
    const GAS float* sp = (const GAS float*)src + (size_t)(k0 + (lane >> 5)) * Nsrc + (lane & 31);
    float v[32];
#pragma unroll
    for (int i = 0; i < 32; ++i) v[i] = sp[(size_t)(2 * i) * Nsrc];
    const int c = lane & 7;
    f32x4 g0 = {1.f, 1.f, 1.f, 1.f}, g1 = g0;
    if (gain) { g0 = *(const GAS f32x4*)(gain + k0 + 8 * c); g1 = *(const GAS f32x4*)(gain + k0 + 8 * c + 4); }
#pragma unroll
    for (int i = 0; i < 32; ++i) scr[(2 * i + (lane >> 5)) * 33 + (lane & 31)] = v[i];
    LDS_WAIT(); asm volatile("" ::: "memory");
#pragma unroll
    for (int j = 0; j < 4; ++j) { const int n = (lane >> 3) + 8 * j; const LAS float* s = scr + (8 * c) * 33 + n;
        v4u o; o.x = pk2(s[0 * 33] * g0.x, s[1 * 33] * g0.y); o.y = pk2(s[2 * 33] * g0.z, s[3 * 33] * g0.w); o.z = pk2(s[4 * 33] * g1.x, s[5 * 33] * g1.y); o.w = pk2(s[6 * 33] * g1.z, s[7 * 33] * g1.w);
        *(GAS v4u*)(dst + (size_t)n * K + k0 + 8 * c) = o; }
    LDS_WAIT(); asm volatile("" ::: "memory");
}

__device__ __forceinline__ float hb_row(const float* xrow, bf16* orow, int lane) {
    const GAS f32x4* xr = (const GAS f32x4*)xrow + lane;
    f32x4 v[4]; float s = 0.f;
#pragma unroll
    for (int j = 0; j < 4; ++j) { v[j] = xr[64 * j]; s += (v[j].x * v[j].x + v[j].y * v[j].y) + (v[j].z * v[j].z + v[j].w * v[j].w); }
    GAS unsigned long long* o8 = (GAS unsigned long long*)orow + lane;
#pragma unroll
    for (int j = 0; j < 4; ++j) o8[64 * j] = (unsigned long long)pk2(v[j].x, v[j].y) | ((unsigned long long)pk2(v[j].z, v[j].w) << 32);
    return wave_sum(s, lane);
}

constexpr int I_GU = 176 * 16, I_DN = 32 * 44, I_AI = 96 * 16, I_SQ = 32 * 16, I_BI = 64 * 16, I_CI = 96 * 16;
constexpr int I_FFN = 2 * I_GU + 2 * I_DN, I_MIXBASE = 8 * I_GU + 8 * I_DN;
static_assert(I_CI == I_AI, "conv_nv");
__device__ __forceinline__ int conv_nv(int L) { return I_FFN + ((L == 1) ? I_BI + I_SQ : I_AI + I_SQ); }
__device__ __forceinline__ int conv_item(int L, int v) {
    if (v < 2 * I_GU) return 2 * L * I_GU + v;
    if (v < I_FFN) return 8 * I_GU + 2 * L * I_DN + (v - 2 * I_GU);
    const int w = v - I_FFN;
    if (L == 0) return (w < I_AI) ? I_MIXBASE + w : I_MIXBASE + 2 * I_AI + (w - I_AI);
    if (L == 3) return (w < I_AI) ? I_MIXBASE + I_AI + w : I_MIXBASE + 2 * I_AI + I_SQ + (w - I_AI);
    if (L == 1) return I_MIXBASE + 2 * I_AI + 2 * I_SQ + w;
    return I_MIXBASE + 2 * I_AI + 2 * I_SQ + I_BI + I_SQ + w;
}
#define CONVERT_BODY \
            int r = it; \
            if (r < 8 * I_GU) { const int mat = r / I_GU; r %= I_GU; const int kb = r / 176, nb = r % 176, pn = nb >> 3, q = nb & 7; \
                const float* src = ((q < 4) ? a.ffn_w_gate : a.ffn_w_up) + (size_t)mat * 1024 * FF + 128 * pn + 32 * (q & 3); \
                transpose_item(src, FF, WGU + (size_t)mat * 5632 * 1024 + (size_t)nb * 32 * 1024, 1024, kb, scr, lane, a.ffn_norm + (size_t)mat * DM); continue; } \
            r -= 8 * I_GU; \
            if (r < 8 * I_DN) { const int mat = r / I_DN; r %= I_DN; const int kb = r / 32, nb = r % 32; \
                transpose_item(a.ffn_w_down + (size_t)mat * FF * 1024 + 32 * nb, 1024, WDN + (size_t)mat * 1024 * FF + (size_t)nb * 32 * FF, FF, kb, scr, lane); continue; } \
            r -= 8 * I_DN; \
            if (r < 2 * I_AI) { const int mat = r / I_AI; r %= I_AI; const int kb = r / 96, nb = r % 96, pn = nb >> 3, q = nb & 7; \
                const int scol = (pn < 8) ? ((q < 4) ? 1024 + 128 * pn + 32 * q : 2048 + 128 * pn + 32 * (q - 4)) : (nb - 64) * 32; \
                transpose_item(a.a_w_in + (size_t)mat * 1024 * 3072 + scol, 3072, WAI + (size_t)mat * 3072 * 1024 + (size_t)nb * 32 * 1024, 1024, kb, scr, lane, a.mix_norm + (size_t)(3 * mat) * DM); continue; } \
            r -= 2 * I_AI; \
            if (r < 2 * I_SQ) { const int mat = r / I_SQ; r %= I_SQ; const int kb = r / 32, nb = r % 32; \
                transpose_item(a.a_w_out + (size_t)mat * 1024 * 1024 + 32 * nb, 1024, WAO + (size_t)mat * 1024 * 1024 + (size_t)nb * 32 * 1024, 1024, kb, scr, lane); continue; } \
            r -= 2 * I_SQ; \
            if (r < I_BI) { const int kb = r / 64, nb = r % 64, pn = nb >> 3, q = nb & 7; \
                const int scol = (q < 4) ? 128 * pn + 32 * q : 1024 + 128 * pn + 32 * (q - 4); \
                transpose_item(a.b_w_in + scol, 2048, WBI + (size_t)nb * 32 * 1024, 1024, kb, scr, lane, a.mix_norm + (size_t)1 * DM); continue; } \
            r -= I_BI; \
            if (r < I_SQ) { const int kb = r / 32, nb = r % 32; \
                transpose_item(a.b_w_out + 32 * nb, 1024, WBO + (size_t)nb * 32 * 1024, 1024, kb, scr, lane); continue; } \
            r -= I_SQ; \
            if (r < I_CI) { const int kb = r / 96, nb = r % 96, pn = nb >> 3, q = nb & 7; \
                const int scol = (pn < 8) ? (pn >> 2) * 1024 + 64 * (4 * (pn & 3) + (q & 3)) + 32 * (q >> 2) : 2048 + (nb - 64) * 32; \
                transpose_item(a.c_w_in + scol, 3088, WCI + (size_t)nb * 32 * 1024, 1024, kb, scr, lane, a.mix_norm + (size_t)2 * DM); continue; } \
            r -= I_CI; \
            { const int kb = r / 32, nb = r % 32; \
                transpose_item(a.c_w_out + 32 * nb, 1024, WCO + (size_t)nb * 32 * 1024, 1024, kb, scr, lane); }

__device__ __forceinline__ void thin_gemm(LAS unsigned char* ldsl, const int tid, const int task, const bf16* A, const bf16* Bt, const int K, const int mode,
                                          bf16* R0, bf16* R1, bf16* R2, float* hmeta, const float scale, const float* qg, const float* kg, float* SSQM, bf16* HB) {
    const int ntasks = (mode == 0) ? 176 : (mode == 2) ? 128 : (mode == 3) ? 48 : 64;
    if (task < 0 || task >= ntasks) return;
    v2u ho_pre = {0u, 0u}; if (mode == 4) ho_pre = *(const GAS v2u*)(HB + (size_t)(MMAIN + (tid & 15)) * 1024 + 16 * task + 4 * ((tid & 63) >> 4));
    float rsm_t = 0.f;
    if (mode != 4) {
#pragma unroll
        for (int i = 0; i < 16; ++i) { const f32x4 q4 = *(const GAS f32x4*)(SSQM + (tid & 15) * 64 + 4 * i); rsm_t += (q4.x + q4.y) + (q4.z + q4.w); } }
    const int lane = tid & 63, wave = __builtin_amdgcn_readfirstlane(tid >> 6), fr = lane & 15, fq = lane >> 4;
    int nt = 1, b0 = 0, b1 = 0, b2 = 0, b3 = 0;
    if (mode <= 1 || (mode == 2 && task < 64)) { const int f0 = 16 * task; b0 = 256 * (f0 >> 7) + (f0 & 127); b1 = b0 + 128; nt = 2; }
    else if (mode == 2) { b0 = 2048 + 16 * (task - 64); }
    else if (mode == 3) { const int sec = task >> 4, hd = task & 15; nt = 4;
        if (sec < 2) { b0 = 256 * (sec * 4 + (hd >> 2)) + 32 * (hd & 3); b1 = b0 + 16; b2 = b0 + 128; b3 = b0 + 144; }
        else { b0 = 2048 + 64 * hd; b1 = b0 + 16; b2 = b0 + 32; b3 = b0 + 48; } }
    else { b0 = 16 * task; }
    const int kw = K >> 3, ksteps = kw >> 5;
    const GAS bf16x8* ap = (const GAS bf16x8*)(A + (size_t)(MMAIN + fr) * K + wave * kw + 8 * fq);
    const GAS bf16x8* p0 = (const GAS bf16x8*)(Bt + (size_t)(b0 + fr) * K + wave * kw + 8 * fq);
    const GAS bf16x8* p1 = (const GAS bf16x8*)(Bt + (size_t)(b1 + fr) * K + wave * kw + 8 * fq);
    const GAS bf16x8* p2 = (const GAS bf16x8*)(Bt + (size_t)(b2 + fr) * K + wave * kw + 8 * fq);
    const GAS bf16x8* p3 = (const GAS bf16x8*)(Bt + (size_t)(b3 + fr) * K + wave * kw + 8 * fq);
    f32x4 c0 = {0.f, 0.f, 0.f, 0.f}, c1 = c0, c2 = c0, c3 = c0;
    if (ksteps > 4) {
        bf16x8 xa[11], wb[11];
#pragma unroll
        for (int ks = 0; ks < 11; ++ks) { xa[ks] = ap[4 * ks]; wb[ks] = p0[4 * ks]; }
#pragma unroll
        for (int ks = 0; ks < 11; ++ks) c0 = __builtin_amdgcn_mfma_f32_16x16x32_bf16(wb[ks], xa[ks], c0, 0, 0, 0);
    } else {
#pragma unroll 4
    for (int ks = 0; ks < ksteps; ++ks) {
        const bf16x8 xa = ap[4 * ks];
        c0 = __builtin_amdgcn_mfma_f32_16x16x32_bf16(p0[4 * ks], xa, c0, 0, 0, 0);
        if (nt >= 2) c1 = __builtin_amdgcn_mfma_f32_16x16x32_bf16(p1[4 * ks], xa, c1, 0, 0, 0);
        if (nt >= 4) { c2 = __builtin_amdgcn_mfma_f32_16x16x32_bf16(p2[4 * ks], xa, c2, 0, 0, 0); c3 = __builtin_amdgcn_mfma_f32_16x16x32_bf16(p3[4 * ks], xa, c3, 0, 0, 0); }
    }
    }
    LAS f32x4* P = (LAS f32x4*)ldsl;
    P[(wave * 4 + 0) * 64 + lane] = c0; P[(wave * 4 + 1) * 64 + lane] = c1; P[(wave * 4 + 2) * 64 + lane] = c2; P[(wave * 4 + 3) * 64 + lane] = c3;
    __syncthreads();
    if (wave == 0) {
#pragma unroll
        for (int w = 1; w < 8; ++w) { c0 += P[(w * 4 + 0) * 64 + lane]; c1 += P[(w * 4 + 1) * 64 + lane]; c2 += P[(w * 4 + 2) * 64 + lane]; c3 += P[(w * 4 + 3) * 64 + lane]; }
        const size_t mrow = (size_t)(MMAIN + fr);
        if (mode != 4) { const float rsm = __builtin_amdgcn_rsqf(rsm_t * (1.f / DM) + EPS); c0 *= rsm; c1 *= rsm; c2 *= rsm; c3 *= rsm; }
        if (mode <= 1 || (mode == 2 && task < 64)) {
            f32x4 r;
            if (mode == 0) {
#pragma unroll
                for (int i = 0; i < 4; ++i) r[i] = c0[i] * pg8::sigm(c0[i]) * c1[i];
            } else if (mode == 1) {
#pragma unroll
                for (int i = 0; i < 4; ++i) r[i] = c0[i] * pg8::sigm(c1[i]);
            } else r = c0 * c1;
            *(GAS v2u*)(R0 + mrow * (mode == 0 ? FF : 1024) + 16 * task + 4 * fq) = (v2u){pk2(r[0], r[1]), pk2(r[2], r[3])};
        } else if (mode == 2) {
            *(GAS v2u*)(R1 + mrow * 1024 + 16 * (task - 64) + 4 * fq) = (v2u){pk2(c0[0], c0[1]), pk2(c0[2], c0[3])};
        } else if (mode == 3) {
            const int sec = task >> 4, hd = task & 15;
            f32x4 v0 = c0, v1 = c1, v2 = c2, v3 = c3;
            if (sec < 2) {
                float ss = (c0[0] * c0[0] + c0[1] * c0[1]) + (c0[2] * c0[2] + c0[3] * c0[3]) + (c1[0] * c1[0] + c1[1] * c1[1]) + (c1[2] * c1[2] + c1[3] * c1[3])
                         + (c2[0] * c2[0] + c2[1] * c2[1]) + (c2[2] * c2[2] + c2[3] * c2[3]) + (c3[0] * c3[0] + c3[1] * c3[1]) + (c3[2] * c3[2] + c3[3] * c3[3]);
                ss += lane_get(ss, lane ^ 16); ss += lane_get(ss, lane ^ 32);
                const float rs = __builtin_amdgcn_rsqf(ss * (1.0f / 64.0f) + EPS) * ((sec == 0) ? pg8::QK_C2 : 1.0f);
                const float* g = (sec == 0) ? qg : kg;
                v0 = c0 * rs * *(const GAS f32x4*)(g + 4 * fq); v1 = c1 * rs * *(const GAS f32x4*)(g + 16 + 4 * fq); v2 = c2 * rs * *(const GAS f32x4*)(g + 32 + 4 * fq); v3 = c3 * rs * *(const GAS f32x4*)(g + 48 + 4 * fq);
            }
            const v2u w0 = {pk2(v0[0], v0[1]), pk2(v0[2], v0[3])}, w1 = {pk2(v1[0], v1[1]), pk2(v1[2], v1[3])}, w2 = {pk2(v2[0], v2[1]), pk2(v2[2], v2[3])}, w3 = {pk2(v3[0], v3[1]), pk2(v3[2], v3[3])};
            const int col = 64 * hd + 4 * fq;
            if (sec == 0) { bf16* q = R0 + mrow * 1024 + col; *(GAS v2u*)q = w0; *(GAS v2u*)(q + 16) = w1; *(GAS v2u*)(q + 32) = w2; *(GAS v2u*)(q + 48) = w3; }
            else { bf16* T = (sec == 1) ? R1 : R2;
#pragma unroll
                for (int b = 0; b < 2; ++b) { bf16* tb = T + (size_t)((b * NH + hd) * 130) * 4096; (void)col;
                    if (sec == 1) { bf16* q = tb + (size_t)(fq >> 1) * 512 + (48 + fr) * 8 + 4 * (fq & 1); *(GAS v2u*)q = w0; *(GAS v2u*)(q + 1024) = w1; *(GAS v2u*)(q + 2048) = w2; *(GAS v2u*)(q + 3072) = w3; }
                    else { bf16* q = tb + (size_t)(48 + fr) * 32 + 4 * fq; *(GAS v2u*)q = w0; *(GAS v2u*)(q + 16) = w1; *(GAS v2u*)(q + 2048) = w2; *(GAS v2u*)(q + 2048 + 16) = w3; } } }
        } else {
            const v2u ho = ho_pre;
            const f32x4 hn = (f32x4){bflo(ho.x), bfhi(ho.x), bflo(ho.y), bfhi(ho.y)} + c0 * scale;
            *(GAS v2u*)(HB + mrow * 1024 + 16 * task + 4 * fq) = (v2u){pk2(hn[0], hn[1]), pk2(hn[2], hn[3])};
            float ps = (hn[0] * hn[0] + hn[1] * hn[1]) + (hn[2] * hn[2] + hn[3] * hn[3]); ps += lane_get(ps, lane ^ 16); ps += lane_get(ps, lane ^ 32);
            if (fq == 0) SSQM[fr * 64 + task] = ps;
        }
    }
    __syncthreads();
}

__global__ void __launch_bounds__(NWAVES * 64, 2) fwd_megakernel(Args a_unused) {
    extern __shared__ __attribute__((aligned(16))) unsigned char lds[];
    cg::grid_group grid = cg::this_grid();
    const int G = gridDim.x, bx = blockIdx.x;
    const int vcu0 = (G % 8 == 0) ? (bx % 8) * (G / 8) + bx / 8 : bx;
    const int NGW = G * NWAVES;
    if (threadIdx.x < 64) ((LAS unsigned*)((LAS unsigned char*)lds + RING_BYTES))[threadIdx.x * 2] = 0u, ((LAS unsigned*)((LAS unsigned char*)lds + RING_BYTES))[threadIdx.x * 2 + 1] = 0u;
    __syncthreads();
    const int wave_s = __builtin_amdgcn_readfirstlane((int)threadIdx.x >> 6);
#define PHASE_ENV() \
    const __attribute__((address_space(4))) Args* kap_ = (const __attribute__((address_space(4))) Args*)__builtin_amdgcn_kernarg_segment_ptr(); asm volatile("" : "+s"(kap_)); \
    const __attribute__((address_space(4))) Args& a = *kap_;     \
    unsigned zero_ = 0u; asm volatile("" : "+s"(zero_)); int vcu = vcu0; asm volatile("" : "+s"(vcu)); \
    int tid = (wave_s << 6) | (int)__builtin_amdgcn_mbcnt_hi(~0u, __builtin_amdgcn_mbcnt_lo(~0u, zero_)); \
    const int lane = tid & 63, wave = __builtin_amdgcn_readfirstlane(tid >> 6), gw = vcu * NWAVES + wave; \
    unsigned char* ws0_ = a.ws; asm volatile("" : "+s"(ws0_)); unsigned char* const ws = (unsigned char*)(GAS unsigned char*)ws0_;     \
    float* hm0_ = a.out; asm volatile("" : "+s"(hm0_)); float* const hmain = (float*)(GAS float*)hm0_; \
    bf16* const WGU = (bf16*)(ws + WS_WGU); bf16* const WDN = (bf16*)(ws + WS_WDN); \
    bf16* const WAI = (bf16*)(ws + WS_WAI); bf16* const WAO = (bf16*)(ws + WS_WAO); bf16* const WBI = (bf16*)(ws + WS_WBI); bf16* const WBO = (bf16*)(ws + WS_WBO); \
    bf16* const WCI = (bf16*)(ws + WS_WCI); bf16* const WCO = (bf16*)(ws + WS_WCO); bf16* const WFt = (bf16*)(ws + WS_WF); \
    bf16* const XN = (bf16*)(ws + WS_XN); \
    bf16* const R0 = (bf16*)(ws + WS_ACT); bf16* const R1 = (bf16*)(ws + WS_ACT + SZ_ROWBUF); bf16* const R2 = (bf16*)(ws + WS_ACT + 2 * SZ_ROWBUF); \
    float* const hmeta = (float*)(ws + WS_HMETA); \
    float* const LF = (float*)(ws + WS_LF); float* const LFM = (float*)(ws + WS_LFM); float* const CS = (float*)(ws + WS_CS); \
    float* const SSQ = (float*)(ws + WS_SSQ); float* const SSQM = (float*)(ws + WS_SSQM); (void)SSQ; (void)SSQM; \
    LAS unsigned char* const ldsl = (LAS unsigned char*)lds; \
    (void)WGU; (void)WDN; (void)WAI; (void)WAO; (void)WBI; (void)WBO; (void)WCI; (void)WCO; (void)WFt; (void)XN; (void)R0; (void)R1; (void)R2; (void)hmeta; (void)LF; (void)LFM; (void)CS; (void)ldsl; (void)lane; (void)gw; (void)hmain;

#ifdef PROBE_SEL
    LAS unsigned long long* const TS = (LAS unsigned long long*)((LAS unsigned char*)lds + RING_BYTES + 12288);
    if (threadIdx.x == 0) { for (int c = 0; c < 8; ++c) TS[c] = 0; TS[8] = __builtin_amdgcn_s_memrealtime(); }
#endif
    XcdBarrier bar;
    { PHASE_ENV(); bar = xcd_barrier_post((unsigned*)(ws + WS_CTL), (volatile LAS unsigned*)(ldsl + MISC_OFF) + 8, tid); }
    {
        PHASE_ENV();
        LAS float* scr = (LAS float*)(ldsl + wave * 16384);
        for (int v = gw; v < conv_nv(0); v += NGW) { const int it = conv_item(0, v);
            CONVERT_BODY
        }
        for (int i = gw * 64 + lane; i < 16 * 1024; i += NGW * 64) { const int h = i >> 10, k = i & 1023; WFt[i] = (bf16)f2bf(a.c_w_in[(size_t)k * 3088 + 3072 + h] * a.mix_norm[2 * DM + k]); }
        for (int m0 = gw; m0 < MROWS; m0 += 2 * NGW) {
            const int m1 = m0 + NGW; const bool has1 = (m1 < MROWS);
            const float* s0 = (m0 < MMAIN) ? a.x + (size_t)m0 * DM : a.meta + (size_t)(m0 - MMAIN) * DM;
            const float* s1 = !has1 ? s0 : (m1 < MMAIN) ? a.x + (size_t)m1 * DM : a.meta + (size_t)(m1 - MMAIN) * DM;
            f32x4 va[4], vb[4];
#pragma unroll
            for (int j = 0; j < 4; ++j) { va[j] = ((const GAS f32x4*)s0 + lane)[64 * j]; vb[j] = ((const GAS f32x4*)s1 + lane)[64 * j]; }
#pragma unroll
            for (int half = 0; half < 2; ++half) {
                if (half == 1 && !has1) break;
                const int m = half ? m1 : m0; float ssl = 0.f;
                GAS unsigned long long* o8 = (GAS unsigned long long*)(XN + (size_t)m * DM) + lane;
#pragma unroll
                for (int j = 0; j < 4; ++j) { const f32x4 v = half ? vb[j] : va[j]; ssl += (v.x * v.x + v.y * v.y) + (v.z * v.z + v.w * v.w);
                    o8[64 * j] = (unsigned long long)pk2(v.x, v.y) | ((unsigned long long)pk2(v.z, v.w) << 32); }
                const float ss = wave_sum(ssl, lane);
                if (m < MMAIN) { if (lane < 4) SSQ[(size_t)m * 4 + lane] = (lane == 0) ? ss : 0.f; } else SSQM[(m - MMAIN) * 64 + lane] = (lane == 0) ? ss : 0.f;
            }
        }
    }
    { PHASE_ENV(); if (ws == nullptr) grid.sync();
      xcd_barrier(bar, tid); }
#ifdef PROBE_SEL
    { PHASE_ENV(); if (tid == 0) { TS[9] = __builtin_amdgcn_s_memrealtime(); TS[0] = TS[9] - TS[8]; } }
#endif
    for (int L = 0; L < DEPTH; ++L) {
        const int mx = L % 3, mj = L / 3;
        for (int s = 0; s <= 10; ++s) {
            if ((s == 6 && mx != 2) || (s == 5 && mx == 2) || s == 0 || s == 3 || s == 8) continue;
#ifdef PROBE_REP
            const int pcat = (s == 1 || s == 9) ? 1 : (s == 2 || s == 10 || s == 7) ? 2 : (s == 4) ? 4 : (s == 5) ? 8 : 16; const int nrep = (PROBE_REP & pcat) ? 2 : 1;
#else
            const int nrep = 1;
#endif
            for (int rp = 0; rp < nrep; ++rp) {
            const bool dry = (rp + 1 < nrep); (void)dry;
            PHASE_ENV();
            if (s == 0 || s == 3 || s == 8) {
                continue;
            } else if (s == 1 || s == 2 || s == 4 || s == 7 || s == 9 || s == 10) {
                pg8::Gemm g; pg8::EpiAll E;
                E.mtiles_main = 64; E.O1 = R0; E.O2 = R1; E.O3 = R2; E.ldo = 1024; E.hmain = hmain; E.hmeta = hmeta; E.scale = 1.f; E.qg = a.c_q_norm; E.kg = a.c_k_norm; E.mode = 0;
                E.ssq = SSQ; E.ssq_out = SSQ; E.hb = XN; E.fout = (L == DEPTH - 1 && s == 10 && !dry) ? hmain : nullptr; E.ldsp = (LAS float*)(ldsl + RING_BYTES + 1024); E.rsl = (const LAS float*)(ldsl + RING_BYTES + 5120);
                g.M = MMAIN;
                if (s == 1 || s == 9) { g.A = XN; g.Bt = WGU + (size_t)(L * 2 + (s == 9)) * 5632 * 1024; g.N = 5632; g.K = 1024; E.mode = 0; E.ldo = FF; }
                else if (s == 2 || s == 10) { g.A = R0; g.Bt = WDN + (size_t)(L * 2 + (s == 10)) * 1024 * FF; g.N = 1024; g.K = FF; E.mode = 4; E.scale = dry ? 0.f : 0.5f; }
                else if (s == 4) {
                    g.A = XN; g.K = 1024;
                    if (mx == 0) { g.Bt = WAI + (size_t)mj * 3072 * 1024; g.N = 3072; E.mode = 2; }
                    else if (mx == 1) { g.Bt = WBI; g.N = 2048; E.mode = 1; }
                    else { g.Bt = WCI; g.N = 3072; E.mode = 3;
                    for (int i = gw; i < 64; i += NGW) { const int tsel = i >> 5, bhh = i & 31; bf16* tb = (tsel ? R2 : R1) + (size_t)(bhh * 130) * 4096; const v4u z4_ = {zero_, zero_, zero_, zero_};
#pragma unroll
                        for (int j = 0; j < 8; ++j) ((GAS v4u*)(tb + 4096 + lane * 64))[j] = z4_;
                        if (lane < 48) {
                            if (tsel == 0) {
#pragma unroll
                                for (int c = 0; c < 8; ++c) *(GAS v4u*)(tb + c * 512 + lane * 8) = z4_; }
                            else {
#pragma unroll
                                for (int c = 0; c < 8; ++c) *(GAS v4u*)(tb + (c >> 2) * 2048 + lane * 32 + (c & 3) * 8) = z4_; } } }
                        const int fr = lane & 15, fq = lane >> 4;
                        for (int grp = gw; grp < MROWS / 16; grp += NGW) {
                            const bf16* xp = XN + (size_t)(16 * grp + fr) * DM + 8 * fq; const bf16* wp = WFt + (size_t)fr * DM + 8 * fq;
                            f32x4 acc = {0.f, 0.f, 0.f, 0.f};
#pragma unroll 16
                            for (int k = 0; k < 32; ++k) { const bf16x8 xa = *(const GAS bf16x8*)(xp + 32 * k), wb = *(const GAS bf16x8*)(wp + 32 * k);
                                acc = __builtin_amdgcn_mfma_f32_16x16x32_bf16(xa, wb, acc, 0, 0, 0); }
                            const float bf = a.c_b_f[fr]; f32x4 o; float rsr[4];
                            if (grp < MMAIN / 16) {
#pragma unroll
                                for (int r = 0; r < 4; ++r) { const f32x4 q4 = *(const GAS f32x4*)(SSQ + (size_t)(16 * grp + 4 * fq + r) * 4); rsr[r] = __builtin_amdgcn_rsqf(((q4.x + q4.y) + (q4.z + q4.w)) * (1.f / DM) + EPS); }
                            } else {
#pragma unroll
                                for (int r = 0; r < 4; ++r) { float t = 0.f; for (int i = 0; i < 16; ++i) { const f32x4 q4 = *(const GAS f32x4*)(SSQM + (4 * fq + r) * 64 + 4 * i); t += (q4.x + q4.y) + (q4.z + q4.w); } rsr[r] = __builtin_amdgcn_rsqf(t * (1.f / DM) + EPS); }
                            }
#pragma unroll
                            for (int r = 0; r < 4; ++r) { const float xv = acc[r] * rsr[r] + bf; o[r] = fminf(xv, 0.f) - log1pf(expf(-fabsf(xv))); }
                            if (grp < MMAIN / 16) { const int r0 = 16 * grp, b = r0 >> 13, t0 = r0 & 8191; *(GAS f32x4*)(LF + ((size_t)(b * NH + fr) * SEQ + t0 + 4 * fq)) = o; }
                            else *(GAS f32x4*)(LFM + fr * 16 + 4 * fq) = o;
                        }
                        asm volatile("s_waitcnt vmcnt(0) lgkmcnt(0)" ::: "memory"); __syncthreads();
                    }
                }
                else { g.K = 1024; g.N = 1024; E.mode = 4; E.scale = dry ? 0.f : 1.f;
                    if (mx == 0) { g.A = R2; g.Bt = WAO + (size_t)mj * 1024 * 1024; } else if (mx == 1) { g.A = R1; g.Bt = WBO; } else { g.A = R0; g.Bt = WCO; } }
                pg8::StaticOrder S; S.init(g.M, g.N, G, bx);
                f32x4 rs_q[3] = {{0.f, 0.f, 0.f, 0.f}, {0.f, 0.f, 0.f, 0.f}, {0.f, 0.f, 0.f, 0.f}}; bool rs_has[3] = {false, false, false};
                if (E.mode != 4) { pg8::Unit uu{0, 0};
#pragma unroll
                    for (int j = 0; j < 3; ++j) { const int i = (tid >> 8) + 2 * j; rs_has[j] = S.next(i, uu); if (rs_has[j]) rs_q[j] = *(const GAS f32x4*)(SSQ + (size_t)(uu.pm * 256 + (tid & 255)) * 4); } }
                for (int rep2 = 0; rep2 < 2; ++rep2) { const int task = (E.mode == 0) ? ((bx >= 128) ? bx - 128 + 128 * rep2 : -1) : (rep2 == 0 ? vcu : -1);
                    thin_gemm(ldsl, tid, task, g.A, g.Bt, g.K, E.mode, R0, R1, R2, hmeta, E.scale, a.c_q_norm, a.c_k_norm, SSQM, XN); }
                if (E.mode != 4) {
                    LAS float* rsl = (LAS float*)(ldsl + RING_BYTES + 5120);
#pragma unroll
                    for (int j = 0; j < 3; ++j) { const int i = (tid >> 8) + 2 * j; if (rs_has[j]) rsl[i * 256 + (tid & 255)] = __builtin_amdgcn_rsqf(((rs_q[j].x + rs_q[j].y) + (rs_q[j].z + rs_q[j].w)) * (1.f / DM) + EPS); }
                }
#ifndef NO_GEMM
                pg8::gemm_phase<pg8::EpiAll, pg8::StaticOrder, PG8_ALIGN, PG8_SP2>(ldsl, g, S, E, tid);
#endif
                if ((s == 1 || s == 9) && L + 1 < DEPTH && bx >= 128 && !dry) {
                    LAS float* scr = (LAS float*)(ldsl + wave * 16384);
                    const int nv = conv_nv(L + 1), lo = (s == 1) ? 0 : nv / 2, hi = (s == 1) ? nv / 2 : nv;
                    for (int v = lo + (bx - 128) * NWAVES + wave; v < hi; v += 128 * NWAVES) { const int it = conv_item(L + 1, v);
                        CONVERT_BODY
                    }
                }
                if (E.mode == 4) {
                    const int pm0 = 8 * (bx & 7) + ((bx >> 3) & 7), pn0 = bx >> 6;
                    if (G == 256 && tid < 256) { const f32x4 p4 = *(const LAS f32x4*)(E.ldsp + tid * 4); SSQ[(size_t)(pm0 * 256 + tid) * 4 + pn0] = (p4.x + p4.y) + (p4.z + p4.w); }
                }
            } else if (s == 5) {
                if (mx == 0) {
                    const float* cw = a.a_conv + (size_t)mj * 3 * DM + 16 * lane;
                    f32x4 w0[4], w1[4], w2[4];
#pragma unroll
                    for (int j = 0; j < 4; ++j) { w0[j] = *(const f32x4*)(cw + 4 * j); w1[j] = *(const f32x4*)(cw + DM + 4 * j); w2[j] = *(const f32x4*)(cw + 2 * DM + 4 * j); }
                    for (int blk = gw; blk < MROWS / 4; blk += NGW) {
                        const bool mainb = (blk < MMAIN / 4); const int r0 = mainb ? 4 * blk : MMAIN + 4 * (blk - MMAIN / 4);
                        int rm1, rm2;
                        if (mainb) { const int t0 = r0 & 8191; rm1 = (t0 >= 1) ? r0 - 1 : MMAIN + 15; rm2 = (t0 >= 2) ? r0 - 2 : MMAIN + 14; }
                        else { const int p0 = r0 - MMAIN; rm1 = (p0 >= 1) ? r0 - 1 : -1; rm2 = (p0 >= 2) ? r0 - 2 : -1; }
                        const v4u z4 = {0u, 0u, 0u, 0u};
                        v4u xw[6][2], bb[4][2];
#pragma unroll
                        for (int hh = 0; hh < 2; ++hh) {
                            xw[0][hh] = (rm2 >= 0) ? ((const GAS v4u*)(R0 + (size_t)rm2 * DM) + 2 * lane)[hh] : z4; xw[1][hh] = (rm1 >= 0) ? ((const GAS v4u*)(R0 + (size_t)rm1 * DM) + 2 * lane)[hh] : z4;
#pragma unroll
                            for (int i = 0; i < 4; ++i) { xw[2 + i][hh] = ((const GAS v4u*)(R0 + (size_t)(r0 + i) * DM) + 2 * lane)[hh]; bb[i][hh] = ((const GAS v4u*)(R1 + (size_t)(r0 + i) * DM) + 2 * lane)[hh]; } }
#pragma unroll
                        for (int i = 0; i < 4; ++i) { GAS v4u* yp = (GAS v4u*)(R2 + (size_t)(r0 + i) * DM) + 2 * lane;
#pragma unroll
                            for (int hh = 0; hh < 2; ++hh) { v4u o;
#pragma unroll
                                for (int e = 0; e < 4; ++e) { const int j = 2 * hh + (e >> 1), c = 2 * (e & 1);
                                    const float lo = bflo(bb[i][hh][e]) * (w2[j][c] * bflo(xw[2 + i][hh][e]) + w1[j][c] * bflo(xw[1 + i][hh][e]) + w0[j][c] * bflo(xw[i][hh][e]));
                                    const float hi = bfhi(bb[i][hh][e]) * (w2[j][c + 1] * bfhi(xw[2 + i][hh][e]) + w1[j][c + 1] * bfhi(xw[1 + i][hh][e]) + w0[j][c + 1] * bfhi(xw[i][hh][e]));
                                    o[e] = pk2(lo, hi); }
                                yp[hh] = o; } }
                    }
                } else if (mx == 1) {
#ifndef NO_CONF
                    const int c = 2 * tid;
                    f32x2 w[31];
#pragma unroll
                    for (int k = 0; k < 31; ++k) w[k] = *(const GAS f32x2*)(a.b_conv + (size_t)k * DM + c);
                    const f32x2 cb = *(const f32x2*)(a.b_conv_bias + c), lg = *(const f32x2*)(a.b_ln_g + c), lb = *(const f32x2*)(a.b_ln_b + c);
                    LAS float* red = (LAS float*)ldsl;
                    LAS float* red2 = red + 256;
                    for (int un = vcu; un < MROWS / 16; un += G) {
                        const int r0 = 16 * un; const bool meta = (r0 >= MMAIN);
                        const int p0 = meta ? 0 : 16 + (r0 & 8191); const int rowb = meta ? 0 : (r0 >> 13) * SEQ;
                        unsigned xin[46];
#pragma unroll
                        for (int j = 0; j < 46; ++j) { const int pj = p0 - 30 + j;
                            xin[j] = (pj >= 0) ? *(const GAS unsigned*)(R0 + (size_t)((pj < 16) ? MMAIN + pj : rowb + pj - 16) * DM + c) : 0u; }
                        f32x2 acc[16];
#pragma unroll
                        for (int i = 0; i < 16; ++i) acc[i] = cb;
#pragma unroll
                        for (int j = 0; j < 46; ++j) { const f32x2 xv = {bflo(xin[j]), bfhi(xin[j])};
#pragma unroll
                            for (int i = 0; i < 16; ++i) { const int k = j - i; if (k >= 0 && k <= 30) acc[i] += w[k] * xv; } }
                        float st[32];
#pragma unroll
                        for (int i = 0; i < 16; ++i) { st[2 * i] = acc[i].x + acc[i].y; st[2 * i + 1] = acc[i].x * acc[i].x + acc[i].y * acc[i].y; }
#pragma unroll
                        for (int i = 0; i < 32; ++i) st[i] = wave_sum(st[i], lane);
                        if (lane == 0) {
#pragma unroll
                            for (int i = 0; i < 8; ++i) *(LAS f32x4*)(red + wave * 32 + 4 * i) = (f32x4){st[4 * i], st[4 * i + 1], st[4 * i + 2], st[4 * i + 3]}; }
                        __syncthreads();
                        if (tid < 32) { float t = 0.f;
#pragma unroll
                            for (int wv = 0; wv < 8; ++wv) t += red[wv * 32 + tid];
                            red2[tid] = t; }
                        __syncthreads();
#pragma unroll
                        for (int i = 0; i < 16; ++i) { const f32x2 sv = *(const LAS f32x2*)(red2 + 2 * i);
                            const float mu = sv.x * (1.f / DM), var = fmaxf(sv.y * (1.f / DM) - mu * mu, 0.f), rs = 1.0f / sqrtf(var + EPS);
                            const float y0 = (acc[i].x - mu) * rs * lg.x + lb.x, y1 = (acc[i].y - mu) * rs * lg.y + lb.y;
                            *(GAS unsigned*)(R1 + (size_t)(r0 + i) * DM + c) = pk2(y0 * pg8::sigm(y0), y1 * pg8::sigm(y1)); }
                    }
#endif
                } else {
                }
            } else if (s == 6) {
                {
                        const int bh = vcu >> 3, h = bh & 15; LAS float* wt = (LAS float*)ldsl;
                        LAS float* csrow = (LAS float*)(ldsl + attn_body::LDS_CS);
                        float cm = 0.f, cmp = 0.f;
#pragma unroll
                        for (int j = 0; j < 16; ++j) { cm += LFM[h * 16 + j]; if (j == tid) cmp = cm; }
                        const float* lp = LF + (size_t)bh * SEQ + 16 * tid; float v[16];
#pragma unroll
                        for (int j = 0; j < 4; ++j) { const f32x4 q = *(const GAS f32x4*)(lp + 4 * j); v[4 * j] = q.x; v[4 * j + 1] = q.y; v[4 * j + 2] = q.z; v[4 * j + 3] = q.w; }
#pragma unroll
                        for (int j = 1; j < 16; ++j) v[j] += v[j - 1];
                        float inc = v[15];
#pragma unroll
                        for (int o = 1; o < 64; o <<= 1) { const float t = lane_get(inc, (lane - o) & 63); if (lane >= o) inc += t; }
                        if (lane == 63) wt[wave] = inc;
                        __syncthreads();
                        float off = cm + inc - v[15];
                        for (int wv = 0; wv < wave; ++wv) off += wt[wv];
#pragma unroll
                        for (int j = 0; j < 4; ++j) *(LAS f32x4*)(csrow + 128 + 16 * tid + 4 * j) = (f32x4){(off + v[4 * j]) * LOG2E, (off + v[4 * j + 1]) * LOG2E, (off + v[4 * j + 2]) * LOG2E, (off + v[4 * j + 3]) * LOG2E};
                        const float cmsh = lane_get(cmp, (lane + 16) & 63);
                        if (tid < 128) csrow[tid] = (tid >= 48 && tid < 64) ? cmsh * LOG2E : __builtin_inff();
                        __syncthreads();
                }
                const attn_body::AttnTensors AT{(const attn_body::bf16*)R0, (const attn_body::bf16*)R1, (const attn_body::bf16*)R2, (attn_body::bf16*)(dry ? (bf16*)(ws + WS_END) : R0), CS};
                const attn_body::StaticOrder S(G, bx);
#ifndef NO_ATTN
                attn_body::attn_phase<attn_body::StaticOrder>((char*)lds, AT, S, tid);
#endif
                }
                if (s == 6 && !dry) {
                PHASE_ENV();
                if (gw < NH) {
                    const int h = gw, q = lane & 15, dc = lane >> 4;
                    const bf16* qp = R0 + (size_t)(MMAIN + q) * DM + 64 * h + 16 * dc;
                    const v4u qa = ((const GAS v4u*)qp)[0], qb = ((const GAS v4u*)qp)[1];
                    float qv[16];
#pragma unroll
                    for (int e = 0; e < 4; ++e) { qv[2 * e] = bflo(qa[e]); qv[2 * e + 1] = bfhi(qa[e]); qv[8 + 2 * e] = bflo(qb[e]); qv[8 + 2 * e + 1] = bfhi(qb[e]); }
                    float sc[16], cbm[16]; { float run = 0.f;
#pragma unroll
                        for (int j = 0; j < 16; ++j) { run += *(const GAS float*)(LFM + h * 16 + j); cbm[j] = run * LOG2E; } }
#pragma unroll
                    for (int jb = 0; jb < 16; jb += 8) {
                        v4u ka[8], kb[8]; float cb[8];
#pragma unroll
                        for (int j = 0; j < 8; ++j) { const bf16* kp = R1 + (size_t)(h * 130) * 4096 + (2 * dc) * 512 + (48 + jb + j) * 8; ka[j] = *(const GAS v4u*)kp; kb[j] = *(const GAS v4u*)(kp + 512);
                            cb[j] = cbm[jb + j]; }
#pragma unroll
                        for (int j = 0; j < 8; ++j) { float d = 0.f;
#pragma unroll
                            for (int e = 0; e < 4; ++e) d += qv[2 * e] * bflo(ka[j][e]) + qv[2 * e + 1] * bfhi(ka[j][e]) + qv[8 + 2 * e] * bflo(kb[j][e]) + qv[8 + 2 * e + 1] * bfhi(kb[j][e]);
                            d += lane_get(d, lane ^ 16); d += lane_get(d, lane ^ 32);
                            sc[jb + j] = (jb + j <= q) ? d - cb[j] : -__builtin_inff(); }
                    }
                    float mrun = sc[0];
#pragma unroll
                    for (int j = 1; j < 16; ++j) mrun = fmaxf(mrun, sc[j]);
                    float l = 0.f, o[16];
#pragma unroll
                    for (int e = 0; e < 16; ++e) o[e] = 0.f;
#pragma unroll
                    for (int jb = 0; jb < 16; jb += 8) {
                        v4u va[8], vb[8];
#pragma unroll
                        for (int j = 0; j < 8; ++j) { const bf16* vp = R2 + (size_t)(h * 130) * 4096 + (dc >> 1) * 2048 + (48 + jb + j) * 32 + 16 * (dc & 1); va[j] = ((const GAS v4u*)vp)[0]; vb[j] = ((const GAS v4u*)vp)[1]; }
#pragma unroll
                        for (int j = 0; j < 8; ++j) { const float p = __builtin_amdgcn_exp2f(sc[jb + j] - mrun); l += p;
#pragma unroll
                            for (int e = 0; e < 4; ++e) { o[2 * e] += p * bflo(va[j][e]); o[2 * e + 1] += p * bfhi(va[j][e]); o[8 + 2 * e] += p * bflo(vb[j][e]); o[8 + 2 * e + 1] += p * bfhi(vb[j][e]); } }
                    }
                    const float rl = 1.0f / l; v4u oa, ob;
#pragma unroll
                    for (int e = 0; e < 4; ++e) { oa[e] = pk2(o[2 * e] * rl, o[2 * e + 1] * rl); ob[e] = pk2(o[8 + 2 * e] * rl, o[8 + 2 * e + 1] * rl); }
                    GAS v4u* op = (GAS v4u*)(R0 + (size_t)(MMAIN + q) * DM + 64 * h + 16 * dc); op[0] = oa; op[1] = ob;
                }
            }
            { PHASE_ENV();
            xcd_barrier(bar, tid);
#ifdef PROBE_SEL
            if (tid == 0) { const unsigned long long tn = __builtin_amdgcn_s_memrealtime(); const int cat = (s == 1 || s == 9) ? 1 : (s == 2 || s == 10) ? 2 : (s == 4) ? 3 : (s == 5) ? 4 : (s == 6) ? 5 : 6;
              TS[cat] += tn - TS[9]; TS[9] = tn; }
#endif
            }
            }
        }
    }
#ifdef PROBE_SEL
    { PHASE_ENV(); if (bx == 0 && tid == 0) { const unsigned long long t0 = __builtin_amdgcn_s_memrealtime(), span = 4ull * TS[PROBE_SEL];
        while (__builtin_amdgcn_s_memrealtime() - t0 < span) __builtin_amdgcn_s_sleep(8); } }
#endif
}

extern "C" void kernel_launch(void* const* d_in, const int* in_sizes, int n_in, void* d_out, int out_size, void* d_ws, size_t ws_size, hipStream_t stream) {
    static int grid = 0;
    if (grid == 0) {
        if (n_in != 21 || out_size != MMAIN * DM || ws_size < WS_END + SZ_ROWBUF) { fprintf(stderr, "kernel_launch: unexpected shapes (n_in %d out %d ws %zu)\n", n_in, out_size, ws_size); grid = -1; return; }
        int dev = 0, cus = 0, per_cu = 0;
        hipGetDevice(&dev); hipDeviceGetAttribute(&cus, hipDeviceAttributeMultiprocessorCount, dev);
        if (hipFuncSetAttribute((const void*)fwd_megakernel, hipFuncAttributeMaxDynamicSharedMemorySize, LDS_BYTES) != hipSuccess) { fprintf(stderr, "kernel_launch: hipFuncSetAttribute failed\n"); grid = -1; return; }
        if (hipOccupancyMaxActiveBlocksPerMultiprocessor(&per_cu, (const void*)fwd_megakernel, NWAVES * 64, LDS_BYTES) != hipSuccess || per_cu < 1) { fprintf(stderr, "kernel_launch: occupancy query says %d\n", per_cu); per_cu = 1; }
        (void)hipGetLastError();
        grid = cus * 1;
        if (grid != 256) fprintf(stderr, "kernel_launch: grid %d (expected 256)\n", grid);
    }
    if (grid < 0) return;
    if (hipMemsetAsync((char*)d_ws + WS_CTL, 0, CTL_ZERO_BYTES, stream) != hipSuccess) { fprintf(stderr, "kernel_launch: hipMemsetAsync failed\n"); return; }
    Args a{};
    const float** f = (const float**)&a;
    for (int i = 0; i < 21; ++i) f[i] = (const float*)d_in[i];
    a.out = (float*)d_out; a.ws = (unsigned char*)d_ws;
    void* args[] = {&a};
    hipError_t e = hipLaunchCooperativeKernel((const void*)fwd_megakernel, dim3(grid), dim3(NWAVES * 64), args, LDS_BYTES, stream);
    if (e != hipSuccess) fprintf(stderr, "cooperative launch failed: %s (grid %d)\n", hipGetErrorString(e), grid);
}
```
